# Optimizing an MI355X kernel written in HIP

```python
import jax
import jax.numpy as jnp
from jax import lax
import numpy as np

D_MODEL = 1024
BATCH = 16
SEQ = 256
DEPTH = 4
DEC_BATCH = 4
DEC_SEQ = 2048
PAST_LEN = 256

GRID_W = 64
N_MIXERS = 3
N_POOL = len(range(0, DEPTH, N_MIXERS))
N_MLA = len(range(1, DEPTH, N_MIXERS))
N_NA = len(range(2, DEPTH, N_MIXERS))

POOL_WINDOWS = (2, 4, 8, 16)
POOL_GROUPS = len(POOL_WINDOWS)
POOL_GROUP_DIM = D_MODEL // POOL_GROUPS

MLA_HEADS = 8
QK_NOPE = 128
QK_ROPE = 64
V_HEAD = 128
Q_LORA = D_MODEL // 2
KV_LORA = D_MODEL // 4
MLA_WIDTH = MLA_HEADS * V_HEAD
MLA_SCALE = (QK_NOPE + QK_ROPE) ** -0.5

NA_HEADS = 16
NA_HEAD_DIM = 64
NA_WIDTH = NA_HEADS * NA_HEAD_DIM
NA_WIN_R = 8
NA_WIN_C = 16
NA_Q_COLS = 16
NA_K_COLS = 2 * NA_WIN_C
NA_SCALE = NA_HEAD_DIM ** -0.5

Q_BLOCK = 128
ROPE_BASE = 10000.0
LN_EPS = 1e-5
RMS_EPS = 1e-6
NEG_INF = -1e30
DEEPNORM_ALPHA = (2 * DEPTH) ** 0.25
DEEPNORM_BETA = (8 * DEPTH) ** -0.25

kernel_name = 'hybrid_diffusion_pool_mla_natten_step'


def layer_norm(x, g, b):
    xf = x.astype(jnp.float32)
    mu = jnp.mean(xf, -1, keepdims=True)
    var = jnp.mean(jnp.square(xf - mu), -1, keepdims=True)
    return ((xf - mu) * lax.rsqrt(var + LN_EPS) * g + b).astype(x.dtype)


def rms_norm(x, g):
    xf = x.astype(jnp.float32)
    return (xf * lax.rsqrt(jnp.mean(xf * xf, -1, keepdims=True) + RMS_EPS) * g).astype(x.dtype)


def adaln(cond, w, b):
    m = jax.nn.silu(cond) @ w + b
    return jnp.split(m[:, None, :], 3, axis=-1)


def axial_rope(x):
    L, dr = x.shape[1], x.shape[-1]
    nf = dr // 4
    inv = ROPE_BASE ** (-jnp.arange(nf, dtype=jnp.float32) / nf)
    t = jnp.arange(L)
    pos = jnp.stack([t // GRID_W, t % GRID_W], -1).astype(jnp.float32)
    ang = pos[:, :, None] * inv
    shape = (1, L) + (1,) * (x.ndim - 3) + (2, nf)
    cos = jnp.cos(ang).reshape(shape)
    sin = jnp.sin(ang).reshape(shape)
    xs = x.astype(jnp.float32).reshape(x.shape[:-1] + (2, 2 * nf))
    x1, x2 = jnp.split(xs, 2, axis=-1)
    out = jnp.concatenate([x1 * cos - x2 * sin, x1 * sin + x2 * cos], -1)
    return out.reshape(x.shape).astype(x.dtype)


def blocked_attention(q, k, v, scale):
    B, Lq, H, dk = q.shape
    nb = Lq // Q_BLOCK
    qb = q.reshape(B, nb, Q_BLOCK, H, dk).transpose(1, 0, 2, 3, 4)

    def one_block(qblk):
        s = jnp.einsum('bqhd,bkhd->bhqk', qblk, k).astype(jnp.float32) * scale
        p = jax.nn.softmax(s, axis=-1)
        return jnp.einsum('bhqk,bkhd->bqhd', p.astype(v.dtype), v)

    o = lax.map(one_block, qb)
    return o.transpose(1, 0, 2, 3, 4).reshape(B, Lq, H, v.shape[-1])


def pool_branch(h, w_in, w_grp, scale, w_out):
    u, z = jnp.split(h @ w_in, 2, axis=-1)
    B, L, _ = u.shape
    ug = u.reshape(B, L, POOL_GROUPS, POOL_GROUP_DIM).astype(jnp.float32)
    csum = jnp.concatenate([jnp.zeros_like(ug[:, :1]), jnp.cumsum(ug, axis=1)], axis=1)
    t = jnp.arange(L)[:, None]
    w = jnp.array(POOL_WINDOWS)[None, :]
    lo = jnp.clip(t - w // 2, 0, L)
    hi = jnp.clip(t + w - w // 2, 0, L)
    gi = jnp.arange(POOL_GROUPS)[None, :]
    win_sum = csum[:, hi, gi] - csum[:, lo, gi]
    cnt = (hi - lo).astype(jnp.float32)[None, :, :, None]
    mixed = (win_sum / cnt - ug).astype(h.dtype)
    mixed = jnp.einsum('blgc,gcd->blgd', mixed, w_grp).reshape(B, L, D_MODEL) * scale
    return (mixed * jax.nn.silu(z)) @ w_out


def mla_inputs(h, w_in, q_norm, w_uq, kv_norm):
    B, L, _ = h.shape
    cq, ckv, kr, z = jnp.split(h @ w_in, [Q_LORA, Q_LORA + KV_LORA, Q_LORA + KV_LORA + QK_ROPE], axis=-1)
    q = (rms_norm(cq, q_norm) @ w_uq).reshape(B, L, MLA_HEADS, QK_NOPE + QK_ROPE)
    return q, rms_norm(ckv, kv_norm), kr, z


def mla_keys_values(ckv, kr, w_ukv):
    B, L, _ = ckv.shape
    kv = (ckv @ w_ukv).reshape(B, L, MLA_HEADS, QK_NOPE + V_HEAD)
    k_nope, v = jnp.split(kv, [QK_NOPE], axis=-1)
    k = jnp.concatenate([k_nope, jnp.broadcast_to(kr[:, :, None, :], (B, L, MLA_HEADS, QK_ROPE))], axis=-1)
    return k, v


def mla_context(h, w_in, q_norm, w_uq, kv_norm, w_ukv, w_out):
    B, L, _ = h.shape
    q, ckv, kr, z = mla_inputs(h, w_in, q_norm, w_uq, kv_norm)
    k, v = mla_keys_values(ckv, kr, w_ukv)
    o = blocked_attention(q, k, v, MLA_SCALE)
    y = (o.reshape(B, L, MLA_WIDTH) * jax.nn.silu(z)) @ w_out
    return y, ckv, kr


def mla_latent(h, ckv_ctx, kr_ctx, w_in, q_norm, w_uq, kv_norm, w_ukv, w_out):
    B, L, _ = h.shape
    q, ckv, kr, z = mla_inputs(h, w_in, q_norm, w_uq, kv_norm)
    q = jnp.concatenate([q[..., :QK_NOPE], axial_rope(q[..., QK_NOPE:])], axis=-1)
    k_ctx, v_ctx = mla_keys_values(ckv_ctx, kr_ctx, w_ukv)
    k_lat, v_lat = mla_keys_values(ckv, axial_rope(kr), w_ukv)
    k = jnp.concatenate([k_ctx, k_lat], axis=1)
    v = jnp.concatenate([v_ctx, v_lat], axis=1)
    o = blocked_attention(q, k, v, MLA_SCALE)
    return (o.reshape(B, L, MLA_WIDTH) * jax.nn.silu(z)) @ w_out


def na_inputs(h, w_in):
    B, L, _ = h.shape
    q, k, v, z = jnp.split(h @ w_in, 4, axis=-1)
    shp = (B, L, NA_HEADS, NA_HEAD_DIM)
    return q.reshape(shp), k.reshape(shp), v.reshape(shp), z


def na_context(h, w_in, w_out):
    B, L, _ = h.shape
    q, k, v, z = na_inputs(h, w_in)
    o = blocked_attention(q, k, v, NA_SCALE)
    y = (o.reshape(B, L, NA_WIDTH) * jax.nn.silu(z)) @ w_out
    return y, k, v


def neighbourhood_attention(q, k, v, k_ctx, v_ctx, rpb):
    B, L, H, dh = q.shape
    rows = L // GRID_W
    kr = min(NA_WIN_R, rows)
    ncb = GRID_W // NA_Q_COLS
    qcols = np.arange(GRID_W).reshape(ncb, NA_Q_COLS)
    cstart = np.clip(qcols - NA_WIN_C // 2, 0, GRID_W - NA_WIN_C)
    bstart = np.clip(np.arange(ncb) * NA_Q_COLS - NA_WIN_C // 2, 0, GRID_W - NA_K_COLS)
    kcols = bstart[:, None] + np.arange(NA_K_COLS)
    col_valid = (kcols[:, None, :] >= cstart[:, :, None]) & (kcols[:, None, :] < cstart[:, :, None] + NA_WIN_C)
    dc_idx = np.clip(kcols[:, None, :] - qcols[:, :, None] + NA_WIN_C - 1, 0, 2 * NA_WIN_C - 2)
    qg = q.reshape(B, rows, GRID_W, H, dh).transpose(1, 0, 2, 3, 4)
    kg = k.reshape(B, rows, GRID_W, H, dh)
    vg = v.reshape(B, rows, GRID_W, H, dh)
    n_loc = kr * NA_K_COLS

    def row_block(args):
        r, q_r = args
        rs = jnp.clip(r - kr // 2, 0, rows - kr)
        kb = lax.dynamic_slice_in_dim(kg, rs, kr, axis=1)[:, :, kcols]
        vb = lax.dynamic_slice_in_dim(vg, rs, kr, axis=1)[:, :, kcols]
        qb = q_r.reshape(B, ncb, NA_Q_COLS, H, dh)
        s_loc = jnp.einsum('bjqhd,bajkhd->bhjqak', qb, kb).astype(jnp.float32) * NA_SCALE
        dr_idx = rs + jnp.arange(kr) - r + NA_WIN_R - 1
        bias = rpb[:, dr_idx[:, None, None, None], dc_idx[None]]
        s_loc = s_loc + bias.transpose(0, 2, 3, 1, 4)[None].astype(jnp.float32)
        s_loc = jnp.where(col_valid[None, None, :, :, None, :], s_loc, NEG_INF)
        s_loc = s_loc.reshape(B, H, ncb, NA_Q_COLS, n_loc)
        s_ctx = jnp.einsum('bjqhd,bchd->bhjqc', qb, k_ctx).astype(jnp.float32) * NA_SCALE
        p = jax.nn.softmax(jnp.concatenate([s_loc, s_ctx], axis=-1), axis=-1).astype(v.dtype)
        p_loc = p[..., :n_loc].reshape(B, H, ncb, NA_Q_COLS, kr, NA_K_COLS)
        o = jnp.einsum('bhjqak,bajkhd->bjqhd', p_loc, vb) + jnp.einsum('bhjqc,bchd->bjqhd', p[..., n_loc:], v_ctx)
        return o.reshape(B, GRID_W, H, dh)

    o = lax.map(row_block, (jnp.arange(rows), qg))
    return o.transpose(1, 0, 2, 3, 4).reshape(B, L, H * dh)


def na_latent(h, k_ctx, v_ctx, w_in, rpb, w_out):
    q, k, v, z = na_inputs(h, w_in)
    o = neighbourhood_attention(q, k, v, k_ctx, v_ctx, rpb)
    return (o * jax.nn.silu(z)) @ w_out


def setup_inputs(seed: int = 0) -> dict:
    key = jax.random.key(seed)
    ks = jax.random.split(key, 25)
    f32 = jnp.float32
    nrm = lambda k, shape, s=1.0: jax.random.normal(k, shape, f32) * s
    D = D_MODEL
    return {
        'x_prompt': nrm(ks[0], (BATCH, SEQ, D)),
        'x_sample': nrm(ks[1], (DEC_BATCH, DEC_SEQ, D)),
        'cache_mla_ckv': nrm(ks[2], (DEC_BATCH, N_MLA, PAST_LEN, KV_LORA)),
        'cache_mla_krope': nrm(ks[3], (DEC_BATCH, N_MLA, PAST_LEN, QK_ROPE)),
        'cache_na_k': nrm(ks[4], (DEC_BATCH, N_NA, PAST_LEN, NA_HEADS, NA_HEAD_DIM)),
        'cache_na_v': nrm(ks[5], (DEC_BATCH, N_NA, PAST_LEN, NA_HEADS, NA_HEAD_DIM)),
        'c': nrm(ks[6], (DEC_BATCH, D)),
        'c_ctx': nrm(ks[7], (D,)),
        'ada_w': nrm(ks[8], (DEPTH, D, 3 * D), 0.5 * D ** -0.5),
        'ada_b': nrm(ks[9], (DEPTH, 3 * D), 0.02),
        'ln_g': 1.0 + nrm(ks[10], (DEPTH, D), 0.02),
        'ln_b': nrm(ks[11], (DEPTH, D), 0.02),
        'pool_w_in': nrm(ks[12], (N_POOL, D, 2 * D), D ** -0.5),
        'pool_w_grp': nrm(ks[13], (N_POOL, POOL_GROUPS, POOL_GROUP_DIM, POOL_GROUP_DIM), POOL_GROUP_DIM ** -0.5),
        'pool_scale': 1.0 + nrm(ks[14], (N_POOL, D), 0.02),
        'pool_w_out': nrm(ks[15], (N_POOL, D, D), DEEPNORM_BETA * D ** -0.5),
        'mla_w_in': nrm(ks[16], (N_MLA, D, Q_LORA + KV_LORA + QK_ROPE + MLA_WIDTH), D ** -0.5),
        'mla_q_norm': 1.0 + nrm(ks[17], (N_MLA, Q_LORA), 0.02),
        'mla_w_uq': nrm(ks[18], (N_MLA, Q_LORA, MLA_HEADS * (QK_NOPE + QK_ROPE)), Q_LORA ** -0.5),
        'mla_kv_norm': 1.0 + nrm(ks[19], (N_MLA, KV_LORA), 0.02),
        'mla_w_ukv': nrm(ks[20], (N_MLA, KV_LORA, MLA_HEADS * (QK_NOPE + V_HEAD)), KV_LORA ** -0.5),
        'mla_w_out': nrm(ks[21], (N_MLA, MLA_WIDTH, D), DEEPNORM_BETA * MLA_WIDTH ** -0.5),
        'na_w_in': nrm(ks[22], (N_NA, D, 4 * NA_WIDTH), D ** -0.5),
        'na_rpb': nrm(ks[23], (N_NA, NA_HEADS, 2 * NA_WIN_R - 1, 2 * NA_WIN_C - 1), 0.1),
        'na_w_out': nrm(ks[24], (N_NA, NA_WIDTH, D), DEEPNORM_BETA * NA_WIDTH ** -0.5),
    }


def reference(x_prompt, x_sample, cache_mla_ckv, cache_mla_krope, cache_na_k, cache_na_v, c, c_ctx,
              ada_w, ada_b, ln_g, ln_b, pool_w_in, pool_w_grp, pool_scale, pool_w_out,
              mla_w_in, mla_q_norm, mla_w_uq, mla_kv_norm, mla_w_ukv, mla_w_out,
              na_w_in, na_rpb, na_w_out):
    yp = x_prompt
    ys = x_sample
    st_ckv, st_kr, st_k, st_v = [], [], [], []
    for i in range(DEPTH):
        kind, j = i % N_MIXERS, i // N_MIXERS
        sh_p, sc_p, g_p = adaln(c_ctx[None], ada_w[i], ada_b[i])
        sh_s, sc_s, g_s = adaln(c, ada_w[i], ada_b[i])
        hp = yp * (1.0 + sc_p) + sh_p
        hs = ys * (1.0 + sc_s) + sh_s
        if kind == 0:
            op = pool_branch(hp, pool_w_in[j], pool_w_grp[j], pool_scale[j], pool_w_out[j])
            os_ = pool_branch(hs, pool_w_in[j], pool_w_grp[j], pool_scale[j], pool_w_out[j])
        elif kind == 1:
            op, ckv, kr = mla_context(hp, mla_w_in[j], mla_q_norm[j], mla_w_uq[j], mla_kv_norm[j], mla_w_ukv[j], mla_w_out[j])
            st_ckv.append(ckv)
            st_kr.append(kr)
            os_ = mla_latent(hs, cache_mla_ckv[:, j], cache_mla_krope[:, j], mla_w_in[j], mla_q_norm[j],
                             mla_w_uq[j], mla_kv_norm[j], mla_w_ukv[j], mla_w_out[j])
        else:
            op, kc, vc = na_context(hp, na_w_in[j], na_w_out[j])
            st_k.append(kc)
            st_v.append(vc)
            os_ = na_latent(hs, cache_na_k[:, j], cache_na_v[:, j], na_w_in[j], na_rpb[j], na_w_out[j])
        yp = layer_norm(DEEPNORM_ALPHA * yp + g_p * op, ln_g[i], ln_b[i])
        ys = layer_norm(DEEPNORM_ALPHA * ys + g_s * os_, ln_g[i], ln_b[i])
    state_mla_ckv = jnp.stack(st_ckv, axis=1)
    state_mla_krope = jnp.stack(st_kr, axis=1)
    state_na_k = jnp.stack(st_k, axis=1)
    state_na_v = jnp.stack(st_v, axis=1)
    return (yp, ys, state_mla_ckv, state_mla_krope, state_na_k, state_na_v)
```

```cpp
#include <hip/hip_runtime.h>
#include <hip/hip_cooperative_groups.h>
#include <stdint.h>
#include <string.h>
#include <stdio.h>
namespace cg = cooperative_groups;

#ifndef MULTI_LAUNCH
#define MULTI_LAUNCH 1
#endif

typedef __attribute__((ext_vector_type(8))) short bf16x8;
typedef __attribute__((ext_vector_type(4))) float f32x4;
typedef __attribute__((ext_vector_type(16))) float f32x16;
typedef __attribute__((ext_vector_type(4))) uint32_t u32x4;
typedef unsigned short u16;
#define DI __device__ __forceinline__
#define MFMA32(a, b, c) __builtin_amdgcn_mfma_f32_32x32x16_bf16((a), (b), (c), 0, 0, 0)
#define MFMA16(a, b, c) __builtin_amdgcn_mfma_f32_16x16x32_bf16((a), (b), (c), 0, 0, 0)

constexpr int TC = 4096, TL = 8192, T = 12288;
constexpr int KVR = 4096 + 4 * 2304;
constexpr float LOG2E = 1.4426950408889634f;
constexpr float ALPHA = 1.681792830507429f;
constexpr float MLA_QS = 0.07216878364870323f * LOG2E;
constexpr float NA_QS = 0.125f * LOG2E;
constexpr int SMEM_BYTES = 73728;
constexpr int NPHASE = 22;

constexpr size_t OUT_YS = 4194304, OUT_CKV = 12582912, OUT_KR = 13631488, OUT_NAK = 13893632, OUT_NAV = 18087936;

struct MatDesc { const float* src; u16* dst; int K, Nsrc, Ndst, tile0; };

struct Params {
  const float *x_prompt, *x_sample, *cache_ckv, *cache_kr, *cache_nak, *cache_nav, *c, *c_ctx, *ada_w, *ada_b, *ln_g, *ln_b;
  const float *pool_scale, *mla_q_norm, *mla_kv_norm, *na_rpb;
  float* out;
  float* mod;
  u16 *H, *SZ;
  u16 *Wpin, *Wgrp, *Wpout, *Wmin, *Wuq, *Wukv, *Wmout, *Wnin, *Wnout;
  u16 *U, *MIX, *PM;
  float* RAW; u16 *AO, *CQN, *CKVN, *KR, *Q, *KN, *VT;
  u16 *NQ, *NK, *NVT, *NAO;
  unsigned* bar;
  MatDesc mats[18];
  int nmat_tiles; int pad0;
};

DI float bf2f(u16 v) { return __uint_as_float(((uint32_t)v) << 16); }
DI u16 f2bf(float x) { uint32_t u = __float_as_uint(x); u += 0x7fffu + ((u >> 16) & 1u); return (u16)(u >> 16); }
DI uint32_t pk2(float a, float b) { return (uint32_t)f2bf(a) | ((uint32_t)f2bf(b) << 16); }
DI float silu(float v) { return v / (1.f + __expf(-v)); }
DI int cond_of(int t) { return t < TC ? 0 : 1 + ((t - TC) >> 11); }
DI int kvrow_of(int t) { return t < TC ? t : TC + ((t - TC) >> 11) * 2304 + 256 + ((t - TC) & 2047); }
DI float wave_sum(float v) {
#pragma unroll
  for (int o = 32; o >= 1; o >>= 1) v += __shfl_xor(v, o);
  return v;
}

#define XB_TMO      128
#define XB_XCNT(j)  (256  + 64 * (j))
#define XB_XSUB(j)  (1280 + 64 * (j))
#define XB_XGEN(j)  (2304 + 64 * (j))
#define XB_TOP      3328
#define XB_TOPGEN   3392
#define XCD_BAR_WORDS 3456
#define XB_SPIN_CAP (1u << 22)
#define LAS __attribute__((address_space(3)))
DI unsigned xb_ld(unsigned* p) { return __hip_atomic_load(p, __ATOMIC_RELAXED, __HIP_MEMORY_SCOPE_AGENT); }
DI unsigned xb_add(unsigned* p, unsigned v) { return __hip_atomic_fetch_add(p, v, __ATOMIC_RELAXED, __HIP_MEMORY_SCOPE_AGENT); }
DI unsigned xb_xcc_id() { return (unsigned)__builtin_amdgcn_s_getreg((3 << 11) | 20) & 0xFu; }
#define XB_SPIN(cond, bar) do { unsigned _sp = 0; while (cond) { __builtin_amdgcn_s_sleep(1); \
    if ((++_sp & 255u) == 0u) { if (xb_ld(&(bar)[XB_TMO])) break; if (_sp > XB_SPIN_CAP) { atomicAdd(&(bar)[XB_TMO], 1u); break; } } } } while (0)
struct XcdBarrier { unsigned* bar; unsigned x; volatile LAS unsigned* st; };
DI XcdBarrier xcd_barrier_post(unsigned* bar, volatile LAS unsigned* st) {
  XcdBarrier b; b.bar = bar; b.x = xb_xcc_id(); b.st = st;
  if (threadIdx.x == 0) (void)xb_add(&bar[XB_XCNT(b.x)], 1u);
  return b;
}
DI void xcd_barrier_complete(unsigned* bar, unsigned x, unsigned& nloc, unsigned& nx) {
  const unsigned G = gridDim.x * gridDim.y * gridDim.z;
  unsigned sum, cnt, mine, sp = 0u;
  for (;;) {
    sum = 0u; cnt = 0u; mine = 0u;
#pragma unroll
    for (unsigned j = 0; j < 16; ++j) { const unsigned c = xb_ld(&bar[XB_XCNT(j)]); sum += c; cnt += (c > 0u) ? 1u : 0u; mine = (j == x) ? c : mine; }
    if (sum == G) break;
    __builtin_amdgcn_s_sleep(1);
    if ((++sp & 255u) == 0u) { if (xb_ld(&bar[XB_TMO])) break; if (sp > XB_SPIN_CAP) { atomicAdd(&bar[XB_TMO], 1u); break; } }
  }
  nloc = mine > 0u ? mine : 1u; nx = cnt > 0u ? cnt : 1u;
}
DI void xcd_barrier(const XcdBarrier& b) {
  asm volatile("s_waitcnt vmcnt(0)" ::: "memory");
  __syncthreads();
  if (threadIdx.x == 0) {
    unsigned* bar = b.bar;
    __builtin_amdgcn_s_waitcnt(0);
    unsigned nloc = b.st[0], nx = b.st[1];
    if (nloc == 0u) { xcd_barrier_complete(bar, b.x, nloc, nx); b.st[0] = nloc; b.st[1] = nx; }
    const unsigned old = xb_add(&bar[XB_XSUB(b.x)], 1u);
    const unsigned gen = old / nloc;
    if (old + 1u == (gen + 1u) * nloc) {
      __builtin_amdgcn_fence(__ATOMIC_RELEASE, "agent");
      asm volatile("s_waitcnt vmcnt(0)" ::: "memory");
      const unsigned og = xb_add(&bar[XB_TOP], 1u);
      const unsigned tg = og / nx;
      if (og + 1u == (tg + 1u) * nx) xb_add(&bar[XB_TOPGEN], 1u);
      else XB_SPIN(xb_ld(&bar[XB_TOPGEN]) == tg, bar);
      __builtin_amdgcn_fence(__ATOMIC_ACQUIRE, "agent");
      xb_add(&bar[XB_XGEN(b.x)], 1u);
      asm volatile("s_waitcnt vmcnt(0)" ::: "memory");
    } else {
      XB_SPIN(xb_ld(&bar[XB_XGEN(b.x)]) == gen, bar);
      __builtin_amdgcn_fence(__ATOMIC_ACQUIRE, "agent");
      asm volatile("s_waitcnt vmcnt(0)" ::: "memory");
    }
  }
  __syncthreads();
}

template <class Epi>
DI void gemm_tile(const u16* __restrict__ A, int lda, const u16* __restrict__ Bt, int ldb, int K, int m0, int n0, int nout_off,
                  char* smem, const Epi& epi) {
  const int tid = threadIdx.x, lane = tid & 63, wid = tid >> 6;
  const int wm = wid >> 1, wn = wid & 1, l31 = lane & 31, lh = lane >> 5;
  u16* As = (u16*)smem;
  u16* Bs = As + 2 * 128 * 72;
  const int srow = tid >> 3, scc = (tid & 7) * 8;
  const u16* ag = A + (size_t)(m0 + srow) * lda + scc;
  const u16* bg = Bt + (size_t)(n0 + srow) * ldb + scc;
  uint4 ra[4], rb[4];
  f32x16 acc[2][2];
#pragma unroll
  for (int i = 0; i < 2; i++)
#pragma unroll
    for (int j = 0; j < 2; j++)
#pragma unroll
      for (int r = 0; r < 16; r++) acc[i][j][r] = 0.f;
  __syncthreads();
#pragma unroll
  for (int i = 0; i < 4; i++) {
    ra[i] = *(const uint4*)(ag + (size_t)(32 * i) * lda);
    rb[i] = *(const uint4*)(bg + (size_t)(32 * i) * ldb);
  }
#pragma unroll
  for (int i = 0; i < 4; i++) {
    *(uint4*)(As + (srow + 32 * i) * 72 + scc) = ra[i];
    *(uint4*)(Bs + (srow + 32 * i) * 72 + scc) = rb[i];
  }
  __syncthreads();
  const int nk = K >> 6;
  for (int kt = 0; kt < nk; kt++) {
    const int buf = kt & 1;
    if (kt + 1 < nk) {
#pragma unroll
      for (int i = 0; i < 4; i++) {
        ra[i] = *(const uint4*)(ag + (size_t)(32 * i) * lda + (kt + 1) * 64);
        rb[i] = *(const uint4*)(bg + (size_t)(32 * i) * ldb + (kt + 1) * 64);
      }
    }
    const u16* as = As + buf * (128 * 72) + (wm * 64 + l31) * 72 + lh * 8;
    const u16* bs = Bs + buf * (128 * 72) + (wn * 64 + l31) * 72 + lh * 8;
#pragma unroll
    for (int ks = 0; ks < 4; ks++) {
      bf16x8 a0 = *(const bf16x8*)(as + ks * 16);
      bf16x8 a1 = *(const bf16x8*)(as + 32 * 72 + ks * 16);
      bf16x8 b0 = *(const bf16x8*)(bs + ks * 16);
      bf16x8 b1 = *(const bf16x8*)(bs + 32 * 72 + ks * 16);
      acc[0][0] = MFMA32(b0, a0, acc[0][0]);
      acc[0][1] = MFMA32(b1, a0, acc[0][1]);
      acc[1][0] = MFMA32(b0, a1, acc[1][0]);
      acc[1][1] = MFMA32(b1, a1, acc[1][1]);
    }
    if (kt + 1 < nk) {
      u16* aw = As + (buf ^ 1) * (128 * 72);
      u16* bw = Bs + (buf ^ 1) * (128 * 72);
#pragma unroll
      for (int i = 0; i < 4; i++) {
        *(uint4*)(aw + (srow + 32 * i) * 72 + scc) = ra[i];
        *(uint4*)(bw + (srow + 32 * i) * 72 + scc) = rb[i];
      }
    }
    __syncthreads();
  }
#pragma unroll
  for (int i = 0; i < 2; i++)
#pragma unroll
    for (int j = 0; j < 2; j++)
      epi(m0 + wm * 64 + i * 32 + l31, nout_off + n0 + wn * 64 + j * 32, lh, acc[i][j]);
}

DI void rope_pair(float x1, float x2, int i, float pos, float& o1, float& o2) {
  const float inv = exp2f(-(float)i * (13.287712379549449f / 16.f));
  const float ang = pos * inv;
  const float c = __cosf(ang), s = __sinf(ang);
  o1 = x1 * c - x2 * s;
  o2 = x1 * s + x2 * c;
}

struct EpiPoolG1 {
  u16 *U, *SZ;
  DI void operator()(int m, int nb, int lh, const f32x16& a) const {
#pragma unroll
    for (int g = 0; g < 4; g++) {
      const int n = nb + 8 * g + 4 * lh;
      if (nb < 1024) {
        uint2 v; v.x = pk2(a[4 * g], a[4 * g + 1]); v.y = pk2(a[4 * g + 2], a[4 * g + 3]);
        *(uint2*)(U + (size_t)m * 1024 + n) = v;
      } else {
        uint2 v; v.x = pk2(silu(a[4 * g]), silu(a[4 * g + 1])); v.y = pk2(silu(a[4 * g + 2]), silu(a[4 * g + 3]));
        *(uint2*)(SZ + (size_t)m * 1024 + n - 1024) = v;
      }
    }
  }
};
struct EpiPoolG2 {
  u16* PM; const u16* SZ; const float* scale;
  DI void operator()(int m, int nb, int lh, const f32x16& a) const {
#pragma unroll
    for (int g = 0; g < 4; g++) {
      const int n = nb + 8 * g + 4 * lh;
      const uint2 z = *(const uint2*)(SZ + (size_t)m * 1024 + n);
      const float4 sc = *(const float4*)(scale + n);
      uint2 v;
      v.x = pk2(a[4 * g] * sc.x * bf2f((u16)(z.x & 0xffff)), a[4 * g + 1] * sc.y * bf2f((u16)(z.x >> 16)));
      v.y = pk2(a[4 * g + 2] * sc.z * bf2f((u16)(z.y & 0xffff)), a[4 * g + 3] * sc.w * bf2f((u16)(z.y >> 16)));
      *(uint2*)(PM + (size_t)m * 1024 + n) = v;
    }
  }
};
struct EpiG3 {
  const float *xp, *xs;
  float* out; const float* mod_layer;
  DI void operator()(int m, int nb, int lh, const f32x16& a) const {
    const float* xr = (m < TC) ? xp + (size_t)m * 1024 : xs + (size_t)(m - TC) * 1024;
    const float* gate = mod_layer + cond_of(m) * 3072 + 2048;
#pragma unroll
    for (int g = 0; g < 4; g++) {
      const int n = nb + 8 * g + 4 * lh;
      const float4 x = *(const float4*)(xr + n);
      const float4 gt = *(const float4*)(gate + n);
      float4 r;
      r.x = ALPHA * x.x + gt.x * a[4 * g]; r.y = ALPHA * x.y + gt.y * a[4 * g + 1];
      r.z = ALPHA * x.z + gt.z * a[4 * g + 2]; r.w = ALPHA * x.w + gt.w * a[4 * g + 3];
      *(float4*)(out + (size_t)m * 1024 + n) = r;
    }
  }
};
struct EpiMlaG1 {
  float* RAW; u16* KR; u16* SZ; float* st_kr;
  DI void operator()(int m, int nb, int lh, const f32x16& a) const {
    if (nb >= 1856) return;
    if (nb < 768) {
#pragma unroll
      for (int g = 0; g < 4; g++) {
        const int n = nb + 8 * g + 4 * lh;
        float4 r; r.x = a[4 * g]; r.y = a[4 * g + 1]; r.z = a[4 * g + 2]; r.w = a[4 * g + 3];
        *(float4*)(RAW + (size_t)m * 768 + n) = r;
      }
    } else if (nb < 832) {
      const int off = nb - 768;
      const bool lat = m >= TC;
      const int tt = (m - TC) & 2047;
      const float pos = (off == 0) ? (float)(tt >> 6) : (float)(tt & 63);
      const size_t kr = (size_t)kvrow_of(m) * 64 + off;
#pragma unroll
      for (int g = 0; g < 2; g++) {
        float o1[4], o2[4];
#pragma unroll
        for (int e = 0; e < 4; e++) {
          const int i = 8 * g + 4 * lh + e;
          const float x1 = a[4 * g + e], x2 = a[4 * (g + 2) + e];
          if (lat) rope_pair(x1, x2, i, pos, o1[e], o2[e]); else { o1[e] = x1; o2[e] = x2; }
        }
        const int i0 = 8 * g + 4 * lh;
        if (!lat) {
          float4 r1; r1.x = o1[0]; r1.y = o1[1]; r1.z = o1[2]; r1.w = o1[3];
          float4 r2; r2.x = o2[0]; r2.y = o2[1]; r2.z = o2[2]; r2.w = o2[3];
          *(float4*)(st_kr + (size_t)m * 64 + off + i0) = r1;
          *(float4*)(st_kr + (size_t)m * 64 + off + i0 + 16) = r2;
        }
        uint2 v1; v1.x = pk2(o1[0], o1[1]); v1.y = pk2(o1[2], o1[3]);
        uint2 v2; v2.x = pk2(o2[0], o2[1]); v2.y = pk2(o2[2], o2[3]);
        *(uint2*)(KR + kr + i0) = v1;
        *(uint2*)(KR + kr + i0 + 16) = v2;
      }
    } else {
#pragma unroll
      for (int g = 0; g < 4; g++) {
        const int n = nb + 8 * g + 4 * lh - 832;
        uint2 v; v.x = pk2(silu(a[4 * g]), silu(a[4 * g + 1])); v.y = pk2(silu(a[4 * g + 2]), silu(a[4 * g + 3]));
        *(uint2*)(SZ + (size_t)m * 1024 + n) = v;
      }
    }
  }
};
struct EpiMlaQ {
  u16* Q;
  DI void operator()(int m, int nb, int lh, const f32x16& a) const {
    const int head = nb / 192, off = nb - head * 192;
    u16* qr = Q + (size_t)m * 1536 + nb;
    if (off < 128) {
#pragma unroll
      for (int g = 0; g < 4; g++) {
        uint2 v; v.x = pk2(a[4 * g] * MLA_QS, a[4 * g + 1] * MLA_QS); v.y = pk2(a[4 * g + 2] * MLA_QS, a[4 * g + 3] * MLA_QS);
        *(uint2*)(qr + 8 * g + 4 * lh) = v;
      }
    } else {
      const bool lat = m >= TC;
      const int tt = (m - TC) & 2047;
      const float pos = (off == 128) ? (float)(tt >> 6) : (float)(tt & 63);
#pragma unroll
      for (int g = 0; g < 2; g++) {
        float o1[4], o2[4];
#pragma unroll
        for (int e = 0; e < 4; e++) {
          const int i = 8 * g + 4 * lh + e;
          const float x1 = a[4 * g + e], x2 = a[4 * (g + 2) + e];
          if (lat) rope_pair(x1, x2, i, pos, o1[e], o2[e]); else { o1[e] = x1; o2[e] = x2; }
        }
        const int i0 = 8 * g + 4 * lh;
        uint2 v1; v1.x = pk2(o1[0] * MLA_QS, o1[1] * MLA_QS); v1.y = pk2(o1[2] * MLA_QS, o1[3] * MLA_QS);
        uint2 v2; v2.x = pk2(o2[0] * MLA_QS, o2[1] * MLA_QS); v2.y = pk2(o2[2] * MLA_QS, o2[3] * MLA_QS);
        *(uint2*)(qr + i0) = v1;
        *(uint2*)(qr + i0 + 16) = v2;
      }
    }
  }
};
struct EpiMlaKV {
  u16 *KN, *VT;
  DI void operator()(int m, int nb, int lh, const f32x16& a) const {
    const int head = nb >> 8, off = nb & 255;
    if (off < 128) {
#pragma unroll
      for (int g = 0; g < 4; g++) {
        uint2 v; v.x = pk2(a[4 * g], a[4 * g + 1]); v.y = pk2(a[4 * g + 2], a[4 * g + 3]);
        *(uint2*)(KN + (size_t)m * 1024 + head * 128 + off + 8 * g + 4 * lh) = v;
      }
    } else {
      size_t base; int Lk, key;
      if (m < TC) { base = (size_t)(m >> 8) * (8 * 128 * 256); Lk = 256; key = m & 255; }
      else { const int r2 = m - TC; const int b = r2 / 2304; key = r2 - b * 2304; Lk = 2304; base = (size_t)16 * 8 * 128 * 256 + (size_t)b * (8 * 128 * 2304); }
      u16* vp = VT + base + (size_t)(head * 128 + off - 128) * Lk + key;
#pragma unroll
      for (int g = 0; g < 4; g++)
#pragma unroll
        for (int e = 0; e < 4; e++) vp[(size_t)(8 * g + 4 * lh + e) * Lk] = f2bf(a[4 * g + e]);
    }
  }
};
struct EpiNaG1 {
  u16 *NQ, *NK, *NVT, *SZ; float *st_k, *st_v;
  DI void operator()(int m, int nb, int lh, const f32x16& a) const {
    if (nb < 1024) {
#pragma unroll
      for (int g = 0; g < 4; g++) {
        uint2 v; v.x = pk2(a[4 * g] * NA_QS, a[4 * g + 1] * NA_QS); v.y = pk2(a[4 * g + 2] * NA_QS, a[4 * g + 3] * NA_QS);
        *(uint2*)(NQ + (size_t)m * 1024 + nb + 8 * g + 4 * lh) = v;
      }
    } else if (nb < 2048) {
      const size_t kr = (size_t)kvrow_of(m) * 1024 + (nb - 1024);
#pragma unroll
      for (int g = 0; g < 4; g++) {
        uint2 v; v.x = pk2(a[4 * g], a[4 * g + 1]); v.y = pk2(a[4 * g + 2], a[4 * g + 3]);
        *(uint2*)(NK + kr + 8 * g + 4 * lh) = v;
        if (m < TC) { float4 r; r.x = a[4 * g]; r.y = a[4 * g + 1]; r.z = a[4 * g + 2]; r.w = a[4 * g + 3];
          *(float4*)(st_k + (size_t)m * 1024 + (nb - 1024) + 8 * g + 4 * lh) = r; }
      }
    } else if (nb < 3072) {
      const int c0 = nb - 2048;
      size_t base; int Lk, key;
      if (m < TC) { base = (size_t)(m >> 8) * (1024 * 256); Lk = 256; key = m & 255; }
      else { const int b = (m - TC) >> 11; key = 256 + ((m - TC) & 2047); Lk = 2304; base = (size_t)16 * 1024 * 256 + (size_t)b * (1024 * 2304); }
      u16* vp = NVT + base + (size_t)c0 * Lk + key;
#pragma unroll
      for (int g = 0; g < 4; g++) {
#pragma unroll
        for (int e = 0; e < 4; e++) vp[(size_t)(8 * g + 4 * lh + e) * Lk] = f2bf(a[4 * g + e]);
        if (m < TC) { float4 r; r.x = a[4 * g]; r.y = a[4 * g + 1]; r.z = a[4 * g + 2]; r.w = a[4 * g + 3];
          *(float4*)(st_v + (size_t)m * 1024 + c0 + 8 * g + 4 * lh) = r; }
      }
    } else {
#pragma unroll
      for (int g = 0; g < 4; g++) {
        uint2 v; v.x = pk2(silu(a[4 * g]), silu(a[4 * g + 1])); v.y = pk2(silu(a[4 * g + 2]), silu(a[4 * g + 3]));
        *(uint2*)(SZ + (size_t)m * 1024 + (nb - 3072) + 8 * g + 4 * lh) = v;
      }
    }
  }
};

template <int NSA, int NSB, int NDT>
DI void attn_dense_wave(const u16* __restrict__ qrow, const u16* __restrict__ kA, int kAstride, const u16* __restrict__ kB,
                        const u16* __restrict__ vt, int Lk, int nkeys, const u16* __restrict__ szrow, u16* __restrict__ orow) {
  const int lane = threadIdx.x & 63, l31 = lane & 31, lh = lane >> 5;
  bf16x8 qf[NSA + NSB];
#pragma unroll
  for (int s = 0; s < NSA + NSB; s++) qf[s] = *(const bf16x8*)(qrow + s * 16 + lh * 8);
  f32x16 o[NDT];
#pragma unroll
  for (int d = 0; d < NDT; d++)
#pragma unroll
    for (int r = 0; r < 16; r++) o[d][r] = 0.f;
  float m = -1e30f, l = 0.f;
  for (int k0 = 0; k0 < nkeys; k0 += 32) {
    f32x16 sa;
#pragma unroll
    for (int r = 0; r < 16; r++) sa[r] = 0.f;
    const u16* kp = kA + (size_t)(k0 + l31) * kAstride + lh * 8;
#pragma unroll
    for (int s = 0; s < NSA; s++) sa = MFMA32(*(const bf16x8*)(kp + s * 16), qf[s], sa);
    if (NSB > 0) {
      const u16* kp2 = kB + (size_t)(k0 + l31) * 64 + lh * 8;
#pragma unroll
      for (int s = 0; s < NSB; s++) sa = MFMA32(*(const bf16x8*)(kp2 + s * 16), qf[NSA + s], sa);
    }
    float mx = sa[0];
#pragma unroll
    for (int r = 1; r < 16; r++) mx = fmaxf(mx, sa[r]);
    mx = fmaxf(mx, __shfl_xor(mx, 32));
    const float mn = fmaxf(m, mx);
    const float alpha = exp2f(m - mn);
    m = mn;
    float ps = 0.f;
#pragma unroll
    for (int r = 0; r < 16; r++) { sa[r] = exp2f(sa[r] - mn); ps += sa[r]; }
    l = l * alpha + ps;
#pragma unroll
    for (int d = 0; d < NDT; d++)
#pragma unroll
      for (int r = 0; r < 16; r++) o[d][r] *= alpha;
#pragma unroll
    for (int sp = 0; sp < 2; sp++) {
      u32x4 pw;
      pw[0] = pk2(sa[8 * sp + 0], sa[8 * sp + 1]); pw[1] = pk2(sa[8 * sp + 2], sa[8 * sp + 3]);
      pw[2] = pk2(sa[8 * sp + 4], sa[8 * sp + 5]); pw[3] = pk2(sa[8 * sp + 6], sa[8 * sp + 7]);
      const bf16x8 pf = __builtin_bit_cast(bf16x8, pw);
#pragma unroll
      for (int d = 0; d < NDT; d++) {
        const u16* vp = vt + (size_t)(d * 32 + l31) * Lk + k0 + 16 * sp + 4 * lh;
        const uint2 lo = *(const uint2*)vp, hi = *(const uint2*)(vp + 8);
        u32x4 vw; vw[0] = lo.x; vw[1] = lo.y; vw[2] = hi.x; vw[3] = hi.y;
        o[d] = MFMA32(__builtin_bit_cast(bf16x8, vw), pf, o[d]);
      }
    }
  }
  l += __shfl_xor(l, 32);
  const float inv = 1.f / l;
#pragma unroll
  for (int d = 0; d < NDT; d++)
#pragma unroll
    for (int g = 0; g < 4; g++) {
      const int d0 = d * 32 + 8 * g + 4 * lh;
      const uint2 z = *(const uint2*)(szrow + d0);
      uint2 v;
      v.x = pk2(o[d][4 * g] * inv * bf2f((u16)(z.x & 0xffff)), o[d][4 * g + 1] * inv * bf2f((u16)(z.x >> 16)));
      v.y = pk2(o[d][4 * g + 2] * inv * bf2f((u16)(z.y & 0xffff)), o[d][4 * g + 3] * inv * bf2f((u16)(z.y >> 16)));
      *(uint2*)(orow + d0) = v;
    }
}

DI void attn_na_wave(const Params& p, int b, int h, int r, int j) {
  const int lane = threadIdx.x & 63, l15 = lane & 15, q4 = lane >> 4;
  const int t = TC + b * 2048 + r * 64 + j * 16 + l15;
  const u16* qrow = p.NQ + (size_t)t * 1024 + h * 64;
  const bf16x8 qf0 = *(const bf16x8*)(qrow + q4 * 8);
  const bf16x8 qf1 = *(const bf16x8*)(qrow + 32 + q4 * 8);
  const int rs = min(max(r - 4, 0), 24);
  const int bstart = min(max(j * 16 - 8, 0), 32);
  const int c = j * 16 + l15;
  const int cstart = min(max(c - 8, 0), 48);
  const u16* kb = p.NK + (size_t)(TC + b * 2304) * 1024 + h * 64;
  const u16* vb = p.NVT + (size_t)16 * 1024 * 256 + (size_t)b * (1024 * 2304) + (size_t)(h * 64) * 2304;
  const float* rp = p.na_rpb + h * 465;
  f32x4 o[4];
#pragma unroll
  for (int d = 0; d < 4; d++) { o[d][0] = 0.f; o[d][1] = 0.f; o[d][2] = 0.f; o[d][3] = 0.f; }
  float m = -1e30f, l = 0.f;
  for (int ch = 0; ch < 16; ch++) {
    const int key0 = ch < 8 ? ch * 32 : 256 + (rs + ch - 8) * 64 + bstart;
    f32x4 s0 = {0.f, 0.f, 0.f, 0.f}, s1 = {0.f, 0.f, 0.f, 0.f};
    const u16* kp = kb + (size_t)(key0 + l15) * 1024 + q4 * 8;
    s0 = MFMA16(*(const bf16x8*)(kp), qf0, s0);
    s0 = MFMA16(*(const bf16x8*)(kp + 32), qf1, s0);
    s1 = MFMA16(*(const bf16x8*)(kp + 16 * 1024), qf0, s1);
    s1 = MFMA16(*(const bf16x8*)(kp + 16 * 1024 + 32), qf1, s1);
    if (ch >= 8) {
      const int dr = rs + (ch - 8) - r + 7;
#pragma unroll
      for (int i = 0; i < 4; i++) {
        const int kc0 = bstart + q4 * 4 + i, kc1 = kc0 + 16;
        const bool v0 = (kc0 >= cstart) && (kc0 < cstart + 16);
        const bool v1 = (kc1 >= cstart) && (kc1 < cstart + 16);
        const int dc0 = min(max(kc0 - c + 15, 0), 30), dc1 = min(max(kc1 - c + 15, 0), 30);
        const float b0 = rp[dr * 31 + dc0] * LOG2E, b1 = rp[dr * 31 + dc1] * LOG2E;
        s0[i] = v0 ? s0[i] + b0 : -1e30f;
        s1[i] = v1 ? s1[i] + b1 : -1e30f;
      }
    }
    float mx = fmaxf(fmaxf(fmaxf(s0[0], s0[1]), fmaxf(s0[2], s0[3])), fmaxf(fmaxf(s1[0], s1[1]), fmaxf(s1[2], s1[3])));
    mx = fmaxf(mx, __shfl_xor(mx, 16));
    mx = fmaxf(mx, __shfl_xor(mx, 32));
    const float mn = fmaxf(m, mx);
    const float alpha = exp2f(m - mn);
    m = mn;
    float ps = 0.f;
#pragma unroll
    for (int i = 0; i < 4; i++) { s0[i] = exp2f(s0[i] - mn); s1[i] = exp2f(s1[i] - mn); ps += s0[i] + s1[i]; }
    l = l * alpha + ps;
    u32x4 pw; pw[0] = pk2(s0[0], s0[1]); pw[1] = pk2(s0[2], s0[3]); pw[2] = pk2(s1[0], s1[1]); pw[3] = pk2(s1[2], s1[3]);
    const bf16x8 pf = __builtin_bit_cast(bf16x8, pw);
#pragma unroll
    for (int d = 0; d < 4; d++) {
      o[d][0] *= alpha; o[d][1] *= alpha; o[d][2] *= alpha; o[d][3] *= alpha;
      const u16* vp = vb + (size_t)(d * 16 + l15) * 2304 + key0 + q4 * 4;
      const uint2 lo = *(const uint2*)vp, hi = *(const uint2*)(vp + 16);
      u32x4 vw; vw[0] = lo.x; vw[1] = lo.y; vw[2] = hi.x; vw[3] = hi.y;
      o[d] = MFMA16(__builtin_bit_cast(bf16x8, vw), pf, o[d]);
    }
  }
  l += __shfl_xor(l, 16);
  l += __shfl_xor(l, 32);
  const float inv = 1.f / l;
  const u16* szrow = p.SZ + (size_t)t * 1024 + h * 64;
  u16* orow = p.NAO + (size_t)t * 1024 + h * 64;
#pragma unroll
  for (int d = 0; d < 4; d++) {
    const int d0 = d * 16 + q4 * 4;
    const uint2 z = *(const uint2*)(szrow + d0);
    uint2 v;
    v.x = pk2(o[d][0] * inv * bf2f((u16)(z.x & 0xffff)), o[d][1] * inv * bf2f((u16)(z.x >> 16)));
    v.y = pk2(o[d][2] * inv * bf2f((u16)(z.y & 0xffff)), o[d][3] * inv * bf2f((u16)(z.y >> 16)));
    *(uint2*)(orow + d0) = v;
  }
}

DI void ph_prep(const Params& p, char* smem) {
  const int tid = threadIdx.x;
  const int ntr = p.nmat_tiles;
  const int ntot = ntr + 192;
  for (int tile = blockIdx.x; tile < ntot; tile += gridDim.x) {
    __syncthreads();
    if (tile < ntr) {
      int mi = 0;
      for (int i = 1; i < 18; i++) if (tile >= p.mats[i].tile0) mi = i;
      const float* src = p.mats[mi].src; u16* dst = p.mats[mi].dst;
      const int K = p.mats[mi].K, Nsrc = p.mats[mi].Nsrc, Ndst = p.mats[mi].Ndst;
      const int lt = tile - p.mats[mi].tile0;
      const int ntn = Ndst >> 6;
      const int kt = lt / ntn, nt = lt - kt * ntn;
      float* ts = (float*)smem;
#pragma unroll
      for (int i = 0; i < 4; i++) {
        const int k = i * 16 + (tid >> 4), n4 = (tid & 15) * 4, n = nt * 64 + n4;
        float4 v = {0.f, 0.f, 0.f, 0.f};
        if (n < Nsrc) v = *(const float4*)(src + (size_t)(kt * 64 + k) * Nsrc + n);
        ts[k * 65 + n4] = v.x; ts[k * 65 + n4 + 1] = v.y; ts[k * 65 + n4 + 2] = v.z; ts[k * 65 + n4 + 3] = v.w;
      }
      __syncthreads();
      const int n = tid >> 2, kc = (tid & 3) * 16;
      uint32_t w[8];
#pragma unroll
      for (int e = 0; e < 8; e++) w[e] = pk2(ts[(kc + 2 * e) * 65 + n], ts[(kc + 2 * e + 1) * 65 + n]);
      u16* dp = dst + (size_t)(nt * 64 + n) * K + kt * 64 + kc;
      uint4 v0; v0.x = w[0]; v0.y = w[1]; v0.z = w[2]; v0.w = w[3];
      uint4 v1; v1.x = w[4]; v1.y = w[5]; v1.z = w[6]; v1.w = w[7];
      *(uint4*)dp = v0; *(uint4*)(dp + 8) = v1;
    } else {
      const int at = tile - ntr;
      const int layer = at / 48, c0 = (at - layer * 48) * 64;
      float* sc = (float*)smem;
      float* red = sc + 5 * 1024;
      for (int i = tid; i < 5 * 1024; i += 256) {
        const int n = i >> 10, k = i & 1023;
        const float v = (n == 0) ? p.c_ctx[k] : p.c[(n - 1) * 1024 + k];
        sc[i] = silu(v);
      }
      __syncthreads();
      const int c4 = (tid & 15) * 4, kg = tid >> 4;
      float acc[5][4];
#pragma unroll
      for (int n = 0; n < 5; n++) { acc[n][0] = 0.f; acc[n][1] = 0.f; acc[n][2] = 0.f; acc[n][3] = 0.f; }
      const float* w = p.ada_w + (size_t)layer * 1024 * 3072 + c0 + c4;
#pragma unroll 4
      for (int kk = 0; kk < 64; kk++) {
        const int k = kg * 64 + kk;
        const float4 wv = *(const float4*)(w + (size_t)k * 3072);
#pragma unroll
        for (int n = 0; n < 5; n++) {
          const float s = sc[n * 1024 + k];
          acc[n][0] += s * wv.x; acc[n][1] += s * wv.y; acc[n][2] += s * wv.z; acc[n][3] += s * wv.w;
        }
      }
#pragma unroll
      for (int n = 0; n < 5; n++) {
        float4 r; r.x = acc[n][0]; r.y = acc[n][1]; r.z = acc[n][2]; r.w = acc[n][3];
        *(float4*)(red + (kg * 5 + n) * 64 + c4) = r;
      }
      __syncthreads();
      for (int o = tid; o < 320; o += 256) {
        const int n = o >> 6, cc = o & 63;
        float s = 0.f;
#pragma unroll
        for (int g = 0; g < 16; g++) s += red[(g * 5 + n) * 64 + cc];
        s += p.ada_b[layer * 3072 + c0 + cc];
        p.mod[(layer * 5 + n) * 3072 + c0 + cc] = s;
      }
    }
  }
}

DI void ph_h0(const Params& p) {
  for (int idx = blockIdx.x * 256 + threadIdx.x; idx < T * 128; idx += gridDim.x * 256) {
    const int t = idx >> 7, c0 = (idx & 127) * 8;
    const float* xr = (t < TC) ? p.x_prompt + (size_t)t * 1024 : p.x_sample + (size_t)(t - TC) * 1024;
    const float* md = p.mod + cond_of(t) * 3072;
    const float4 x0 = *(const float4*)(xr + c0), x1 = *(const float4*)(xr + c0 + 4);
    const float4 sh0 = *(const float4*)(md + c0), sh1 = *(const float4*)(md + c0 + 4);
    const float4 sc0 = *(const float4*)(md + 1024 + c0), sc1 = *(const float4*)(md + 1024 + c0 + 4);
    uint4 v;
    v.x = pk2(x0.x * (1.f + sc0.x) + sh0.x, x0.y * (1.f + sc0.y) + sh0.y);
    v.y = pk2(x0.z * (1.f + sc0.z) + sh0.z, x0.w * (1.f + sc0.w) + sh0.w);
    v.z = pk2(x1.x * (1.f + sc1.x) + sh1.x, x1.y * (1.f + sc1.y) + sh1.y);
    v.w = pk2(x1.z * (1.f + sc1.z) + sh1.z, x1.w * (1.f + sc1.w) + sh1.w);
    *(uint4*)(p.H + (size_t)t * 1024 + c0) = v;
  }
}

template <class Epi>
DI void gemm_phase(const u16* A, int lda, const u16* Bt, int ldb, int K, int MT, int NT, char* smem, const Epi& epi) {
  const int ntile = MT * NT;
  for (int tile = blockIdx.x; tile < ntile; tile += gridDim.x) {
    const int nt = tile / MT, mt = tile - nt * MT;
    gemm_tile(A, lda, Bt, ldb, K, mt * 128, nt * 128, 0, smem, epi);
  }
}

DI void ph_mix(const Params& p) {
  for (int idx = blockIdx.x * 256 + threadIdx.x; idx < T * 128; idx += gridDim.x * 256) {
    const int t = idx >> 7, c0 = (idx & 127) * 8;
    const int g = c0 >> 8;
    const int hw = 1 << g;
    int s0, L, tt;
    if (t < TC) { s0 = t & ~255; tt = t & 255; L = 256; } else { s0 = TC + ((t - TC) & ~2047); tt = (t - TC) & 2047; L = 2048; }
    const int lo = max(tt - hw, 0), hi = min(tt + hw, L);
    float acc[8];
#pragma unroll
    for (int e = 0; e < 8; e++) acc[e] = 0.f;
    for (int s = lo; s < hi; s++) {
      const uint4 u = *(const uint4*)(p.U + (size_t)(s0 + s) * 1024 + c0);
      acc[0] += bf2f((u16)(u.x & 0xffff)); acc[1] += bf2f((u16)(u.x >> 16));
      acc[2] += bf2f((u16)(u.y & 0xffff)); acc[3] += bf2f((u16)(u.y >> 16));
      acc[4] += bf2f((u16)(u.z & 0xffff)); acc[5] += bf2f((u16)(u.z >> 16));
      acc[6] += bf2f((u16)(u.w & 0xffff)); acc[7] += bf2f((u16)(u.w >> 16));
    }
    const float ic = 1.f / (float)(hi - lo);
    const uint4 u = *(const uint4*)(p.U + (size_t)t * 1024 + c0);
    uint4 v;
    v.x = pk2(acc[0] * ic - bf2f((u16)(u.x & 0xffff)), acc[1] * ic - bf2f((u16)(u.x >> 16)));
    v.y = pk2(acc[2] * ic - bf2f((u16)(u.y & 0xffff)), acc[3] * ic - bf2f((u16)(u.y >> 16)));
    v.z = pk2(acc[4] * ic - bf2f((u16)(u.z & 0xffff)), acc[5] * ic - bf2f((u16)(u.z >> 16)));
    v.w = pk2(acc[6] * ic - bf2f((u16)(u.w & 0xffff)), acc[7] * ic - bf2f((u16)(u.w >> 16)));
    *(uint4*)(p.MIX + (size_t)t * 1024 + c0) = v;
  }
}

DI void ph_pool_g2(const Params& p, int j, char* smem) {
  EpiPoolG2 epi{p.PM, p.SZ, p.pool_scale + j * 1024};
  for (int tile = blockIdx.x; tile < 96 * 8; tile += gridDim.x) {
    const int gn = tile / 96, mt = tile - gn * 96;
    const int g = gn >> 1, ns = gn & 1;
    gemm_tile(p.MIX + g * 256, 1024, p.Wgrp + (size_t)(j * 4 + g) * 65536, 256, 256, mt * 128, ns * 128, g * 256, smem, epi);
  }
}

DI void ph_ln(const Params& p, int layer) {
  const int lane = threadIdx.x & 63, wid = threadIdx.x >> 6;
  const float* g = p.ln_g + layer * 1024;
  const float* bb = p.ln_b + layer * 1024;
  for (int row = blockIdx.x * 4 + wid; row < T; row += gridDim.x * 4) {
    float* xr = p.out + (size_t)row * 1024;
    float4 v[4];
    float s = 0.f;
#pragma unroll
    for (int i = 0; i < 4; i++) { v[i] = *(const float4*)(xr + i * 256 + lane * 4); s += v[i].x + v[i].y + v[i].z + v[i].w; }
    const float mu = wave_sum(s) * (1.f / 1024.f);
    float q = 0.f;
#pragma unroll
    for (int i = 0; i < 4; i++) {
      v[i].x -= mu; v[i].y -= mu; v[i].z -= mu; v[i].w -= mu;
      q += v[i].x * v[i].x + v[i].y * v[i].y + v[i].z * v[i].z + v[i].w * v[i].w;
    }
    const float rstd = rsqrtf(wave_sum(q) * (1.f / 1024.f) + 1e-5f);
    const float* md = p.mod + ((layer + 1) * 5 + cond_of(row)) * 3072;
#pragma unroll
    for (int i = 0; i < 4; i++) {
      const int cc = i * 256 + lane * 4;
      const float4 gg = *(const float4*)(g + cc), be = *(const float4*)(bb + cc);
      float4 y;
      y.x = v[i].x * rstd * gg.x + be.x; y.y = v[i].y * rstd * gg.y + be.y;
      y.z = v[i].z * rstd * gg.z + be.z; y.w = v[i].w * rstd * gg.w + be.w;
      *(float4*)(xr + cc) = y;
      if (layer < 3) {
        const float4 sh = *(const float4*)(md + cc), sc = *(const float4*)(md + 1024 + cc);
        uint2 h;
        h.x = pk2(y.x * (1.f + sc.x) + sh.x, y.y * (1.f + sc.y) + sh.y);
        h.y = pk2(y.z * (1.f + sc.z) + sh.z, y.w * (1.f + sc.w) + sh.w);
        *(uint2*)(p.H + (size_t)row * 1024 + cc) = h;
      }
    }
  }
}

DI void ph_mla_norm(const Params& p) {
  const int lane = threadIdx.x & 63, wid = threadIdx.x >> 6;
  for (int row = blockIdx.x * 4 + wid; row < T + 1024; row += gridDim.x * 4) {
    if (row < T) {
      const float* rr = p.RAW + (size_t)row * 768;
      const float4 a0 = *(const float4*)(rr + lane * 8), a1 = *(const float4*)(rr + lane * 8 + 4);
      const float4 k0 = *(const float4*)(rr + 512 + lane * 4);
      float s1 = a0.x * a0.x + a0.y * a0.y + a0.z * a0.z + a0.w * a0.w + a1.x * a1.x + a1.y * a1.y + a1.z * a1.z + a1.w * a1.w;
      float s2 = k0.x * k0.x + k0.y * k0.y + k0.z * k0.z + k0.w * k0.w;
      const float r1 = rsqrtf(wave_sum(s1) * (1.f / 512.f) + 1e-6f);
      const float r2 = rsqrtf(wave_sum(s2) * (1.f / 256.f) + 1e-6f);
      const float4 g0 = *(const float4*)(p.mla_q_norm + lane * 8), g1 = *(const float4*)(p.mla_q_norm + lane * 8 + 4);
      uint4 v;
      v.x = pk2(a0.x * r1 * g0.x, a0.y * r1 * g0.y); v.y = pk2(a0.z * r1 * g0.z, a0.w * r1 * g0.w);
      v.z = pk2(a1.x * r1 * g1.x, a1.y * r1 * g1.y); v.w = pk2(a1.z * r1 * g1.z, a1.w * r1 * g1.w);
      *(uint4*)(p.CQN + (size_t)row * 512 + lane * 8) = v;
      const float4 kg = *(const float4*)(p.mla_kv_norm + lane * 4);
      float4 kn; kn.x = k0.x * r2 * kg.x; kn.y = k0.y * r2 * kg.y; kn.z = k0.z * r2 * kg.z; kn.w = k0.w * r2 * kg.w;
      uint2 kv; kv.x = pk2(kn.x, kn.y); kv.y = pk2(kn.z, kn.w);
      *(uint2*)(p.CKVN + (size_t)kvrow_of(row) * 256 + lane * 4) = kv;
      if (row < TC) *(float4*)(p.out + OUT_CKV + (size_t)row * 256 + lane * 4) = kn;
    } else {
      const int cr = row - T, b = cr >> 8, pp = cr & 255;
      const size_t kvr = (size_t)TC + b * 2304 + pp;
      const float4 k0 = *(const float4*)(p.cache_ckv + (size_t)cr * 256 + lane * 4);
      uint2 kv; kv.x = pk2(k0.x, k0.y); kv.y = pk2(k0.z, k0.w);
      *(uint2*)(p.CKVN + kvr * 256 + lane * 4) = kv;
      p.KR[kvr * 64 + lane] = f2bf(p.cache_kr[(size_t)cr * 64 + lane]);
    }
  }
}

DI void ph_mla_g2(const Params& p, char* smem) {
  EpiMlaQ eq{p.Q};
  EpiMlaKV ekv{p.KN, p.VT};
  const int n1 = 96 * 12, n2 = 104 * 16;
  for (int tile = blockIdx.x; tile < n1 + n2; tile += gridDim.x) {
    if (tile < n1) {
      const int nt = tile / 96, mt = tile - nt * 96;
      gemm_tile(p.CQN, 512, p.Wuq, 512, 512, mt * 128, nt * 128, 0, smem, eq);
    } else {
      const int t2 = tile - n1;
      const int nt = t2 / 104, mt = t2 - nt * 104;
      gemm_tile(p.CKVN, 256, p.Wukv, 256, 256, mt * 128, nt * 128, 0, smem, ekv);
    }
  }
}

DI void ph_mla_attn(const Params& p) {
  const int wid = threadIdx.x >> 6, l31 = threadIdx.x & 31;
  for (int u = blockIdx.x; u < 768; u += gridDim.x) {
    int t0, kvrow0, nkeys, Lk, h; size_t vbase;
    if (u < 512) {
      const int b = u >> 7, rem = u & 127; h = rem >> 4; const int qb = rem & 15;
      t0 = TC + b * 2048 + qb * 128 + wid * 32; kvrow0 = TC + b * 2304; nkeys = 2304; Lk = 2304;
      vbase = (size_t)16 * 8 * 128 * 256 + (size_t)b * (8 * 128 * 2304) + (size_t)h * 128 * 2304;
    } else {
      const int v = u - 512; const int b = v >> 4; h = (v >> 1) & 7; const int qb = v & 1;
      t0 = b * 256 + qb * 128 + wid * 32; kvrow0 = b * 256; nkeys = 256; Lk = 256;
      vbase = (size_t)b * (8 * 128 * 256) + (size_t)h * 128 * 256;
    }
    const int t = t0 + l31;
    attn_dense_wave<8, 4, 4>(p.Q + (size_t)t * 1536 + h * 192, p.KN + (size_t)kvrow0 * 1024 + h * 128, 1024,
                             p.KR + (size_t)kvrow0 * 64, p.VT + vbase, Lk, nkeys,
                             p.SZ + (size_t)t * 1024 + h * 128, p.AO + (size_t)t * 1024 + h * 128);
  }
}

DI void ph_na_g1(const Params& p, char* smem) {
  EpiNaG1 epi{p.NQ, p.NK, p.NVT, p.SZ, p.out + OUT_NAK, p.out + OUT_NAV};
  const int n1 = 96 * 32;
  for (int tile = blockIdx.x; tile < n1 + 64; tile += gridDim.x) {
    if (tile < n1) {
      const int nt = tile / 96, mt = tile - nt * 96;
      gemm_tile(p.H, 1024, p.Wnin, 1024, 1024, mt * 128, nt * 128, 0, smem, epi);
    } else {
      const int ct = tile - n1;
      const int b = ct >> 4, p0 = (ct & 15) * 16;
      const int c4 = threadIdx.x * 4;
      const size_t kvb = (size_t)TC + b * 2304;
      u16* vtb = p.NVT + (size_t)16 * 1024 * 256 + (size_t)b * (1024 * 2304);
      float vv[4][16];
#pragma unroll
      for (int i = 0; i < 16; i++) {
        const size_t src = ((size_t)(b * 256 + p0 + i)) * 1024 + c4;
        const float4 k = *(const float4*)(p.cache_nak + src);
        uint2 kv; kv.x = pk2(k.x, k.y); kv.y = pk2(k.z, k.w);
        *(uint2*)(p.NK + (kvb + p0 + i) * 1024 + c4) = kv;
        const float4 v = *(const float4*)(p.cache_nav + src);
        vv[0][i] = v.x; vv[1][i] = v.y; vv[2][i] = v.z; vv[3][i] = v.w;
      }
#pragma unroll
      for (int e = 0; e < 4; e++) {
        uint4 w0, w1;
        w0.x = pk2(vv[e][0], vv[e][1]); w0.y = pk2(vv[e][2], vv[e][3]); w0.z = pk2(vv[e][4], vv[e][5]); w0.w = pk2(vv[e][6], vv[e][7]);
        w1.x = pk2(vv[e][8], vv[e][9]); w1.y = pk2(vv[e][10], vv[e][11]); w1.z = pk2(vv[e][12], vv[e][13]); w1.w = pk2(vv[e][14], vv[e][15]);
        u16* dp = vtb + (size_t)(c4 + e) * 2304 + p0;
        *(uint4*)dp = w0; *(uint4*)(dp + 8) = w1;
      }
    }
  }
}

DI void ph_na_attn(const Params& p) {
  const int wid = threadIdx.x >> 6, l31 = threadIdx.x & 31;
  for (int u = blockIdx.x; u < 512 + 2048; u += gridDim.x) {
    if (u < 512) {
      const int b = u >> 5, h = (u >> 1) & 15, qb = u & 1;
      const int t = b * 256 + qb * 128 + wid * 32 + l31;
      attn_dense_wave<4, 0, 2>(p.NQ + (size_t)t * 1024 + h * 64, p.NK + (size_t)(b * 256) * 1024 + h * 64, 1024, nullptr,
                               p.NVT + (size_t)b * (1024 * 256) + (size_t)h * 64 * 256, 256, 256,
                               p.SZ + (size_t)t * 1024 + h * 64, p.NAO + (size_t)t * 1024 + h * 64);
    } else {
      const int v = u - 512;
      const int b = v >> 9, h = (v >> 5) & 15, r = v & 31;
      attn_na_wave(p, b, h, r, wid);
    }
  }
}

template <int ph>
DI void run_phase(const Params& p, char* smem) {
  if constexpr (ph == 0) ph_prep(p, smem);
  else if constexpr (ph == 1) ph_h0(p);
  else if constexpr (ph == 2 || ph == 17) {
    constexpr int j = (ph == 2) ? 0 : 1;
    EpiPoolG1 e{p.U, p.SZ};
    gemm_phase(p.H, 1024, p.Wpin + (size_t)j * 2048 * 1024, 1024, 1024, 96, 16, smem, e);
  }
  else if constexpr (ph == 3 || ph == 18) ph_mix(p);
  else if constexpr (ph == 4 || ph == 19) ph_pool_g2(p, (ph == 4) ? 0 : 1, smem);
  else if constexpr (ph == 5) {
    EpiG3 e{p.x_prompt, p.x_sample, p.out, p.mod};
    gemm_phase(p.PM, 1024, p.Wpout, 1024, 1024, 96, 8, smem, e);
  }
  else if constexpr (ph == 20) {
    EpiG3 e{p.out, p.out + OUT_YS, p.out, p.mod + 3 * 5 * 3072};
    gemm_phase(p.PM, 1024, p.Wpout + (size_t)1024 * 1024, 1024, 1024, 96, 8, smem, e);
  }
  else if constexpr (ph == 6) ph_ln(p, 0);
  else if constexpr (ph == 21) ph_ln(p, 3);
  else if constexpr (ph == 7) {
    EpiMlaG1 e{p.RAW, p.KR, p.SZ, p.out + OUT_KR};
    gemm_phase(p.H, 1024, p.Wmin, 1024, 1024, 96, 15, smem, e);
  }
  else if constexpr (ph == 8) ph_mla_norm(p);
  else if constexpr (ph == 9) ph_mla_g2(p, smem);
  else if constexpr (ph == 10) ph_mla_attn(p);
  else if constexpr (ph == 11) {
    EpiG3 e{p.out, p.out + OUT_YS, p.out, p.mod + 1 * 5 * 3072};
    gemm_phase(p.AO, 1024, p.Wmout, 1024, 1024, 96, 8, smem, e);
  }
  else if constexpr (ph == 12) ph_ln(p, 1);
  else if constexpr (ph == 13) ph_na_g1(p, smem);
  else if constexpr (ph == 14) ph_na_attn(p);
  else if constexpr (ph == 15) {
    EpiG3 e{p.out, p.out + OUT_YS, p.out, p.mod + 2 * 5 * 3072};
    gemm_phase(p.NAO, 1024, p.Wnout, 1024, 1024, 96, 8, smem, e);
  }
  else if constexpr (ph == 16) ph_ln(p, 2);
}

#define RUN_PH(n) if (ph_lo <= (n) && (n) < ph_hi) { run_phase<n>(p, smem); if ((n) + 1 < ph_hi) xcd_barrier(xb); }

__global__ void __launch_bounds__(256, 2) mega(Params p, int ph_lo, int ph_hi) {
  __shared__ __attribute__((aligned(16))) char smem[SMEM_BYTES + 16];
  if (ph_lo < 0) { cg::this_grid().sync(); return; }
  const bool multi = (ph_hi - ph_lo) > 1;
  XcdBarrier xb; xb.bar = p.bar; xb.x = 0; xb.st = (volatile LAS unsigned*)(smem + SMEM_BYTES);
  if (multi) {
    if (threadIdx.x == 0) { *(uint4*)(smem + SMEM_BYTES) = make_uint4(0u, 0u, 0u, 0u); }
    __syncthreads();
    xb = xcd_barrier_post(p.bar, (volatile LAS unsigned*)(smem + SMEM_BYTES));
  }
  RUN_PH(0) RUN_PH(1) RUN_PH(2) RUN_PH(3) RUN_PH(4) RUN_PH(5) RUN_PH(6) RUN_PH(7) RUN_PH(8) RUN_PH(9) RUN_PH(10)
  RUN_PH(11) RUN_PH(12) RUN_PH(13) RUN_PH(14) RUN_PH(15) RUN_PH(16) RUN_PH(17) RUN_PH(18) RUN_PH(19) RUN_PH(20) RUN_PH(21)
}

extern "C" void kernel_launch(void* const* d_in, const int* in_sizes, int n_in, void* d_out, int out_size, void* d_ws, size_t ws_size,
                              hipStream_t stream) {
  Params p;
  memset(&p, 0, sizeof(p));
  const float* const* in = (const float* const*)d_in;
  p.x_prompt = in[0]; p.x_sample = in[1]; p.cache_ckv = in[2]; p.cache_kr = in[3]; p.cache_nak = in[4]; p.cache_nav = in[5];
  p.c = in[6]; p.c_ctx = in[7]; p.ada_w = in[8]; p.ada_b = in[9]; p.ln_g = in[10]; p.ln_b = in[11];
  const float* pool_w_in = in[12]; const float* pool_w_grp = in[13]; p.pool_scale = in[14]; const float* pool_w_out = in[15];
  const float* mla_w_in = in[16]; p.mla_q_norm = in[17]; const float* mla_w_uq = in[18]; p.mla_kv_norm = in[19];
  const float* mla_w_ukv = in[20]; const float* mla_w_out = in[21]; const float* na_w_in = in[22]; p.na_rpb = in[23];
  const float* na_w_out = in[24];
  p.out = (float*)d_out;

  char* ws = (char*)d_ws;
  size_t off = 0;
  auto take = [&](size_t bytes) { char* r = ws + off; off += (bytes + 255) & ~(size_t)255; return r; };
  p.bar = (unsigned*)take(XCD_BAR_WORDS * 4);
  p.mod = (float*)take((size_t)4 * 5 * 3072 * 4);
  p.Wpin = (u16*)take((size_t)2 * 2048 * 1024 * 2);
  p.Wgrp = (u16*)take((size_t)8 * 65536 * 2);
  p.Wpout = (u16*)take((size_t)2 * 1024 * 1024 * 2);
  p.Wmin = (u16*)take((size_t)1920 * 1024 * 2);
  p.Wuq = (u16*)take((size_t)1536 * 512 * 2);
  p.Wukv = (u16*)take((size_t)2048 * 256 * 2);
  p.Wmout = (u16*)take((size_t)1024 * 1024 * 2);
  p.Wnin = (u16*)take((size_t)4096 * 1024 * 2);
  p.Wnout = (u16*)take((size_t)1024 * 1024 * 2);
  p.H = (u16*)take((size_t)T * 1024 * 2);
  p.SZ = (u16*)take((size_t)T * 1024 * 2);
  const size_t arena0 = off;
  p.U = (u16*)take((size_t)T * 1024 * 2);
  p.MIX = (u16*)take((size_t)T * 1024 * 2);
  p.PM = (u16*)take((size_t)T * 1024 * 2);
  off = arena0;
  p.RAW = (float*)take((size_t)T * 768 * 4);
  p.AO = (u16*)p.RAW;
  p.CQN = (u16*)take((size_t)T * 512 * 2);
  p.CKVN = (u16*)take((size_t)KVR * 256 * 2);
  p.KR = (u16*)take((size_t)KVR * 64 * 2);
  p.Q = (u16*)take((size_t)T * 1536 * 2);
  p.KN = (u16*)take((size_t)KVR * 1024 * 2);
  p.VT = (u16*)take((size_t)KVR * 1024 * 2);
  off = arena0;
  p.NQ = (u16*)take((size_t)T * 1024 * 2);
  p.NK = (u16*)take((size_t)KVR * 1024 * 2);
  p.NVT = (u16*)take((size_t)KVR * 1024 * 2);
  p.NAO = (u16*)take((size_t)T * 1024 * 2);

  int nm = 0, tiles = 0;
  auto add = [&](const float* src, u16* dst, int K, int Nsrc, int Ndst) {
    p.mats[nm].src = src; p.mats[nm].dst = dst; p.mats[nm].K = K; p.mats[nm].Nsrc = Nsrc; p.mats[nm].Ndst = Ndst; p.mats[nm].tile0 = tiles;
    tiles += (K / 64) * (Ndst / 64); nm++;
  };
  for (int j = 0; j < 2; j++) add(pool_w_in + (size_t)j * 1024 * 2048, p.Wpin + (size_t)j * 2048 * 1024, 1024, 2048, 2048);
  for (int j = 0; j < 8; j++) add(pool_w_grp + (size_t)j * 65536, p.Wgrp + (size_t)j * 65536, 256, 256, 256);
  for (int j = 0; j < 2; j++) add(pool_w_out + (size_t)j * 1024 * 1024, p.Wpout + (size_t)j * 1024 * 1024, 1024, 1024, 1024);
  add(mla_w_in, p.Wmin, 1024, 1856, 1920);
  add(mla_w_uq, p.Wuq, 512, 1536, 1536);
  add(mla_w_ukv, p.Wukv, 256, 2048, 2048);
  add(mla_w_out, p.Wmout, 1024, 1024, 1024);
  add(na_w_in, p.Wnin, 1024, 4096, 4096);
  add(na_w_out, p.Wnout, 1024, 1024, 1024);
  p.nmat_tiles = tiles;

  (void)hipMemsetAsync(p.bar, 0, XCD_BAR_WORDS * 4, stream);
#if MULTI_LAUNCH
  for (int ph = 0; ph < NPHASE; ph++) hipLaunchKernelGGL(mega, dim3(512), dim3(256), 0, stream, p, ph, ph + 1);
#else
  static int grid_blocks = 0;
  if (!grid_blocks) {
    int dev = 0, cus = 0, per_cu = 0;
    hipGetDevice(&dev);
    hipDeviceGetAttribute(&cus, hipDeviceAttributeMultiprocessorCount, dev);
    hipOccupancyMaxActiveBlocksPerMultiprocessor(&per_cu, mega, 256, 0);
    if (per_cu > 2) per_cu = 2;
    if (per_cu < 1) per_cu = 1;
    grid_blocks = cus * per_cu;
  }
  int lo = 0, hi = NPHASE;
  void* args[] = {&p, &lo, &hi};
  hipError_t e = hipLaunchCooperativeKernel((void*)mega, dim3(grid_blocks), dim3(256), args, 0, stream);
  if (e != hipSuccess) fprintf(stderr, "cooperative launch failed: %s (grid %d)\n", hipGetErrorString(e), grid_blocks);
#endif
}
```

```cpp
#include <hip/hip_runtime.h>
#include <hip/hip_cooperative_groups.h>
#include <stdint.h>
#include <string.h>
#include <stdio.h>
namespace cg = cooperative_groups;

#ifndef MULTI_LAUNCH
#define MULTI_LAUNCH 0
#endif

typedef __attribute__((ext_vector_type(8))) short bf16x8;
typedef __attribute__((ext_vector_type(4))) float f32x4;
typedef __attribute__((ext_vector_type(16))) float f32x16;
typedef __attribute__((ext_vector_type(4))) uint32_t u32x4;
typedef unsigned short u16;
#define DI __device__ __forceinline__
#define MFMA32(a, b, c) __builtin_amdgcn_mfma_f32_32x32x16_bf16((a), (b), (c), 0, 0, 0)
#define MFMA16(a, b, c) __builtin_amdgcn_mfma_f32_16x16x32_bf16((a), (b), (c), 0, 0, 0)

constexpr int TC = 4096, TL = 8192, T = 12288;
constexpr int KVR = 4096 + 4 * 2304;
constexpr float LOG2E = 1.4426950408889634f;
constexpr float ALPHA = 1.681792830507429f;
constexpr float MLA_QS = 0.07216878364870323f * LOG2E;
constexpr float NA_QS = 0.125f * LOG2E;
constexpr int SMEM_BYTES = 73728;
constexpr int NPHASE = 22;

constexpr size_t OUT_YS = 4194304, OUT_CKV = 12582912, OUT_KR = 13631488, OUT_NAK = 13893632, OUT_NAV = 18087936;

struct MatDesc { const float* src; u16* dst; int K, Nsrc, Ndst, tile0; };

struct Params {
  const float *x_prompt, *x_sample, *cache_ckv, *cache_kr, *cache_nak, *cache_nav, *c, *c_ctx, *ada_w, *ada_b, *ln_g, *ln_b;
  const float *pool_scale, *mla_q_norm, *mla_kv_norm, *na_rpb;
  float* out;
  float* mod;
  u16 *H, *SZ;
  u16 *Wpin, *Wgrp, *Wpout, *Wmin, *Wuq, *Wukv, *Wmout, *Wnin, *Wnout;
  u16 *U, *MIX, *PM;
  float* RAW; u16 *AO, *CQN, *CKVN, *KR, *Q, *KN, *VT;
  u16 *NQ, *NK, *NVT, *NAO;
  unsigned* bar;
  MatDesc mats[18];
  int nmat_tiles; int pad0;
};

DI float bf2f(u16 v) { return __uint_as_float(((uint32_t)v) << 16); }
DI u16 f2bf(float x) { uint32_t u = __float_as_uint(x); u += 0x7fffu + ((u >> 16) & 1u); return (u16)(u >> 16); }
DI uint32_t pk2(float a, float b) { return (uint32_t)f2bf(a) | ((uint32_t)f2bf(b) << 16); }
DI float silu(float v) { return v / (1.f + __expf(-v)); }
DI int cond_of(int t) { return t < TC ? 0 : 1 + ((t - TC) >> 11); }
DI int kvrow_of(int t) { return t < TC ? t : TC + ((t - TC) >> 11) * 2304 + 256 + ((t - TC) & 2047); }
DI float wave_sum(float v) {
#pragma unroll
  for (int o = 32; o >= 1; o >>= 1) v += __shfl_xor(v, o);
  return v;
}

#define XB_TMO      128
#define XB_XCNT(j)  (256  + 64 * (j))
#define XB_XSUB(j)  (1280 + 64 * (j))
#define XB_XGEN(j)  (2304 + 64 * (j))
#define XB_TOP      3328
#define XB_TOPGEN   3392
#define XCD_BAR_WORDS 3456
#define XB_SPIN_CAP (1u << 22)
#define LAS __attribute__((address_space(3)))
DI unsigned xb_ld(unsigned* p) { return __hip_atomic_load(p, __ATOMIC_RELAXED, __HIP_MEMORY_SCOPE_AGENT); }
DI unsigned xb_add(unsigned* p, unsigned v) { return __hip_atomic_fetch_add(p, v, __ATOMIC_RELAXED, __HIP_MEMORY_SCOPE_AGENT); }
DI unsigned xb_xcc_id() { return (unsigned)__builtin_amdgcn_s_getreg((3 << 11) | 20) & 0xFu; }
#define XB_SPIN(cond, bar) do { unsigned _sp = 0; while (cond) { __builtin_amdgcn_s_sleep(1); \
    if ((++_sp & 255u) == 0u) { if (xb_ld(&(bar)[XB_TMO])) break; if (_sp > XB_SPIN_CAP) { atomicAdd(&(bar)[XB_TMO], 1u); break; } } } } while (0)
struct XcdBarrier { unsigned* bar; unsigned x; volatile LAS unsigned* st; };
DI XcdBarrier xcd_barrier_post(unsigned* bar, volatile LAS unsigned* st) {
  XcdBarrier b; b.bar = bar; b.x = xb_xcc_id(); b.st = st;
  if (threadIdx.x == 0) (void)xb_add(&bar[XB_XCNT(b.x)], 1u);
  return b;
}
DI void xcd_barrier_complete(unsigned* bar, unsigned x, unsigned& nloc, unsigned& nx) {
  const unsigned G = gridDim.x * gridDim.y * gridDim.z;
  unsigned sum, cnt, mine, sp = 0u;
  for (;;) {
    sum = 0u; cnt = 0u; mine = 0u;
#pragma unroll
    for (unsigned j = 0; j < 16; ++j) { const unsigned c = xb_ld(&bar[XB_XCNT(j)]); sum += c; cnt += (c > 0u) ? 1u : 0u; mine = (j == x) ? c : mine; }
    if (sum == G) break;
    __builtin_amdgcn_s_sleep(1);
    if ((++sp & 255u) == 0u) { if (xb_ld(&bar[XB_TMO])) break; if (sp > XB_SPIN_CAP) { atomicAdd(&bar[XB_TMO], 1u); break; } }
  }
  nloc = mine > 0u ? mine : 1u; nx = cnt > 0u ? cnt : 1u;
}
DI void xcd_barrier(const XcdBarrier& b) {
  asm volatile("s_waitcnt vmcnt(0)" ::: "memory");
  __syncthreads();
  if (threadIdx.x == 0) {
    unsigned* bar = b.bar;
    __builtin_amdgcn_s_waitcnt(0);
    unsigned nloc = b.st[0], nx = b.st[1];
    if (nloc == 0u) { xcd_barrier_complete(bar, b.x, nloc, nx); b.st[0] = nloc; b.st[1] = nx; }
    const unsigned old = xb_add(&bar[XB_XSUB(b.x)], 1u);
    const unsigned gen = old / nloc;
    if (old + 1u == (gen + 1u) * nloc) {
      __builtin_amdgcn_fence(__ATOMIC_RELEASE, "agent");
      asm volatile("s_waitcnt vmcnt(0)" ::: "memory");
      const unsigned og = xb_add(&bar[XB_TOP], 1u);
      const unsigned tg = og / nx;
      if (og + 1u == (tg + 1u) * nx) xb_add(&bar[XB_TOPGEN], 1u);
      else XB_SPIN(xb_ld(&bar[XB_TOPGEN]) == tg, bar);
      __builtin_amdgcn_fence(__ATOMIC_ACQUIRE, "agent");
      xb_add(&bar[XB_XGEN(b.x)], 1u);
      asm volatile("s_waitcnt vmcnt(0)" ::: "memory");
    } else {
      XB_SPIN(xb_ld(&bar[XB_XGEN(b.x)]) == gen, bar);
      __builtin_amdgcn_fence(__ATOMIC_ACQUIRE, "agent");
      asm volatile("s_waitcnt vmcnt(0)" ::: "memory");
    }
  }
  __syncthreads();
}

template <class Epi>
DI void gemm_tile(const u16* __restrict__ A, int lda, const u16* __restrict__ Bt, int ldb, int K, int m0, int n0, int nout_off,
                  char* smem, const Epi& epi) {
  const int tid = threadIdx.x, lane = tid & 63, wid = tid >> 6;
  const int wm = wid >> 1, wn = wid & 1, l31 = lane & 31, lh = lane >> 5;
  u16* As = (u16*)smem;
  u16* Bs = As + 2 * 128 * 72;
  const int srow = tid >> 3, scc = (tid & 7) * 8;
  const u16* ag = A + (size_t)(m0 + srow) * lda + scc;
  const u16* bg = Bt + (size_t)(n0 + srow) * ldb + scc;
  uint4 ra[4], rb[4];
  f32x16 acc[2][2];
#pragma unroll
  for (int i = 0; i < 2; i++)
#pragma unroll
    for (int j = 0; j < 2; j++)
#pragma unroll
      for (int r = 0; r < 16; r++) acc[i][j][r] = 0.f;
  __syncthreads();
#pragma unroll
  for (int i = 0; i < 4; i++) {
    ra[i] = *(const uint4*)(ag + (size_t)(32 * i) * lda);
    rb[i] = *(const uint4*)(bg + (size_t)(32 * i) * ldb);
  }
#pragma unroll
  for (int i = 0; i < 4; i++) {
    *(uint4*)(As + (srow + 32 * i) * 72 + scc) = ra[i];
    *(uint4*)(Bs + (srow + 32 * i) * 72 + scc) = rb[i];
  }
  __syncthreads();
  const int nk = K >> 6;
  for (int kt = 0; kt < nk; kt++) {
    const int buf = kt & 1;
    if (kt + 1 < nk) {
#pragma unroll
      for (int i = 0; i < 4; i++) {
        ra[i] = *(const uint4*)(ag + (size_t)(32 * i) * lda + (kt + 1) * 64);
        rb[i] = *(const uint4*)(bg + (size_t)(32 * i) * ldb + (kt + 1) * 64);
      }
    }
    const u16* as = As + buf * (128 * 72) + (wm * 64 + l31) * 72 + lh * 8;
    const u16* bs = Bs + buf * (128 * 72) + (wn * 64 + l31) * 72 + lh * 8;
#pragma unroll
    for (int ks = 0; ks < 4; ks++) {
      bf16x8 a0 = *(const bf16x8*)(as + ks * 16);
      bf16x8 a1 = *(const bf16x8*)(as + 32 * 72 + ks * 16);
      bf16x8 b0 = *(const bf16x8*)(bs + ks * 16);
      bf16x8 b1 = *(const bf16x8*)(bs + 32 * 72 + ks * 16);
      acc[0][0] = MFMA32(b0, a0, acc[0][0]);
      acc[0][1] = MFMA32(b1, a0, acc[0][1]);
      acc[1][0] = MFMA32(b0, a1, acc[1][0]);
      acc[1][1] = MFMA32(b1, a1, acc[1][1]);
    }
    if (kt + 1 < nk) {
      u16* aw = As + (buf ^ 1) * (128 * 72);
      u16* bw = Bs + (buf ^ 1) * (128 * 72);
#pragma unroll
      for (int i = 0; i < 4; i++) {
        *(uint4*)(aw + (srow + 32 * i) * 72 + scc) = ra[i];
        *(uint4*)(bw + (srow + 32 * i) * 72 + scc) = rb[i];
      }
    }
    __syncthreads();
  }
#pragma unroll
  for (int i = 0; i < 2; i++)
#pragma unroll
    for (int j = 0; j < 2; j++)
      epi(m0 + wm * 64 + i * 32 + l31, nout_off + n0 + wn * 64 + j * 32, lh, acc[i][j]);
}

DI void rope_pair(float x1, float x2, int i, float pos, float& o1, float& o2) {
  const float inv = exp2f(-(float)i * (13.287712379549449f / 16.f));
  const float ang = pos * inv;
  const float c = __cosf(ang), s = __sinf(ang);
  o1 = x1 * c - x2 * s;
  o2 = x1 * s + x2 * c;
}

struct EpiPoolG1 {
  u16 *U, *SZ;
  DI void operator()(int m, int nb, int lh, const f32x16& a) const {
#pragma unroll
    for (int g = 0; g < 4; g++) {
      const int n = nb + 8 * g + 4 * lh;
      if (nb < 1024) {
        uint2 v; v.x = pk2(a[4 * g], a[4 * g + 1]); v.y = pk2(a[4 * g + 2], a[4 * g + 3]);
        *(uint2*)(U + (size_t)m * 1024 + n) = v;
      } else {
        uint2 v; v.x = pk2(silu(a[4 * g]), silu(a[4 * g + 1])); v.y = pk2(silu(a[4 * g + 2]), silu(a[4 * g + 3]));
        *(uint2*)(SZ + (size_t)m * 1024 + n - 1024) = v;
      }
    }
  }
};
struct EpiPoolG2 {
  u16* PM; const u16* SZ; const float* scale;
  DI void operator()(int m, int nb, int lh, const f32x16& a) const {
#pragma unroll
    for (int g = 0; g < 4; g++) {
      const int n = nb + 8 * g + 4 * lh;
      const uint2 z = *(const uint2*)(SZ + (size_t)m * 1024 + n);
      const float4 sc = *(const float4*)(scale + n);
      uint2 v;
      v.x = pk2(a[4 * g] * sc.x * bf2f((u16)(z.x & 0xffff)), a[4 * g + 1] * sc.y * bf2f((u16)(z.x >> 16)));
      v.y = pk2(a[4 * g + 2] * sc.z * bf2f((u16)(z.y & 0xffff)), a[4 * g + 3] * sc.w * bf2f((u16)(z.y >> 16)));
      *(uint2*)(PM + (size_t)m * 1024 + n) = v;
    }
  }
};
struct EpiG3 {
  const float *xp, *xs;
  float* out; const float* mod_layer;
  DI void operator()(int m, int nb, int lh, const f32x16& a) const {
    const float* xr = (m < TC) ? xp + (size_t)m * 1024 : xs + (size_t)(m - TC) * 1024;
    const float* gate = mod_layer + cond_of(m) * 3072 + 2048;
#pragma unroll
    for (int g = 0; g < 4; g++) {
      const int n = nb + 8 * g + 4 * lh;
      const float4 x = *(const float4*)(xr + n);
      const float4 gt = *(const float4*)(gate + n);
      float4 r;
      r.x = ALPHA * x.x + gt.x * a[4 * g]; r.y = ALPHA * x.y + gt.y * a[4 * g + 1];
      r.z = ALPHA * x.z + gt.z * a[4 * g + 2]; r.w = ALPHA * x.w + gt.w * a[4 * g + 3];
      *(float4*)(out + (size_t)m * 1024 + n) = r;
    }
  }
};
struct EpiMlaG1 {
  float* RAW; u16* KR; u16* SZ; float* st_kr;
  DI void operator()(int m, int nb, int lh, const f32x16& a) const {
    if (nb >= 1856) return;
    if (nb < 768) {
#pragma unroll
      for (int g = 0; g < 4; g++) {
        const int n = nb + 8 * g + 4 * lh;
        float4 r; r.x = a[4 * g]; r.y = a[4 * g + 1]; r.z = a[4 * g + 2]; r.w = a[4 * g + 3];
        *(float4*)(RAW + (size_t)m * 768 + n) = r;
      }
    } else if (nb < 832) {
      const int off = nb - 768;
      const bool lat = m >= TC;
      const int tt = (m - TC) & 2047;
      const float pos = (off == 0) ? (float)(tt >> 6) : (float)(tt & 63);
      const size_t kr = (size_t)kvrow_of(m) * 64 + off;
#pragma unroll
      for (int g = 0; g < 2; g++) {
        float o1[4], o2[4];
#pragma unroll
        for (int e = 0; e < 4; e++) {
          const int i = 8 * g + 4 * lh + e;
          const float x1 = a[4 * g + e], x2 = a[4 * (g + 2) + e];
          if (lat) rope_pair(x1, x2, i, pos, o1[e], o2[e]); else { o1[e] = x1; o2[e] = x2; }
        }
        const int i0 = 8 * g + 4 * lh;
        if (!lat) {
          float4 r1; r1.x = o1[0]; r1.y = o1[1]; r1.z = o1[2]; r1.w = o1[3];
          float4 r2; r2.x = o2[0]; r2.y = o2[1]; r2.z = o2[2]; r2.w = o2[3];
          *(float4*)(st_kr + (size_t)m * 64 + off + i0) = r1;
          *(float4*)(st_kr + (size_t)m * 64 + off + i0 + 16) = r2;
        }
        uint2 v1; v1.x = pk2(o1[0], o1[1]); v1.y = pk2(o1[2], o1[3]);
        uint2 v2; v2.x = pk2(o2[0], o2[1]); v2.y = pk2(o2[2], o2[3]);
        *(uint2*)(KR + kr + i0) = v1;
        *(uint2*)(KR + kr + i0 + 16) = v2;
      }
    } else {
#pragma unroll
      for (int g = 0; g < 4; g++) {
        const int n = nb + 8 * g + 4 * lh - 832;
        uint2 v; v.x = pk2(silu(a[4 * g]), silu(a[4 * g + 1])); v.y = pk2(silu(a[4 * g + 2]), silu(a[4 * g + 3]));
        *(uint2*)(SZ + (size_t)m * 1024 + n) = v;
      }
    }
  }
};
struct EpiMlaQ {
  u16* Q;
  DI void operator()(int m, int nb, int lh, const f32x16& a) const {
    const int head = nb / 192, off = nb - head * 192;
    u16* qr = Q + (size_t)m * 1536 + nb;
    if (off < 128) {
#pragma unroll
      for (int g = 0; g < 4; g++) {
        uint2 v; v.x = pk2(a[4 * g] * MLA_QS, a[4 * g + 1] * MLA_QS); v.y = pk2(a[4 * g + 2] * MLA_QS, a[4 * g + 3] * MLA_QS);
        *(uint2*)(qr + 8 * g + 4 * lh) = v;
      }
    } else {
      const bool lat = m >= TC;
      const int tt = (m - TC) & 2047;
      const float pos = (off == 128) ? (float)(tt >> 6) : (float)(tt & 63);
#pragma unroll
      for (int g = 0; g < 2; g++) {
        float o1[4], o2[4];
#pragma unroll
        for (int e = 0; e < 4; e++) {
          const int i = 8 * g + 4 * lh + e;
          const float x1 = a[4 * g + e], x2 = a[4 * (g + 2) + e];
          if (lat) rope_pair(x1, x2, i, pos, o1[e], o2[e]); else { o1[e] = x1; o2[e] = x2; }
        }
        const int i0 = 8 * g + 4 * lh;
        uint2 v1; v1.x = pk2(o1[0] * MLA_QS, o1[1] * MLA_QS); v1.y = pk2(o1[2] * MLA_QS, o1[3] * MLA_QS);
        uint2 v2; v2.x = pk2(o2[0] * MLA_QS, o2[1] * MLA_QS); v2.y = pk2(o2[2] * MLA_QS, o2[3] * MLA_QS);
        *(uint2*)(qr + i0) = v1;
        *(uint2*)(qr + i0 + 16) = v2;
      }
    }
  }
};
struct EpiMlaKV {
  u16 *KN, *VT;
  DI void operator()(int m, int nb, int lh, const f32x16& a) const {
    const int head = nb >> 8, off = nb & 255;
    if (off < 128) {
#pragma unroll
      for (int g = 0; g < 4; g++) {
        uint2 v; v.x = pk2(a[4 * g], a[4 * g + 1]); v.y = pk2(a[4 * g + 2], a[4 * g + 3]);
        *(uint2*)(KN + (size_t)m * 1024 + head * 128 + off + 8 * g + 4 * lh) = v;
      }
    } else {
      size_t base; int Lk, key;
      if (m < TC) { base = (size_t)(m >> 8) * (8 * 128 * 256); Lk = 256; key = m & 255; }
      else { const int r2 = m - TC; const int b = r2 / 2304; key = r2 - b * 2304; Lk = 2304; base = (size_t)16 * 8 * 128 * 256 + (size_t)b * (8 * 128 * 2304); }
      u16* vp = VT + base + (size_t)(head * 128 + off - 128) * Lk + key;
#pragma unroll
      for (int g = 0; g < 4; g++)
#pragma unroll
        for (int e = 0; e < 4; e++) vp[(size_t)(8 * g + 4 * lh + e) * Lk] = f2bf(a[4 * g + e]);
    }
  }
};
struct EpiNaG1 {
  u16 *NQ, *NK, *NVT, *SZ; float *st_k, *st_v;
  DI void operator()(int m, int nb, int lh, const f32x16& a) const {
    if (nb < 1024) {
#pragma unroll
      for (int g = 0; g < 4; g++) {
        uint2 v; v.x = pk2(a[4 * g] * NA_QS, a[4 * g + 1] * NA_QS); v.y = pk2(a[4 * g + 2] * NA_QS, a[4 * g + 3] * NA_QS);
        *(uint2*)(NQ + (size_t)m * 1024 + nb + 8 * g + 4 * lh) = v;
      }
    } else if (nb < 2048) {
      const size_t kr = (size_t)kvrow_of(m) * 1024 + (nb - 1024);
#pragma unroll
      for (int g = 0; g < 4; g++) {
        uint2 v; v.x = pk2(a[4 * g], a[4 * g + 1]); v.y = pk2(a[4 * g + 2], a[4 * g + 3]);
        *(uint2*)(NK + kr + 8 * g + 4 * lh) = v;
        if (m < TC) { float4 r; r.x = a[4 * g]; r.y = a[4 * g + 1]; r.z = a[4 * g + 2]; r.w = a[4 * g + 3];
          *(float4*)(st_k + (size_t)m * 1024 + (nb - 1024) + 8 * g + 4 * lh) = r; }
      }
    } else if (nb < 3072) {
      const int c0 = nb - 2048;
      size_t base; int Lk, key;
      if (m < TC) { base = (size_t)(m >> 8) * (1024 * 256); Lk = 256; key = m & 255; }
      else { const int b = (m - TC) >> 11; key = 256 + ((m - TC) & 2047); Lk = 2304; base = (size_t)16 * 1024 * 256 + (size_t)b * (1024 * 2304); }
      u16* vp = NVT + base + (size_t)c0 * Lk + key;
#pragma unroll
      for (int g = 0; g < 4; g++) {
#pragma unroll
        for (int e = 0; e < 4; e++) vp[(size_t)(8 * g + 4 * lh + e) * Lk] = f2bf(a[4 * g + e]);
        if (m < TC) { float4 r; r.x = a[4 * g]; r.y = a[4 * g + 1]; r.z = a[4 * g + 2]; r.w = a[4 * g + 3];
          *(float4*)(st_v + (size_t)m * 1024 + c0 + 8 * g + 4 * lh) = r; }
      }
    } else {
#pragma unroll
      for (int g = 0; g < 4; g++) {
        uint2 v; v.x = pk2(silu(a[4 * g]), silu(a[4 * g + 1])); v.y = pk2(silu(a[4 * g + 2]), silu(a[4 * g + 3]));
        *(uint2*)(SZ + (size_t)m * 1024 + (nb - 3072) + 8 * g + 4 * lh) = v;
      }
    }
  }
};

template <int NSA, int NSB, int NDT>
DI void attn_dense_wave(const u16* __restrict__ qrow, const u16* __restrict__ kA, int kAstride, const u16* __restrict__ kB,
                        const u16* __restrict__ vt, int Lk, int nkeys, const u16* __restrict__ szrow, u16* __restrict__ orow) {
  const int lane = threadIdx.x & 63, l31 = lane & 31, lh = lane >> 5;
  bf16x8 qf[NSA + NSB];
#pragma unroll
  for (int s = 0; s < NSA + NSB; s++) qf[s] = *(const bf16x8*)(qrow + s * 16 + lh * 8);
  f32x16 o[NDT];
#pragma unroll
  for (int d = 0; d < NDT; d++)
#pragma unroll
    for (int r = 0; r < 16; r++) o[d][r] = 0.f;
  float m = -1e30f, l = 0.f;
  for (int k0 = 0; k0 < nkeys; k0 += 32) {
    f32x16 sa;
#pragma unroll
    for (int r = 0; r < 16; r++) sa[r] = 0.f;
    const u16* kp = kA + (size_t)(k0 + l31) * kAstride + lh * 8;
#pragma unroll
    for (int s = 0; s < NSA; s++) sa = MFMA32(*(const bf16x8*)(kp + s * 16), qf[s], sa);
    if (NSB > 0) {
      const u16* kp2 = kB + (size_t)(k0 + l31) * 64 + lh * 8;
#pragma unroll
      for (int s = 0; s < NSB; s++) sa = MFMA32(*(const bf16x8*)(kp2 + s * 16), qf[NSA + s], sa);
    }
    float mx = sa[0];
#pragma unroll
    for (int r = 1; r < 16; r++) mx = fmaxf(mx, sa[r]);
    mx = fmaxf(mx, __shfl_xor(mx, 32));
    const float mn = fmaxf(m, mx);
    const float alpha = exp2f(m - mn);
    m = mn;
    float ps = 0.f;
#pragma unroll
    for (int r = 0; r < 16; r++) { sa[r] = exp2f(sa[r] - mn); ps += sa[r]; }
    l = l * alpha + ps;
#pragma unroll
    for (int d = 0; d < NDT; d++)
#pragma unroll
      for (int r = 0; r < 16; r++) o[d][r] *= alpha;
#pragma unroll
    for (int sp = 0; sp < 2; sp++) {
      u32x4 pw;
      pw[0] = pk2(sa[8 * sp + 0], sa[8 * sp + 1]); pw[1] = pk2(sa[8 * sp + 2], sa[8 * sp + 3]);
      pw[2] = pk2(sa[8 * sp + 4], sa[8 * sp + 5]); pw[3] = pk2(sa[8 * sp + 6], sa[8 * sp + 7]);
      const bf16x8 pf = __builtin_bit_cast(bf16x8, pw);
#pragma unroll
      for (int d = 0; d < NDT; d++) {
        const u16* vp = vt + (size_t)(d * 32 + l31) * Lk + k0 + 16 * sp + 4 * lh;
        const uint2 lo = *(const uint2*)vp, hi = *(const uint2*)(vp + 8);
        u32x4 vw; vw[0] = lo.x; vw[1] = lo.y; vw[2] = hi.x; vw[3] = hi.y;
        o[d] = MFMA32(__builtin_bit_cast(bf16x8, vw), pf, o[d]);
      }
    }
  }
  l += __shfl_xor(l, 32);
  const float inv = 1.f / l;
#pragma unroll
  for (int d = 0; d < NDT; d++)
#pragma unroll
    for (int g = 0; g < 4; g++) {
      const int d0 = d * 32 + 8 * g + 4 * lh;
      const uint2 z = *(const uint2*)(szrow + d0);
      uint2 v;
      v.x = pk2(o[d][4 * g] * inv * bf2f((u16)(z.x & 0xffff)), o[d][4 * g + 1] * inv * bf2f((u16)(z.x >> 16)));
      v.y = pk2(o[d][4 * g + 2] * inv * bf2f((u16)(z.y & 0xffff)), o[d][4 * g + 3] * inv * bf2f((u16)(z.y >> 16)));
      *(uint2*)(orow + d0) = v;
    }
}

DI void attn_na_wave(const Params& p, int b, int h, int r, int j) {
  const int lane = threadIdx.x & 63, l15 = lane & 15, q4 = lane >> 4;
  const int t = TC + b * 2048 + r * 64 + j * 16 + l15;
  const u16* qrow = p.NQ + (size_t)t * 1024 + h * 64;
  const bf16x8 qf0 = *(const bf16x8*)(qrow + q4 * 8);
  const bf16x8 qf1 = *(const bf16x8*)(qrow + 32 + q4 * 8);
  const int rs = min(max(r - 4, 0), 24);
  const int bstart = min(max(j * 16 - 8, 0), 32);
  const int c = j * 16 + l15;
  const int cstart = min(max(c - 8, 0), 48);
  const u16* kb = p.NK + (size_t)(TC + b * 2304) * 1024 + h * 64;
  const u16* vb = p.NVT + (size_t)16 * 1024 * 256 + (size_t)b * (1024 * 2304) + (size_t)(h * 64) * 2304;
  const float* rp = p.na_rpb + h * 465;
  f32x4 o[4];
#pragma unroll
  for (int d = 0; d < 4; d++) { o[d][0] = 0.f; o[d][1] = 0.f; o[d][2] = 0.f; o[d][3] = 0.f; }
  float m = -1e30f, l = 0.f;
  for (int ch = 0; ch < 16; ch++) {
    const int key0 = ch < 8 ? ch * 32 : 256 + (rs + ch - 8) * 64 + bstart;
    f32x4 s0 = {0.f, 0.f, 0.f, 0.f}, s1 = {0.f, 0.f, 0.f, 0.f};
    const u16* kp = kb + (size_t)(key0 + l15) * 1024 + q4 * 8;
    s0 = MFMA16(*(const bf16x8*)(kp), qf0, s0);
    s0 = MFMA16(*(const bf16x8*)(kp + 32), qf1, s0);
    s1 = MFMA16(*(const bf16x8*)(kp + 16 * 1024), qf0, s1);
    s1 = MFMA16(*(const bf16x8*)(kp + 16 * 1024 + 32), qf1, s1);
    if (ch >= 8) {
      const int dr = rs + (ch - 8) - r + 7;
#pragma unroll
      for (int i = 0; i < 4; i++) {
        const int kc0 = bstart + q4 * 4 + i, kc1 = kc0 + 16;
        const bool v0 = (kc0 >= cstart) && (kc0 < cstart + 16);
        const bool v1 = (kc1 >= cstart) && (kc1 < cstart + 16);
        const int dc0 = min(max(kc0 - c + 15, 0), 30), dc1 = min(max(kc1 - c + 15, 0), 30);
        const float b0 = rp[dr * 31 + dc0] * LOG2E, b1 = rp[dr * 31 + dc1] * LOG2E;
        s0[i] = v0 ? s0[i] + b0 : -1e30f;
        s1[i] = v1 ? s1[i] + b1 : -1e30f;
      }
    }
    float mx = fmaxf(fmaxf(fmaxf(s0[0], s0[1]), fmaxf(s0[2], s0[3])), fmaxf(fmaxf(s1[0], s1[1]), fmaxf(s1[2], s1[3])));
    mx = fmaxf(mx, __shfl_xor(mx, 16));
    mx = fmaxf(mx, __shfl_xor(mx, 32));
    const float mn = fmaxf(m, mx);
    const float alpha = exp2f(m - mn);
    m = mn;
    float ps = 0.f;
#pragma unroll
    for (int i = 0; i < 4; i++) { s0[i] = exp2f(s0[i] - mn); s1[i] = exp2f(s1[i] - mn); ps += s0[i] + s1[i]; }
    l = l * alpha + ps;
    u32x4 pw; pw[0] = pk2(s0[0], s0[1]); pw[1] = pk2(s0[2], s0[3]); pw[2] = pk2(s1[0], s1[1]); pw[3] = pk2(s1[2], s1[3]);
    const bf16x8 pf = __builtin_bit_cast(bf16x8, pw);
#pragma unroll
    for (int d = 0; d < 4; d++) {
      o[d][0] *= alpha; o[d][1] *= alpha; o[d][2] *= alpha; o[d][3] *= alpha;
      const u16* vp = vb + (size_t)(d * 16 + l15) * 2304 + key0 + q4 * 4;
      const uint2 lo = *(const uint2*)vp, hi = *(const uint2*)(vp + 16);
      u32x4 vw; vw[0] = lo.x; vw[1] = lo.y; vw[2] = hi.x; vw[3] = hi.y;
      o[d] = MFMA16(__builtin_bit_cast(bf16x8, vw), pf, o[d]);
    }
  }
  l += __shfl_xor(l, 16);
  l += __shfl_xor(l, 32);
  const float inv = 1.f / l;
  const u16* szrow = p.SZ + (size_t)t * 1024 + h * 64;
  u16* orow = p.NAO + (size_t)t * 1024 + h * 64;
#pragma unroll
  for (int d = 0; d < 4; d++) {
    const int d0 = d * 16 + q4 * 4;
    const uint2 z = *(const uint2*)(szrow + d0);
    uint2 v;
    v.x = pk2(o[d][0] * inv * bf2f((u16)(z.x & 0xffff)), o[d][1] * inv * bf2f((u16)(z.x >> 16)));
    v.y = pk2(o[d][2] * inv * bf2f((u16)(z.y & 0xffff)), o[d][3] * inv * bf2f((u16)(z.y >> 16)));
    *(uint2*)(orow + d0) = v;
  }
}

DI void ph_prep(const Params& p, char* smem) {
  const int tid = threadIdx.x;
  const int ntr = p.nmat_tiles;
  const int ntot = ntr + 192;
  for (int tile = blockIdx.x; tile < ntot; tile += gridDim.x) {
    __syncthreads();
    if (tile < ntr) {
      int mi = 0;
      for (int i = 1; i < 18; i++) if (tile >= p.mats[i].tile0) mi = i;
      const float* src = p.mats[mi].src; u16* dst = p.mats[mi].dst;
      const int K = p.mats[mi].K, Nsrc = p.mats[mi].Nsrc, Ndst = p.mats[mi].Ndst;
      const int lt = tile - p.mats[mi].tile0;
      const int ntn = Ndst >> 6;
      const int kt = lt / ntn, nt = lt - kt * ntn;
      float* ts = (float*)smem;
#pragma unroll
      for (int i = 0; i < 4; i++) {
        const int k = i * 16 + (tid >> 4), n4 = (tid & 15) * 4, n = nt * 64 + n4;
        float4 v = {0.f, 0.f, 0.f, 0.f};
        if (n < Nsrc) v = *(const float4*)(src + (size_t)(kt * 64 + k) * Nsrc + n);
        ts[k * 65 + n4] = v.x; ts[k * 65 + n4 + 1] = v.y; ts[k * 65 + n4 + 2] = v.z; ts[k * 65 + n4 + 3] = v.w;
      }
      __syncthreads();
      const int n = tid >> 2, kc = (tid & 3) * 16;
      uint32_t w[8];
#pragma unroll
      for (int e = 0; e < 8; e++) w[e] = pk2(ts[(kc + 2 * e) * 65 + n], ts[(kc + 2 * e + 1) * 65 + n]);
      u16* dp = dst + (size_t)(nt * 64 + n) * K + kt * 64 + kc;
      uint4 v0; v0.x = w[0]; v0.y = w[1]; v0.z = w[2]; v0.w = w[3];
      uint4 v1; v1.x = w[4]; v1.y = w[5]; v1.z = w[6]; v1.w = w[7];
      *(uint4*)dp = v0; *(uint4*)(dp + 8) = v1;
    } else {
      const int at = tile - ntr;
      const int layer = at / 48, c0 = (at - layer * 48) * 64;
      float* sc = (float*)smem;
      float* red = sc + 5 * 1024;
      for (int i = tid; i < 5 * 1024; i += 256) {
        const int n = i >> 10, k = i & 1023;
        const float v = (n == 0) ? p.c_ctx[k] : p.c[(n - 1) * 1024 + k];
        sc[i] = silu(v);
      }
      __syncthreads();
      const int c4 = (tid & 15) * 4, kg = tid >> 4;
      float acc[5][4];
#pragma unroll
      for (int n = 0; n < 5; n++) { acc[n][0] = 0.f; acc[n][1] = 0.f; acc[n][2] = 0.f; acc[n][3] = 0.f; }
      const float* w = p.ada_w + (size_t)layer * 1024 * 3072 + c0 + c4;
#pragma unroll 4
      for (int kk = 0; kk < 64; kk++) {
        const int k = kg * 64 + kk;
        const float4 wv = *(const float4*)(w + (size_t)k * 3072);
#pragma unroll
        for (int n = 0; n < 5; n++) {
          const float s = sc[n * 1024 + k];
          acc[n][0] += s * wv.x; acc[n][1] += s * wv.y; acc[n][2] += s * wv.z; acc[n][3] += s * wv.w;
        }
      }
#pragma unroll
      for (int n = 0; n < 5; n++) {
        float4 r; r.x = acc[n][0]; r.y = acc[n][1]; r.z = acc[n][2]; r.w = acc[n][3];
        *(float4*)(red + (kg * 5 + n) * 64 + c4) = r;
      }
      __syncthreads();
      for (int o = tid; o < 320; o += 256) {
        const int n = o >> 6, cc = o & 63;
        float s = 0.f;
#pragma unroll
        for (int g = 0; g < 16; g++) s += red[(g * 5 + n) * 64 + cc];
        s += p.ada_b[layer * 3072 + c0 + cc];
        p.mod[(layer * 5 + n) * 3072 + c0 + cc] = s;
      }
    }
  }
}

DI void ph_h0(const Params& p) {
  for (int idx = blockIdx.x * 256 + threadIdx.x; idx < T * 128; idx += gridDim.x * 256) {
    const int t = idx >> 7, c0 = (idx & 127) * 8;
    const float* xr = (t < TC) ? p.x_prompt + (size_t)t * 1024 : p.x_sample + (size_t)(t - TC) * 1024;
    const float* md = p.mod + cond_of(t) * 3072;
    const float4 x0 = *(const float4*)(xr + c0), x1 = *(const float4*)(xr + c0 + 4);
    const float4 sh0 = *(const float4*)(md + c0), sh1 = *(const float4*)(md + c0 + 4);
    const float4 sc0 = *(const float4*)(md + 1024 + c0), sc1 = *(const float4*)(md + 1024 + c0 + 4);
    uint4 v;
    v.x = pk2(x0.x * (1.f + sc0.x) + sh0.x, x0.y * (1.f + sc0.y) + sh0.y);
    v.y = pk2(x0.z * (1.f + sc0.z) + sh0.z, x0.w * (1.f + sc0.w) + sh0.w);
    v.z = pk2(x1.x * (1.f + sc1.x) + sh1.x, x1.y * (1.f + sc1.y) + sh1.y);
    v.w = pk2(x1.z * (1.f + sc1.z) + sh1.z, x1.w * (1.f + sc1.w) + sh1.w);
    *(uint4*)(p.H + (size_t)t * 1024 + c0) = v;
  }
}

template <class Epi>
DI void gemm_phase(const u16* A, int lda, const u16* Bt, int ldb, int K, int MT, int NT, char* smem, const Epi& epi) {
  const int ntile = MT * NT;
  for (int tile = blockIdx.x; tile < ntile; tile += gridDim.x) {
    const int nt = tile / MT, mt = tile - nt * MT;
    gemm_tile(A, lda, Bt, ldb, K, mt * 128, nt * 128, 0, smem, epi);
  }
}

DI void ph_mix(const Params& p) {
  for (int idx = blockIdx.x * 256 + threadIdx.x; idx < T * 128; idx += gridDim.x * 256) {
    const int t = idx >> 7, c0 = (idx & 127) * 8;
    const int g = c0 >> 8;
    const int hw = 1 << g;
    int s0, L, tt;
    if (t < TC) { s0 = t & ~255; tt = t & 255; L = 256; } else { s0 = TC + ((t - TC) & ~2047); tt = (t - TC) & 2047; L = 2048; }
    const int lo = max(tt - hw, 0), hi = min(tt + hw, L);
    float acc[8];
#pragma unroll
    for (int e = 0; e < 8; e++) acc[e] = 0.f;
    for (int s = lo; s < hi; s++) {
      const uint4 u = *(const uint4*)(p.U + (size_t)(s0 + s) * 1024 + c0);
      acc[0] += bf2f((u16)(u.x & 0xffff)); acc[1] += bf2f((u16)(u.x >> 16));
      acc[2] += bf2f((u16)(u.y & 0xffff)); acc[3] += bf2f((u16)(u.y >> 16));
      acc[4] += bf2f((u16)(u.z & 0xffff)); acc[5] += bf2f((u16)(u.z >> 16));
      acc[6] += bf2f((u16)(u.w & 0xffff)); acc[7] += bf2f((u16)(u.w >> 16));
    }
    const float ic = 1.f / (float)(hi - lo);
    const uint4 u = *(const uint4*)(p.U + (size_t)t * 1024 + c0);
    uint4 v;
    v.x = pk2(acc[0] * ic - bf2f((u16)(u.x & 0xffff)), acc[1] * ic - bf2f((u16)(u.x >> 16)));
    v.y = pk2(acc[2] * ic - bf2f((u16)(u.y & 0xffff)), acc[3] * ic - bf2f((u16)(u.y >> 16)));
    v.z = pk2(acc[4] * ic - bf2f((u16)(u.z & 0xffff)), acc[5] * ic - bf2f((u16)(u.z >> 16)));
    v.w = pk2(acc[6] * ic - bf2f((u16)(u.w & 0xffff)), acc[7] * ic - bf2f((u16)(u.w >> 16)));
    *(uint4*)(p.MIX + (size_t)t * 1024 + c0) = v;
  }
}

DI void ph_pool_g2(const Params& p, int j, char* smem) {
  EpiPoolG2 epi{p.PM, p.SZ, p.pool_scale + j * 1024};
  for (int tile = blockIdx.x; tile < 96 * 8; tile += gridDim.x) {
    const int gn = tile / 96, mt = tile - gn * 96;
    const int g = gn >> 1, ns = gn & 1;
    gemm_tile(p.MIX + g * 256, 1024, p.Wgrp + (size_t)(j * 4 + g) * 65536, 256, 256, mt * 128, ns * 128, g * 256, smem, epi);
  }
}

DI void ph_ln(const Params& p, int layer) {
  const int lane = threadIdx.x & 63, wid = threadIdx.x >> 6;
  const float* g = p.ln_g + layer * 1024;
  const float* bb = p.ln_b + layer * 1024;
  for (int row = blockIdx.x * 4 + wid; row < T; row += gridDim.x * 4) {
    float* xr = p.out + (size_t)row * 1024;
    float4 v[4];
    float s = 0.f;
#pragma unroll
    for (int i = 0; i < 4; i++) { v[i] = *(const float4*)(xr + i * 256 + lane * 4); s += v[i].x + v[i].y + v[i].z + v[i].w; }
    const float mu = wave_sum(s) * (1.f / 1024.f);
    float q = 0.f;
#pragma unroll
    for (int i = 0; i < 4; i++) {
      v[i].x -= mu; v[i].y -= mu; v[i].z -= mu; v[i].w -= mu;
      q += v[i].x * v[i].x + v[i].y * v[i].y + v[i].z * v[i].z + v[i].w * v[i].w;
    }
    const float rstd = rsqrtf(wave_sum(q) * (1.f / 1024.f) + 1e-5f);
    const float* md = p.mod + ((layer + 1) * 5 + cond_of(row)) * 3072;
#pragma unroll
    for (int i = 0; i < 4; i++) {
      const int cc = i * 256 + lane * 4;
      const float4 gg = *(const float4*)(g + cc), be = *(const float4*)(bb + cc);
      float4 y;
      y.x = v[i].x * rstd * gg.x + be.x; y.y = v[i].y * rstd * gg.y + be.y;
      y.z = v[i].z * rstd * gg.z + be.z; y.w = v[i].w * rstd * gg.w + be.w;
      *(float4*)(xr + cc) = y;
      if (layer < 3) {
        const float4 sh = *(const float4*)(md + cc), sc = *(const float4*)(md + 1024 + cc);
        uint2 h;
        h.x = pk2(y.x * (1.f + sc.x) + sh.x, y.y * (1.f + sc.y) + sh.y);
        h.y = pk2(y.z * (1.f + sc.z) + sh.z, y.w * (1.f + sc.w) + sh.w);
        *(uint2*)(p.H + (size_t)row * 1024 + cc) = h;
      }
    }
  }
}

DI void ph_mla_norm(const Params& p) {
  const int lane = threadIdx.x & 63, wid = threadIdx.x >> 6;
  for (int row = blockIdx.x * 4 + wid; row < T + 1024; row += gridDim.x * 4) {
    if (row < T) {
      const float* rr = p.RAW + (size_t)row * 768;
      const float4 a0 = *(const float4*)(rr + lane * 8), a1 = *(const float4*)(rr + lane * 8 + 4);
      const float4 k0 = *(const float4*)(rr + 512 + lane * 4);
      float s1 = a0.x * a0.x + a0.y * a0.y + a0.z * a0.z + a0.w * a0.w + a1.x * a1.x + a1.y * a1.y + a1.z * a1.z + a1.w * a1.w;
      float s2 = k0.x * k0.x + k0.y * k0.y + k0.z * k0.z + k0.w * k0.w;
      const float r1 = rsqrtf(wave_sum(s1) * (1.f / 512.f) + 1e-6f);
      const float r2 = rsqrtf(wave_sum(s2) * (1.f / 256.f) + 1e-6f);
      const float4 g0 = *(const float4*)(p.mla_q_norm + lane * 8), g1 = *(const float4*)(p.mla_q_norm + lane * 8 + 4);
      uint4 v;
      v.x = pk2(a0.x * r1 * g0.x, a0.y * r1 * g0.y); v.y = pk2(a0.z * r1 * g0.z, a0.w * r1 * g0.w);
      v.z = pk2(a1.x * r1 * g1.x, a1.y * r1 * g1.y); v.w = pk2(a1.z * r1 * g1.z, a1.w * r1 * g1.w);
      *(uint4*)(p.CQN + (size_t)row * 512 + lane * 8) = v;
      const float4 kg = *(const float4*)(p.mla_kv_norm + lane * 4);
      float4 kn; kn.x = k0.x * r2 * kg.x; kn.y = k0.y * r2 * kg.y; kn.z = k0.z * r2 * kg.z; kn.w = k0.w * r2 * kg.w;
      uint2 kv; kv.x = pk2(kn.x, kn.y); kv.y = pk2(kn.z, kn.w);
      *(uint2*)(p.CKVN + (size_t)kvrow_of(row) * 256 + lane * 4) = kv;
      if (row < TC) *(float4*)(p.out + OUT_CKV + (size_t)row * 256 + lane * 4) = kn;
    } else {
      const int cr = row - T, b = cr >> 8, pp = cr & 255;
      const size_t kvr = (size_t)TC + b * 2304 + pp;
      const float4 k0 = *(const float4*)(p.cache_ckv + (size_t)cr * 256 + lane * 4);
      uint2 kv; kv.x = pk2(k0.x, k0.y); kv.y = pk2(k0.z, k0.w);
      *(uint2*)(p.CKVN + kvr * 256 + lane * 4) = kv;
      p.KR[kvr * 64 + lane] = f2bf(p.cache_kr[(size_t)cr * 64 + lane]);
    }
  }
}

DI void ph_mla_g2(const Params& p, char* smem) {
  EpiMlaQ eq{p.Q};
  EpiMlaKV ekv{p.KN, p.VT};
  const int n1 = 96 * 12, n2 = 104 * 16;
  for (int tile = blockIdx.x; tile < n1 + n2; tile += gridDim.x) {
    if (tile < n1) {
      const int nt = tile / 96, mt = tile - nt * 96;
      gemm_tile(p.CQN, 512, p.Wuq, 512, 512, mt * 128, nt * 128, 0, smem, eq);
    } else {
      const int t2 = tile - n1;
      const int nt = t2 / 104, mt = t2 - nt * 104;
      gemm_tile(p.CKVN, 256, p.Wukv, 256, 256, mt * 128, nt * 128, 0, smem, ekv);
    }
  }
}

DI void ph_mla_attn(const Params& p) {
  const int wid = threadIdx.x >> 6, l31 = threadIdx.x & 31;
  for (int u = blockIdx.x; u < 768; u += gridDim.x) {
    int t0, kvrow0, nkeys, Lk, h; size_t vbase;
    if (u < 512) {
      const int b = u >> 7, rem = u & 127; h = rem >> 4; const int qb = rem & 15;
      t0 = TC + b * 2048 + qb * 128 + wid * 32; kvrow0 = TC + b * 2304; nkeys = 2304; Lk = 2304;
      vbase = (size_t)16 * 8 * 128 * 256 + (size_t)b * (8 * 128 * 2304) + (size_t)h * 128 * 2304;
    } else {
      const int v = u - 512; const int b = v >> 4; h = (v >> 1) & 7; const int qb = v & 1;
      t0 = b * 256 + qb * 128 + wid * 32; kvrow0 = b * 256; nkeys = 256; Lk = 256;
      vbase = (size_t)b * (8 * 128 * 256) + (size_t)h * 128 * 256;
    }
    const int t = t0 + l31;
    attn_dense_wave<8, 4, 4>(p.Q + (size_t)t * 1536 + h * 192, p.KN + (size_t)kvrow0 * 1024 + h * 128, 1024,
                             p.KR + (size_t)kvrow0 * 64, p.VT + vbase, Lk, nkeys,
                             p.SZ + (size_t)t * 1024 + h * 128, p.AO + (size_t)t * 1024 + h * 128);
  }
}

DI void ph_na_g1(const Params& p, char* smem) {
  EpiNaG1 epi{p.NQ, p.NK, p.NVT, p.SZ, p.out + OUT_NAK, p.out + OUT_NAV};
  const int n1 = 96 * 32;
  for (int tile = blockIdx.x; tile < n1 + 64; tile += gridDim.x) {
    if (tile < n1) {
      const int nt = tile / 96, mt = tile - nt * 96;
      gemm_tile(p.H, 1024, p.Wnin, 1024, 1024, mt * 128, nt * 128, 0, smem, epi);
    } else {
      const int ct = tile - n1;
      const int b = ct >> 4, p0 = (ct & 15) * 16;
      const int c4 = threadIdx.x * 4;
      const size_t kvb = (size_t)TC + b * 2304;
      u16* vtb = p.NVT + (size_t)16 * 1024 * 256 + (size_t)b * (1024 * 2304);
      float vv[4][16];
#pragma unroll
      for (int i = 0; i < 16; i++) {
        const size_t src = ((size_t)(b * 256 + p0 + i)) * 1024 + c4;
        const float4 k = *(const float4*)(p.cache_nak + src);
        uint2 kv; kv.x = pk2(k.x, k.y); kv.y = pk2(k.z, k.w);
        *(uint2*)(p.NK + (kvb + p0 + i) * 1024 + c4) = kv;
        const float4 v = *(const float4*)(p.cache_nav + src);
        vv[0][i] = v.x; vv[1][i] = v.y; vv[2][i] = v.z; vv[3][i] = v.w;
      }
#pragma unroll
      for (int e = 0; e < 4; e++) {
        uint4 w0, w1;
        w0.x = pk2(vv[e][0], vv[e][1]); w0.y = pk2(vv[e][2], vv[e][3]); w0.z = pk2(vv[e][4], vv[e][5]); w0.w = pk2(vv[e][6], vv[e][7]);
        w1.x = pk2(vv[e][8], vv[e][9]); w1.y = pk2(vv[e][10], vv[e][11]); w1.z = pk2(vv[e][12], vv[e][13]); w1.w = pk2(vv[e][14], vv[e][15]);
        u16* dp = vtb + (size_t)(c4 + e) * 2304 + p0;
        *(uint4*)dp = w0; *(uint4*)(dp + 8) = w1;
      }
    }
  }
}

DI void ph_na_attn(const Params& p) {
  const int wid = threadIdx.x >> 6, l31 = threadIdx.x & 31;
  for (int u = blockIdx.x; u < 512 + 2048; u += gridDim.x) {
    if (u < 512) {
      const int b = u >> 5, h = (u >> 1) & 15, qb = u & 1;
      const int t = b * 256 + qb * 128 + wid * 32 + l31;
      attn_dense_wave<4, 0, 2>(p.NQ + (size_t)t * 1024 + h * 64, p.NK + (size_t)(b * 256) * 1024 + h * 64, 1024, nullptr,
                               p.NVT + (size_t)b * (1024 * 256) + (size_t)h * 64 * 256, 256, 256,
                               p.SZ + (size_t)t * 1024 + h * 64, p.NAO + (size_t)t * 1024 + h * 64);
    } else {
      const int v = u - 512;
      const int b = v >> 9, h = (v >> 5) & 15, r = v & 31;
      attn_na_wave(p, b, h, r, wid);
    }
  }
}

template <int ph>
DI void run_phase(const Params& p, char* smem) {
  if constexpr (ph == 0) ph_prep(p, smem);
  else if constexpr (ph == 1) ph_h0(p);
  else if constexpr (ph == 2 || ph == 17) {
    constexpr int j = (ph == 2) ? 0 : 1;
    EpiPoolG1 e{p.U, p.SZ};
    gemm_phase(p.H, 1024, p.Wpin + (size_t)j * 2048 * 1024, 1024, 1024, 96, 16, smem, e);
  }
  else if constexpr (ph == 3 || ph == 18) ph_mix(p);
  else if constexpr (ph == 4 || ph == 19) ph_pool_g2(p, (ph == 4) ? 0 : 1, smem);
  else if constexpr (ph == 5) {
    EpiG3 e{p.x_prompt, p.x_sample, p.out, p.mod};
    gemm_phase(p.PM, 1024, p.Wpout, 1024, 1024, 96, 8, smem, e);
  }
  else if constexpr (ph == 20) {
    EpiG3 e{p.out, p.out + OUT_YS, p.out, p.mod + 3 * 5 * 3072};
    gemm_phase(p.PM, 1024, p.Wpout + (size_t)1024 * 1024, 1024, 1024, 96, 8, smem, e);
  }
  else if constexpr (ph == 6) ph_ln(p, 0);
  else if constexpr (ph == 21) ph_ln(p, 3);
  else if constexpr (ph == 7) {
    EpiMlaG1 e{p.RAW, p.KR, p.SZ, p.out + OUT_KR};
    gemm_phase(p.H, 1024, p.Wmin, 1024, 1024, 96, 15, smem, e);
  }
  else if constexpr (ph == 8) ph_mla_norm(p);
  else if constexpr (ph == 9) ph_mla_g2(p, smem);
  else if constexpr (ph == 10) ph_mla_attn(p);
  else if constexpr (ph == 11) {
    EpiG3 e{p.out, p.out + OUT_YS, p.out, p.mod + 1 * 5 * 3072};
    gemm_phase(p.AO, 1024, p.Wmout, 1024, 1024, 96, 8, smem, e);
  }
  else if constexpr (ph == 12) ph_ln(p, 1);
  else if constexpr (ph == 13) ph_na_g1(p, smem);
  else if constexpr (ph == 14) ph_na_attn(p);
  else if constexpr (ph == 15) {
    EpiG3 e{p.out, p.out + OUT_YS, p.out, p.mod + 2 * 5 * 3072};
    gemm_phase(p.NAO, 1024, p.Wnout, 1024, 1024, 96, 8, smem, e);
  }
  else if constexpr (ph == 16) ph_ln(p, 2);
}

#define RUN_PH(n) if (ph_lo <= (n) && (n) < ph_hi) { run_phase<n>(p, smem); if ((n) + 1 < ph_hi) xcd_barrier(xb); }

__global__ void __launch_bounds__(256, 2) mega(Params p, int ph_lo, int ph_hi) {
  __shared__ __attribute__((aligned(16))) char smem[SMEM_BYTES + 16];
  if (ph_lo < 0) { cg::this_grid().sync(); return; }
  const bool multi = (ph_hi - ph_lo) > 1;
  XcdBarrier xb; xb.bar = p.bar; xb.x = 0; xb.st = (volatile LAS unsigned*)(smem + SMEM_BYTES);
  if (multi) {
    if (threadIdx.x == 0) { *(uint4*)(smem + SMEM_BYTES) = make_uint4(0u, 0u, 0u, 0u); }
    __syncthreads();
    xb = xcd_barrier_post(p.bar, (volatile LAS unsigned*)(smem + SMEM_BYTES));
  }
  RUN_PH(0) RUN_PH(1) RUN_PH(2) RUN_PH(3) RUN_PH(4) RUN_PH(5) RUN_PH(6) RUN_PH(7) RUN_PH(8) RUN_PH(9) RUN_PH(10)
  RUN_PH(11) RUN_PH(12) RUN_PH(13) RUN_PH(14) RUN_PH(15) RUN_PH(16) RUN_PH(17) RUN_PH(18) RUN_PH(19) RUN_PH(20) RUN_PH(21)
}

extern "C" void kernel_launch(void* const* d_in, const int* in_sizes, int n_in, void* d_out, int out_size, void* d_ws, size_t ws_size,
                              hipStream_t stream) {
  Params p;
  memset(&p, 0, sizeof(p));
  const float* const* in = (const float* const*)d_in;
  p.x_prompt = in[0]; p.x_sample = in[1]; p.cache_ckv = in[2]; p.cache_kr = in[3]; p.cache_nak = in[4]; p.cache_nav = in[5];
  p.c = in[6]; p.c_ctx = in[7]; p.ada_w = in[8]; p.ada_b = in[9]; p.ln_g = in[10]; p.ln_b = in[11];
  const float* pool_w_in = in[12]; const float* pool_w_grp = in[13]; p.pool_scale = in[14]; const float* pool_w_out = in[15];
  const float* mla_w_in = in[16]; p.mla_q_norm = in[17]; const float* mla_w_uq = in[18]; p.mla_kv_norm = in[19];
  const float* mla_w_ukv = in[20]; const float* mla_w_out = in[21]; const float* na_w_in = in[22]; p.na_rpb = in[23];
  const float* na_w_out = in[24];
  p.out = (float*)d_out;

  char* ws = (char*)d_ws;
  size_t off = 0;
  auto take = [&](size_t bytes) { char* r = ws + off; off += (bytes + 255) & ~(size_t)255; return r; };
  p.bar = (unsigned*)take(XCD_BAR_WORDS * 4);
  p.mod = (float*)take((size_t)4 * 5 * 3072 * 4);
  p.Wpin = (u16*)take((size_t)2 * 2048 * 1024 * 2);
  p.Wgrp = (u16*)take((size_t)8 * 65536 * 2);
  p.Wpout = (u16*)take((size_t)2 * 1024 * 1024 * 2);
  p.Wmin = (u16*)take((size_t)1920 * 1024 * 2);
  p.Wuq = (u16*)take((size_t)1536 * 512 * 2);
  p.Wukv = (u16*)take((size_t)2048 * 256 * 2);
  p.Wmout = (u16*)take((size_t)1024 * 1024 * 2);
  p.Wnin = (u16*)take((size_t)4096 * 1024 * 2);
  p.Wnout = (u16*)take((size_t)1024 * 1024 * 2);
  p.H = (u16*)take((size_t)T * 1024 * 2);
  p.SZ = (u16*)take((size_t)T * 1024 * 2);
  const size_t arena0 = off;
  p.U = (u16*)take((size_t)T * 1024 * 2);
  p.MIX = (u16*)take((size_t)T * 1024 * 2);
  p.PM = (u16*)take((size_t)T * 1024 * 2);
  off = arena0;
  p.RAW = (float*)take((size_t)T * 768 * 4);
  p.AO = (u16*)p.RAW;
  p.CQN = (u16*)take((size_t)T * 512 * 2);
  p.CKVN = (u16*)take((size_t)KVR * 256 * 2);
  p.KR = (u16*)take((size_t)KVR * 64 * 2);
  p.Q = (u16*)take((size_t)T * 1536 * 2);
  p.KN = (u16*)take((size_t)KVR * 1024 * 2);
  p.VT = (u16*)take((size_t)KVR * 1024 * 2);
  off = arena0;
  p.NQ = (u16*)take((size_t)T * 1024 * 2);
  p.NK = (u16*)take((size_t)KVR * 1024 * 2);
  p.NVT = (u16*)take((size_t)KVR * 1024 * 2);
  p.NAO = (u16*)take((size_t)T * 1024 * 2);

  int nm = 0, tiles = 0;
  auto add = [&](const float* src, u16* dst, int K, int Nsrc, int Ndst) {
    p.mats[nm].src = src; p.mats[nm].dst = dst; p.mats[nm].K = K; p.mats[nm].Nsrc = Nsrc; p.mats[nm].Ndst = Ndst; p.mats[nm].tile0 = tiles;
    tiles += (K / 64) * (Ndst / 64); nm++;
  };
  for (int j = 0; j < 2; j++) add(pool_w_in + (size_t)j * 1024 * 2048, p.Wpin + (size_t)j * 2048 * 1024, 1024, 2048, 2048);
  for (int j = 0; j < 8; j++) add(pool_w_grp + (size_t)j * 65536, p.Wgrp + (size_t)j * 65536, 256, 256, 256);
  for (int j = 0; j < 2; j++) add(pool_w_out + (size_t)j * 1024 * 1024, p.Wpout + (size_t)j * 1024 * 1024, 1024, 1024, 1024);
  add(mla_w_in, p.Wmin, 1024, 1856, 1920);
  add(mla_w_uq, p.Wuq, 512, 1536, 1536);
  add(mla_w_ukv, p.Wukv, 256, 2048, 2048);
  add(mla_w_out, p.Wmout, 1024, 1024, 1024);
  add(na_w_in, p.Wnin, 1024, 4096, 4096);
  add(na_w_out, p.Wnout, 1024, 1024, 1024);
  p.nmat_tiles = tiles;

  (void)hipMemsetAsync(p.bar, 0, XCD_BAR_WORDS * 4, stream);
#if MULTI_LAUNCH
  for (int ph = 0; ph < NPHASE; ph++) hipLaunchKernelGGL(mega, dim3(512), dim3(256), 0, stream, p, ph, ph + 1);
#else
  static int grid_blocks = 0;
  if (!grid_blocks) {
    int dev = 0, cus = 0, per_cu = 0;
    hipGetDevice(&dev);
    hipDeviceGetAttribute(&cus, hipDeviceAttributeMultiprocessorCount, dev);
    hipOccupancyMaxActiveBlocksPerMultiprocessor(&per_cu, mega, 256, 0);
    if (per_cu > 2) per_cu = 2;
    if (per_cu < 1) per_cu = 1;
    grid_blocks = cus * per_cu;
  }
  int lo = 0, hi = NPHASE;
  void* args[] = {&p, &lo, &hi};
  hipError_t e = hipLaunchCooperativeKernel((void*)mega, dim3(grid_blocks), dim3(256), args, 0, stream);
  if (e != hipSuccess) fprintf(stderr, "cooperative launch failed: %s (grid %d)\n", hipGetErrorString(e), grid_blocks);
#endif
}
```

```cpp
#include <hip/hip_runtime.h>
#include <hip/hip_cooperative_groups.h>
#include <stdint.h>
#include <string.h>
#include <stdio.h>
namespace cg = cooperative_groups;

#ifndef MULTI_LAUNCH
#define MULTI_LAUNCH 0
#endif

typedef __attribute__((ext_vector_type(8))) short bf16x8;
typedef __attribute__((ext_vector_type(4))) float f32x4;
typedef __attribute__((ext_vector_type(16))) float f32x16;
typedef __attribute__((ext_vector_type(4))) uint32_t u32x4;
typedef unsigned short u16;
#define DI __device__ __forceinline__
#define MFMA32(a, b, c) __builtin_amdgcn_mfma_f32_32x32x16_bf16((a), (b), (c), 0, 0, 0)
#define MFMA16(a, b, c) __builtin_amdgcn_mfma_f32_16x16x32_bf16((a), (b), (c), 0, 0, 0)

constexpr int TC = 4096, TL = 8192, T = 12288;
constexpr int KVR = 4096 + 4 * 2304;
constexpr float LOG2E = 1.4426950408889634f;
constexpr float ALPHA = 1.681792830507429f;
constexpr float MLA_QS = 0.07216878364870323f * LOG2E;
constexpr float NA_QS = 0.125f * LOG2E;
constexpr int SMEM_BYTES = 73728;
constexpr int NPHASE = 22;

constexpr size_t OUT_YS = 4194304, OUT_CKV = 12582912, OUT_KR = 13631488, OUT_NAK = 13893632, OUT_NAV = 18087936;

struct MatDesc { const float* src; u16* dst; int K, Nsrc, Ndst, tile0; };

struct Params {
  const float *x_prompt, *x_sample, *cache_ckv, *cache_kr, *cache_nak, *cache_nav, *c, *c_ctx, *ada_w, *ada_b, *ln_g, *ln_b;
  const float *pool_scale, *mla_q_norm, *mla_kv_norm, *na_rpb;
  float* out;
  float* mod;
  u16 *H, *SZ;
  u16 *Wpin, *Wgrp, *Wpout, *Wmin, *Wuq, *Wukv, *Wmout, *Wnin, *Wnout;
  u16 *U, *MIX, *PM;
  float* RAW; u16 *AO, *CQN, *CKVN, *KR, *Q, *KN, *VT;
  u16 *NQ, *NK, *NVT, *NAO;
  unsigned* bar;
  MatDesc mats[18];
  int nmat_tiles; int pad0;
};

DI float bf2f(u16 v) { return __uint_as_float(((uint32_t)v) << 16); }
DI u16 f2bf(float x) { uint32_t u = __float_as_uint(x); u += 0x7fffu + ((u >> 16) & 1u); return (u16)(u >> 16); }
DI uint32_t pk2(float a, float b) { return (uint32_t)f2bf(a) | ((uint32_t)f2bf(b) << 16); }
DI float silu(float v) { return v / (1.f + __expf(-v)); }
DI int cond_of(int t) { return t < TC ? 0 : 1 + ((t - TC) >> 11); }
DI int kvrow_of(int t) { return t < TC ? t : TC + ((t - TC) >> 11) * 2304 + 256 + ((t - TC) & 2047); }
DI int perm16(int key) { const int k = key & 15; return (key & ~15) | (k & 3) | ((k >> 1) & 4) | ((k << 1) & 8); }
DI float wave_sum(float v) {
#pragma unroll
  for (int o = 32; o >= 1; o >>= 1) v += __shfl_xor(v, o);
  return v;
}

#define XB_TMO      128
#define XB_XCNT(j)  (256  + 64 * (j))
#define XB_XSUB(j)  (1280 + 64 * (j))
#define XB_XGEN(j)  (2304 + 64 * (j))
#define XB_TOP      3328
#define XB_TOPGEN   3392
#define XCD_BAR_WORDS 3456
#define XB_SPIN_CAP (1u << 22)
#define LAS __attribute__((address_space(3)))
DI unsigned xb_ld(unsigned* p) { return __hip_atomic_load(p, __ATOMIC_RELAXED, __HIP_MEMORY_SCOPE_AGENT); }
DI unsigned xb_add(unsigned* p, unsigned v) { return __hip_atomic_fetch_add(p, v, __ATOMIC_RELAXED, __HIP_MEMORY_SCOPE_AGENT); }
DI unsigned xb_xcc_id() { return (unsigned)__builtin_amdgcn_s_getreg((3 << 11) | 20) & 0xFu; }
#define XB_SPIN(cond, bar) do { unsigned _sp = 0; while (cond) { __builtin_amdgcn_s_sleep(1); \
    if ((++_sp & 255u) == 0u) { if (xb_ld(&(bar)[XB_TMO])) break; if (_sp > XB_SPIN_CAP) { atomicAdd(&(bar)[XB_TMO], 1u); break; } } } } while (0)
struct XcdBarrier { unsigned* bar; unsigned x; volatile LAS unsigned* st; };
DI XcdBarrier xcd_barrier_post(unsigned* bar, volatile LAS unsigned* st) {
  XcdBarrier b; b.bar = bar; b.x = xb_xcc_id(); b.st = st;
  if (threadIdx.x == 0) (void)xb_add(&bar[XB_XCNT(b.x)], 1u);
  return b;
}
DI void xcd_barrier_complete(unsigned* bar, unsigned x, unsigned& nloc, unsigned& nx) {
  const unsigned G = gridDim.x * gridDim.y * gridDim.z;
  unsigned sum, cnt, mine, sp = 0u;
  for (;;) {
    sum = 0u; cnt = 0u; mine = 0u;
#pragma unroll
    for (unsigned j = 0; j < 16; ++j) { const unsigned c = xb_ld(&bar[XB_XCNT(j)]); sum += c; cnt += (c > 0u) ? 1u : 0u; mine = (j == x) ? c : mine; }
    if (sum == G) break;
    __builtin_amdgcn_s_sleep(1);
    if ((++sp & 255u) == 0u) { if (xb_ld(&bar[XB_TMO])) break; if (sp > XB_SPIN_CAP) { atomicAdd(&bar[XB_TMO], 1u); break; } }
  }
  nloc = mine > 0u ? mine : 1u; nx = cnt > 0u ? cnt : 1u;
}
DI void xcd_barrier(const XcdBarrier& b) {
  asm volatile("s_waitcnt vmcnt(0)" ::: "memory");
  __syncthreads();
  if (threadIdx.x == 0) {
    unsigned* bar = b.bar;
    __builtin_amdgcn_s_waitcnt(0);
    unsigned nloc = b.st[0], nx = b.st[1];
    if (nloc == 0u) { xcd_barrier_complete(bar, b.x, nloc, nx); b.st[0] = nloc; b.st[1] = nx; }
    const unsigned old = xb_add(&bar[XB_XSUB(b.x)], 1u);
    const unsigned gen = old / nloc;
    if (old + 1u == (gen + 1u) * nloc) {
      __builtin_amdgcn_fence(__ATOMIC_RELEASE, "agent");
      asm volatile("s_waitcnt vmcnt(0)" ::: "memory");
      const unsigned og = xb_add(&bar[XB_TOP], 1u);
      const unsigned tg = og / nx;
      if (og + 1u == (tg + 1u) * nx) xb_add(&bar[XB_TOPGEN], 1u);
      else XB_SPIN(xb_ld(&bar[XB_TOPGEN]) == tg, bar);
      __builtin_amdgcn_fence(__ATOMIC_ACQUIRE, "agent");
      xb_add(&bar[XB_XGEN(b.x)], 1u);
      asm volatile("s_waitcnt vmcnt(0)" ::: "memory");
    } else {
      XB_SPIN(xb_ld(&bar[XB_XGEN(b.x)]) == gen, bar);
      __builtin_amdgcn_fence(__ATOMIC_ACQUIRE, "agent");
      asm volatile("s_waitcnt vmcnt(0)" ::: "memory");
    }
  }
  __syncthreads();
}

template <class Epi>
DI void gemm_tile(const u16* __restrict__ A, int lda, const u16* __restrict__ Bt, int ldb, int K, int m0, int n0, int nout_off,
                  char* smem, const Epi& epi) {
  const int tid = threadIdx.x, lane = tid & 63, wid = tid >> 6;
  const int wm = wid >> 1, wn = wid & 1, l31 = lane & 31, lh = lane >> 5;
  u16* As = (u16*)smem;
  u16* Bs = As + 2 * 128 * 72;
  const int srow = tid >> 3, scc = (tid & 7) * 8;
  const u16* ag = A + (size_t)(m0 + srow) * lda + scc;
  const u16* bg = Bt + (size_t)(n0 + srow) * ldb + scc;
  uint4 ra[4], rb[4];
  f32x16 acc[2][2];
#pragma unroll
  for (int i = 0; i < 2; i++)
#pragma unroll
    for (int j = 0; j < 2; j++)
#pragma unroll
      for (int r = 0; r < 16; r++) acc[i][j][r] = 0.f;
  __syncthreads();
#pragma unroll
  for (int i = 0; i < 4; i++) {
    ra[i] = *(const uint4*)(ag + (size_t)(32 * i) * lda);
    rb[i] = *(const uint4*)(bg + (size_t)(32 * i) * ldb);
  }
#pragma unroll
  for (int i = 0; i < 4; i++) {
    *(uint4*)(As + (srow + 32 * i) * 72 + scc) = ra[i];
    *(uint4*)(Bs + (srow + 32 * i) * 72 + scc) = rb[i];
  }
  __syncthreads();
  const int nk = K >> 6;
  for (int kt = 0; kt < nk; kt++) {
    const int buf = kt & 1;
    if (kt + 1 < nk) {
#pragma unroll
      for (int i = 0; i < 4; i++) {
        ra[i] = *(const uint4*)(ag + (size_t)(32 * i) * lda + (kt + 1) * 64);
        rb[i] = *(const uint4*)(bg + (size_t)(32 * i) * ldb + (kt + 1) * 64);
      }
    }
    const u16* as = As + buf * (128 * 72) + (wm * 64 + l31) * 72 + lh * 8;
    const u16* bs = Bs + buf * (128 * 72) + (wn * 64 + l31) * 72 + lh * 8;
#pragma unroll
    for (int ks = 0; ks < 4; ks++) {
      bf16x8 a0 = *(const bf16x8*)(as + ks * 16);
      bf16x8 a1 = *(const bf16x8*)(as + 32 * 72 + ks * 16);
      bf16x8 b0 = *(const bf16x8*)(bs + ks * 16);
      bf16x8 b1 = *(const bf16x8*)(bs + 32 * 72 + ks * 16);
      acc[0][0] = MFMA32(b0, a0, acc[0][0]);
      acc[0][1] = MFMA32(b1, a0, acc[0][1]);
      acc[1][0] = MFMA32(b0, a1, acc[1][0]);
      acc[1][1] = MFMA32(b1, a1, acc[1][1]);
    }
    if (kt + 1 < nk) {
      u16* aw = As + (buf ^ 1) * (128 * 72);
      u16* bw = Bs + (buf ^ 1) * (128 * 72);
#pragma unroll
      for (int i = 0; i < 4; i++) {
        *(uint4*)(aw + (srow + 32 * i) * 72 + scc) = ra[i];
        *(uint4*)(bw + (srow + 32 * i) * 72 + scc) = rb[i];
      }
    }
    __syncthreads();
  }
#pragma unroll
  for (int i = 0; i < 2; i++)
#pragma unroll
    for (int j = 0; j < 2; j++)
      epi(m0 + wm * 64 + i * 32 + l31, nout_off + n0 + wn * 64 + j * 32, lh, acc[i][j]);
}

DI void rope_pair(float x1, float x2, int i, float pos, float& o1, float& o2) {
  const float inv = exp2f(-(float)i * (13.287712379549449f / 16.f));
  const float ang = pos * inv;
  const float c = __cosf(ang), s = __sinf(ang);
  o1 = x1 * c - x2 * s;
  o2 = x1 * s + x2 * c;
}

struct EpiPoolG1 {
  u16 *U, *SZ;
  DI void operator()(int m, int nb, int lh, const f32x16& a) const {
#pragma unroll
    for (int g = 0; g < 4; g++) {
      const int n = nb + 8 * g + 4 * lh;
      if (nb < 1024) {
        uint2 v; v.x = pk2(a[4 * g], a[4 * g + 1]); v.y = pk2(a[4 * g + 2], a[4 * g + 3]);
        *(uint2*)(U + (size_t)m * 1024 + n) = v;
      } else {
        uint2 v; v.x = pk2(silu(a[4 * g]), silu(a[4 * g + 1])); v.y = pk2(silu(a[4 * g + 2]), silu(a[4 * g + 3]));
        *(uint2*)(SZ + (size_t)m * 1024 + n - 1024) = v;
      }
    }
  }
};
struct EpiPoolG2 {
  u16* PM; const u16* SZ; const float* scale;
  DI void operator()(int m, int nb, int lh, const f32x16& a) const {
#pragma unroll
    for (int g = 0; g < 4; g++) {
      const int n = nb + 8 * g + 4 * lh;
      const uint2 z = *(const uint2*)(SZ + (size_t)m * 1024 + n);
      const float4 sc = *(const float4*)(scale + n);
      uint2 v;
      v.x = pk2(a[4 * g] * sc.x * bf2f((u16)(z.x & 0xffff)), a[4 * g + 1] * sc.y * bf2f((u16)(z.x >> 16)));
      v.y = pk2(a[4 * g + 2] * sc.z * bf2f((u16)(z.y & 0xffff)), a[4 * g + 3] * sc.w * bf2f((u16)(z.y >> 16)));
      *(uint2*)(PM + (size_t)m * 1024 + n) = v;
    }
  }
};
struct EpiG3 {
  const float *xp, *xs;
  float* out; const float* mod_layer;
  DI void operator()(int m, int nb, int lh, const f32x16& a) const {
    const float* xr = (m < TC) ? xp + (size_t)m * 1024 : xs + (size_t)(m - TC) * 1024;
    const float* gate = mod_layer + cond_of(m) * 3072 + 2048;
#pragma unroll
    for (int g = 0; g < 4; g++) {
      const int n = nb + 8 * g + 4 * lh;
      const float4 x = *(const float4*)(xr + n);
      const float4 gt = *(const float4*)(gate + n);
      float4 r;
      r.x = ALPHA * x.x + gt.x * a[4 * g]; r.y = ALPHA * x.y + gt.y * a[4 * g + 1];
      r.z = ALPHA * x.z + gt.z * a[4 * g + 2]; r.w = ALPHA * x.w + gt.w * a[4 * g + 3];
      *(float4*)(out + (size_t)m * 1024 + n) = r;
    }
  }
};
struct EpiMlaG1 {
  float* RAW; u16* KR; u16* SZ; float* st_kr;
  DI void operator()(int m, int nb, int lh, const f32x16& a) const {
    if (nb >= 1856) return;
    if (nb < 768) {
#pragma unroll
      for (int g = 0; g < 4; g++) {
        const int n = nb + 8 * g + 4 * lh;
        float4 r; r.x = a[4 * g]; r.y = a[4 * g + 1]; r.z = a[4 * g + 2]; r.w = a[4 * g + 3];
        *(float4*)(RAW + (size_t)m * 768 + n) = r;
      }
    } else if (nb < 832) {
      const int off = nb - 768;
      const bool lat = m >= TC;
      const int tt = (m - TC) & 2047;
      const float pos = (off == 0) ? (float)(tt >> 6) : (float)(tt & 63);
      const size_t kr = (size_t)kvrow_of(m) * 64 + off;
#pragma unroll
      for (int g = 0; g < 2; g++) {
        float o1[4], o2[4];
#pragma unroll
        for (int e = 0; e < 4; e++) {
          const int i = 8 * g + 4 * lh + e;
          const float x1 = a[4 * g + e], x2 = a[4 * (g + 2) + e];
          if (lat) rope_pair(x1, x2, i, pos, o1[e], o2[e]); else { o1[e] = x1; o2[e] = x2; }
        }
        const int i0 = 8 * g + 4 * lh;
        if (!lat) {
          float4 r1; r1.x = o1[0]; r1.y = o1[1]; r1.z = o1[2]; r1.w = o1[3];
          float4 r2; r2.x = o2[0]; r2.y = o2[1]; r2.z = o2[2]; r2.w = o2[3];
          *(float4*)(st_kr + (size_t)m * 64 + off + i0) = r1;
          *(float4*)(st_kr + (size_t)m * 64 + off + i0 + 16) = r2;
        }
        uint2 v1; v1.x = pk2(o1[0], o1[1]); v1.y = pk2(o1[2], o1[3]);
        uint2 v2; v2.x = pk2(o2[0], o2[1]); v2.y = pk2(o2[2], o2[3]);
        *(uint2*)(KR + kr + i0) = v1;
        *(uint2*)(KR + kr + i0 + 16) = v2;
      }
    } else {
#pragma unroll
      for (int g = 0; g < 4; g++) {
        const int n = nb + 8 * g + 4 * lh - 832;
        uint2 v; v.x = pk2(silu(a[4 * g]), silu(a[4 * g + 1])); v.y = pk2(silu(a[4 * g + 2]), silu(a[4 * g + 3]));
        *(uint2*)(SZ + (size_t)m * 1024 + n) = v;
      }
    }
  }
};
struct EpiMlaQ {
  u16* Q;
  DI void operator()(int m, int nb, int lh, const f32x16& a) const {
    const int head = nb / 192, off = nb - head * 192;
    u16* qr = Q + (size_t)m * 1536 + nb;
    if (off < 128) {
#pragma unroll
      for (int g = 0; g < 4; g++) {
        uint2 v; v.x = pk2(a[4 * g] * MLA_QS, a[4 * g + 1] * MLA_QS); v.y = pk2(a[4 * g + 2] * MLA_QS, a[4 * g + 3] * MLA_QS);
        *(uint2*)(qr + 8 * g + 4 * lh) = v;
      }
    } else {
      const bool lat = m >= TC;
      const int tt = (m - TC) & 2047;
      const float pos = (off == 128) ? (float)(tt >> 6) : (float)(tt & 63);
#pragma unroll
      for (int g = 0; g < 2; g++) {
        float o1[4], o2[4];
#pragma unroll
        for (int e = 0; e < 4; e++) {
          const int i = 8 * g + 4 * lh + e;
          const float x1 = a[4 * g + e], x2 = a[4 * (g + 2) + e];
          if (lat) rope_pair(x1, x2, i, pos, o1[e], o2[e]); else { o1[e] = x1; o2[e] = x2; }
        }
        const int i0 = 8 * g + 4 * lh;
        uint2 v1; v1.x = pk2(o1[0] * MLA_QS, o1[1] * MLA_QS); v1.y = pk2(o1[2] * MLA_QS, o1[3] * MLA_QS);
        uint2 v2; v2.x = pk2(o2[0] * MLA_QS, o2[1] * MLA_QS); v2.y = pk2(o2[2] * MLA_QS, o2[3] * MLA_QS);
        *(uint2*)(qr + i0) = v1;
        *(uint2*)(qr + i0 + 16) = v2;
      }
    }
  }
};
struct EpiMlaKV {
  u16 *KN, *VT;
  DI void operator()(int m, int nb, int lh, const f32x16& a) const {
    const int head = nb >> 8, off = nb & 255;
    if (off < 128) {
#pragma unroll
      for (int g = 0; g < 4; g++) {
        uint2 v; v.x = pk2(a[4 * g], a[4 * g + 1]); v.y = pk2(a[4 * g + 2], a[4 * g + 3]);
        *(uint2*)(KN + (size_t)m * 1024 + head * 128 + off + 8 * g + 4 * lh) = v;
      }
    } else {
      size_t base; int Lk, key;
      if (m < TC) { base = (size_t)(m >> 8) * (8 * 128 * 256); Lk = 256; key = m & 255; }
      else { const int r2 = m - TC; const int b = r2 / 2304; key = r2 - b * 2304; Lk = 2304; base = (size_t)16 * 8 * 128 * 256 + (size_t)b * (8 * 128 * 2304); }
      u16* vp = VT + base + (size_t)(head * 128 + off - 128) * Lk + perm16(key);
#pragma unroll
      for (int g = 0; g < 4; g++)
#pragma unroll
        for (int e = 0; e < 4; e++) vp[(size_t)(8 * g + 4 * lh + e) * Lk] = f2bf(a[4 * g + e]);
    }
  }
};
struct EpiNaG1 {
  u16 *NQ, *NK, *NVT, *SZ; float *st_k, *st_v;
  DI void operator()(int m, int nb, int lh, const f32x16& a) const {
    if (nb < 1024) {
#pragma unroll
      for (int g = 0; g < 4; g++) {
        uint2 v; v.x = pk2(a[4 * g] * NA_QS, a[4 * g + 1] * NA_QS); v.y = pk2(a[4 * g + 2] * NA_QS, a[4 * g + 3] * NA_QS);
        *(uint2*)(NQ + (size_t)m * 1024 + nb + 8 * g + 4 * lh) = v;
      }
    } else if (nb < 2048) {
      const size_t kr = (size_t)kvrow_of(m) * 1024 + (nb - 1024);
#pragma unroll
      for (int g = 0; g < 4; g++) {
        uint2 v; v.x = pk2(a[4 * g], a[4 * g + 1]); v.y = pk2(a[4 * g + 2], a[4 * g + 3]);
        *(uint2*)(NK + kr + 8 * g + 4 * lh) = v;
        if (m < TC) { float4 r; r.x = a[4 * g]; r.y = a[4 * g + 1]; r.z = a[4 * g + 2]; r.w = a[4 * g + 3];
          *(float4*)(st_k + (size_t)m * 1024 + (nb - 1024) + 8 * g + 4 * lh) = r; }
      }
    } else if (nb < 3072) {
      const int c0 = nb - 2048;
      size_t base; int Lk, key;
      if (m < TC) { base = (size_t)(m >> 8) * (1024 * 256); Lk = 256; key = perm16(m & 255); }
      else { const int b = (m - TC) >> 11; key = 256 + ((m - TC) & 2047); Lk = 2304; base = (size_t)16 * 1024 * 256 + (size_t)b * (1024 * 2304); }
      u16* vp = NVT + base + (size_t)c0 * Lk + key;
#pragma unroll
      for (int g = 0; g < 4; g++) {
#pragma unroll
        for (int e = 0; e < 4; e++) vp[(size_t)(8 * g + 4 * lh + e) * Lk] = f2bf(a[4 * g + e]);
        if (m < TC) { float4 r; r.x = a[4 * g]; r.y = a[4 * g + 1]; r.z = a[4 * g + 2]; r.w = a[4 * g + 3];
          *(float4*)(st_v + (size_t)m * 1024 + c0 + 8 * g + 4 * lh) = r; }
      }
    } else {
#pragma unroll
      for (int g = 0; g < 4; g++) {
        uint2 v; v.x = pk2(silu(a[4 * g]), silu(a[4 * g + 1])); v.y = pk2(silu(a[4 * g + 2]), silu(a[4 * g + 3]));
        *(uint2*)(SZ + (size_t)m * 1024 + (nb - 3072) + 8 * g + 4 * lh) = v;
      }
    }
  }
};

template <int NSA, int NSB, int NDT>
DI void attn_dense_wave(const u16* __restrict__ qrow, const u16* __restrict__ kA, int kAstride, const u16* __restrict__ kB,
                        const u16* __restrict__ vt, int Lk, int nkeys, const u16* __restrict__ szrow, u16* __restrict__ orow) {
  const int lane = threadIdx.x & 63, l31 = lane & 31, lh = lane >> 5;
  bf16x8 qf[NSA + NSB];
#pragma unroll
  for (int s = 0; s < NSA + NSB; s++) qf[s] = *(const bf16x8*)(qrow + s * 16 + lh * 8);
  f32x16 o[NDT];
#pragma unroll
  for (int d = 0; d < NDT; d++)
#pragma unroll
    for (int r = 0; r < 16; r++) o[d][r] = 0.f;
  float m = -1e30f, l = 0.f;
  for (int k0 = 0; k0 < nkeys; k0 += 32) {
    f32x16 sa;
#pragma unroll
    for (int r = 0; r < 16; r++) sa[r] = 0.f;
    const u16* kp = kA + (size_t)(k0 + l31) * kAstride + lh * 8;
#pragma unroll
    for (int s = 0; s < NSA; s++) sa = MFMA32(*(const bf16x8*)(kp + s * 16), qf[s], sa);
    if (NSB > 0) {
      const u16* kp2 = kB + (size_t)(k0 + l31) * 64 + lh * 8;
#pragma unroll
      for (int s = 0; s < NSB; s++) sa = MFMA32(*(const bf16x8*)(kp2 + s * 16), qf[NSA + s], sa);
    }
    float mx = sa[0];
#pragma unroll
    for (int r = 1; r < 16; r++) mx = fmaxf(mx, sa[r]);
    mx = fmaxf(mx, __shfl_xor(mx, 32));
    const float mn = fmaxf(m, mx);
    const float alpha = exp2f(m - mn);
    m = mn;
    float ps = 0.f;
#pragma unroll
    for (int r = 0; r < 16; r++) { sa[r] = exp2f(sa[r] - mn); ps += sa[r]; }
    l = l * alpha + ps;
#pragma unroll
    for (int d = 0; d < NDT; d++)
#pragma unroll
      for (int r = 0; r < 16; r++) o[d][r] *= alpha;
#pragma unroll
    for (int sp = 0; sp < 2; sp++) {
      u32x4 pw;
      pw[0] = pk2(sa[8 * sp + 0], sa[8 * sp + 1]); pw[1] = pk2(sa[8 * sp + 2], sa[8 * sp + 3]);
      pw[2] = pk2(sa[8 * sp + 4], sa[8 * sp + 5]); pw[3] = pk2(sa[8 * sp + 6], sa[8 * sp + 7]);
      const bf16x8 pf = __builtin_bit_cast(bf16x8, pw);
#pragma unroll
      for (int d = 0; d < NDT; d++) {
        const u16* vp = vt + (size_t)(d * 32 + l31) * Lk + k0 + 16 * sp + 4 * lh;
        const uint2 lo = *(const uint2*)vp, hi = *(const uint2*)(vp + 8);
        u32x4 vw; vw[0] = lo.x; vw[1] = lo.y; vw[2] = hi.x; vw[3] = hi.y;
        o[d] = MFMA32(__builtin_bit_cast(bf16x8, vw), pf, o[d]);
      }
    }
  }
  l += __shfl_xor(l, 32);
  const float inv = 1.f / l;
#pragma unroll
  for (int d = 0; d < NDT; d++)
#pragma unroll
    for (int g = 0; g < 4; g++) {
      const int d0 = d * 32 + 8 * g + 4 * lh;
      const uint2 z = *(const uint2*)(szrow + d0);
      uint2 v;
      v.x = pk2(o[d][4 * g] * inv * bf2f((u16)(z.x & 0xffff)), o[d][4 * g + 1] * inv * bf2f((u16)(z.x >> 16)));
      v.y = pk2(o[d][4 * g + 2] * inv * bf2f((u16)(z.y & 0xffff)), o[d][4 * g + 3] * inv * bf2f((u16)(z.y >> 16)));
      *(uint2*)(orow + d0) = v;
    }
}


template <int NSA, int NSB, int NDT>
DI void attn_dense_block(char* smem, const u16* __restrict__ qrow, const u16* __restrict__ kA, int kAstride, const u16* __restrict__ kB,
                         const u16* __restrict__ vt, int Lk, int nkeys, const u16* __restrict__ szrow, u16* __restrict__ orow) {
  constexpr int NS = NSA + NSB, DK = 16 * NS, KST = DK + 8, DV = 32 * NDT, VST = 72;
  constexpr int CA = NSA * 2, CB = NSB * 2;
  constexpr int NLA = 64 * CA / 256, NLB = 64 * CB / 256, NLV = DV * 8 / 256;
  const int tid = threadIdx.x, lane = tid & 63, l31 = lane & 31, lh = lane >> 5;
  u16* Ks = (u16*)smem;
  u16* Vs = Ks + 64 * KST;
  u32x4 ra[NLA], rb[NLB > 0 ? NLB : 1], rv[NLV];
  bf16x8 qf[NS];
#pragma unroll
  for (int s = 0; s < NS; s++) qf[s] = *(const bf16x8*)(qrow + s * 16 + lh * 8);
  f32x16 o[NDT];
#pragma unroll
  for (int d = 0; d < NDT; d++)
#pragma unroll
    for (int r = 0; r < 16; r++) o[d][r] = 0.f;
  float m = -1e30f, l = 0.f;

    {
#pragma unroll
      for (int i = 0; i < NLA; i++) { const int c = tid + 256 * i; const int row = c / CA, cc = c % CA;
        ra[i] = *(const u32x4*)(kA + (size_t)((0) + row) * kAstride + cc * 8); }
      if constexpr (NLB > 0) {
#pragma unroll
        for (int i = 0; i < NLB; i++) { const int c = tid + 256 * i; const int row = c / CB, cc = c % CB;
          rb[i] = *(const u32x4*)(kB + (size_t)((0) + row) * 64 + cc * 8); }
      }
#pragma unroll
      for (int i = 0; i < NLV; i++) { const int c = tid + 256 * i; const int row = c >> 3, cc = c & 7;
        rv[i] = *(const u32x4*)(vt + (size_t)row * Lk + (0) + cc * 8); }
    }
  __syncthreads();
    {
#pragma unroll
      for (int i = 0; i < NLA; i++) { const int c = tid + 256 * i; const int row = c / CA, cc = c % CA;
        *(u32x4*)(Ks + row * KST + cc * 8) = ra[i]; }
      if constexpr (NLB > 0) {
#pragma unroll
        for (int i = 0; i < NLB; i++) { const int c = tid + 256 * i; const int row = c / CB, cc = c % CB;
          *(u32x4*)(Ks + row * KST + NSA * 16 + cc * 8) = rb[i]; }
      }
#pragma unroll
      for (int i = 0; i < NLV; i++) { const int c = tid + 256 * i; const int row = c >> 3, cc = c & 7;
        *(u32x4*)(Vs + row * VST + cc * 8) = rv[i]; }
    }
  __syncthreads();
  for (int k0 = 0; k0 < nkeys; k0 += 64) {
    const bool more = (k0 + 64) < nkeys;
    const int kn = more ? k0 + 64 : k0;
    {
#pragma unroll
      for (int i = 0; i < NLA; i++) { const int c = tid + 256 * i; const int row = c / CA, cc = c % CA;
        ra[i] = *(const u32x4*)(kA + (size_t)(kn + row) * kAstride + cc * 8); }
      if constexpr (NLB > 0) {
#pragma unroll
        for (int i = 0; i < NLB; i++) { const int c = tid + 256 * i; const int row = c / CB, cc = c % CB;
          rb[i] = *(const u32x4*)(kB + (size_t)(kn + row) * 64 + cc * 8); }
      }
#pragma unroll
      for (int i = 0; i < NLV; i++) { const int c = tid + 256 * i; const int row = c >> 3, cc = c & 7;
        rv[i] = *(const u32x4*)(vt + (size_t)row * Lk + kn + cc * 8); }
    }
#pragma unroll
    for (int hh = 0; hh < 2; hh++) {
      f32x16 s0;
#pragma unroll
      for (int r = 0; r < 16; r++) s0[r] = 0.f;
      const u16* kp = Ks + (hh * 32 + l31) * KST + lh * 8;
#pragma unroll
      for (int s = 0; s < NS; s++) s0 = MFMA32(*(const bf16x8*)(kp + s * 16), qf[s], s0);
      float mx = s0[0];
#pragma unroll
      for (int r = 1; r < 16; r++) mx = fmaxf(mx, s0[r]);
      mx = fmaxf(mx, __shfl_xor(mx, 32));
      if (__any(mx > m + 8.f)) {
        const float mn = fmaxf(m, mx);
        const float alpha = exp2f(m - mn);
        m = mn;
        l *= alpha;
#pragma unroll
        for (int d = 0; d < NDT; d++)
#pragma unroll
          for (int r = 0; r < 16; r++) o[d][r] *= alpha;
      }
      float ps = 0.f;
#pragma unroll
      for (int r = 0; r < 16; r++) { s0[r] = exp2f(s0[r] - m); ps += s0[r]; }
      l += ps;
      const u16* vp = Vs + l31 * VST + hh * 32 + lh * 8;
#pragma unroll
      for (int sp = 0; sp < 2; sp++) {
        u32x4 pw;
        pw[0] = pk2(s0[8 * sp + 0], s0[8 * sp + 1]); pw[1] = pk2(s0[8 * sp + 2], s0[8 * sp + 3]);
        pw[2] = pk2(s0[8 * sp + 4], s0[8 * sp + 5]); pw[3] = pk2(s0[8 * sp + 6], s0[8 * sp + 7]);
        const bf16x8 pf = __builtin_bit_cast(bf16x8, pw);
#pragma unroll
        for (int d = 0; d < NDT; d++) o[d] = MFMA32(*(const bf16x8*)(vp + d * 32 * VST + sp * 16), pf, o[d]);
      }
    }
    __syncthreads();
    if (more)
    {
#pragma unroll
      for (int i = 0; i < NLA; i++) { const int c = tid + 256 * i; const int row = c / CA, cc = c % CA;
        *(u32x4*)(Ks + row * KST + cc * 8) = ra[i]; }
      if constexpr (NLB > 0) {
#pragma unroll
        for (int i = 0; i < NLB; i++) { const int c = tid + 256 * i; const int row = c / CB, cc = c % CB;
          *(u32x4*)(Ks + row * KST + NSA * 16 + cc * 8) = rb[i]; }
      }
#pragma unroll
      for (int i = 0; i < NLV; i++) { const int c = tid + 256 * i; const int row = c >> 3, cc = c & 7;
        *(u32x4*)(Vs + row * VST + cc * 8) = rv[i]; }
    }
    __syncthreads();
  }
  l += __shfl_xor(l, 32);
  const float inv = 1.f / l;
#pragma unroll
  for (int d = 0; d < NDT; d++)
#pragma unroll
    for (int g = 0; g < 4; g++) {
      const int d0 = d * 32 + 8 * g + 4 * lh;
      const uint2 z = *(const uint2*)(szrow + d0);
      uint2 v;
      v.x = pk2(o[d][4 * g] * inv * bf2f((u16)(z.x & 0xffff)), o[d][4 * g + 1] * inv * bf2f((u16)(z.x >> 16)));
      v.y = pk2(o[d][4 * g + 2] * inv * bf2f((u16)(z.y & 0xffff)), o[d][4 * g + 3] * inv * bf2f((u16)(z.y >> 16)));
      *(uint2*)(orow + d0) = v;
    }
}

DI void attn_na_wave(const Params& p, int b, int h, int r, int j) {
  const int lane = threadIdx.x & 63, l15 = lane & 15, q4 = lane >> 4;
  const int t = TC + b * 2048 + r * 64 + j * 16 + l15;
  const u16* qrow = p.NQ + (size_t)t * 1024 + h * 64;
  const bf16x8 qf0 = *(const bf16x8*)(qrow + q4 * 8);
  const bf16x8 qf1 = *(const bf16x8*)(qrow + 32 + q4 * 8);
  const int rs = min(max(r - 4, 0), 24);
  const int bstart = min(max(j * 16 - 8, 0), 32);
  const int c = j * 16 + l15;
  const int cstart = min(max(c - 8, 0), 48);
  const u16* kb = p.NK + (size_t)(TC + b * 2304) * 1024 + h * 64;
  const u16* vb = p.NVT + (size_t)16 * 1024 * 256 + (size_t)b * (1024 * 2304) + (size_t)(h * 64) * 2304;
  const float* rp = p.na_rpb + h * 465;
  f32x4 o[4];
#pragma unroll
  for (int d = 0; d < 4; d++) { o[d][0] = 0.f; o[d][1] = 0.f; o[d][2] = 0.f; o[d][3] = 0.f; }
  float m = -1e30f, l = 0.f;
  for (int ch = 0; ch < 16; ch++) {
    const int key0 = ch < 8 ? ch * 32 : 256 + (rs + ch - 8) * 64 + bstart;
    f32x4 s0 = {0.f, 0.f, 0.f, 0.f}, s1 = {0.f, 0.f, 0.f, 0.f};
    const u16* kp = kb + (size_t)(key0 + l15) * 1024 + q4 * 8;
    s0 = MFMA16(*(const bf16x8*)(kp), qf0, s0);
    s0 = MFMA16(*(const bf16x8*)(kp + 32), qf1, s0);
    s1 = MFMA16(*(const bf16x8*)(kp + 16 * 1024), qf0, s1);
    s1 = MFMA16(*(const bf16x8*)(kp + 16 * 1024 + 32), qf1, s1);
    if (ch >= 8) {
      const int dr = rs + (ch - 8) - r + 7;
#pragma unroll
      for (int i = 0; i < 4; i++) {
        const int kc0 = bstart + q4 * 4 + i, kc1 = kc0 + 16;
        const bool v0 = (kc0 >= cstart) && (kc0 < cstart + 16);
        const bool v1 = (kc1 >= cstart) && (kc1 < cstart + 16);
        const int dc0 = min(max(kc0 - c + 15, 0), 30), dc1 = min(max(kc1 - c + 15, 0), 30);
        const float b0 = rp[dr * 31 + dc0] * LOG2E, b1 = rp[dr * 31 + dc1] * LOG2E;
        s0[i] = v0 ? s0[i] + b0 : -1e30f;
        s1[i] = v1 ? s1[i] + b1 : -1e30f;
      }
    }
    float mx = fmaxf(fmaxf(fmaxf(s0[0], s0[1]), fmaxf(s0[2], s0[3])), fmaxf(fmaxf(s1[0], s1[1]), fmaxf(s1[2], s1[3])));
    mx = fmaxf(mx, __shfl_xor(mx, 16));
    mx = fmaxf(mx, __shfl_xor(mx, 32));
    const float mn = fmaxf(m, mx);
    const float alpha = exp2f(m - mn);
    m = mn;
    float ps = 0.f;
#pragma unroll
    for (int i = 0; i < 4; i++) { s0[i] = exp2f(s0[i] - mn); s1[i] = exp2f(s1[i] - mn); ps += s0[i] + s1[i]; }
    l = l * alpha + ps;
    u32x4 pw; pw[0] = pk2(s0[0], s0[1]); pw[1] = pk2(s0[2], s0[3]); pw[2] = pk2(s1[0], s1[1]); pw[3] = pk2(s1[2], s1[3]);
    const bf16x8 pf = __builtin_bit_cast(bf16x8, pw);
#pragma unroll
    for (int d = 0; d < 4; d++) {
      o[d][0] *= alpha; o[d][1] *= alpha; o[d][2] *= alpha; o[d][3] *= alpha;
      const u16* vp = vb + (size_t)(d * 16 + l15) * 2304 + key0 + q4 * 4;
      const uint2 lo = *(const uint2*)vp, hi = *(const uint2*)(vp + 16);
      u32x4 vw; vw[0] = lo.x; vw[1] = lo.y; vw[2] = hi.x; vw[3] = hi.y;
      o[d] = MFMA16(__builtin_bit_cast(bf16x8, vw), pf, o[d]);
    }
  }
  l += __shfl_xor(l, 16);
  l += __shfl_xor(l, 32);
  const float inv = 1.f / l;
  const u16* szrow = p.SZ + (size_t)t * 1024 + h * 64;
  u16* orow = p.NAO + (size_t)t * 1024 + h * 64;
#pragma unroll
  for (int d = 0; d < 4; d++) {
    const int d0 = d * 16 + q4 * 4;
    const uint2 z = *(const uint2*)(szrow + d0);
    uint2 v;
    v.x = pk2(o[d][0] * inv * bf2f((u16)(z.x & 0xffff)), o[d][1] * inv * bf2f((u16)(z.x >> 16)));
    v.y = pk2(o[d][2] * inv * bf2f((u16)(z.y & 0xffff)), o[d][3] * inv * bf2f((u16)(z.y >> 16)));
    *(uint2*)(orow + d0) = v;
  }
}

DI void ph_prep(const Params& p, char* smem) {
  const int tid = threadIdx.x;
  const int ntr = p.nmat_tiles;
  const int ntot = ntr + 192;
  for (int tile = blockIdx.x; tile < ntot; tile += gridDim.x) {
    __syncthreads();
    if (tile < ntr) {
      int mi = 0;
      for (int i = 1; i < 18; i++) if (tile >= p.mats[i].tile0) mi = i;
      const float* src = p.mats[mi].src; u16* dst = p.mats[mi].dst;
      const int K = p.mats[mi].K, Nsrc = p.mats[mi].Nsrc, Ndst = p.mats[mi].Ndst;
      const int lt = tile - p.mats[mi].tile0;
      const int ntn = Ndst >> 6;
      const int kt = lt / ntn, nt = lt - kt * ntn;
      float* ts = (float*)smem;
#pragma unroll
      for (int i = 0; i < 4; i++) {
        const int k = i * 16 + (tid >> 4), n4 = (tid & 15) * 4, n = nt * 64 + n4;
        float4 v = {0.f, 0.f, 0.f, 0.f};
        if (n < Nsrc) v = *(const float4*)(src + (size_t)(kt * 64 + k) * Nsrc + n);
        ts[k * 65 + n4] = v.x; ts[k * 65 + n4 + 1] = v.y; ts[k * 65 + n4 + 2] = v.z; ts[k * 65 + n4 + 3] = v.w;
      }
      __syncthreads();
      const int n = tid >> 2, kc = (tid & 3) * 16;
      uint32_t w[8];
#pragma unroll
      for (int e = 0; e < 8; e++) w[e] = pk2(ts[(kc + 2 * e) * 65 + n], ts[(kc + 2 * e + 1) * 65 + n]);
      u16* dp = dst + (size_t)(nt * 64 + n) * K + kt * 64 + kc;
      uint4 v0; v0.x = w[0]; v0.y = w[1]; v0.z = w[2]; v0.w = w[3];
      uint4 v1; v1.x = w[4]; v1.y = w[5]; v1.z = w[6]; v1.w = w[7];
      *(uint4*)dp = v0; *(uint4*)(dp + 8) = v1;
    } else {
      const int at = tile - ntr;
      const int layer = at / 48, c0 = (at - layer * 48) * 64;
      float* sc = (float*)smem;
      float* red = sc + 5 * 1024;
      for (int i = tid; i < 5 * 1024; i += 256) {
        const int n = i >> 10, k = i & 1023;
        const float v = (n == 0) ? p.c_ctx[k] : p.c[(n - 1) * 1024 + k];
        sc[i] = silu(v);
      }
      __syncthreads();
      const int c4 = (tid & 15) * 4, kg = tid >> 4;
      float acc[5][4];
#pragma unroll
      for (int n = 0; n < 5; n++) { acc[n][0] = 0.f; acc[n][1] = 0.f; acc[n][2] = 0.f; acc[n][3] = 0.f; }
      const float* w = p.ada_w + (size_t)layer * 1024 * 3072 + c0 + c4;
#pragma unroll 4
      for (int kk = 0; kk < 64; kk++) {
        const int k = kg * 64 + kk;
        const float4 wv = *(const float4*)(w + (size_t)k * 3072);
#pragma unroll
        for (int n = 0; n < 5; n++) {
          const float s = sc[n * 1024 + k];
          acc[n][0] += s * wv.x; acc[n][1] += s * wv.y; acc[n][2] += s * wv.z; acc[n][3] += s * wv.w;
        }
      }
#pragma unroll
      for (int n = 0; n < 5; n++) {
        float4 r; r.x = acc[n][0]; r.y = acc[n][1]; r.z = acc[n][2]; r.w = acc[n][3];
        *(float4*)(red + (kg * 5 + n) * 64 + c4) = r;
      }
      __syncthreads();
      for (int o = tid; o < 320; o += 256) {
        const int n = o >> 6, cc = o & 63;
        float s = 0.f;
#pragma unroll
        for (int g = 0; g < 16; g++) s += red[(g * 5 + n) * 64 + cc];
        s += p.ada_b[layer * 3072 + c0 + cc];
        p.mod[(layer * 5 + n) * 3072 + c0 + cc] = s;
      }
    }
  }
}

DI void ph_h0(const Params& p) {
  for (int idx = blockIdx.x * 256 + threadIdx.x; idx < T * 128; idx += gridDim.x * 256) {
    const int t = idx >> 7, c0 = (idx & 127) * 8;
    const float* xr = (t < TC) ? p.x_prompt + (size_t)t * 1024 : p.x_sample + (size_t)(t - TC) * 1024;
    const float* md = p.mod + cond_of(t) * 3072;
    const float4 x0 = *(const float4*)(xr + c0), x1 = *(const float4*)(xr + c0 + 4);
    const float4 sh0 = *(const float4*)(md + c0), sh1 = *(const float4*)(md + c0 + 4);
    const float4 sc0 = *(const float4*)(md + 1024 + c0), sc1 = *(const float4*)(md + 1024 + c0 + 4);
    uint4 v;
    v.x = pk2(x0.x * (1.f + sc0.x) + sh0.x, x0.y * (1.f + sc0.y) + sh0.y);
    v.y = pk2(x0.z * (1.f + sc0.z) + sh0.z, x0.w * (1.f + sc0.w) + sh0.w);
    v.z = pk2(x1.x * (1.f + sc1.x) + sh1.x, x1.y * (1.f + sc1.y) + sh1.y);
    v.w = pk2(x1.z * (1.f + sc1.z) + sh1.z, x1.w * (1.f + sc1.w) + sh1.w);
    *(uint4*)(p.H + (size_t)t * 1024 + c0) = v;
  }
}

template <class Epi>
DI void gemm_phase(const u16* A, int lda, const u16* Bt, int ldb, int K, int MT, int NT, char* smem, const Epi& epi) {
  const int ntile = MT * NT;
  for (int tile = blockIdx.x; tile < ntile; tile += gridDim.x) {
    const int nt = tile / MT, mt = tile - nt * MT;
    gemm_tile(A, lda, Bt, ldb, K, mt * 128, nt * 128, 0, smem, epi);
  }
}

DI void ph_mix(const Params& p) {
  for (int idx = blockIdx.x * 256 + threadIdx.x; idx < T * 128; idx += gridDim.x * 256) {
    const int t = idx >> 7, c0 = (idx & 127) * 8;
    const int g = c0 >> 8;
    const int hw = 1 << g;
    int s0, L, tt;
    if (t < TC) { s0 = t & ~255; tt = t & 255; L = 256; } else { s0 = TC + ((t - TC) & ~2047); tt = (t - TC) & 2047; L = 2048; }
    const int lo = max(tt - hw, 0), hi = min(tt + hw, L);
    float acc[8];
#pragma unroll
    for (int e = 0; e < 8; e++) acc[e] = 0.f;
    for (int s = lo; s < hi; s++) {
      const uint4 u = *(const uint4*)(p.U + (size_t)(s0 + s) * 1024 + c0);
      acc[0] += bf2f((u16)(u.x & 0xffff)); acc[1] += bf2f((u16)(u.x >> 16));
      acc[2] += bf2f((u16)(u.y & 0xffff)); acc[3] += bf2f((u16)(u.y >> 16));
      acc[4] += bf2f((u16)(u.z & 0xffff)); acc[5] += bf2f((u16)(u.z >> 16));
      acc[6] += bf2f((u16)(u.w & 0xffff)); acc[7] += bf2f((u16)(u.w >> 16));
    }
    const float ic = 1.f / (float)(hi - lo);
    const uint4 u = *(const uint4*)(p.U + (size_t)t * 1024 + c0);
    uint4 v;
    v.x = pk2(acc[0] * ic - bf2f((u16)(u.x & 0xffff)), acc[1] * ic - bf2f((u16)(u.x >> 16)));
    v.y = pk2(acc[2] * ic - bf2f((u16)(u.y & 0xffff)), acc[3] * ic - bf2f((u16)(u.y >> 16)));
    v.z = pk2(acc[4] * ic - bf2f((u16)(u.z & 0xffff)), acc[5] * ic - bf2f((u16)(u.z >> 16)));
    v.w = pk2(acc[6] * ic - bf2f((u16)(u.w & 0xffff)), acc[7] * ic - bf2f((u16)(u.w >> 16)));
    *(uint4*)(p.MIX + (size_t)t * 1024 + c0) = v;
  }
}

DI void ph_pool_g2(const Params& p, int j, char* smem) {
  EpiPoolG2 epi{p.PM, p.SZ, p.pool_scale + j * 1024};
  for (int tile = blockIdx.x; tile < 96 * 8; tile += gridDim.x) {
    const int gn = tile / 96, mt = tile - gn * 96;
    const int g = gn >> 1, ns = gn & 1;
    gemm_tile(p.MIX + g * 256, 1024, p.Wgrp + (size_t)(j * 4 + g) * 65536, 256, 256, mt * 128, ns * 128, g * 256, smem, epi);
  }
}

DI void ph_ln(const Params& p, int layer) {
  const int lane = threadIdx.x & 63, wid = threadIdx.x >> 6;
  const float* g = p.ln_g + layer * 1024;
  const float* bb = p.ln_b + layer * 1024;
  for (int row = blockIdx.x * 4 + wid; row < T; row += gridDim.x * 4) {
    float* xr = p.out + (size_t)row * 1024;
    float4 v[4];
    float s = 0.f;
#pragma unroll
    for (int i = 0; i < 4; i++) { v[i] = *(const float4*)(xr + i * 256 + lane * 4); s += v[i].x + v[i].y + v[i].z + v[i].w; }
    const float mu = wave_sum(s) * (1.f / 1024.f);
    float q = 0.f;
#pragma unroll
    for (int i = 0; i < 4; i++) {
      v[i].x -= mu; v[i].y -= mu; v[i].z -= mu; v[i].w -= mu;
      q += v[i].x * v[i].x + v[i].y * v[i].y + v[i].z * v[i].z + v[i].w * v[i].w;
    }
    const float rstd = rsqrtf(wave_sum(q) * (1.f / 1024.f) + 1e-5f);
    const float* md = p.mod + ((layer + 1) * 5 + cond_of(row)) * 3072;
#pragma unroll
    for (int i = 0; i < 4; i++) {
      const int cc = i * 256 + lane * 4;
      const float4 gg = *(const float4*)(g + cc), be = *(const float4*)(bb + cc);
      float4 y;
      y.x = v[i].x * rstd * gg.x + be.x; y.y = v[i].y * rstd * gg.y + be.y;
      y.z = v[i].z * rstd * gg.z + be.z; y.w = v[i].w * rstd * gg.w + be.w;
      *(float4*)(xr + cc) = y;
      if (layer < 3) {
        const float4 sh = *(const float4*)(md + cc), sc = *(const float4*)(md + 1024 + cc);
        uint2 h;
        h.x = pk2(y.x * (1.f + sc.x) + sh.x, y.y * (1.f + sc.y) + sh.y);
        h.y = pk2(y.z * (1.f + sc.z) + sh.z, y.w * (1.f + sc.w) + sh.w);
        *(uint2*)(p.H + (size_t)row * 1024 + cc) = h;
      }
    }
  }
}

DI void ph_mla_norm(const Params& p) {
  const int lane = threadIdx.x & 63, wid = threadIdx.x >> 6;
  for (int row = blockIdx.x * 4 + wid; row < T + 1024; row += gridDim.x * 4) {
    if (row < T) {
      const float* rr = p.RAW + (size_t)row * 768;
      const float4 a0 = *(const float4*)(rr + lane * 8), a1 = *(const float4*)(rr + lane * 8 + 4);
      const float4 k0 = *(const float4*)(rr + 512 + lane * 4);
      float s1 = a0.x * a0.x + a0.y * a0.y + a0.z * a0.z + a0.w * a0.w + a1.x * a1.x + a1.y * a1.y + a1.z * a1.z + a1.w * a1.w;
      float s2 = k0.x * k0.x + k0.y * k0.y + k0.z * k0.z + k0.w * k0.w;
      const float r1 = rsqrtf(wave_sum(s1) * (1.f / 512.f) + 1e-6f);
      const float r2 = rsqrtf(wave_sum(s2) * (1.f / 256.f) + 1e-6f);
      const float4 g0 = *(const float4*)(p.mla_q_norm + lane * 8), g1 = *(const float4*)(p.mla_q_norm + lane * 8 + 4);
      uint4 v;
      v.x = pk2(a0.x * r1 * g0.x, a0.y * r1 * g0.y); v.y = pk2(a0.z * r1 * g0.z, a0.w * r1 * g0.w);
      v.z = pk2(a1.x * r1 * g1.x, a1.y * r1 * g1.y); v.w = pk2(a1.z * r1 * g1.z, a1.w * r1 * g1.w);
      *(uint4*)(p.CQN + (size_t)row * 512 + lane * 8) = v;
      const float4 kg = *(const float4*)(p.mla_kv_norm + lane * 4);
      float4 kn; kn.x = k0.x * r2 * kg.x; kn.y = k0.y * r2 * kg.y; kn.z = k0.z * r2 * kg.z; kn.w = k0.w * r2 * kg.w;
      uint2 kv; kv.x = pk2(kn.x, kn.y); kv.y = pk2(kn.z, kn.w);
      *(uint2*)(p.CKVN + (size_t)kvrow_of(row) * 256 + lane * 4) = kv;
      if (row < TC) *(float4*)(p.out + OUT_CKV + (size_t)row * 256 + lane * 4) = kn;
    } else {
      const int cr = row - T, b = cr >> 8, pp = cr & 255;
      const size_t kvr = (size_t)TC + b * 2304 + pp;
      const float4 k0 = *(const float4*)(p.cache_ckv + (size_t)cr * 256 + lane * 4);
      uint2 kv; kv.x = pk2(k0.x, k0.y); kv.y = pk2(k0.z, k0.w);
      *(uint2*)(p.CKVN + kvr * 256 + lane * 4) = kv;
      p.KR[kvr * 64 + lane] = f2bf(p.cache_kr[(size_t)cr * 64 + lane]);
    }
  }
}

DI void ph_mla_g2(const Params& p, char* smem) {
  EpiMlaQ eq{p.Q};
  EpiMlaKV ekv{p.KN, p.VT};
  const int n1 = 96 * 12, n2 = 104 * 16;
  for (int tile = blockIdx.x; tile < n1 + n2; tile += gridDim.x) {
    if (tile < n1) {
      const int nt = tile / 96, mt = tile - nt * 96;
      gemm_tile(p.CQN, 512, p.Wuq, 512, 512, mt * 128, nt * 128, 0, smem, eq);
    } else {
      const int t2 = tile - n1;
      const int nt = t2 / 104, mt = t2 - nt * 104;
      gemm_tile(p.CKVN, 256, p.Wukv, 256, 256, mt * 128, nt * 128, 0, smem, ekv);
    }
  }
}

DI void ph_mla_attn(const Params& p, char* smem) {
  const int wid = threadIdx.x >> 6, l31 = threadIdx.x & 31;
  for (int u = blockIdx.x; u < 768; u += gridDim.x) {
    int t0, kvrow0, nkeys, Lk, h; size_t vbase;
    if (u < 512) {
      const int xcd = u & 7, slot = u >> 3; const int pair = xcd * 4 + (slot >> 4); const int qb = slot & 15;
      const int b = pair >> 3; h = pair & 7;
      t0 = TC + b * 2048 + qb * 128 + wid * 32; kvrow0 = TC + b * 2304; nkeys = 2304; Lk = 2304;
      vbase = (size_t)16 * 8 * 128 * 256 + (size_t)b * (8 * 128 * 2304) + (size_t)h * 128 * 2304;
    } else {
      const int v = u - 512; const int b = v >> 4; h = (v >> 1) & 7; const int qb = v & 1;
      t0 = b * 256 + qb * 128 + wid * 32; kvrow0 = b * 256; nkeys = 256; Lk = 256;
      vbase = (size_t)b * (8 * 128 * 256) + (size_t)h * 128 * 256;
    }
    const int t = t0 + l31;
    attn_dense_block<8, 4, 4>(smem, p.Q + (size_t)t * 1536 + h * 192, p.KN + (size_t)kvrow0 * 1024 + h * 128, 1024,
                             p.KR + (size_t)kvrow0 * 64, p.VT + vbase, Lk, nkeys,
                             p.SZ + (size_t)t * 1024 + h * 128, p.AO + (size_t)t * 1024 + h * 128);
  }
}

DI void ph_na_g1(const Params& p, char* smem) {
  EpiNaG1 epi{p.NQ, p.NK, p.NVT, p.SZ, p.out + OUT_NAK, p.out + OUT_NAV};
  const int n1 = 96 * 32;
  for (int tile = blockIdx.x; tile < n1 + 64; tile += gridDim.x) {
    if (tile < n1) {
      const int nt = tile / 96, mt = tile - nt * 96;
      gemm_tile(p.H, 1024, p.Wnin, 1024, 1024, mt * 128, nt * 128, 0, smem, epi);
    } else {
      const int ct = tile - n1;
      const int b = ct >> 4, p0 = (ct & 15) * 16;
      const int c4 = threadIdx.x * 4;
      const size_t kvb = (size_t)TC + b * 2304;
      u16* vtb = p.NVT + (size_t)16 * 1024 * 256 + (size_t)b * (1024 * 2304);
      float vv[4][16];
#pragma unroll
      for (int i = 0; i < 16; i++) {
        const size_t src = ((size_t)(b * 256 + p0 + i)) * 1024 + c4;
        const float4 k = *(const float4*)(p.cache_nak + src);
        uint2 kv; kv.x = pk2(k.x, k.y); kv.y = pk2(k.z, k.w);
        *(uint2*)(p.NK + (kvb + p0 + i) * 1024 + c4) = kv;
        const float4 v = *(const float4*)(p.cache_nav + src);
        vv[0][i] = v.x; vv[1][i] = v.y; vv[2][i] = v.z; vv[3][i] = v.w;
      }
#pragma unroll
      for (int e = 0; e < 4; e++) {
        uint4 w0, w1;
        w0.x = pk2(vv[e][0], vv[e][1]); w0.y = pk2(vv[e][2], vv[e][3]); w0.z = pk2(vv[e][4], vv[e][5]); w0.w = pk2(vv[e][6], vv[e][7]);
        w1.x = pk2(vv[e][8], vv[e][9]); w1.y = pk2(vv[e][10], vv[e][11]); w1.z = pk2(vv[e][12], vv[e][13]); w1.w = pk2(vv[e][14], vv[e][15]);
        u16* dp = vtb + (size_t)(c4 + e) * 2304 + p0;
        *(uint4*)dp = w0; *(uint4*)(dp + 8) = w1;
      }
    }
  }
}

DI void ph_na_attn(const Params& p, char* smem) {
  const int wid = threadIdx.x >> 6, l31 = threadIdx.x & 31;
  for (int u = blockIdx.x; u < 512 + 2048; u += gridDim.x) {
    if (u < 512) {
      const int b = u >> 5, h = (u >> 1) & 15, qb = u & 1;
      const int t = b * 256 + qb * 128 + wid * 32 + l31;
      attn_dense_block<4, 0, 2>(smem, p.NQ + (size_t)t * 1024 + h * 64, p.NK + (size_t)(b * 256) * 1024 + h * 64, 1024, nullptr,
                               p.NVT + (size_t)b * (1024 * 256) + (size_t)h * 64 * 256, 256, 256,
                               p.SZ + (size_t)t * 1024 + h * 64, p.NAO + (size_t)t * 1024 + h * 64);
    } else {
      const int v = u - 512;
      const int b = v >> 9, h = (v >> 5) & 15, r = v & 31;
      attn_na_wave(p, b, h, r, wid);
    }
  }
}

template <int ph>
DI void run_phase(const Params& p, char* smem) {
  if constexpr (ph == 0) ph_prep(p, smem);
  else if constexpr (ph == 1) ph_h0(p);
  else if constexpr (ph == 2 || ph == 17) {
    constexpr int j = (ph == 2) ? 0 : 1;
    EpiPoolG1 e{p.U, p.SZ};
    gemm_phase(p.H, 1024, p.Wpin + (size_t)j * 2048 * 1024, 1024, 1024, 96, 16, smem, e);
  }
  else if constexpr (ph == 3 || ph == 18) ph_mix(p);
  else if constexpr (ph == 4 || ph == 19) ph_pool_g2(p, (ph == 4) ? 0 : 1, smem);
  else if constexpr (ph == 5) {
    EpiG3 e{p.x_prompt, p.x_sample, p.out, p.mod};
    gemm_phase(p.PM, 1024, p.Wpout, 1024, 1024, 96, 8, smem, e);
  }
  else if constexpr (ph == 20) {
    EpiG3 e{p.out, p.out + OUT_YS, p.out, p.mod + 3 * 5 * 3072};
    gemm_phase(p.PM, 1024, p.Wpout + (size_t)1024 * 1024, 1024, 1024, 96, 8, smem, e);
  }
  else if constexpr (ph == 6) ph_ln(p, 0);
  else if constexpr (ph == 21) ph_ln(p, 3);
  else if constexpr (ph == 7) {
    EpiMlaG1 e{p.RAW, p.KR, p.SZ, p.out + OUT_KR};
    gemm_phase(p.H, 1024, p.Wmin, 1024, 1024, 96, 15, smem, e);
  }
  else if constexpr (ph == 8) ph_mla_norm(p);
  else if constexpr (ph == 9) ph_mla_g2(p, smem);
  else if constexpr (ph == 10) ph_mla_attn(p, smem);
  else if constexpr (ph == 11) {
    EpiG3 e{p.out, p.out + OUT_YS, p.out, p.mod + 1 * 5 * 3072};
    gemm_phase(p.AO, 1024, p.Wmout, 1024, 1024, 96, 8, smem, e);
  }
  else if constexpr (ph == 12) ph_ln(p, 1);
  else if constexpr (ph == 13) ph_na_g1(p, smem);
  else if constexpr (ph == 14) ph_na_attn(p, smem);
  else if constexpr (ph == 15) {
    EpiG3 e{p.out, p.out + OUT_YS, p.out, p.mod + 2 * 5 * 3072};
    gemm_phase(p.NAO, 1024, p.Wnout, 1024, 1024, 96, 8, smem, e);
  }
  else if constexpr (ph == 16) ph_ln(p, 2);
}

#define RUN_PH(n) if (ph_lo <= (n) && (n) < ph_hi) { run_phase<n>(p, smem); if ((n) + 1 < ph_hi) xcd_barrier(xb); }

__global__ void __launch_bounds__(256, 2) mega(Params p, int ph_lo, int ph_hi) {
  __shared__ __attribute__((aligned(16))) char smem[SMEM_BYTES + 16];
  if (ph_lo < 0) { cg::this_grid().sync(); return; }
  const bool multi = (ph_hi - ph_lo) > 1;
  XcdBarrier xb; xb.bar = p.bar; xb.x = 0; xb.st = (volatile LAS unsigned*)(smem + SMEM_BYTES);
  if (multi) {
    if (threadIdx.x == 0) { *(uint4*)(smem + SMEM_BYTES) = make_uint4(0u, 0u, 0u, 0u); }
    __syncthreads();
    xb = xcd_barrier_post(p.bar, (volatile LAS unsigned*)(smem + SMEM_BYTES));
  }
  RUN_PH(0) RUN_PH(1) RUN_PH(2) RUN_PH(3) RUN_PH(4) RUN_PH(5) RUN_PH(6) RUN_PH(7) RUN_PH(8) RUN_PH(9) RUN_PH(10)
  RUN_PH(11) RUN_PH(12) RUN_PH(13) RUN_PH(14) RUN_PH(15) RUN_PH(16) RUN_PH(17) RUN_PH(18) RUN_PH(19) RUN_PH(20) RUN_PH(21)
}

extern "C" void kernel_launch(void* const* d_in, const int* in_sizes, int n_in, void* d_out, int out_size, void* d_ws, size_t ws_size,
                              hipStream_t stream) {
  Params p;
  memset(&p, 0, sizeof(p));
  const float* const* in = (const float* const*)d_in;
  p.x_prompt = in[0]; p.x_sample = in[1]; p.cache_ckv = in[2]; p.cache_kr = in[3]; p.cache_nak = in[4]; p.cache_nav = in[5];
  p.c = in[6]; p.c_ctx = in[7]; p.ada_w = in[8]; p.ada_b = in[9]; p.ln_g = in[10]; p.ln_b = in[11];
  const float* pool_w_in = in[12]; const float* pool_w_grp = in[13]; p.pool_scale = in[14]; const float* pool_w_out = in[15];
  const float* mla_w_in = in[16]; p.mla_q_norm = in[17]; const float* mla_w_uq = in[18]; p.mla_kv_norm = in[19];
  const float* mla_w_ukv = in[20]; const float* mla_w_out = in[21]; const float* na_w_in = in[22]; p.na_rpb = in[23];
  const float* na_w_out = in[24];
  p.out = (float*)d_out;

  char* ws = (char*)d_ws;
  size_t off = 0;
  auto take = [&](size_t bytes) { char* r = ws + off; off += (bytes + 255) & ~(size_t)255; return r; };
  p.bar = (unsigned*)take(XCD_BAR_WORDS * 4);
  p.mod = (float*)take((size_t)4 * 5 * 3072 * 4);
  p.Wpin = (u16*)take((size_t)2 * 2048 * 1024 * 2);
  p.Wgrp = (u16*)take((size_t)8 * 65536 * 2);
  p.Wpout = (u16*)take((size_t)2 * 1024 * 1024 * 2);
  p.Wmin = (u16*)take((size_t)1920 * 1024 * 2);
  p.Wuq = (u16*)take((size_t)1536 * 512 * 2);
  p.Wukv = (u16*)take((size_t)2048 * 256 * 2);
  p.Wmout = (u16*)take((size_t)1024 * 1024 * 2);
  p.Wnin = (u16*)take((size_t)4096 * 1024 * 2);
  p.Wnout = (u16*)take((size_t)1024 * 1024 * 2);
  p.H = (u16*)take((size_t)T * 1024 * 2);
  p.SZ = (u16*)take((size_t)T * 1024 * 2);
  const size_t arena0 = off;
  p.U = (u16*)take((size_t)T * 1024 * 2);
  p.MIX = (u16*)take((size_t)T * 1024 * 2);
  p.PM = (u16*)take((size_t)T * 1024 * 2);
  off = arena0;
  p.RAW = (float*)take((size_t)T * 768 * 4);
  p.AO = (u16*)p.RAW;
  p.CQN = (u16*)take((size_t)T * 512 * 2);
  p.CKVN = (u16*)take((size_t)KVR * 256 * 2);
  p.KR = (u16*)take((size_t)KVR * 64 * 2);
  p.Q = (u16*)take((size_t)T * 1536 * 2);
  p.KN = (u16*)take((size_t)KVR * 1024 * 2);
  p.VT = (u16*)take((size_t)KVR * 1024 * 2);
  off = arena0;
  p.NQ = (u16*)take((size_t)T * 1024 * 2);
  p.NK = (u16*)take((size_t)KVR * 1024 * 2);
  p.NVT = (u16*)take((size_t)KVR * 1024 * 2);
  p.NAO = (u16*)take((size_t)T * 1024 * 2);

  int nm = 0, tiles = 0;
  auto add = [&](const float* src, u16* dst, int K, int Nsrc, int Ndst) {
    p.mats[nm].src = src; p.mats[nm].dst = dst; p.mats[nm].K = K; p.mats[nm].Nsrc = Nsrc; p.mats[nm].Ndst = Ndst; p.mats[nm].tile0 = tiles;
    tiles += (K / 64) * (Ndst / 64); nm++;
  };
  for (int j = 0; j < 2; j++) add(pool_w_in + (size_t)j * 1024 * 2048, p.Wpin + (size_t)j * 2048 * 1024, 1024, 2048, 2048);
  for (int j = 0; j < 8; j++) add(pool_w_grp + (size_t)j * 65536, p.Wgrp + (size_t)j * 65536, 256, 256, 256);
  for (int j = 0; j < 2; j++) add(pool_w_out + (size_t)j * 1024 * 1024, p.Wpout + (size_t)j * 1024 * 1024, 1024, 1024, 1024);
  add(mla_w_in, p.Wmin, 1024, 1856, 1920);
  add(mla_w_uq, p.Wuq, 512, 1536, 1536);
  add(mla_w_ukv, p.Wukv, 256, 2048, 2048);
  add(mla_w_out, p.Wmout, 1024, 1024, 1024);
  add(na_w_in, p.Wnin, 1024, 4096, 4096);
  add(na_w_out, p.Wnout, 1024, 1024, 1024);
  p.nmat_tiles = tiles;

  (void)hipMemsetAsync(p.bar, 0, XCD_BAR_WORDS * 4, stream);
#if MULTI_LAUNCH
  for (int ph = 0; ph < NPHASE; ph++) hipLaunchKernelGGL(mega, dim3(512), dim3(256), 0, stream, p, ph, ph + 1);
#else
  static int grid_blocks = 0;
  if (!grid_blocks) {
    int dev = 0, cus = 0, per_cu = 0;
    hipGetDevice(&dev);
    hipDeviceGetAttribute(&cus, hipDeviceAttributeMultiprocessorCount, dev);
    hipOccupancyMaxActiveBlocksPerMultiprocessor(&per_cu, mega, 256, 0);
    if (per_cu > 2) per_cu = 2;
    if (per_cu < 1) per_cu = 1;
    grid_blocks = cus * per_cu;
  }
  int lo = 0, hi = NPHASE;
  void* args[] = {&p, &lo, &hi};
  hipError_t e = hipLaunchCooperativeKernel((void*)mega, dim3(grid_blocks), dim3(256), args, 0, stream);
  if (e != hipSuccess) fprintf(stderr, "cooperative launch failed: %s (grid %d)\n", hipGetErrorString(e), grid_blocks);
#endif
}
```

```cpp
#include <hip/hip_runtime.h>
#include <hip/hip_cooperative_groups.h>
#include <stdint.h>
#include <string.h>
#include <stdio.h>
namespace cg = cooperative_groups;

#ifndef MULTI_LAUNCH
#define MULTI_LAUNCH 0
#endif

typedef __attribute__((ext_vector_type(8))) short bf16x8;
typedef __attribute__((ext_vector_type(4))) float f32x4;
typedef __attribute__((ext_vector_type(16))) float f32x16;
typedef __attribute__((ext_vector_type(4))) uint32_t u32x4;
typedef unsigned short u16;
#define DI __device__ __forceinline__
#define MFMA32(a, b, c) __builtin_amdgcn_mfma_f32_32x32x16_bf16((a), (b), (c), 0, 0, 0)
#define MFMA16(a, b, c) __builtin_amdgcn_mfma_f32_16x16x32_bf16((a), (b), (c), 0, 0, 0)

constexpr int TC = 4096, TL = 8192, T = 12288;
constexpr int KVR = 4096 + 4 * 2304;
constexpr float LOG2E = 1.4426950408889634f;
constexpr float ALPHA = 1.681792830507429f;
constexpr float MLA_QS = 0.07216878364870323f * LOG2E;
constexpr float NA_QS = 0.125f * LOG2E;
constexpr int SMEM_BYTES = 73728;
constexpr int NPHASE = 22;

constexpr size_t OUT_YS = 4194304, OUT_CKV = 12582912, OUT_KR = 13631488, OUT_NAK = 13893632, OUT_NAV = 18087936;

struct MatDesc { const float* src; u16* dst; int K, Nsrc, Ndst, tile0; };

struct Params {
  const float *x_prompt, *x_sample, *cache_ckv, *cache_kr, *cache_nak, *cache_nav, *c, *c_ctx, *ada_w, *ada_b, *ln_g, *ln_b;
  const float *pool_scale, *mla_q_norm, *mla_kv_norm, *na_rpb;
  float* out;
  float* mod;
  u16 *H, *SZ;
  u16 *Wpin, *Wgrp, *Wpout, *Wmin, *Wuq, *Wukv, *Wmout, *Wnin, *Wnout;
  u16 *U, *MIX, *PM;
  float* RAW; u16 *AO, *CQN, *CKVN, *KR, *Q, *KN, *VT;
  u16 *NQ, *NK, *NVT, *NAO;
  unsigned* bar;
  MatDesc mats[18];
  int nmat_tiles; int pad0;
};

DI float bf2f(u16 v) { return __uint_as_float(((uint32_t)v) << 16); }
DI u16 f2bf(float x) { uint32_t u = __float_as_uint(x); u += 0x7fffu + ((u >> 16) & 1u); return (u16)(u >> 16); }
DI uint32_t pk2(float a, float b) { return (uint32_t)f2bf(a) | ((uint32_t)f2bf(b) << 16); }
DI float silu(float v) { return v / (1.f + __expf(-v)); }
DI int cond_of(int t) { return t < TC ? 0 : 1 + ((t - TC) >> 11); }
DI int kvrow_of(int t) { return t < TC ? t : TC + ((t - TC) >> 11) * 2304 + 256 + ((t - TC) & 2047); }
DI int perm16(int key) { const int k = key & 15; return (key & ~15) | (k & 3) | ((k >> 1) & 4) | ((k << 1) & 8); }
DI float wave_sum(float v) {
#pragma unroll
  for (int o = 32; o >= 1; o >>= 1) v += __shfl_xor(v, o);
  return v;
}

#define XB_TMO      128
#define XB_XCNT(j)  (256  + 64 * (j))
#define XB_XSUB(j)  (1280 + 64 * (j))
#define XB_XGEN(j)  (2304 + 64 * (j))
#define XB_TOP      3328
#define XB_TOPGEN   3392
#define XCD_BAR_WORDS 3456
#define XB_SPIN_CAP (1u << 22)
#define LAS __attribute__((address_space(3)))
DI unsigned xb_ld(unsigned* p) { return __hip_atomic_load(p, __ATOMIC_RELAXED, __HIP_MEMORY_SCOPE_AGENT); }
DI unsigned xb_add(unsigned* p, unsigned v) { return __hip_atomic_fetch_add(p, v, __ATOMIC_RELAXED, __HIP_MEMORY_SCOPE_AGENT); }
DI unsigned xb_xcc_id() { return (unsigned)__builtin_amdgcn_s_getreg((3 << 11) | 20) & 0xFu; }
#define XB_SPIN(cond, bar) do { unsigned _sp = 0; while (cond) { __builtin_amdgcn_s_sleep(1); \
    if ((++_sp & 255u) == 0u) { if (xb_ld(&(bar)[XB_TMO])) break; if (_sp > XB_SPIN_CAP) { atomicAdd(&(bar)[XB_TMO], 1u); break; } } } } while (0)
struct XcdBarrier { unsigned* bar; unsigned x; volatile LAS unsigned* st; };
DI XcdBarrier xcd_barrier_post(unsigned* bar, volatile LAS unsigned* st) {
  XcdBarrier b; b.bar = bar; b.x = xb_xcc_id(); b.st = st;
  if (threadIdx.x == 0) (void)xb_add(&bar[XB_XCNT(b.x)], 1u);
  return b;
}
DI void xcd_barrier_complete(unsigned* bar, unsigned x, unsigned& nloc, unsigned& nx) {
  const unsigned G = gridDim.x * gridDim.y * gridDim.z;
  unsigned sum, cnt, mine, sp = 0u;
  for (;;) {
    sum = 0u; cnt = 0u; mine = 0u;
#pragma unroll
    for (unsigned j = 0; j < 16; ++j) { const unsigned c = xb_ld(&bar[XB_XCNT(j)]); sum += c; cnt += (c > 0u) ? 1u : 0u; mine = (j == x) ? c : mine; }
    if (sum == G) break;
    __builtin_amdgcn_s_sleep(1);
    if ((++sp & 255u) == 0u) { if (xb_ld(&bar[XB_TMO])) break; if (sp > XB_SPIN_CAP) { atomicAdd(&bar[XB_TMO], 1u); break; } }
  }
  nloc = mine > 0u ? mine : 1u; nx = cnt > 0u ? cnt : 1u;
}
DI void xcd_barrier(const XcdBarrier& b) {
  asm volatile("s_waitcnt vmcnt(0)" ::: "memory");
  __syncthreads();
  if (threadIdx.x == 0) {
    unsigned* bar = b.bar;
    __builtin_amdgcn_s_waitcnt(0);
    unsigned nloc = b.st[0], nx = b.st[1];
    if (nloc == 0u) { xcd_barrier_complete(bar, b.x, nloc, nx); b.st[0] = nloc; b.st[1] = nx; }
    const unsigned old = xb_add(&bar[XB_XSUB(b.x)], 1u);
    const unsigned gen = old / nloc;
    if (old + 1u == (gen + 1u) * nloc) {
      __builtin_amdgcn_fence(__ATOMIC_RELEASE, "agent");
      asm volatile("s_waitcnt vmcnt(0)" ::: "memory");
      const unsigned og = xb_add(&bar[XB_TOP], 1u);
      const unsigned tg = og / nx;
      if (og + 1u == (tg + 1u) * nx) xb_add(&bar[XB_TOPGEN], 1u);
      else XB_SPIN(xb_ld(&bar[XB_TOPGEN]) == tg, bar);
      __builtin_amdgcn_fence(__ATOMIC_ACQUIRE, "agent");
      xb_add(&bar[XB_XGEN(b.x)], 1u);
      asm volatile("s_waitcnt vmcnt(0)" ::: "memory");
    } else {
      XB_SPIN(xb_ld(&bar[XB_XGEN(b.x)]) == gen, bar);
      __builtin_amdgcn_fence(__ATOMIC_ACQUIRE, "agent");
      asm volatile("s_waitcnt vmcnt(0)" ::: "memory");
    }
  }
  __syncthreads();
}

template <class Epi>
DI void gemm_tile(const u16* __restrict__ A, int lda, const u16* __restrict__ Bt, int ldb, int K, int m0, int n0, int nout_off,
                  char* smem, const Epi& epi) {
  const int tid = threadIdx.x, lane = tid & 63, wid = tid >> 6;
  const int wm = wid >> 1, wn = wid & 1, l31 = lane & 31, lh = lane >> 5;
  u16* As = (u16*)smem;
  u16* Bs = As + 2 * 128 * 72;
  const int srow = tid >> 3, scc = (tid & 7) * 8;
  const u16* ag = A + (size_t)(m0 + srow) * lda + scc;
  const u16* bg = Bt + (size_t)(n0 + srow) * ldb + scc;
  uint4 ra[4], rb[4];
  f32x16 acc[2][2];
#pragma unroll
  for (int i = 0; i < 2; i++)
#pragma unroll
    for (int j = 0; j < 2; j++)
#pragma unroll
      for (int r = 0; r < 16; r++) acc[i][j][r] = 0.f;
  __syncthreads();
#pragma unroll
  for (int i = 0; i < 4; i++) {
    ra[i] = *(const uint4*)(ag + (size_t)(32 * i) * lda);
    rb[i] = *(const uint4*)(bg + (size_t)(32 * i) * ldb);
  }
#pragma unroll
  for (int i = 0; i < 4; i++) {
    *(uint4*)(As + (srow + 32 * i) * 72 + scc) = ra[i];
    *(uint4*)(Bs + (srow + 32 * i) * 72 + scc) = rb[i];
  }
  __syncthreads();
  const int nk = K >> 6;
  for (int kt = 0; kt < nk; kt++) {
    const int buf = kt & 1;
    if (kt + 1 < nk) {
#pragma unroll
      for (int i = 0; i < 4; i++) {
        ra[i] = *(const uint4*)(ag + (size_t)(32 * i) * lda + (kt + 1) * 64);
        rb[i] = *(const uint4*)(bg + (size_t)(32 * i) * ldb + (kt + 1) * 64);
      }
    }
    const u16* as = As + buf * (128 * 72) + (wm * 64 + l31) * 72 + lh * 8;
    const u16* bs = Bs + buf * (128 * 72) + (wn * 64 + l31) * 72 + lh * 8;
#pragma unroll
    for (int ks = 0; ks < 4; ks++) {
      bf16x8 a0 = *(const bf16x8*)(as + ks * 16);
      bf16x8 a1 = *(const bf16x8*)(as + 32 * 72 + ks * 16);
      bf16x8 b0 = *(const bf16x8*)(bs + ks * 16);
      bf16x8 b1 = *(const bf16x8*)(bs + 32 * 72 + ks * 16);
      acc[0][0] = MFMA32(b0, a0, acc[0][0]);
      acc[0][1] = MFMA32(b1, a0, acc[0][1]);
      acc[1][0] = MFMA32(b0, a1, acc[1][0]);
      acc[1][1] = MFMA32(b1, a1, acc[1][1]);
    }
    if (kt + 1 < nk) {
      u16* aw = As + (buf ^ 1) * (128 * 72);
      u16* bw = Bs + (buf ^ 1) * (128 * 72);
#pragma unroll
      for (int i = 0; i < 4; i++) {
        *(uint4*)(aw + (srow + 32 * i) * 72 + scc) = ra[i];
        *(uint4*)(bw + (srow + 32 * i) * 72 + scc) = rb[i];
      }
    }
    __syncthreads();
  }
#pragma unroll
  for (int i = 0; i < 2; i++)
#pragma unroll
    for (int j = 0; j < 2; j++)
      epi(m0 + wm * 64 + i * 32 + l31, nout_off + n0 + wn * 64 + j * 32, lh, acc[i][j]);
}

DI void rope_pair(float x1, float x2, int i, float pos, float& o1, float& o2) {
  const float inv = exp2f(-(float)i * (13.287712379549449f / 16.f));
  const float ang = pos * inv;
  const float c = __cosf(ang), s = __sinf(ang);
  o1 = x1 * c - x2 * s;
  o2 = x1 * s + x2 * c;
}

struct EpiPoolG1 {
  u16 *U, *SZ;
  DI void operator()(int m, int nb, int lh, const f32x16& a) const {
#pragma unroll
    for (int g = 0; g < 4; g++) {
      const int n = nb + 8 * g + 4 * lh;
      if (nb < 1024) {
        uint2 v; v.x = pk2(a[4 * g], a[4 * g + 1]); v.y = pk2(a[4 * g + 2], a[4 * g + 3]);
        *(uint2*)(U + (size_t)m * 1024 + n) = v;
      } else {
        uint2 v; v.x = pk2(silu(a[4 * g]), silu(a[4 * g + 1])); v.y = pk2(silu(a[4 * g + 2]), silu(a[4 * g + 3]));
        *(uint2*)(SZ + (size_t)m * 1024 + n - 1024) = v;
      }
    }
  }
};
struct EpiPoolG2 {
  u16* PM; const u16* SZ; const float* scale;
  DI void operator()(int m, int nb, int lh, const f32x16& a) const {
#pragma unroll
    for (int g = 0; g < 4; g++) {
      const int n = nb + 8 * g + 4 * lh;
      const uint2 z = *(const uint2*)(SZ + (size_t)m * 1024 + n);
      const float4 sc = *(const float4*)(scale + n);
      uint2 v;
      v.x = pk2(a[4 * g] * sc.x * bf2f((u16)(z.x & 0xffff)), a[4 * g + 1] * sc.y * bf2f((u16)(z.x >> 16)));
      v.y = pk2(a[4 * g + 2] * sc.z * bf2f((u16)(z.y & 0xffff)), a[4 * g + 3] * sc.w * bf2f((u16)(z.y >> 16)));
      *(uint2*)(PM + (size_t)m * 1024 + n) = v;
    }
  }
};
struct EpiG3 {
  const float *xp, *xs;
  float* out; const float* mod_layer;
  DI void operator()(int m, int nb, int lh, const f32x16& a) const {
    const float* xr = (m < TC) ? xp + (size_t)m * 1024 : xs + (size_t)(m - TC) * 1024;
    const float* gate = mod_layer + cond_of(m) * 3072 + 2048;
#pragma unroll
    for (int g = 0; g < 4; g++) {
      const int n = nb + 8 * g + 4 * lh;
      const float4 x = *(const float4*)(xr + n);
      const float4 gt = *(const float4*)(gate + n);
      float4 r;
      r.x = ALPHA * x.x + gt.x * a[4 * g]; r.y = ALPHA * x.y + gt.y * a[4 * g + 1];
      r.z = ALPHA * x.z + gt.z * a[4 * g + 2]; r.w = ALPHA * x.w + gt.w * a[4 * g + 3];
      *(float4*)(out + (size_t)m * 1024 + n) = r;
    }
  }
};
struct EpiMlaG1 {
  float* RAW; u16* KR; u16* SZ; float* st_kr;
  DI void operator()(int m, int nb, int lh, const f32x16& a) const {
    if (nb >= 1856) return;
    if (nb < 768) {
#pragma unroll
      for (int g = 0; g < 4; g++) {
        const int n = nb + 8 * g + 4 * lh;
        float4 r; r.x = a[4 * g]; r.y = a[4 * g + 1]; r.z = a[4 * g + 2]; r.w = a[4 * g + 3];
        *(float4*)(RAW + (size_t)m * 768 + n) = r;
      }
    } else if (nb < 832) {
      const int off = nb - 768;
      const bool lat = m >= TC;
      const int tt = (m - TC) & 2047;
      const float pos = (off == 0) ? (float)(tt >> 6) : (float)(tt & 63);
      const size_t kr = (size_t)kvrow_of(m) * 64 + off;
#pragma unroll
      for (int g = 0; g < 2; g++) {
        float o1[4], o2[4];
#pragma unroll
        for (int e = 0; e < 4; e++) {
          const int i = 8 * g + 4 * lh + e;
          const float x1 = a[4 * g + e], x2 = a[4 * (g + 2) + e];
          if (lat) rope_pair(x1, x2, i, pos, o1[e], o2[e]); else { o1[e] = x1; o2[e] = x2; }
        }
        const int i0 = 8 * g + 4 * lh;
        if (!lat) {
          float4 r1; r1.x = o1[0]; r1.y = o1[1]; r1.z = o1[2]; r1.w = o1[3];
          float4 r2; r2.x = o2[0]; r2.y = o2[1]; r2.z = o2[2]; r2.w = o2[3];
          *(float4*)(st_kr + (size_t)m * 64 + off + i0) = r1;
          *(float4*)(st_kr + (size_t)m * 64 + off + i0 + 16) = r2;
        }
        uint2 v1; v1.x = pk2(o1[0], o1[1]); v1.y = pk2(o1[2], o1[3]);
        uint2 v2; v2.x = pk2(o2[0], o2[1]); v2.y = pk2(o2[2], o2[3]);
        *(uint2*)(KR + kr + i0) = v1;
        *(uint2*)(KR + kr + i0 + 16) = v2;
      }
    } else {
#pragma unroll
      for (int g = 0; g < 4; g++) {
        const int n = nb + 8 * g + 4 * lh - 832;
        uint2 v; v.x = pk2(silu(a[4 * g]), silu(a[4 * g + 1])); v.y = pk2(silu(a[4 * g + 2]), silu(a[4 * g + 3]));
        *(uint2*)(SZ + (size_t)m * 1024 + n) = v;
      }
    }
  }
};
struct EpiMlaQ {
  u16* Q;
  DI void operator()(int m, int nb, int lh, const f32x16& a) const {
    const int head = nb / 192, off = nb - head * 192;
    u16* qr = Q + (size_t)m * 1536 + nb;
    if (off < 128) {
#pragma unroll
      for (int g = 0; g < 4; g++) {
        uint2 v; v.x = pk2(a[4 * g] * MLA_QS, a[4 * g + 1] * MLA_QS); v.y = pk2(a[4 * g + 2] * MLA_QS, a[4 * g + 3] * MLA_QS);
        *(uint2*)(qr + 8 * g + 4 * lh) = v;
      }
    } else {
      const bool lat = m >= TC;
      const int tt = (m - TC) & 2047;
      const float pos = (off == 128) ? (float)(tt >> 6) : (float)(tt & 63);
#pragma unroll
      for (int g = 0; g < 2; g++) {
        float o1[4], o2[4];
#pragma unroll
        for (int e = 0; e < 4; e++) {
          const int i = 8 * g + 4 * lh + e;
          const float x1 = a[4 * g + e], x2 = a[4 * (g + 2) + e];
          if (lat) rope_pair(x1, x2, i, pos, o1[e], o2[e]); else { o1[e] = x1; o2[e] = x2; }
        }
        const int i0 = 8 * g + 4 * lh;
        uint2 v1; v1.x = pk2(o1[0] * MLA_QS, o1[1] * MLA_QS); v1.y = pk2(o1[2] * MLA_QS, o1[3] * MLA_QS);
        uint2 v2; v2.x = pk2(o2[0] * MLA_QS, o2[1] * MLA_QS); v2.y = pk2(o2[2] * MLA_QS, o2[3] * MLA_QS);
        *(uint2*)(qr + i0) = v1;
        *(uint2*)(qr + i0 + 16) = v2;
      }
    }
  }
};
struct EpiMlaKV {
  u16 *KN, *VT;
  DI void operator()(int m, int nb, int lh, const f32x16& a) const {
    const int head = nb >> 8, off = nb & 255;
    if (off < 128) {
#pragma unroll
      for (int g = 0; g < 4; g++) {
        uint2 v; v.x = pk2(a[4 * g], a[4 * g + 1]); v.y = pk2(a[4 * g + 2], a[4 * g + 3]);
        *(uint2*)(KN + (size_t)m * 1024 + head * 128 + off + 8 * g + 4 * lh) = v;
      }
    } else {
      size_t base; int Lk, key;
      if (m < TC) { base = (size_t)(m >> 8) * (8 * 128 * 256); Lk = 256; key = m & 255; }
      else { const int r2 = m - TC; const int b = r2 / 2304; key = r2 - b * 2304; Lk = 2304; base = (size_t)16 * 8 * 128 * 256 + (size_t)b * (8 * 128 * 2304); }
      u16* vp = VT + base + (size_t)(head * 128 + off - 128) * Lk + perm16(key);
#pragma unroll
      for (int g = 0; g < 4; g++)
#pragma unroll
        for (int e = 0; e < 4; e++) vp[(size_t)(8 * g + 4 * lh + e) * Lk] = f2bf(a[4 * g + e]);
    }
  }
};
struct EpiNaG1 {
  u16 *NQ, *NK, *NVT, *SZ; float *st_k, *st_v;
  DI void operator()(int m, int nb, int lh, const f32x16& a) const {
    if (nb < 1024) {
#pragma unroll
      for (int g = 0; g < 4; g++) {
        uint2 v; v.x = pk2(a[4 * g] * NA_QS, a[4 * g + 1] * NA_QS); v.y = pk2(a[4 * g + 2] * NA_QS, a[4 * g + 3] * NA_QS);
        *(uint2*)(NQ + (size_t)m * 1024 + nb + 8 * g + 4 * lh) = v;
      }
    } else if (nb < 2048) {
      const size_t kr = (size_t)kvrow_of(m) * 1024 + (nb - 1024);
#pragma unroll
      for (int g = 0; g < 4; g++) {
        uint2 v; v.x = pk2(a[4 * g], a[4 * g + 1]); v.y = pk2(a[4 * g + 2], a[4 * g + 3]);
        *(uint2*)(NK + kr + 8 * g + 4 * lh) = v;
        if (m < TC) { float4 r; r.x = a[4 * g]; r.y = a[4 * g + 1]; r.z = a[4 * g + 2]; r.w = a[4 * g + 3];
          *(float4*)(st_k + (size_t)m * 1024 + (nb - 1024) + 8 * g + 4 * lh) = r; }
      }
    } else if (nb < 3072) {
      const int c0 = nb - 2048;
      size_t base; int Lk, key;
      if (m < TC) { base = (size_t)(m >> 8) * (1024 * 256); Lk = 256; key = perm16(m & 255); }
      else { const int b = (m - TC) >> 11; key = 256 + ((m - TC) & 2047); Lk = 2304; base = (size_t)16 * 1024 * 256 + (size_t)b * (1024 * 2304); }
      u16* vp = NVT + base + (size_t)c0 * Lk + key;
#pragma unroll
      for (int g = 0; g < 4; g++) {
#pragma unroll
        for (int e = 0; e < 4; e++) vp[(size_t)(8 * g + 4 * lh + e) * Lk] = f2bf(a[4 * g + e]);
        if (m < TC) { float4 r; r.x = a[4 * g]; r.y = a[4 * g + 1]; r.z = a[4 * g + 2]; r.w = a[4 * g + 3];
          *(float4*)(st_v + (size_t)m * 1024 + c0 + 8 * g + 4 * lh) = r; }
      }
    } else {
#pragma unroll
      for (int g = 0; g < 4; g++) {
        uint2 v; v.x = pk2(silu(a[4 * g]), silu(a[4 * g + 1])); v.y = pk2(silu(a[4 * g + 2]), silu(a[4 * g + 3]));
        *(uint2*)(SZ + (size_t)m * 1024 + (nb - 3072) + 8 * g + 4 * lh) = v;
      }
    }
  }
};

template <int NSA, int NSB, int NDT>
DI void attn_dense_wave(const u16* __restrict__ qrow, const u16* __restrict__ kA, int kAstride, const u16* __restrict__ kB,
                        const u16* __restrict__ vt, int Lk, int nkeys, const u16* __restrict__ szrow, u16* __restrict__ orow) {
  const int lane = threadIdx.x & 63, l31 = lane & 31, lh = lane >> 5;
  bf16x8 qf[NSA + NSB];
#pragma unroll
  for (int s = 0; s < NSA + NSB; s++) qf[s] = *(const bf16x8*)(qrow + s * 16 + lh * 8);
  f32x16 o[NDT];
#pragma unroll
  for (int d = 0; d < NDT; d++)
#pragma unroll
    for (int r = 0; r < 16; r++) o[d][r] = 0.f;
  float m = -1e30f, l = 0.f;
  for (int k0 = 0; k0 < nkeys; k0 += 32) {
    f32x16 sa;
#pragma unroll
    for (int r = 0; r < 16; r++) sa[r] = 0.f;
    const u16* kp = kA + (size_t)(k0 + l31) * kAstride + lh * 8;
#pragma unroll
    for (int s = 0; s < NSA; s++) sa = MFMA32(*(const bf16x8*)(kp + s * 16), qf[s], sa);
    if (NSB > 0) {
      const u16* kp2 = kB + (size_t)(k0 + l31) * 64 + lh * 8;
#pragma unroll
      for (int s = 0; s < NSB; s++) sa = MFMA32(*(const bf16x8*)(kp2 + s * 16), qf[NSA + s], sa);
    }
    float mx = sa[0];
#pragma unroll
    for (int r = 1; r < 16; r++) mx = fmaxf(mx, sa[r]);
    mx = fmaxf(mx, __shfl_xor(mx, 32));
    const float mn = fmaxf(m, mx);
    const float alpha = exp2f(m - mn);
    m = mn;
    float ps = 0.f;
#pragma unroll
    for (int r = 0; r < 16; r++) { sa[r] = exp2f(sa[r] - mn); ps += sa[r]; }
    l = l * alpha + ps;
#pragma unroll
    for (int d = 0; d < NDT; d++)
#pragma unroll
      for (int r = 0; r < 16; r++) o[d][r] *= alpha;
#pragma unroll
    for (int sp = 0; sp < 2; sp++) {
      u32x4 pw;
      pw[0] = pk2(sa[8 * sp + 0], sa[8 * sp + 1]); pw[1] = pk2(sa[8 * sp + 2], sa[8 * sp + 3]);
      pw[2] = pk2(sa[8 * sp + 4], sa[8 * sp + 5]); pw[3] = pk2(sa[8 * sp + 6], sa[8 * sp + 7]);
      const bf16x8 pf = __builtin_bit_cast(bf16x8, pw);
#pragma unroll
      for (int d = 0; d < NDT; d++) {
        const u16* vp = vt + (size_t)(d * 32 + l31) * Lk + k0 + 16 * sp + 4 * lh;
        const uint2 lo = *(const uint2*)vp, hi = *(const uint2*)(vp + 8);
        u32x4 vw; vw[0] = lo.x; vw[1] = lo.y; vw[2] = hi.x; vw[3] = hi.y;
        o[d] = MFMA32(__builtin_bit_cast(bf16x8, vw), pf, o[d]);
      }
    }
  }
  l += __shfl_xor(l, 32);
  const float inv = 1.f / l;
#pragma unroll
  for (int d = 0; d < NDT; d++)
#pragma unroll
    for (int g = 0; g < 4; g++) {
      const int d0 = d * 32 + 8 * g + 4 * lh;
      const uint2 z = *(const uint2*)(szrow + d0);
      uint2 v;
      v.x = pk2(o[d][4 * g] * inv * bf2f((u16)(z.x & 0xffff)), o[d][4 * g + 1] * inv * bf2f((u16)(z.x >> 16)));
      v.y = pk2(o[d][4 * g + 2] * inv * bf2f((u16)(z.y & 0xffff)), o[d][4 * g + 3] * inv * bf2f((u16)(z.y >> 16)));
      *(uint2*)(orow + d0) = v;
    }
}


template <int NSA, int NSB, int NDT>
DI void attn_dense_block(char* smem, const u16* __restrict__ qrow, const u16* __restrict__ kA, int kAstride, const u16* __restrict__ kB,
                         const u16* __restrict__ vt, int Lk, int nkeys, const u16* __restrict__ szrow, u16* __restrict__ orow) {
  constexpr int NS = NSA + NSB, DK = 16 * NS, KST = DK + 8, DV = 32 * NDT, VST = 72;
  constexpr int CA = NSA * 2, CB = NSB * 2;
  constexpr int NLA = 64 * CA / 256, NLB = 64 * CB / 256, NLV = DV * 8 / 256;
  const int tid = threadIdx.x, lane = tid & 63, l31 = lane & 31, lh = lane >> 5;
  u16* Ks = (u16*)smem;
  u16* Vs = Ks + 64 * KST;
  u32x4 ra[NLA], rb[NLB > 0 ? NLB : 1], rv[NLV];
  bf16x8 qf[NS];
#pragma unroll
  for (int s = 0; s < NS; s++) qf[s] = *(const bf16x8*)(qrow + s * 16 + lh * 8);
  f32x16 o[NDT];
#pragma unroll
  for (int d = 0; d < NDT; d++)
#pragma unroll
    for (int r = 0; r < 16; r++) o[d][r] = 0.f;
  float m = -1e30f, l = 0.f;

    {
#pragma unroll
      for (int i = 0; i < NLA; i++) { const int c = tid + 256 * i; const int row = c / CA, cc = c % CA;
        ra[i] = *(const u32x4*)(kA + (size_t)((0) + row) * kAstride + cc * 8); }
      if constexpr (NLB > 0) {
#pragma unroll
        for (int i = 0; i < NLB; i++) { const int c = tid + 256 * i; const int row = c / CB, cc = c % CB;
          rb[i] = *(const u32x4*)(kB + (size_t)((0) + row) * 64 + cc * 8); }
      }
#pragma unroll
      for (int i = 0; i < NLV; i++) { const int c = tid + 256 * i; const int row = c >> 3, cc = c & 7;
        rv[i] = *(const u32x4*)(vt + (size_t)row * Lk + (0) + cc * 8); }
    }
  __syncthreads();
    {
#pragma unroll
      for (int i = 0; i < NLA; i++) { const int c = tid + 256 * i; const int row = c / CA, cc = c % CA;
        *(u32x4*)(Ks + row * KST + cc * 8) = ra[i]; }
      if constexpr (NLB > 0) {
#pragma unroll
        for (int i = 0; i < NLB; i++) { const int c = tid + 256 * i; const int row = c / CB, cc = c % CB;
          *(u32x4*)(Ks + row * KST + NSA * 16 + cc * 8) = rb[i]; }
      }
#pragma unroll
      for (int i = 0; i < NLV; i++) { const int c = tid + 256 * i; const int row = c >> 3, cc = c & 7;
        *(u32x4*)(Vs + row * VST + cc * 8) = rv[i]; }
    }
  __syncthreads();
  for (int k0 = 0; k0 < nkeys; k0 += 64) {
    const bool more = (k0 + 64) < nkeys;
    const int kn = more ? k0 + 64 : k0;
    {
#pragma unroll
      for (int i = 0; i < NLA; i++) { const int c = tid + 256 * i; const int row = c / CA, cc = c % CA;
        ra[i] = *(const u32x4*)(kA + (size_t)(kn + row) * kAstride + cc * 8); }
      if constexpr (NLB > 0) {
#pragma unroll
        for (int i = 0; i < NLB; i++) { const int c = tid + 256 * i; const int row = c / CB, cc = c % CB;
          rb[i] = *(const u32x4*)(kB + (size_t)(kn + row) * 64 + cc * 8); }
      }
#pragma unroll
      for (int i = 0; i < NLV; i++) { const int c = tid + 256 * i; const int row = c >> 3, cc = c & 7;
        rv[i] = *(const u32x4*)(vt + (size_t)row * Lk + kn + cc * 8); }
    }
#pragma unroll
    for (int hh = 0; hh < 2; hh++) {
      f32x16 s0;
#pragma unroll
      for (int r = 0; r < 16; r++) s0[r] = 0.f;
      const u16* kp = Ks + (hh * 32 + l31) * KST + lh * 8;
#pragma unroll
      for (int s = 0; s < NS; s++) s0 = MFMA32(*(const bf16x8*)(kp + s * 16), qf[s], s0);
      float mx = s0[0];
#pragma unroll
      for (int r = 1; r < 16; r++) mx = fmaxf(mx, s0[r]);
      mx = fmaxf(mx, __shfl_xor(mx, 32));
      if (__any(mx > m + 8.f)) {
        const float mn = fmaxf(m, mx);
        const float alpha = exp2f(m - mn);
        m = mn;
        l *= alpha;
#pragma unroll
        for (int d = 0; d < NDT; d++)
#pragma unroll
          for (int r = 0; r < 16; r++) o[d][r] *= alpha;
      }
      float ps = 0.f;
#pragma unroll
      for (int r = 0; r < 16; r++) { s0[r] = exp2f(s0[r] - m); ps += s0[r]; }
      l += ps;
      const u16* vp = Vs + l31 * VST + hh * 32 + lh * 8;
#pragma unroll
      for (int sp = 0; sp < 2; sp++) {
        u32x4 pw;
        pw[0] = pk2(s0[8 * sp + 0], s0[8 * sp + 1]); pw[1] = pk2(s0[8 * sp + 2], s0[8 * sp + 3]);
        pw[2] = pk2(s0[8 * sp + 4], s0[8 * sp + 5]); pw[3] = pk2(s0[8 * sp + 6], s0[8 * sp + 7]);
        const bf16x8 pf = __builtin_bit_cast(bf16x8, pw);
#pragma unroll
        for (int d = 0; d < NDT; d++) o[d] = MFMA32(*(const bf16x8*)(vp + d * 32 * VST + sp * 16), pf, o[d]);
      }
    }
    __syncthreads();
    if (more)
    {
#pragma unroll
      for (int i = 0; i < NLA; i++) { const int c = tid + 256 * i; const int row = c / CA, cc = c % CA;
        *(u32x4*)(Ks + row * KST + cc * 8) = ra[i]; }
      if constexpr (NLB > 0) {
#pragma unroll
        for (int i = 0; i < NLB; i++) { const int c = tid + 256 * i; const int row = c / CB, cc = c % CB;
          *(u32x4*)(Ks + row * KST + NSA * 16 + cc * 8) = rb[i]; }
      }
#pragma unroll
      for (int i = 0; i < NLV; i++) { const int c = tid + 256 * i; const int row = c >> 3, cc = c & 7;
        *(u32x4*)(Vs + row * VST + cc * 8) = rv[i]; }
    }
    __syncthreads();
  }
  l += __shfl_xor(l, 32);
  const float inv = 1.f / l;
#pragma unroll
  for (int d = 0; d < NDT; d++)
#pragma unroll
    for (int g = 0; g < 4; g++) {
      const int d0 = d * 32 + 8 * g + 4 * lh;
      const uint2 z = *(const uint2*)(szrow + d0);
      uint2 v;
      v.x = pk2(o[d][4 * g] * inv * bf2f((u16)(z.x & 0xffff)), o[d][4 * g + 1] * inv * bf2f((u16)(z.x >> 16)));
      v.y = pk2(o[d][4 * g + 2] * inv * bf2f((u16)(z.y & 0xffff)), o[d][4 * g + 3] * inv * bf2f((u16)(z.y >> 16)));
      *(uint2*)(orow + d0) = v;
    }
}

DI void attn_na_wave(const Params& p, int b, int h, int r, int j) {
  const int lane = threadIdx.x & 63, l15 = lane & 15, q4 = lane >> 4;
  const int t = TC + b * 2048 + r * 64 + j * 16 + l15;
  const u16* qrow = p.NQ + (size_t)t * 1024 + h * 64;
  const bf16x8 qf0 = *(const bf16x8*)(qrow + q4 * 8);
  const bf16x8 qf1 = *(const bf16x8*)(qrow + 32 + q4 * 8);
  const int rs = min(max(r - 4, 0), 24);
  const int bstart = min(max(j * 16 - 8, 0), 32);
  const int c = j * 16 + l15;
  const int cstart = min(max(c - 8, 0), 48);
  const u16* kb = p.NK + (size_t)(TC + b * 2304) * 1024 + h * 64;
  const u16* vb = p.NVT + (size_t)16 * 1024 * 256 + (size_t)b * (1024 * 2304) + (size_t)(h * 64) * 2304;
  const float* rp = p.na_rpb + h * 465;
  f32x4 o[4];
#pragma unroll
  for (int d = 0; d < 4; d++) { o[d][0] = 0.f; o[d][1] = 0.f; o[d][2] = 0.f; o[d][3] = 0.f; }
  float m = -1e30f, l = 0.f;
  const int krow0 = 8 * (l15 >> 2) + (l15 & 3);
  for (int cg4 = 0; cg4 < 4; cg4++) {
    bf16x8 kf[4][4];
    bf16x8 vf[4][4];
#pragma unroll
    for (int c4 = 0; c4 < 4; c4++) {
      const int ch = cg4 * 4 + c4;
      const int key0 = ch < 8 ? ch * 32 : 256 + (rs + ch - 8) * 64 + bstart;
      const u16* kp = kb + (size_t)(key0 + krow0) * 1024 + q4 * 8;
      kf[c4][0] = *(const bf16x8*)(kp);
      kf[c4][1] = *(const bf16x8*)(kp + 32);
      kf[c4][2] = *(const bf16x8*)(kp + 4 * 1024);
      kf[c4][3] = *(const bf16x8*)(kp + 4 * 1024 + 32);
#pragma unroll
      for (int d = 0; d < 4; d++) vf[c4][d] = *(const bf16x8*)(vb + (size_t)(d * 16 + l15) * 2304 + key0 + q4 * 8);
    }
#pragma unroll
    for (int c4 = 0; c4 < 4; c4++) {
      const int ch = cg4 * 4 + c4;
      f32x4 s0 = {0.f, 0.f, 0.f, 0.f}, s1 = {0.f, 0.f, 0.f, 0.f};
      s0 = MFMA16(kf[c4][0], qf0, s0);
      s0 = MFMA16(kf[c4][1], qf1, s0);
      s1 = MFMA16(kf[c4][2], qf0, s1);
      s1 = MFMA16(kf[c4][3], qf1, s1);
      if (cg4 >= 2) {
        const int dr = rs + (ch - 8) - r + 7;
#pragma unroll
        for (int i = 0; i < 4; i++) {
          const int kc0 = bstart + q4 * 8 + i, kc1 = kc0 + 4;
          const bool v0 = (kc0 >= cstart) && (kc0 < cstart + 16);
          const bool v1 = (kc1 >= cstart) && (kc1 < cstart + 16);
          const int dc0 = min(max(kc0 - c + 15, 0), 30), dc1 = min(max(kc1 - c + 15, 0), 30);
          const float b0 = rp[dr * 31 + dc0] * LOG2E, b1 = rp[dr * 31 + dc1] * LOG2E;
          s0[i] = v0 ? s0[i] + b0 : -1e30f;
          s1[i] = v1 ? s1[i] + b1 : -1e30f;
        }
      }
      float mx = fmaxf(fmaxf(fmaxf(s0[0], s0[1]), fmaxf(s0[2], s0[3])), fmaxf(fmaxf(s1[0], s1[1]), fmaxf(s1[2], s1[3])));
      mx = fmaxf(mx, __shfl_xor(mx, 16));
      mx = fmaxf(mx, __shfl_xor(mx, 32));
      const float mn = fmaxf(m, mx);
      const float alpha = exp2f(m - mn);
      m = mn;
      float ps = 0.f;
#pragma unroll
      for (int i = 0; i < 4; i++) { s0[i] = exp2f(s0[i] - mn); s1[i] = exp2f(s1[i] - mn); ps += s0[i] + s1[i]; }
      l = l * alpha + ps;
      u32x4 pw; pw[0] = pk2(s0[0], s0[1]); pw[1] = pk2(s0[2], s0[3]); pw[2] = pk2(s1[0], s1[1]); pw[3] = pk2(s1[2], s1[3]);
      const bf16x8 pf = __builtin_bit_cast(bf16x8, pw);
#pragma unroll
      for (int d = 0; d < 4; d++) {
        o[d][0] *= alpha; o[d][1] *= alpha; o[d][2] *= alpha; o[d][3] *= alpha;
        o[d] = MFMA16(vf[c4][d], pf, o[d]);
      }
    }
  }
  l += __shfl_xor(l, 16);
  l += __shfl_xor(l, 32);
  const float inv = 1.f / l;
  const u16* szrow = p.SZ + (size_t)t * 1024 + h * 64;
  u16* orow = p.NAO + (size_t)t * 1024 + h * 64;
#pragma unroll
  for (int d = 0; d < 4; d++) {
    const int d0 = d * 16 + q4 * 4;
    const uint2 z = *(const uint2*)(szrow + d0);
    uint2 v;
    v.x = pk2(o[d][0] * inv * bf2f((u16)(z.x & 0xffff)), o[d][1] * inv * bf2f((u16)(z.x >> 16)));
    v.y = pk2(o[d][2] * inv * bf2f((u16)(z.y & 0xffff)), o[d][3] * inv * bf2f((u16)(z.y >> 16)));
    *(uint2*)(orow + d0) = v;
  }
}

DI void ph_prep(const Params& p, char* smem) {
  const int tid = threadIdx.x;
  const int ntr = p.nmat_tiles;
  const int ntot = ntr + 192;
  for (int tile = blockIdx.x; tile < ntot; tile += gridDim.x) {
    __syncthreads();
    if (tile < ntr) {
      int mi = 0;
      for (int i = 1; i < 18; i++) if (tile >= p.mats[i].tile0) mi = i;
      const float* src = p.mats[mi].src; u16* dst = p.mats[mi].dst;
      const int K = p.mats[mi].K, Nsrc = p.mats[mi].Nsrc, Ndst = p.mats[mi].Ndst;
      const int lt = tile - p.mats[mi].tile0;
      const int ntn = Ndst >> 6;
      const int kt = lt / ntn, nt = lt - kt * ntn;
      float* ts = (float*)smem;
#pragma unroll
      for (int i = 0; i < 4; i++) {
        const int k = i * 16 + (tid >> 4), n4 = (tid & 15) * 4, n = nt * 64 + n4;
        float4 v = {0.f, 0.f, 0.f, 0.f};
        if (n < Nsrc) v = *(const float4*)(src + (size_t)(kt * 64 + k) * Nsrc + n);
        ts[k * 65 + n4] = v.x; ts[k * 65 + n4 + 1] = v.y; ts[k * 65 + n4 + 2] = v.z; ts[k * 65 + n4 + 3] = v.w;
      }
      __syncthreads();
      const int n = tid >> 2, kc = (tid & 3) * 16;
      uint32_t w[8];
#pragma unroll
      for (int e = 0; e < 8; e++) w[e] = pk2(ts[(kc + 2 * e) * 65 + n], ts[(kc + 2 * e + 1) * 65 + n]);
      u16* dp = dst + (size_t)(nt * 64 + n) * K + kt * 64 + kc;
      uint4 v0; v0.x = w[0]; v0.y = w[1]; v0.z = w[2]; v0.w = w[3];
      uint4 v1; v1.x = w[4]; v1.y = w[5]; v1.z = w[6]; v1.w = w[7];
      *(uint4*)dp = v0; *(uint4*)(dp + 8) = v1;
    } else {
      const int at = tile - ntr;
      const int layer = at / 48, c0 = (at - layer * 48) * 64;
      float* sc = (float*)smem;
      float* red = sc + 5 * 1024;
      for (int i = tid; i < 5 * 1024; i += 256) {
        const int n = i >> 10, k = i & 1023;
        const float v = (n == 0) ? p.c_ctx[k] : p.c[(n - 1) * 1024 + k];
        sc[i] = silu(v);
      }
      __syncthreads();
      const int c4 = (tid & 15) * 4, kg = tid >> 4;
      float acc[5][4];
#pragma unroll
      for (int n = 0; n < 5; n++) { acc[n][0] = 0.f; acc[n][1] = 0.f; acc[n][2] = 0.f; acc[n][3] = 0.f; }
      const float* w = p.ada_w + (size_t)layer * 1024 * 3072 + c0 + c4;
#pragma unroll 4
      for (int kk = 0; kk < 64; kk++) {
        const int k = kg * 64 + kk;
        const float4 wv = *(const float4*)(w + (size_t)k * 3072);
#pragma unroll
        for (int n = 0; n < 5; n++) {
          const float s = sc[n * 1024 + k];
          acc[n][0] += s * wv.x; acc[n][1] += s * wv.y; acc[n][2] += s * wv.z; acc[n][3] += s * wv.w;
        }
      }
#pragma unroll
      for (int n = 0; n < 5; n++) {
        float4 r; r.x = acc[n][0]; r.y = acc[n][1]; r.z = acc[n][2]; r.w = acc[n][3];
        *(float4*)(red + (kg * 5 + n) * 64 + c4) = r;
      }
      __syncthreads();
      for (int o = tid; o < 320; o += 256) {
        const int n = o >> 6, cc = o & 63;
        float s = 0.f;
#pragma unroll
        for (int g = 0; g < 16; g++) s += red[(g * 5 + n) * 64 + cc];
        s += p.ada_b[layer * 3072 + c0 + cc];
        p.mod[(layer * 5 + n) * 3072 + c0 + cc] = s;
      }
    }
  }
}

DI void ph_h0(const Params& p) {
  for (int idx = blockIdx.x * 256 + threadIdx.x; idx < T * 128; idx += gridDim.x * 256) {
    const int t = idx >> 7, c0 = (idx & 127) * 8;
    const float* xr = (t < TC) ? p.x_prompt + (size_t)t * 1024 : p.x_sample + (size_t)(t - TC) * 1024;
    const float* md = p.mod + cond_of(t) * 3072;
    const float4 x0 = *(const float4*)(xr + c0), x1 = *(const float4*)(xr + c0 + 4);
    const float4 sh0 = *(const float4*)(md + c0), sh1 = *(const float4*)(md + c0 + 4);
    const float4 sc0 = *(const float4*)(md + 1024 + c0), sc1 = *(const float4*)(md + 1024 + c0 + 4);
    uint4 v;
    v.x = pk2(x0.x * (1.f + sc0.x) + sh0.x, x0.y * (1.f + sc0.y) + sh0.y);
    v.y = pk2(x0.z * (1.f + sc0.z) + sh0.z, x0.w * (1.f + sc0.w) + sh0.w);
    v.z = pk2(x1.x * (1.f + sc1.x) + sh1.x, x1.y * (1.f + sc1.y) + sh1.y);
    v.w = pk2(x1.z * (1.f + sc1.z) + sh1.z, x1.w * (1.f + sc1.w) + sh1.w);
    *(uint4*)(p.H + (size_t)t * 1024 + c0) = v;
  }
}

template <class Epi>
DI void gemm_phase(const u16* A, int lda, const u16* Bt, int ldb, int K, int MT, int NT, char* smem, const Epi& epi) {
  const int ntile = MT * NT;
  for (int tile = blockIdx.x; tile < ntile; tile += gridDim.x) {
    const int nt = tile / MT, mt = tile - nt * MT;
    gemm_tile(A, lda, Bt, ldb, K, mt * 128, nt * 128, 0, smem, epi);
  }
}

DI void unpack8(const u32x4& u, float* f) {
  f[0] = __uint_as_float(u[0] << 16); f[1] = __uint_as_float(u[0] & 0xffff0000u);
  f[2] = __uint_as_float(u[1] << 16); f[3] = __uint_as_float(u[1] & 0xffff0000u);
  f[4] = __uint_as_float(u[2] << 16); f[5] = __uint_as_float(u[2] & 0xffff0000u);
  f[6] = __uint_as_float(u[3] << 16); f[7] = __uint_as_float(u[3] & 0xffff0000u);
}
template <int HW>
DI void mix_item(const Params& p, int rpair) {
  const int lane = threadIdx.x & 63;
  constexpr int g = (HW == 1) ? 0 : (HW == 2) ? 1 : (HW == 4) ? 2 : 3;
  constexpr int NR = 8 + 2 * HW;
  const int c0 = (g * 32 + (lane & 31)) * 8;
  const int t0 = (rpair * 2 + (lane >> 5)) * 8;
  int s0, L, tt0;
  if (t0 < TC) { s0 = t0 & ~255; tt0 = t0 & 255; L = 256; } else { s0 = TC + ((t0 - TC) & ~2047); tt0 = (t0 - TC) & 2047; L = 2048; }
  u32x4 rows[NR];
#pragma unroll
  for (int r = 0; r < NR; r++) {
    const int tt = tt0 - HW + r;
    u32x4 v = {0u, 0u, 0u, 0u};
    if (tt >= 0 && tt < L) v = *(const u32x4*)(p.U + (size_t)(s0 + tt) * 1024 + c0);
    rows[r] = v;
  }
  float sum[8];
#pragma unroll
  for (int k = 0; k < 8; k++) sum[k] = 0.f;
#pragma unroll
  for (int r = 0; r < 2 * HW; r++) {
    float f[8]; unpack8(rows[r], f);
#pragma unroll
    for (int k = 0; k < 8; k++) sum[k] += f[k];
  }
#pragma unroll
  for (int e = 0; e < 8; e++) {
    const int tt = tt0 + e;
    const int lo = max(tt - HW, 0), hi = min(tt + HW, L);
    const float ic = 1.f / (float)(hi - lo);
    float own[8]; unpack8(rows[e + HW], own);
    u32x4 v;
    v[0] = pk2(sum[0] * ic - own[0], sum[1] * ic - own[1]);
    v[1] = pk2(sum[2] * ic - own[2], sum[3] * ic - own[3]);
    v[2] = pk2(sum[4] * ic - own[4], sum[5] * ic - own[5]);
    v[3] = pk2(sum[6] * ic - own[6], sum[7] * ic - own[7]);
    *(u32x4*)(p.MIX + (size_t)(s0 + tt) * 1024 + c0) = v;
    if (e < 7) {
      float fo[8], fi[8]; unpack8(rows[e], fo); unpack8(rows[e + 2 * HW], fi);
#pragma unroll
      for (int k = 0; k < 8; k++) sum[k] += fi[k] - fo[k];
    }
  }
}
DI void ph_mix(const Params& p) {
  const int wid = threadIdx.x >> 6;
  for (int item = blockIdx.x * 4 + wid; item < 768 * 4; item += gridDim.x * 4) {
    const int rpair = item >> 2, g = item & 3;
    if (g == 0) mix_item<1>(p, rpair);
    else if (g == 1) mix_item<2>(p, rpair);
    else if (g == 2) mix_item<4>(p, rpair);
    else mix_item<8>(p, rpair);
  }
}

DI void ph_pool_g2(const Params& p, int j, char* smem) {
  EpiPoolG2 epi{p.PM, p.SZ, p.pool_scale + j * 1024};
  for (int tile = blockIdx.x; tile < 96 * 8; tile += gridDim.x) {
    const int gn = tile / 96, mt = tile - gn * 96;
    const int g = gn >> 1, ns = gn & 1;
    gemm_tile(p.MIX + g * 256, 1024, p.Wgrp + (size_t)(j * 4 + g) * 65536, 256, 256, mt * 128, ns * 128, g * 256, smem, epi);
  }
}

DI void ph_ln(const Params& p, int layer) {
  const int lane = threadIdx.x & 63, wid = threadIdx.x >> 6;
  const float* g = p.ln_g + layer * 1024;
  const float* bb = p.ln_b + layer * 1024;
  for (int row = blockIdx.x * 4 + wid; row < T; row += gridDim.x * 4) {
    float* xr = p.out + (size_t)row * 1024;
    float4 v[4];
    float s = 0.f;
#pragma unroll
    for (int i = 0; i < 4; i++) { v[i] = *(const float4*)(xr + i * 256 + lane * 4); s += v[i].x + v[i].y + v[i].z + v[i].w; }
    const float mu = wave_sum(s) * (1.f / 1024.f);
    float q = 0.f;
#pragma unroll
    for (int i = 0; i < 4; i++) {
      v[i].x -= mu; v[i].y -= mu; v[i].z -= mu; v[i].w -= mu;
      q += v[i].x * v[i].x + v[i].y * v[i].y + v[i].z * v[i].z + v[i].w * v[i].w;
    }
    const float rstd = rsqrtf(wave_sum(q) * (1.f / 1024.f) + 1e-5f);
    const float* md = p.mod + ((layer + 1) * 5 + cond_of(row)) * 3072;
#pragma unroll
    for (int i = 0; i < 4; i++) {
      const int cc = i * 256 + lane * 4;
      const float4 gg = *(const float4*)(g + cc), be = *(const float4*)(bb + cc);
      float4 y;
      y.x = v[i].x * rstd * gg.x + be.x; y.y = v[i].y * rstd * gg.y + be.y;
      y.z = v[i].z * rstd * gg.z + be.z; y.w = v[i].w * rstd * gg.w + be.w;
      *(float4*)(xr + cc) = y;
      if (layer < 3) {
        const float4 sh = *(const float4*)(md + cc), sc = *(const float4*)(md + 1024 + cc);
        uint2 h;
        h.x = pk2(y.x * (1.f + sc.x) + sh.x, y.y * (1.f + sc.y) + sh.y);
        h.y = pk2(y.z * (1.f + sc.z) + sh.z, y.w * (1.f + sc.w) + sh.w);
        *(uint2*)(p.H + (size_t)row * 1024 + cc) = h;
      }
    }
  }
}

DI void ph_mla_norm(const Params& p) {
  const int lane = threadIdx.x & 63, wid = threadIdx.x >> 6;
  for (int row = blockIdx.x * 4 + wid; row < T + 1024; row += gridDim.x * 4) {
    if (row < T) {
      const float* rr = p.RAW + (size_t)row * 768;
      const float4 a0 = *(const float4*)(rr + lane * 8), a1 = *(const float4*)(rr + lane * 8 + 4);
      const float4 k0 = *(const float4*)(rr + 512 + lane * 4);
      float s1 = a0.x * a0.x + a0.y * a0.y + a0.z * a0.z + a0.w * a0.w + a1.x * a1.x + a1.y * a1.y + a1.z * a1.z + a1.w * a1.w;
      float s2 = k0.x * k0.x + k0.y * k0.y + k0.z * k0.z + k0.w * k0.w;
      const float r1 = rsqrtf(wave_sum(s1) * (1.f / 512.f) + 1e-6f);
      const float r2 = rsqrtf(wave_sum(s2) * (1.f / 256.f) + 1e-6f);
      const float4 g0 = *(const float4*)(p.mla_q_norm + lane * 8), g1 = *(const float4*)(p.mla_q_norm + lane * 8 + 4);
      uint4 v;
      v.x = pk2(a0.x * r1 * g0.x, a0.y * r1 * g0.y); v.y = pk2(a0.z * r1 * g0.z, a0.w * r1 * g0.w);
      v.z = pk2(a1.x * r1 * g1.x, a1.y * r1 * g1.y); v.w = pk2(a1.z * r1 * g1.z, a1.w * r1 * g1.w);
      *(uint4*)(p.CQN + (size_t)row * 512 + lane * 8) = v;
      const float4 kg = *(const float4*)(p.mla_kv_norm + lane * 4);
      float4 kn; kn.x = k0.x * r2 * kg.x; kn.y = k0.y * r2 * kg.y; kn.z = k0.z * r2 * kg.z; kn.w = k0.w * r2 * kg.w;
      uint2 kv; kv.x = pk2(kn.x, kn.y); kv.y = pk2(kn.z, kn.w);
      *(uint2*)(p.CKVN + (size_t)kvrow_of(row) * 256 + lane * 4) = kv;
      if (row < TC) *(float4*)(p.out + OUT_CKV + (size_t)row * 256 + lane * 4) = kn;
    } else {
      const int cr = row - T, b = cr >> 8, pp = cr & 255;
      const size_t kvr = (size_t)TC + b * 2304 + pp;
      const float4 k0 = *(const float4*)(p.cache_ckv + (size_t)cr * 256 + lane * 4);
      uint2 kv; kv.x = pk2(k0.x, k0.y); kv.y = pk2(k0.z, k0.w);
      *(uint2*)(p.CKVN + kvr * 256 + lane * 4) = kv;
      p.KR[kvr * 64 + lane] = f2bf(p.cache_kr[(size_t)cr * 64 + lane]);
    }
  }
}

DI void ph_mla_g2(const Params& p, char* smem) {
  EpiMlaQ eq{p.Q};
  EpiMlaKV ekv{p.KN, p.VT};
  const int n1 = 96 * 12, n2 = 104 * 16;
  for (int tile = blockIdx.x; tile < n1 + n2; tile += gridDim.x) {
    if (tile < n1) {
      const int nt = tile / 96, mt = tile - nt * 96;
      gemm_tile(p.CQN, 512, p.Wuq, 512, 512, mt * 128, nt * 128, 0, smem, eq);
    } else {
      const int t2 = tile - n1;
      const int nt = t2 / 104, mt = t2 - nt * 104;
      gemm_tile(p.CKVN, 256, p.Wukv, 256, 256, mt * 128, nt * 128, 0, smem, ekv);
    }
  }
}

DI void ph_mla_attn(const Params& p, char* smem) {
  const int wid = threadIdx.x >> 6, l31 = threadIdx.x & 31;
  for (int u = blockIdx.x; u < 768; u += gridDim.x) {
    int t0, kvrow0, nkeys, Lk, h; size_t vbase;
    if (u < 512) {
      const int xcd = u & 7, slot = u >> 3; const int pair = xcd * 4 + (slot >> 4); const int qb = slot & 15;
      const int b = pair >> 3; h = pair & 7;
      t0 = TC + b * 2048 + qb * 128 + wid * 32; kvrow0 = TC + b * 2304; nkeys = 2304; Lk = 2304;
      vbase = (size_t)16 * 8 * 128 * 256 + (size_t)b * (8 * 128 * 2304) + (size_t)h * 128 * 2304;
    } else {
      const int v = u - 512; const int b = v >> 4; h = (v >> 1) & 7; const int qb = v & 1;
      t0 = b * 256 + qb * 128 + wid * 32; kvrow0 = b * 256; nkeys = 256; Lk = 256;
      vbase = (size_t)b * (8 * 128 * 256) + (size_t)h * 128 * 256;
    }
    const int t = t0 + l31;
    attn_dense_block<8, 4, 4>(smem, p.Q + (size_t)t * 1536 + h * 192, p.KN + (size_t)kvrow0 * 1024 + h * 128, 1024,
                             p.KR + (size_t)kvrow0 * 64, p.VT + vbase, Lk, nkeys,
                             p.SZ + (size_t)t * 1024 + h * 128, p.AO + (size_t)t * 1024 + h * 128);
  }
}

DI void ph_na_g1(const Params& p, char* smem) {
  EpiNaG1 epi{p.NQ, p.NK, p.NVT, p.SZ, p.out + OUT_NAK, p.out + OUT_NAV};
  const int n1 = 96 * 32;
  for (int tile = blockIdx.x; tile < n1 + 64; tile += gridDim.x) {
    if (tile < n1) {
      const int nt = tile / 96, mt = tile - nt * 96;
      gemm_tile(p.H, 1024, p.Wnin, 1024, 1024, mt * 128, nt * 128, 0, smem, epi);
    } else {
      const int ct = tile - n1;
      const int b = ct >> 4, p0 = (ct & 15) * 16;
      const int c4 = threadIdx.x * 4;
      const size_t kvb = (size_t)TC + b * 2304;
      u16* vtb = p.NVT + (size_t)16 * 1024 * 256 + (size_t)b * (1024 * 2304);
      float vv[4][16];
#pragma unroll
      for (int i = 0; i < 16; i++) {
        const size_t src = ((size_t)(b * 256 + p0 + i)) * 1024 + c4;
        const float4 k = *(const float4*)(p.cache_nak + src);
        uint2 kv; kv.x = pk2(k.x, k.y); kv.y = pk2(k.z, k.w);
        *(uint2*)(p.NK + (kvb + p0 + i) * 1024 + c4) = kv;
        const float4 v = *(const float4*)(p.cache_nav + src);
        vv[0][i] = v.x; vv[1][i] = v.y; vv[2][i] = v.z; vv[3][i] = v.w;
      }
#pragma unroll
      for (int e = 0; e < 4; e++) {
        uint4 w0, w1;
        w0.x = pk2(vv[e][0], vv[e][1]); w0.y = pk2(vv[e][2], vv[e][3]); w0.z = pk2(vv[e][4], vv[e][5]); w0.w = pk2(vv[e][6], vv[e][7]);
        w1.x = pk2(vv[e][8], vv[e][9]); w1.y = pk2(vv[e][10], vv[e][11]); w1.z = pk2(vv[e][12], vv[e][13]); w1.w = pk2(vv[e][14], vv[e][15]);
        u16* dp = vtb + (size_t)(c4 + e) * 2304 + p0;
        *(uint4*)dp = w0; *(uint4*)(dp + 8) = w1;
      }
    }
  }
}

DI void ph_na_attn(const Params& p, char* smem) {
  const int wid = threadIdx.x >> 6, l31 = threadIdx.x & 31;
  for (int u = blockIdx.x; u < 512 + 2048; u += gridDim.x) {
    if (u < 512) {
      const int b = u >> 5, h = (u >> 1) & 15, qb = u & 1;
      const int t = b * 256 + qb * 128 + wid * 32 + l31;
      attn_dense_block<4, 0, 2>(smem, p.NQ + (size_t)t * 1024 + h * 64, p.NK + (size_t)(b * 256) * 1024 + h * 64, 1024, nullptr,
                               p.NVT + (size_t)b * (1024 * 256) + (size_t)h * 64 * 256, 256, 256,
                               p.SZ + (size_t)t * 1024 + h * 64, p.NAO + (size_t)t * 1024 + h * 64);
    } else {
      const int v = u - 512;
      const int b = v >> 9, h = (v >> 5) & 15, r = v & 31;
      attn_na_wave(p, b, h, r, wid);
    }
  }
}

template <int ph>
DI void run_phase(const Params& p, char* smem) {
  if constexpr (ph == 0) ph_prep(p, smem);
  else if constexpr (ph == 1) ph_h0(p);
  else if constexpr (ph == 2 || ph == 17) {
    constexpr int j = (ph == 2) ? 0 : 1;
    EpiPoolG1 e{p.U, p.SZ};
    gemm_phase(p.H, 1024, p.Wpin + (size_t)j * 2048 * 1024, 1024, 1024, 96, 16, smem, e);
  }
  else if constexpr (ph == 3 || ph == 18) ph_mix(p);
  else if constexpr (ph == 4 || ph == 19) ph_pool_g2(p, (ph == 4) ? 0 : 1, smem);
  else if constexpr (ph == 5) {
    EpiG3 e{p.x_prompt, p.x_sample, p.out, p.mod};
    gemm_phase(p.PM, 1024, p.Wpout, 1024, 1024, 96, 8, smem, e);
  }
  else if constexpr (ph == 20) {
    EpiG3 e{p.out, p.out + OUT_YS, p.out, p.mod + 3 * 5 * 3072};
    gemm_phase(p.PM, 1024, p.Wpout + (size_t)1024 * 1024, 1024, 1024, 96, 8, smem, e);
  }
  else if constexpr (ph == 6) ph_ln(p, 0);
  else if constexpr (ph == 21) ph_ln(p, 3);
  else if constexpr (ph == 7) {
    EpiMlaG1 e{p.RAW, p.KR, p.SZ, p.out + OUT_KR};
    gemm_phase(p.H, 1024, p.Wmin, 1024, 1024, 96, 15, smem, e);
  }
  else if constexpr (ph == 8) ph_mla_norm(p);
  else if constexpr (ph == 9) ph_mla_g2(p, smem);
  else if constexpr (ph == 10) ph_mla_attn(p, smem);
  else if constexpr (ph == 11) {
    EpiG3 e{p.out, p.out + OUT_YS, p.out, p.mod + 1 * 5 * 3072};
    gemm_phase(p.AO, 1024, p.Wmout, 1024, 1024, 96, 8, smem, e);
  }
  else if constexpr (ph == 12) ph_ln(p, 1);
  else if constexpr (ph == 13) ph_na_g1(p, smem);
  else if constexpr (ph == 14) ph_na_attn(p, smem);
  else if constexpr (ph == 15) {
    EpiG3 e{p.out, p.out + OUT_YS, p.out, p.mod + 2 * 5 * 3072};
    gemm_phase(p.NAO, 1024, p.Wnout, 1024, 1024, 96, 8, smem, e);
  }
  else if constexpr (ph == 16) ph_ln(p, 2);
}

#define RUN_PH(n) if (ph_lo <= (n) && (n) < ph_hi) { run_phase<n>(p, smem); if ((n) + 1 < ph_hi) xcd_barrier(xb); }

__global__ void __launch_bounds__(256, 2) mega(Params p, int ph_lo, int ph_hi) {
  __shared__ __attribute__((aligned(16))) char smem[SMEM_BYTES + 16];
  if (ph_lo < 0) { cg::this_grid().sync(); return; }
  const bool multi = (ph_hi - ph_lo) > 1;
  XcdBarrier xb; xb.bar = p.bar; xb.x = 0; xb.st = (volatile LAS unsigned*)(smem + SMEM_BYTES);
  if (multi) {
    if (threadIdx.x == 0) { *(uint4*)(smem + SMEM_BYTES) = make_uint4(0u, 0u, 0u, 0u); }
    __syncthreads();
    xb = xcd_barrier_post(p.bar, (volatile LAS unsigned*)(smem + SMEM_BYTES));
  }
  RUN_PH(0) RUN_PH(1) RUN_PH(2) RUN_PH(3) RUN_PH(4) RUN_PH(5) RUN_PH(6) RUN_PH(7) RUN_PH(8) RUN_PH(9) RUN_PH(10)
  RUN_PH(11) RUN_PH(12) RUN_PH(13) RUN_PH(14) RUN_PH(15) RUN_PH(16) RUN_PH(17) RUN_PH(18) RUN_PH(19) RUN_PH(20) RUN_PH(21)
}

extern "C" void kernel_launch(void* const* d_in, const int* in_sizes, int n_in, void* d_out, int out_size, void* d_ws, size_t ws_size,
                              hipStream_t stream) {
  Params p;
  memset(&p, 0, sizeof(p));
  const float* const* in = (const float* const*)d_in;
  p.x_prompt = in[0]; p.x_sample = in[1]; p.cache_ckv = in[2]; p.cache_kr = in[3]; p.cache_nak = in[4]; p.cache_nav = in[5];
  p.c = in[6]; p.c_ctx = in[7]; p.ada_w = in[8]; p.ada_b = in[9]; p.ln_g = in[10]; p.ln_b = in[11];
  const float* pool_w_in = in[12]; const float* pool_w_grp = in[13]; p.pool_scale = in[14]; const float* pool_w_out = in[15];
  const float* mla_w_in = in[16]; p.mla_q_norm = in[17]; const float* mla_w_uq = in[18]; p.mla_kv_norm = in[19];
  const float* mla_w_ukv = in[20]; const float* mla_w_out = in[21]; const float* na_w_in = in[22]; p.na_rpb = in[23];
  const float* na_w_out = in[24];
  p.out = (float*)d_out;

  char* ws = (char*)d_ws;
  size_t off = 0;
  auto take = [&](size_t bytes) { char* r = ws + off; off += (bytes + 255) & ~(size_t)255; return r; };
  p.bar = (unsigned*)take(XCD_BAR_WORDS * 4);
  p.mod = (float*)take((size_t)4 * 5 * 3072 * 4);
  p.Wpin = (u16*)take((size_t)2 * 2048 * 1024 * 2);
  p.Wgrp = (u16*)take((size_t)8 * 65536 * 2);
  p.Wpout = (u16*)take((size_t)2 * 1024 * 1024 * 2);
  p.Wmin = (u16*)take((size_t)1920 * 1024 * 2);
  p.Wuq = (u16*)take((size_t)1536 * 512 * 2);
  p.Wukv = (u16*)take((size_t)2048 * 256 * 2);
  p.Wmout = (u16*)take((size_t)1024 * 1024 * 2);
  p.Wnin = (u16*)take((size_t)4096 * 1024 * 2);
  p.Wnout = (u16*)take((size_t)1024 * 1024 * 2);
  p.H = (u16*)take((size_t)T * 1024 * 2);
  p.SZ = (u16*)take((size_t)T * 1024 * 2);
  const size_t arena0 = off;
  p.U = (u16*)take((size_t)T * 1024 * 2);
  p.MIX = (u16*)take((size_t)T * 1024 * 2);
  p.PM = (u16*)take((size_t)T * 1024 * 2);
  off = arena0;
  p.RAW = (float*)take((size_t)T * 768 * 4);
  p.AO = (u16*)p.RAW;
  p.CQN = (u16*)take((size_t)T * 512 * 2);
  p.CKVN = (u16*)take((size_t)KVR * 256 * 2);
  p.KR = (u16*)take((size_t)KVR * 64 * 2);
  p.Q = (u16*)take((size_t)T * 1536 * 2);
  p.KN = (u16*)take((size_t)KVR * 1024 * 2);
  p.VT = (u16*)take((size_t)KVR * 1024 * 2);
  off = arena0;
  p.NQ = (u16*)take((size_t)T * 1024 * 2);
  p.NK = (u16*)take((size_t)KVR * 1024 * 2);
  p.NVT = (u16*)take((size_t)KVR * 1024 * 2);
  p.NAO = (u16*)take((size_t)T * 1024 * 2);

  int nm = 0, tiles = 0;
  auto add = [&](const float* src, u16* dst, int K, int Nsrc, int Ndst) {
    p.mats[nm].src = src; p.mats[nm].dst = dst; p.mats[nm].K = K; p.mats[nm].Nsrc = Nsrc; p.mats[nm].Ndst = Ndst; p.mats[nm].tile0 = tiles;
    tiles += (K / 64) * (Ndst / 64); nm++;
  };
  for (int j = 0; j < 2; j++) add(pool_w_in + (size_t)j * 1024 * 2048, p.Wpin + (size_t)j * 2048 * 1024, 1024, 2048, 2048);
  for (int j = 0; j < 8; j++) add(pool_w_grp + (size_t)j * 65536, p.Wgrp + (size_t)j * 65536, 256, 256, 256);
  for (int j = 0; j < 2; j++) add(pool_w_out + (size_t)j * 1024 * 1024, p.Wpout + (size_t)j * 1024 * 1024, 1024, 1024, 1024);
  add(mla_w_in, p.Wmin, 1024, 1856, 1920);
  add(mla_w_uq, p.Wuq, 512, 1536, 1536);
  add(mla_w_ukv, p.Wukv, 256, 2048, 2048);
  add(mla_w_out, p.Wmout, 1024, 1024, 1024);
  add(na_w_in, p.Wnin, 1024, 4096, 4096);
  add(na_w_out, p.Wnout, 1024, 1024, 1024);
  p.nmat_tiles = tiles;

  (void)hipMemsetAsync(p.bar, 0, XCD_BAR_WORDS * 4, stream);
#if MULTI_LAUNCH
  for (int ph = 0; ph < NPHASE; ph++) hipLaunchKernelGGL(mega, dim3(512), dim3(256), 0, stream, p, ph, ph + 1);
#else
  static int grid_blocks = 0;
  if (!grid_blocks) {
    int dev = 0, cus = 0, per_cu = 0;
    hipGetDevice(&dev);
    hipDeviceGetAttribute(&cus, hipDeviceAttributeMultiprocessorCount, dev);
    hipOccupancyMaxActiveBlocksPerMultiprocessor(&per_cu, mega, 256, 0);
    if (per_cu > 2) per_cu = 2;
    if (per_cu < 1) per_cu = 1;
    grid_blocks = cus * per_cu;
  }
  int lo = 0, hi = NPHASE;
  void* args[] = {&p, &lo, &hi};
  hipError_t e = hipLaunchCooperativeKernel((void*)mega, dim3(grid_blocks), dim3(256), args, 0, stream);
  if (e != hipSuccess) fprintf(stderr, "cooperative launch failed: %s (grid %d)\n", hipGetErrorString(e), grid_blocks);
#endif
}
```

```cpp
#include <hip/hip_runtime.h>
#include <hip/hip_cooperative_groups.h>
#include <stdint.h>
#include <string.h>
#include <stdio.h>
namespace cg = cooperative_groups;

#ifndef MULTI_LAUNCH
#define MULTI_LAUNCH 0
#endif

typedef __attribute__((ext_vector_type(8))) short bf16x8;
typedef __attribute__((ext_vector_type(4))) float f32x4;
typedef __attribute__((ext_vector_type(16))) float f32x16;
typedef __attribute__((ext_vector_type(4))) uint32_t u32x4;
typedef unsigned short u16;
#define DI __device__ __forceinline__
#define MFMA32(a, b, c) __builtin_amdgcn_mfma_f32_32x32x16_bf16((a), (b), (c), 0, 0, 0)
#define MFMA16(a, b, c) __builtin_amdgcn_mfma_f32_16x16x32_bf16((a), (b), (c), 0, 0, 0)

constexpr int TC = 4096, TL = 8192, T = 12288;
constexpr int KVR = 4096 + 4 * 2304;
constexpr float LOG2E = 1.4426950408889634f;
constexpr float ALPHA = 1.681792830507429f;
constexpr float MLA_QS = 0.07216878364870323f * LOG2E;
constexpr float NA_QS = 0.125f * LOG2E;
constexpr int SMEM_BYTES = 73728;
constexpr int NPHASE = 22;

constexpr size_t OUT_YS = 4194304, OUT_CKV = 12582912, OUT_KR = 13631488, OUT_NAK = 13893632, OUT_NAV = 18087936;

struct MatDesc { const float* src; u16* dst; int K, Nsrc, Ndst, tile0; };

struct Params {
  const float *x_prompt, *x_sample, *cache_ckv, *cache_kr, *cache_nak, *cache_nav, *c, *c_ctx, *ada_w, *ada_b, *ln_g, *ln_b;
  const float *pool_scale, *mla_q_norm, *mla_kv_norm, *na_rpb;
  float* out;
  float* mod;
  u16 *H, *SZ;
  u16 *Wpin, *Wgrp, *Wpout, *Wmin, *Wuq, *Wukv, *Wmout, *Wnin, *Wnout;
  u16 *U, *MIX, *PM;
  float* RAW; u16 *AO, *CQN, *CKVN, *KR, *Q, *KN, *VT;
  u16 *NQ, *NK, *NVT, *NAO;
  unsigned* bar;
  MatDesc mats[18];
  int nmat_tiles; int pad0;
};

DI float bf2f(u16 v) { return __uint_as_float(((uint32_t)v) << 16); }
DI u16 f2bf(float x) { uint32_t u = __float_as_uint(x); u += 0x7fffu + ((u >> 16) & 1u); return (u16)(u >> 16); }
DI uint32_t pk2(float a, float b) { return (uint32_t)f2bf(a) | ((uint32_t)f2bf(b) << 16); }
DI float silu(float v) { return v / (1.f + __expf(-v)); }
DI int cond_of(int t) { return t < TC ? 0 : 1 + ((t - TC) >> 11); }
DI int kvrow_of(int t) { return t < TC ? t : TC + ((t - TC) >> 11) * 2304 + 256 + ((t - TC) & 2047); }
DI int perm16(int key) { const int k = key & 15; return (key & ~15) | (k & 3) | ((k >> 1) & 4) | ((k << 1) & 8); }
DI float wave_sum(float v) {
#pragma unroll
  for (int o = 32; o >= 1; o >>= 1) v += __shfl_xor(v, o);
  return v;
}

#define XB_TMO      128
#define XB_XCNT(j)  (256  + 64 * (j))
#define XB_XSUB(j)  (1280 + 64 * (j))
#define XB_XGEN(j)  (2304 + 64 * (j))
#define XB_TOP      3328
#define XB_TOPGEN   3392
#define XCD_BAR_WORDS 3456
#define XB_SPIN_CAP (1u << 22)
#define LAS __attribute__((address_space(3)))
DI unsigned xb_ld(unsigned* p) { return __hip_atomic_load(p, __ATOMIC_RELAXED, __HIP_MEMORY_SCOPE_AGENT); }
DI unsigned xb_add(unsigned* p, unsigned v) { return __hip_atomic_fetch_add(p, v, __ATOMIC_RELAXED, __HIP_MEMORY_SCOPE_AGENT); }
DI unsigned xb_xcc_id() { return (unsigned)__builtin_amdgcn_s_getreg((3 << 11) | 20) & 0xFu; }
#define XB_SPIN(cond, bar) do { unsigned _sp = 0; while (cond) { __builtin_amdgcn_s_sleep(1); \
    if ((++_sp & 255u) == 0u) { if (xb_ld(&(bar)[XB_TMO])) break; if (_sp > XB_SPIN_CAP) { atomicAdd(&(bar)[XB_TMO], 1u); break; } } } } while (0)
struct XcdBarrier { unsigned* bar; unsigned x; volatile LAS unsigned* st; };
DI XcdBarrier xcd_barrier_post(unsigned* bar, volatile LAS unsigned* st) {
  XcdBarrier b; b.bar = bar; b.x = xb_xcc_id(); b.st = st;
  if (threadIdx.x == 0) (void)xb_add(&bar[XB_XCNT(b.x)], 1u);
  return b;
}
DI void xcd_barrier_complete(unsigned* bar, unsigned x, unsigned& nloc, unsigned& nx) {
  const unsigned G = gridDim.x * gridDim.y * gridDim.z;
  unsigned sum, cnt, mine, sp = 0u;
  for (;;) {
    sum = 0u; cnt = 0u; mine = 0u;
#pragma unroll
    for (unsigned j = 0; j < 16; ++j) { const unsigned c = xb_ld(&bar[XB_XCNT(j)]); sum += c; cnt += (c > 0u) ? 1u : 0u; mine = (j == x) ? c : mine; }
    if (sum == G) break;
    __builtin_amdgcn_s_sleep(1);
    if ((++sp & 255u) == 0u) { if (xb_ld(&bar[XB_TMO])) break; if (sp > XB_SPIN_CAP) { atomicAdd(&bar[XB_TMO], 1u); break; } }
  }
  nloc = mine > 0u ? mine : 1u; nx = cnt > 0u ? cnt : 1u;
}
DI void xcd_barrier(const XcdBarrier& b) {
  asm volatile("s_waitcnt vmcnt(0)" ::: "memory");
  __syncthreads();
  if (threadIdx.x == 0) {
    unsigned* bar = b.bar;
    __builtin_amdgcn_s_waitcnt(0);
    unsigned nloc = b.st[0], nx = b.st[1];
    if (nloc == 0u) { xcd_barrier_complete(bar, b.x, nloc, nx); b.st[0] = nloc; b.st[1] = nx; }
    const unsigned old = xb_add(&bar[XB_XSUB(b.x)], 1u);
    const unsigned gen = old / nloc;
    if (old + 1u == (gen + 1u) * nloc) {
      __builtin_amdgcn_fence(__ATOMIC_RELEASE, "agent");
      asm volatile("s_waitcnt vmcnt(0)" ::: "memory");
      const unsigned og = xb_add(&bar[XB_TOP], 1u);
      const unsigned tg = og / nx;
      if (og + 1u == (tg + 1u) * nx) xb_add(&bar[XB_TOPGEN], 1u);
      else XB_SPIN(xb_ld(&bar[XB_TOPGEN]) == tg, bar);
      __builtin_amdgcn_fence(__ATOMIC_ACQUIRE, "agent");
      xb_add(&bar[XB_XGEN(b.x)], 1u);
      asm volatile("s_waitcnt vmcnt(0)" ::: "memory");
    } else {
      XB_SPIN(xb_ld(&bar[XB_XGEN(b.x)]) == gen, bar);
      __builtin_amdgcn_fence(__ATOMIC_ACQUIRE, "agent");
      asm volatile("s_waitcnt vmcnt(0)" ::: "memory");
    }
  }
  __syncthreads();
}

template <class Epi>
DI void gemm_tile(const u16* __restrict__ A, int lda, const u16* __restrict__ Bt, int ldb, int K, int m0, int n0, int nout_off,
                  char* smem, const Epi& epi) {
  const int tid = threadIdx.x, lane = tid & 63, wid = tid >> 6;
  const int wm = wid >> 1, wn = wid & 1, l31 = lane & 31, lh = lane >> 5;
  char* As = smem;
  char* Bs = smem + 32768;
  const int srow = tid >> 3;
  const int scc = ((tid & 7) ^ ((tid >> 4) & 7)) * 8;
  const u16* ag = A + (size_t)(m0 + srow) * lda + scc;
  const u16* bg = Bt + (size_t)(n0 + srow) * ldb + scc;
  LAS char* awr = (LAS char*)(As + wid * 1024);
  LAS char* bwr = (LAS char*)(Bs + wid * 1024);
  f32x16 acc[2][2];
#pragma unroll
  for (int i = 0; i < 2; i++)
#pragma unroll
    for (int j = 0; j < 2; j++)
#pragma unroll
      for (int r = 0; r < 16; r++) acc[i][j][r] = 0.f;
  __syncthreads();
#pragma unroll
  for (int i = 0; i < 4; i++) {
    __builtin_amdgcn_global_load_lds((const void*)(ag + (size_t)(32 * i) * lda), (LAS void*)(awr + i * 4096), 16, 0, 0);
    __builtin_amdgcn_global_load_lds((const void*)(bg + (size_t)(32 * i) * ldb), (LAS void*)(bwr + i * 4096), 16, 0, 0);
  }
  asm volatile("s_waitcnt vmcnt(0)" ::: "memory");
  __syncthreads();
  const int nk = K >> 6;
  const int sw = (l31 >> 1) & 7;
  for (int kt = 0; kt < nk; kt++) {
    const int buf = kt & 1;
    if (kt + 1 < nk) {
#pragma unroll
      for (int i = 0; i < 4; i++) {
        __builtin_amdgcn_global_load_lds((const void*)(ag + (size_t)(32 * i) * lda + (kt + 1) * 64), (LAS void*)(awr + (buf ^ 1) * 16384 + i * 4096), 16, 0, 0);
        __builtin_amdgcn_global_load_lds((const void*)(bg + (size_t)(32 * i) * ldb + (kt + 1) * 64), (LAS void*)(bwr + (buf ^ 1) * 16384 + i * 4096), 16, 0, 0);
      }
    }
    const char* as = As + buf * 16384 + (wm * 64 + l31) * 128;
    const char* bs = Bs + buf * 16384 + (wn * 64 + l31) * 128;
#pragma unroll
    for (int ks = 0; ks < 4; ks++) {
      const int co = ((2 * ks + lh) ^ sw) << 4;
      bf16x8 a0 = *(const bf16x8*)(as + co);
      bf16x8 a1 = *(const bf16x8*)(as + 32 * 128 + co);
      bf16x8 b0 = *(const bf16x8*)(bs + co);
      bf16x8 b1 = *(const bf16x8*)(bs + 32 * 128 + co);
      acc[0][0] = MFMA32(b0, a0, acc[0][0]);
      acc[0][1] = MFMA32(b1, a0, acc[0][1]);
      acc[1][0] = MFMA32(b0, a1, acc[1][0]);
      acc[1][1] = MFMA32(b1, a1, acc[1][1]);
    }
    asm volatile("s_waitcnt vmcnt(0)" ::: "memory");
    __syncthreads();
  }
#pragma unroll
  for (int i = 0; i < 2; i++)
#pragma unroll
    for (int j = 0; j < 2; j++)
      epi(m0 + wm * 64 + i * 32 + l31, nout_off + n0 + wn * 64 + j * 32, lh, acc[i][j]);
}

DI void rope_pair(float x1, float x2, int i, float pos, float& o1, float& o2) {
  const float inv = exp2f(-(float)i * (13.287712379549449f / 16.f));
  const float ang = pos * inv;
  const float c = __cosf(ang), s = __sinf(ang);
  o1 = x1 * c - x2 * s;
  o2 = x1 * s + x2 * c;
}

struct EpiPoolG1 {
  u16 *U, *SZ;
  DI void operator()(int m, int nb, int lh, const f32x16& a) const {
#pragma unroll
    for (int g = 0; g < 4; g++) {
      const int n = nb + 8 * g + 4 * lh;
      if (nb < 1024) {
        uint2 v; v.x = pk2(a[4 * g], a[4 * g + 1]); v.y = pk2(a[4 * g + 2], a[4 * g + 3]);
        *(uint2*)(U + (size_t)m * 1024 + n) = v;
      } else {
        uint2 v; v.x = pk2(silu(a[4 * g]), silu(a[4 * g + 1])); v.y = pk2(silu(a[4 * g + 2]), silu(a[4 * g + 3]));
        *(uint2*)(SZ + (size_t)m * 1024 + n - 1024) = v;
      }
    }
  }
};
struct EpiPoolG2 {
  u16* PM; const u16* SZ; const float* scale;
  DI void operator()(int m, int nb, int lh, const f32x16& a) const {
#pragma unroll
    for (int g = 0; g < 4; g++) {
      const int n = nb + 8 * g + 4 * lh;
      const uint2 z = *(const uint2*)(SZ + (size_t)m * 1024 + n);
      const float4 sc = *(const float4*)(scale + n);
      uint2 v;
      v.x = pk2(a[4 * g] * sc.x * bf2f((u16)(z.x & 0xffff)), a[4 * g + 1] * sc.y * bf2f((u16)(z.x >> 16)));
      v.y = pk2(a[4 * g + 2] * sc.z * bf2f((u16)(z.y & 0xffff)), a[4 * g + 3] * sc.w * bf2f((u16)(z.y >> 16)));
      *(uint2*)(PM + (size_t)m * 1024 + n) = v;
    }
  }
};
struct EpiG3 {
  const float *xp, *xs;
  float* out; const float* mod_layer;
  DI void operator()(int m, int nb, int lh, const f32x16& a) const {
    const float* xr = (m < TC) ? xp + (size_t)m * 1024 : xs + (size_t)(m - TC) * 1024;
    const float* gate = mod_layer + cond_of(m) * 3072 + 2048;
#pragma unroll
    for (int g = 0; g < 4; g++) {
      const int n = nb + 8 * g + 4 * lh;
      const float4 x = *(const float4*)(xr + n);
      const float4 gt = *(const float4*)(gate + n);
      float4 r;
      r.x = ALPHA * x.x + gt.x * a[4 * g]; r.y = ALPHA * x.y + gt.y * a[4 * g + 1];
      r.z = ALPHA * x.z + gt.z * a[4 * g + 2]; r.w = ALPHA * x.w + gt.w * a[4 * g + 3];
      *(float4*)(out + (size_t)m * 1024 + n) = r;
    }
  }
};
struct EpiMlaG1 {
  float* RAW; u16* KR; u16* SZ; float* st_kr;
  DI void operator()(int m, int nb, int lh, const f32x16& a) const {
    if (nb >= 1856) return;
    if (nb < 768) {
#pragma unroll
      for (int g = 0; g < 4; g++) {
        const int n = nb + 8 * g + 4 * lh;
        float4 r; r.x = a[4 * g]; r.y = a[4 * g + 1]; r.z = a[4 * g + 2]; r.w = a[4 * g + 3];
        *(float4*)(RAW + (size_t)m * 768 + n) = r;
      }
    } else if (nb < 832) {
      const int off = nb - 768;
      const bool lat = m >= TC;
      const int tt = (m - TC) & 2047;
      const float pos = (off == 0) ? (float)(tt >> 6) : (float)(tt & 63);
      const size_t kr = (size_t)kvrow_of(m) * 64 + off;
#pragma unroll
      for (int g = 0; g < 2; g++) {
        float o1[4], o2[4];
#pragma unroll
        for (int e = 0; e < 4; e++) {
          const int i = 8 * g + 4 * lh + e;
          const float x1 = a[4 * g + e], x2 = a[4 * (g + 2) + e];
          if (lat) rope_pair(x1, x2, i, pos, o1[e], o2[e]); else { o1[e] = x1; o2[e] = x2; }
        }
        const int i0 = 8 * g + 4 * lh;
        if (!lat) {
          float4 r1; r1.x = o1[0]; r1.y = o1[1]; r1.z = o1[2]; r1.w = o1[3];
          float4 r2; r2.x = o2[0]; r2.y = o2[1]; r2.z = o2[2]; r2.w = o2[3];
          *(float4*)(st_kr + (size_t)m * 64 + off + i0) = r1;
          *(float4*)(st_kr + (size_t)m * 64 + off + i0 + 16) = r2;
        }
        uint2 v1; v1.x = pk2(o1[0], o1[1]); v1.y = pk2(o1[2], o1[3]);
        uint2 v2; v2.x = pk2(o2[0], o2[1]); v2.y = pk2(o2[2], o2[3]);
        *(uint2*)(KR + kr + i0) = v1;
        *(uint2*)(KR + kr + i0 + 16) = v2;
      }
    } else {
#pragma unroll
      for (int g = 0; g < 4; g++) {
        const int n = nb + 8 * g + 4 * lh - 832;
        uint2 v; v.x = pk2(silu(a[4 * g]), silu(a[4 * g + 1])); v.y = pk2(silu(a[4 * g + 2]), silu(a[4 * g + 3]));
        *(uint2*)(SZ + (size_t)m * 1024 + n) = v;
      }
    }
  }
};
struct EpiMlaQ {
  u16* Q;
  DI void operator()(int m, int nb, int lh, const f32x16& a) const {
    const int head = nb / 192, off = nb - head * 192;
    u16* qr = Q + (size_t)m * 1536 + nb;
    if (off < 128) {
#pragma unroll
      for (int g = 0; g < 4; g++) {
        uint2 v; v.x = pk2(a[4 * g] * MLA_QS, a[4 * g + 1] * MLA_QS); v.y = pk2(a[4 * g + 2] * MLA_QS, a[4 * g + 3] * MLA_QS);
        *(uint2*)(qr + 8 * g + 4 * lh) = v;
      }
    } else {
      const bool lat = m >= TC;
      const int tt = (m - TC) & 2047;
      const float pos = (off == 128) ? (float)(tt >> 6) : (float)(tt & 63);
#pragma unroll
      for (int g = 0; g < 2; g++) {
        float o1[4], o2[4];
#pragma unroll
        for (int e = 0; e < 4; e++) {
          const int i = 8 * g + 4 * lh + e;
          const float x1 = a[4 * g + e], x2 = a[4 * (g + 2) + e];
          if (lat) rope_pair(x1, x2, i, pos, o1[e], o2[e]); else { o1[e] = x1; o2[e] = x2; }
        }
        const int i0 = 8 * g + 4 * lh;
        uint2 v1; v1.x = pk2(o1[0] * MLA_QS, o1[1] * MLA_QS); v1.y = pk2(o1[2] * MLA_QS, o1[3] * MLA_QS);
        uint2 v2; v2.x = pk2(o2[0] * MLA_QS, o2[1] * MLA_QS); v2.y = pk2(o2[2] * MLA_QS, o2[3] * MLA_QS);
        *(uint2*)(qr + i0) = v1;
        *(uint2*)(qr + i0 + 16) = v2;
      }
    }
  }
};
struct EpiMlaKV {
  u16 *KN, *VT;
  DI void operator()(int m, int nb, int lh, const f32x16& a) const {
    const int head = nb >> 8, off = nb & 255;
    if (off < 128) {
#pragma unroll
      for (int g = 0; g < 4; g++) {
        uint2 v; v.x = pk2(a[4 * g], a[4 * g + 1]); v.y = pk2(a[4 * g + 2], a[4 * g + 3]);
        *(uint2*)(KN + (size_t)m * 1024 + head * 128 + off + 8 * g + 4 * lh) = v;
      }
    } else {
      size_t base; int Lk, key;
      if (m < TC) { base = (size_t)(m >> 8) * (8 * 128 * 256); Lk = 256; key = m & 255; }
      else { const int r2 = m - TC; const int b = r2 / 2304; key = r2 - b * 2304; Lk = 2304; base = (size_t)16 * 8 * 128 * 256 + (size_t)b * (8 * 128 * 2304); }
      u16* vp = VT + base + (size_t)(head * 128 + off - 128) * Lk + perm16(key);
#pragma unroll
      for (int g = 0; g < 4; g++)
#pragma unroll
        for (int e = 0; e < 4; e++) vp[(size_t)(8 * g + 4 * lh + e) * Lk] = f2bf(a[4 * g + e]);
    }
  }
};
struct EpiNaG1 {
  u16 *NQ, *NK, *NVT, *SZ; float *st_k, *st_v;
  DI void operator()(int m, int nb, int lh, const f32x16& a) const {
    if (nb < 1024) {
#pragma unroll
      for (int g = 0; g < 4; g++) {
        uint2 v; v.x = pk2(a[4 * g] * NA_QS, a[4 * g + 1] * NA_QS); v.y = pk2(a[4 * g + 2] * NA_QS, a[4 * g + 3] * NA_QS);
        *(uint2*)(NQ + (size_t)m * 1024 + nb + 8 * g + 4 * lh) = v;
      }
    } else if (nb < 2048) {
      const size_t kr = (size_t)kvrow_of(m) * 1024 + (nb - 1024);
#pragma unroll
      for (int g = 0; g < 4; g++) {
        uint2 v; v.x = pk2(a[4 * g], a[4 * g + 1]); v.y = pk2(a[4 * g + 2], a[4 * g + 3]);
        *(uint2*)(NK + kr + 8 * g + 4 * lh) = v;
        if (m < TC) { float4 r; r.x = a[4 * g]; r.y = a[4 * g + 1]; r.z = a[4 * g + 2]; r.w = a[4 * g + 3];
          *(float4*)(st_k + (size_t)m * 1024 + (nb - 1024) + 8 * g + 4 * lh) = r; }
      }
    } else if (nb < 3072) {
      const int c0 = nb - 2048;
      size_t base; int Lk, key;
      if (m < TC) { base = (size_t)(m >> 8) * (1024 * 256); Lk = 256; key = perm16(m & 255); }
      else { const int b = (m - TC) >> 11; key = 256 + ((m - TC) & 2047); Lk = 2304; base = (size_t)16 * 1024 * 256 + (size_t)b * (1024 * 2304); }
      u16* vp = NVT + base + (size_t)c0 * Lk + key;
#pragma unroll
      for (int g = 0; g < 4; g++) {
#pragma unroll
        for (int e = 0; e < 4; e++) vp[(size_t)(8 * g + 4 * lh + e) * Lk] = f2bf(a[4 * g + e]);
        if (m < TC) { float4 r; r.x = a[4 * g]; r.y = a[4 * g + 1]; r.z = a[4 * g + 2]; r.w = a[4 * g + 3];
          *(float4*)(st_v + (size_t)m * 1024 + c0 + 8 * g + 4 * lh) = r; }
      }
    } else {
#pragma unroll
      for (int g = 0; g < 4; g++) {
        uint2 v; v.x = pk2(silu(a[4 * g]), silu(a[4 * g + 1])); v.y = pk2(silu(a[4 * g + 2]), silu(a[4 * g + 3]));
        *(uint2*)(SZ + (size_t)m * 1024 + (nb - 3072) + 8 * g + 4 * lh) = v;
      }
    }
  }
};

template <int NSA, int NSB, int NDT>
DI void attn_dense_wave(const u16* __restrict__ qrow, const u16* __restrict__ kA, int kAstride, const u16* __restrict__ kB,
                        const u16* __restrict__ vt, int Lk, int nkeys, const u16* __restrict__ szrow, u16* __restrict__ orow) {
  const int lane = threadIdx.x & 63, l31 = lane & 31, lh = lane >> 5;
  bf16x8 qf[NSA + NSB];
#pragma unroll
  for (int s = 0; s < NSA + NSB; s++) qf[s] = *(const bf16x8*)(qrow + s * 16 + lh * 8);
  f32x16 o[NDT];
#pragma unroll
  for (int d = 0; d < NDT; d++)
#pragma unroll
    for (int r = 0; r < 16; r++) o[d][r] = 0.f;
  float m = -1e30f, l = 0.f;
  for (int k0 = 0; k0 < nkeys; k0 += 32) {
    f32x16 sa;
#pragma unroll
    for (int r = 0; r < 16; r++) sa[r] = 0.f;
    const u16* kp = kA + (size_t)(k0 + l31) * kAstride + lh * 8;
#pragma unroll
    for (int s = 0; s < NSA; s++) sa = MFMA32(*(const bf16x8*)(kp + s * 16), qf[s], sa);
    if (NSB > 0) {
      const u16* kp2 = kB + (size_t)(k0 + l31) * 64 + lh * 8;
#pragma unroll
      for (int s = 0; s < NSB; s++) sa = MFMA32(*(const bf16x8*)(kp2 + s * 16), qf[NSA + s], sa);
    }
    float mx = sa[0];
#pragma unroll
    for (int r = 1; r < 16; r++) mx = fmaxf(mx, sa[r]);
    mx = fmaxf(mx, __shfl_xor(mx, 32));
    const float mn = fmaxf(m, mx);
    const float alpha = exp2f(m - mn);
    m = mn;
    float ps = 0.f;
#pragma unroll
    for (int r = 0; r < 16; r++) { sa[r] = exp2f(sa[r] - mn); ps += sa[r]; }
    l = l * alpha + ps;
#pragma unroll
    for (int d = 0; d < NDT; d++)
#pragma unroll
      for (int r = 0; r < 16; r++) o[d][r] *= alpha;
#pragma unroll
    for (int sp = 0; sp < 2; sp++) {
      u32x4 pw;
      pw[0] = pk2(sa[8 * sp + 0], sa[8 * sp + 1]); pw[1] = pk2(sa[8 * sp + 2], sa[8 * sp + 3]);
      pw[2] = pk2(sa[8 * sp + 4], sa[8 * sp + 5]); pw[3] = pk2(sa[8 * sp + 6], sa[8 * sp + 7]);
      const bf16x8 pf = __builtin_bit_cast(bf16x8, pw);
#pragma unroll
      for (int d = 0; d < NDT; d++) {
        const u16* vp = vt + (size_t)(d * 32 + l31) * Lk + k0 + 16 * sp + 4 * lh;
        const uint2 lo = *(const uint2*)vp, hi = *(const uint2*)(vp + 8);
        u32x4 vw; vw[0] = lo.x; vw[1] = lo.y; vw[2] = hi.x; vw[3] = hi.y;
        o[d] = MFMA32(__builtin_bit_cast(bf16x8, vw), pf, o[d]);
      }
    }
  }
  l += __shfl_xor(l, 32);
  const float inv = 1.f / l;
#pragma unroll
  for (int d = 0; d < NDT; d++)
#pragma unroll
    for (int g = 0; g < 4; g++) {
      const int d0 = d * 32 + 8 * g + 4 * lh;
      const uint2 z = *(const uint2*)(szrow + d0);
      uint2 v;
      v.x = pk2(o[d][4 * g] * inv * bf2f((u16)(z.x & 0xffff)), o[d][4 * g + 1] * inv * bf2f((u16)(z.x >> 16)));
      v.y = pk2(o[d][4 * g + 2] * inv * bf2f((u16)(z.y & 0xffff)), o[d][4 * g + 3] * inv * bf2f((u16)(z.y >> 16)));
      *(uint2*)(orow + d0) = v;
    }
}


template <int NSA, int NSB, int NDT>
DI void attn_dense_block(char* smem, const u16* __restrict__ qrow, const u16* __restrict__ kA, int kAstride, const u16* __restrict__ kB,
                         const u16* __restrict__ vt, int Lk, int nkeys, const u16* __restrict__ szrow, u16* __restrict__ orow) {
  constexpr int NS = NSA + NSB, DK = 16 * NS, KST = DK + 8, DV = 32 * NDT, VST = 72;
  constexpr int CA = NSA * 2, CB = NSB * 2;
  constexpr int NLA = 64 * CA / 256, NLB = 64 * CB / 256, NLV = DV * 8 / 256;
  const int tid = threadIdx.x, lane = tid & 63, l31 = lane & 31, lh = lane >> 5;
  u16* Ks = (u16*)smem;
  u16* Vs = Ks + 64 * KST;
  u32x4 ra[NLA], rb[NLB > 0 ? NLB : 1], rv[NLV];
  bf16x8 qf[NS];
#pragma unroll
  for (int s = 0; s < NS; s++) qf[s] = *(const bf16x8*)(qrow + s * 16 + lh * 8);
  f32x16 o[NDT];
#pragma unroll
  for (int d = 0; d < NDT; d++)
#pragma unroll
    for (int r = 0; r < 16; r++) o[d][r] = 0.f;
  float m = -1e30f, l = 0.f;

    {
#pragma unroll
      for (int i = 0; i < NLA; i++) { const int c = tid + 256 * i; const int row = c / CA, cc = c % CA;
        ra[i] = *(const u32x4*)(kA + (size_t)((0) + row) * kAstride + cc * 8); }
      if constexpr (NLB > 0) {
#pragma unroll
        for (int i = 0; i < NLB; i++) { const int c = tid + 256 * i; const int row = c / CB, cc = c % CB;
          rb[i] = *(const u32x4*)(kB + (size_t)((0) + row) * 64 + cc * 8); }
      }
#pragma unroll
      for (int i = 0; i < NLV; i++) { const int c = tid + 256 * i; const int row = c >> 3, cc = c & 7;
        rv[i] = *(const u32x4*)(vt + (size_t)row * Lk + (0) + cc * 8); }
    }
  __syncthreads();
    {
#pragma unroll
      for (int i = 0; i < NLA; i++) { const int c = tid + 256 * i; const int row = c / CA, cc = c % CA;
        *(u32x4*)(Ks + row * KST + cc * 8) = ra[i]; }
      if constexpr (NLB > 0) {
#pragma unroll
        for (int i = 0; i < NLB; i++) { const int c = tid + 256 * i; const int row = c / CB, cc = c % CB;
          *(u32x4*)(Ks + row * KST + NSA * 16 + cc * 8) = rb[i]; }
      }
#pragma unroll
      for (int i = 0; i < NLV; i++) { const int c = tid + 256 * i; const int row = c >> 3, cc = c & 7;
        *(u32x4*)(Vs + row * VST + cc * 8) = rv[i]; }
    }
  __syncthreads();
  for (int k0 = 0; k0 < nkeys; k0 += 64) {
    const bool more = (k0 + 64) < nkeys;
    const int kn = more ? k0 + 64 : k0;
    {
#pragma unroll
      for (int i = 0; i < NLA; i++) { const int c = tid + 256 * i; const int row = c / CA, cc = c % CA;
        ra[i] = *(const u32x4*)(kA + (size_t)(kn + row) * kAstride + cc * 8); }
      if constexpr (NLB > 0) {
#pragma unroll
        for (int i = 0; i < NLB; i++) { const int c = tid + 256 * i; const int row = c / CB, cc = c % CB;
          rb[i] = *(const u32x4*)(kB + (size_t)(kn + row) * 64 + cc * 8); }
      }
#pragma unroll
      for (int i = 0; i < NLV; i++) { const int c = tid + 256 * i; const int row = c >> 3, cc = c & 7;
        rv[i] = *(const u32x4*)(vt + (size_t)row * Lk + kn + cc * 8); }
    }
#pragma unroll 1
    for (int hh = 0; hh < 2; hh++) {
      f32x16 s0;
#pragma unroll
      for (int r = 0; r < 16; r++) s0[r] = 0.f;
      const u16* kp = Ks + (hh * 32 + l31) * KST + lh * 8;
#pragma unroll
      for (int s = 0; s < NS; s++) {
        s0 = MFMA32(*(const bf16x8*)(kp + s * 16), qf[s], s0);
        if ((s & 3) == 3 && s + 1 < NS) __builtin_amdgcn_sched_barrier(0);
      }
      float mx = s0[0];
#pragma unroll
      for (int r = 1; r < 16; r++) mx = fmaxf(mx, s0[r]);
      mx = fmaxf(mx, __shfl_xor(mx, 32));
      if (__any(mx > m + 8.f)) {
        const float mn = fmaxf(m, mx);
        const float alpha = exp2f(m - mn);
        m = mn;
        l *= alpha;
#pragma unroll
        for (int d = 0; d < NDT; d++)
#pragma unroll
          for (int r = 0; r < 16; r++) o[d][r] *= alpha;
      }
      float ps = 0.f;
#pragma unroll
      for (int r = 0; r < 16; r++) { s0[r] = exp2f(s0[r] - m); ps += s0[r]; }
      l += ps;
      const u16* vp = Vs + l31 * VST + hh * 32 + lh * 8;
#pragma unroll
      for (int sp = 0; sp < 2; sp++) {
        u32x4 pw;
        pw[0] = pk2(s0[8 * sp + 0], s0[8 * sp + 1]); pw[1] = pk2(s0[8 * sp + 2], s0[8 * sp + 3]);
        pw[2] = pk2(s0[8 * sp + 4], s0[8 * sp + 5]); pw[3] = pk2(s0[8 * sp + 6], s0[8 * sp + 7]);
        const bf16x8 pf = __builtin_bit_cast(bf16x8, pw);
#pragma unroll
        for (int d = 0; d < NDT; d++) o[d] = MFMA32(*(const bf16x8*)(vp + d * 32 * VST + sp * 16), pf, o[d]);
      }
    }
    __syncthreads();
    if (more)
    {
#pragma unroll
      for (int i = 0; i < NLA; i++) { const int c = tid + 256 * i; const int row = c / CA, cc = c % CA;
        *(u32x4*)(Ks + row * KST + cc * 8) = ra[i]; }
      if constexpr (NLB > 0) {
#pragma unroll
        for (int i = 0; i < NLB; i++) { const int c = tid + 256 * i; const int row = c / CB, cc = c % CB;
          *(u32x4*)(Ks + row * KST + NSA * 16 + cc * 8) = rb[i]; }
      }
#pragma unroll
      for (int i = 0; i < NLV; i++) { const int c = tid + 256 * i; const int row = c >> 3, cc = c & 7;
        *(u32x4*)(Vs + row * VST + cc * 8) = rv[i]; }
    }
    __syncthreads();
  }
  l += __shfl_xor(l, 32);
  const float inv = 1.f / l;
#pragma unroll
  for (int d = 0; d < NDT; d++)
#pragma unroll
    for (int g = 0; g < 4; g++) {
      const int d0 = d * 32 + 8 * g + 4 * lh;
      const uint2 z = *(const uint2*)(szrow + d0);
      uint2 v;
      v.x = pk2(o[d][4 * g] * inv * bf2f((u16)(z.x & 0xffff)), o[d][4 * g + 1] * inv * bf2f((u16)(z.x >> 16)));
      v.y = pk2(o[d][4 * g + 2] * inv * bf2f((u16)(z.y & 0xffff)), o[d][4 * g + 3] * inv * bf2f((u16)(z.y >> 16)));
      *(uint2*)(orow + d0) = v;
    }
}

DI void attn_na_wave(const Params& p, int b, int h, int r, int j) {
  const int lane = threadIdx.x & 63, l15 = lane & 15, q4 = lane >> 4;
  const int t = TC + b * 2048 + r * 64 + j * 16 + l15;
  const u16* qrow = p.NQ + (size_t)t * 1024 + h * 64;
  const bf16x8 qf0 = *(const bf16x8*)(qrow + q4 * 8);
  const bf16x8 qf1 = *(const bf16x8*)(qrow + 32 + q4 * 8);
  const int rs = min(max(r - 4, 0), 24);
  const int bstart = min(max(j * 16 - 8, 0), 32);
  const int c = j * 16 + l15;
  const int cstart = min(max(c - 8, 0), 48);
  const u16* kb = p.NK + (size_t)(TC + b * 2304) * 1024 + h * 64;
  const u16* vb = p.NVT + (size_t)16 * 1024 * 256 + (size_t)b * (1024 * 2304) + (size_t)(h * 64) * 2304;
  const float* rp = p.na_rpb + h * 465;
  f32x4 o[4];
#pragma unroll
  for (int d = 0; d < 4; d++) { o[d][0] = 0.f; o[d][1] = 0.f; o[d][2] = 0.f; o[d][3] = 0.f; }
  float m = -1e30f, l = 0.f;
  const int krow0 = 8 * (l15 >> 2) + (l15 & 3);
  for (int cg4 = 0; cg4 < 4; cg4++) {
    bf16x8 kf[4][4];
    bf16x8 vf[4][4];
#pragma unroll
    for (int c4 = 0; c4 < 4; c4++) {
      const int ch = cg4 * 4 + c4;
      const int key0 = ch < 8 ? ch * 32 : 256 + (rs + ch - 8) * 64 + bstart;
      const u16* kp = kb + (size_t)(key0 + krow0) * 1024 + q4 * 8;
      kf[c4][0] = *(const bf16x8*)(kp);
      kf[c4][1] = *(const bf16x8*)(kp + 32);
      kf[c4][2] = *(const bf16x8*)(kp + 4 * 1024);
      kf[c4][3] = *(const bf16x8*)(kp + 4 * 1024 + 32);
#pragma unroll
      for (int d = 0; d < 4; d++) vf[c4][d] = *(const bf16x8*)(vb + (size_t)(d * 16 + l15) * 2304 + key0 + q4 * 8);
    }
#pragma unroll
    for (int c4 = 0; c4 < 4; c4++) {
      const int ch = cg4 * 4 + c4;
      f32x4 s0 = {0.f, 0.f, 0.f, 0.f}, s1 = {0.f, 0.f, 0.f, 0.f};
      s0 = MFMA16(kf[c4][0], qf0, s0);
      s0 = MFMA16(kf[c4][1], qf1, s0);
      s1 = MFMA16(kf[c4][2], qf0, s1);
      s1 = MFMA16(kf[c4][3], qf1, s1);
      if (cg4 >= 2) {
        const int dr = rs + (ch - 8) - r + 7;
#pragma unroll
        for (int i = 0; i < 4; i++) {
          const int kc0 = bstart + q4 * 8 + i, kc1 = kc0 + 4;
          const bool v0 = (kc0 >= cstart) && (kc0 < cstart + 16);
          const bool v1 = (kc1 >= cstart) && (kc1 < cstart + 16);
          const int dc0 = min(max(kc0 - c + 15, 0), 30), dc1 = min(max(kc1 - c + 15, 0), 30);
          const float b0 = rp[dr * 31 + dc0] * LOG2E, b1 = rp[dr * 31 + dc1] * LOG2E;
          s0[i] = v0 ? s0[i] + b0 : -1e30f;
          s1[i] = v1 ? s1[i] + b1 : -1e30f;
        }
      }
      float mx = fmaxf(fmaxf(fmaxf(s0[0], s0[1]), fmaxf(s0[2], s0[3])), fmaxf(fmaxf(s1[0], s1[1]), fmaxf(s1[2], s1[3])));
      mx = fmaxf(mx, __shfl_xor(mx, 16));
      mx = fmaxf(mx, __shfl_xor(mx, 32));
      const float mn = fmaxf(m, mx);
      const float alpha = exp2f(m - mn);
      m = mn;
      float ps = 0.f;
#pragma unroll
      for (int i = 0; i < 4; i++) { s0[i] = exp2f(s0[i] - mn); s1[i] = exp2f(s1[i] - mn); ps += s0[i] + s1[i]; }
      l = l * alpha + ps;
      u32x4 pw; pw[0] = pk2(s0[0], s0[1]); pw[1] = pk2(s0[2], s0[3]); pw[2] = pk2(s1[0], s1[1]); pw[3] = pk2(s1[2], s1[3]);
      const bf16x8 pf = __builtin_bit_cast(bf16x8, pw);
#pragma unroll
      for (int d = 0; d < 4; d++) {
        o[d][0] *= alpha; o[d][1] *= alpha; o[d][2] *= alpha; o[d][3] *= alpha;
        o[d] = MFMA16(vf[c4][d], pf, o[d]);
      }
    }
  }
  l += __shfl_xor(l, 16);
  l += __shfl_xor(l, 32);
  const float inv = 1.f / l;
  const u16* szrow = p.SZ + (size_t)t * 1024 + h * 64;
  u16* orow = p.NAO + (size_t)t * 1024 + h * 64;
#pragma unroll
  for (int d = 0; d < 4; d++) {
    const int d0 = d * 16 + q4 * 4;
    const uint2 z = *(const uint2*)(szrow + d0);
    uint2 v;
    v.x = pk2(o[d][0] * inv * bf2f((u16)(z.x & 0xffff)), o[d][1] * inv * bf2f((u16)(z.x >> 16)));
    v.y = pk2(o[d][2] * inv * bf2f((u16)(z.y & 0xffff)), o[d][3] * inv * bf2f((u16)(z.y >> 16)));
    *(uint2*)(orow + d0) = v;
  }
}

DI void ph_prep(const Params& p, char* smem) {
  const int tid = threadIdx.x;
  const int ntr = p.nmat_tiles;
  const int ntot = ntr + 192;
  for (int tile = blockIdx.x; tile < ntot; tile += gridDim.x) {
    __syncthreads();
    if (tile < ntr) {
      int mi = 0;
      for (int i = 1; i < 18; i++) if (tile >= p.mats[i].tile0) mi = i;
      const float* src = p.mats[mi].src; u16* dst = p.mats[mi].dst;
      const int K = p.mats[mi].K, Nsrc = p.mats[mi].Nsrc, Ndst = p.mats[mi].Ndst;
      const int lt = tile - p.mats[mi].tile0;
      const int ntn = Ndst >> 6;
      const int kt = lt / ntn, nt = lt - kt * ntn;
      float* ts = (float*)smem;
#pragma unroll
      for (int i = 0; i < 4; i++) {
        const int k = i * 16 + (tid >> 4), n4 = (tid & 15) * 4, n = nt * 64 + n4;
        float4 v = {0.f, 0.f, 0.f, 0.f};
        if (n < Nsrc) v = *(const float4*)(src + (size_t)(kt * 64 + k) * Nsrc + n);
        ts[k * 65 + n4] = v.x; ts[k * 65 + n4 + 1] = v.y; ts[k * 65 + n4 + 2] = v.z; ts[k * 65 + n4 + 3] = v.w;
      }
      __syncthreads();
      const int n = tid >> 2, kc = (tid & 3) * 16;
      uint32_t w[8];
#pragma unroll
      for (int e = 0; e < 8; e++) w[e] = pk2(ts[(kc + 2 * e) * 65 + n], ts[(kc + 2 * e + 1) * 65 + n]);
      u16* dp = dst + (size_t)(nt * 64 + n) * K + kt * 64 + kc;
      uint4 v0; v0.x = w[0]; v0.y = w[1]; v0.z = w[2]; v0.w = w[3];
      uint4 v1; v1.x = w[4]; v1.y = w[5]; v1.z = w[6]; v1.w = w[7];
      *(uint4*)dp = v0; *(uint4*)(dp + 8) = v1;
    } else {
      const int at = tile - ntr;
      const int layer = at / 48, c0 = (at - layer * 48) * 64;
      float* sc = (float*)smem;
      float* red = sc + 5 * 1024;
      for (int i = tid; i < 5 * 1024; i += 256) {
        const int n = i >> 10, k = i & 1023;
        const float v = (n == 0) ? p.c_ctx[k] : p.c[(n - 1) * 1024 + k];
        sc[i] = silu(v);
      }
      __syncthreads();
      const int c4 = (tid & 15) * 4, kg = tid >> 4;
      float acc[5][4];
#pragma unroll
      for (int n = 0; n < 5; n++) { acc[n][0] = 0.f; acc[n][1] = 0.f; acc[n][2] = 0.f; acc[n][3] = 0.f; }
      const float* w = p.ada_w + (size_t)layer * 1024 * 3072 + c0 + c4;
#pragma unroll 4
      for (int kk = 0; kk < 64; kk++) {
        const int k = kg * 64 + kk;
        const float4 wv = *(const float4*)(w + (size_t)k * 3072);
#pragma unroll
        for (int n = 0; n < 5; n++) {
          const float s = sc[n * 1024 + k];
          acc[n][0] += s * wv.x; acc[n][1] += s * wv.y; acc[n][2] += s * wv.z; acc[n][3] += s * wv.w;
        }
      }
#pragma unroll
      for (int n = 0; n < 5; n++) {
        float4 r; r.x = acc[n][0]; r.y = acc[n][1]; r.z = acc[n][2]; r.w = acc[n][3];
        *(float4*)(red + (kg * 5 + n) * 64 + c4) = r;
      }
      __syncthreads();
      for (int o = tid; o < 320; o += 256) {
        const int n = o >> 6, cc = o & 63;
        float s = 0.f;
#pragma unroll
        for (int g = 0; g < 16; g++) s += red[(g * 5 + n) * 64 + cc];
        s += p.ada_b[layer * 3072 + c0 + cc];
        p.mod[(layer * 5 + n) * 3072 + c0 + cc] = s;
      }
    }
  }
}

DI void ph_h0(const Params& p) {
  for (int idx = blockIdx.x * 256 + threadIdx.x; idx < T * 128; idx += gridDim.x * 256) {
    const int t = idx >> 7, c0 = (idx & 127) * 8;
    const float* xr = (t < TC) ? p.x_prompt + (size_t)t * 1024 : p.x_sample + (size_t)(t - TC) * 1024;
    const float* md = p.mod + cond_of(t) * 3072;
    const float4 x0 = *(const float4*)(xr + c0), x1 = *(const float4*)(xr + c0 + 4);
    const float4 sh0 = *(const float4*)(md + c0), sh1 = *(const float4*)(md + c0 + 4);
    const float4 sc0 = *(const float4*)(md + 1024 + c0), sc1 = *(const float4*)(md + 1024 + c0 + 4);
    uint4 v;
    v.x = pk2(x0.x * (1.f + sc0.x) + sh0.x, x0.y * (1.f + sc0.y) + sh0.y);
    v.y = pk2(x0.z * (1.f + sc0.z) + sh0.z, x0.w * (1.f + sc0.w) + sh0.w);
    v.z = pk2(x1.x * (1.f + sc1.x) + sh1.x, x1.y * (1.f + sc1.y) + sh1.y);
    v.w = pk2(x1.z * (1.f + sc1.z) + sh1.z, x1.w * (1.f + sc1.w) + sh1.w);
    *(uint4*)(p.H + (size_t)t * 1024 + c0) = v;
  }
}

template <class Epi>
DI void gemm_phase(const u16* A, int lda, const u16* Bt, int ldb, int K, int MT, int NT, char* smem, const Epi& epi) {
  const int ntile = MT * NT;
  for (int tile = blockIdx.x; tile < ntile; tile += gridDim.x) {
    const int nt = tile / MT, mt = tile - nt * MT;
    gemm_tile(A, lda, Bt, ldb, K, mt * 128, nt * 128, 0, smem, epi);
  }
}

DI void unpack8(const u32x4& u, float* f) {
  f[0] = __uint_as_float(u[0] << 16); f[1] = __uint_as_float(u[0] & 0xffff0000u);
  f[2] = __uint_as_float(u[1] << 16); f[3] = __uint_as_float(u[1] & 0xffff0000u);
  f[4] = __uint_as_float(u[2] << 16); f[5] = __uint_as_float(u[2] & 0xffff0000u);
  f[6] = __uint_as_float(u[3] << 16); f[7] = __uint_as_float(u[3] & 0xffff0000u);
}
template <int HW>
DI void mix_item(const Params& p, int rpair) {
  const int lane = threadIdx.x & 63;
  constexpr int g = (HW == 1) ? 0 : (HW == 2) ? 1 : (HW == 4) ? 2 : 3;
  constexpr int NR = 8 + 2 * HW;
  const int c0 = (g * 32 + (lane & 31)) * 8;
  const int t0 = (rpair * 2 + (lane >> 5)) * 8;
  int s0, L, tt0;
  if (t0 < TC) { s0 = t0 & ~255; tt0 = t0 & 255; L = 256; } else { s0 = TC + ((t0 - TC) & ~2047); tt0 = (t0 - TC) & 2047; L = 2048; }
  u32x4 rows[NR];
#pragma unroll
  for (int r = 0; r < NR; r++) {
    const int tt = tt0 - HW + r;
    u32x4 v = {0u, 0u, 0u, 0u};
    if (tt >= 0 && tt < L) v = *(const u32x4*)(p.U + (size_t)(s0 + tt) * 1024 + c0);
    rows[r] = v;
  }
  float sum[8];
#pragma unroll
  for (int k = 0; k < 8; k++) sum[k] = 0.f;
#pragma unroll
  for (int r = 0; r < 2 * HW; r++) {
    float f[8]; unpack8(rows[r], f);
#pragma unroll
    for (int k = 0; k < 8; k++) sum[k] += f[k];
  }
#pragma unroll
  for (int e = 0; e < 8; e++) {
    const int tt = tt0 + e;
    const int lo = max(tt - HW, 0), hi = min(tt + HW, L);
    const float ic = 1.f / (float)(hi - lo);
    float own[8]; unpack8(rows[e + HW], own);
    u32x4 v;
    v[0] = pk2(sum[0] * ic - own[0], sum[1] * ic - own[1]);
    v[1] = pk2(sum[2] * ic - own[2], sum[3] * ic - own[3]);
    v[2] = pk2(sum[4] * ic - own[4], sum[5] * ic - own[5]);
    v[3] = pk2(sum[6] * ic - own[6], sum[7] * ic - own[7]);
    *(u32x4*)(p.MIX + (size_t)(s0 + tt) * 1024 + c0) = v;
    if (e < 7) {
      float fo[8], fi[8]; unpack8(rows[e], fo); unpack8(rows[e + 2 * HW], fi);
#pragma unroll
      for (int k = 0; k < 8; k++) sum[k] += fi[k] - fo[k];
    }
  }
}
DI void ph_mix(const Params& p) {
  const int wid = threadIdx.x >> 6;
  for (int item = blockIdx.x * 4 + wid; item < 768 * 4; item += gridDim.x * 4) {
    const int rpair = item >> 2, g = item & 3;
    if (g == 0) mix_item<1>(p, rpair);
    else if (g == 1) mix_item<2>(p, rpair);
    else if (g == 2) mix_item<4>(p, rpair);
    else mix_item<8>(p, rpair);
  }
}

DI void ph_pool_g2(const Params& p, int j, char* smem) {
  EpiPoolG2 epi{p.PM, p.SZ, p.pool_scale + j * 1024};
  for (int tile = blockIdx.x; tile < 96 * 8; tile += gridDim.x) {
    const int gn = tile / 96, mt = tile - gn * 96;
    const int g = gn >> 1, ns = gn & 1;
    gemm_tile(p.MIX + g * 256, 1024, p.Wgrp + (size_t)(j * 4 + g) * 65536, 256, 256, mt * 128, ns * 128, g * 256, smem, epi);
  }
}

DI void ph_ln(const Params& p, int layer) {
  const int lane = threadIdx.x & 63, wid = threadIdx.x >> 6;
  const float* g = p.ln_g + layer * 1024;
  const float* bb = p.ln_b + layer * 1024;
  for (int row = blockIdx.x * 4 + wid; row < T; row += gridDim.x * 4) {
    float* xr = p.out + (size_t)row * 1024;
    float4 v[4];
    float s = 0.f;
#pragma unroll
    for (int i = 0; i < 4; i++) { v[i] = *(const float4*)(xr + i * 256 + lane * 4); s += v[i].x + v[i].y + v[i].z + v[i].w; }
    const float mu = wave_sum(s) * (1.f / 1024.f);
    float q = 0.f;
#pragma unroll
    for (int i = 0; i < 4; i++) {
      v[i].x -= mu; v[i].y -= mu; v[i].z -= mu; v[i].w -= mu;
      q += v[i].x * v[i].x + v[i].y * v[i].y + v[i].z * v[i].z + v[i].w * v[i].w;
    }
    const float rstd = rsqrtf(wave_sum(q) * (1.f / 1024.f) + 1e-5f);
    const float* md = p.mod + ((layer + 1) * 5 + cond_of(row)) * 3072;
#pragma unroll
    for (int i = 0; i < 4; i++) {
      const int cc = i * 256 + lane * 4;
      const float4 gg = *(const float4*)(g + cc), be = *(const float4*)(bb + cc);
      float4 y;
      y.x = v[i].x * rstd * gg.x + be.x; y.y = v[i].y * rstd * gg.y + be.y;
      y.z = v[i].z * rstd * gg.z + be.z; y.w = v[i].w * rstd * gg.w + be.w;
      *(float4*)(xr + cc) = y;
      if (layer < 3) {
        const float4 sh = *(const float4*)(md + cc), sc = *(const float4*)(md + 1024 + cc);
        uint2 h;
        h.x = pk2(y.x * (1.f + sc.x) + sh.x, y.y * (1.f + sc.y) + sh.y);
        h.y = pk2(y.z * (1.f + sc.z) + sh.z, y.w * (1.f + sc.w) + sh.w);
        *(uint2*)(p.H + (size_t)row * 1024 + cc) = h;
      }
    }
  }
}

DI void ph_mla_norm(const Params& p) {
  const int lane = threadIdx.x & 63, wid = threadIdx.x >> 6;
  for (int row = blockIdx.x * 4 + wid; row < T + 1024; row += gridDim.x * 4) {
    if (row < T) {
      const float* rr = p.RAW + (size_t)row * 768;
      const float4 a0 = *(const float4*)(rr + lane * 8), a1 = *(const float4*)(rr + lane * 8 + 4);
      const float4 k0 = *(const float4*)(rr + 512 + lane * 4);
      float s1 = a0.x * a0.x + a0.y * a0.y + a0.z * a0.z + a0.w * a0.w + a1.x * a1.x + a1.y * a1.y + a1.z * a1.z + a1.w * a1.w;
      float s2 = k0.x * k0.x + k0.y * k0.y + k0.z * k0.z + k0.w * k0.w;
      const float r1 = rsqrtf(wave_sum(s1) * (1.f / 512.f) + 1e-6f);
      const float r2 = rsqrtf(wave_sum(s2) * (1.f / 256.f) + 1e-6f);
      const float4 g0 = *(const float4*)(p.mla_q_norm + lane * 8), g1 = *(const float4*)(p.mla_q_norm + lane * 8 + 4);
      uint4 v;
      v.x = pk2(a0.x * r1 * g0.x, a0.y * r1 * g0.y); v.y = pk2(a0.z * r1 * g0.z, a0.w * r1 * g0.w);
      v.z = pk2(a1.x * r1 * g1.x, a1.y * r1 * g1.y); v.w = pk2(a1.z * r1 * g1.z, a1.w * r1 * g1.w);
      *(uint4*)(p.CQN + (size_t)row * 512 + lane * 8) = v;
      const float4 kg = *(const float4*)(p.mla_kv_norm + lane * 4);
      float4 kn; kn.x = k0.x * r2 * kg.x; kn.y = k0.y * r2 * kg.y; kn.z = k0.z * r2 * kg.z; kn.w = k0.w * r2 * kg.w;
      uint2 kv; kv.x = pk2(kn.x, kn.y); kv.y = pk2(kn.z, kn.w);
      *(uint2*)(p.CKVN + (size_t)kvrow_of(row) * 256 + lane * 4) = kv;
      if (row < TC) *(float4*)(p.out + OUT_CKV + (size_t)row * 256 + lane * 4) = kn;
    } else {
      const int cr = row - T, b = cr >> 8, pp = cr & 255;
      const size_t kvr = (size_t)TC + b * 2304 + pp;
      const float4 k0 = *(const float4*)(p.cache_ckv + (size_t)cr * 256 + lane * 4);
      uint2 kv; kv.x = pk2(k0.x, k0.y); kv.y = pk2(k0.z, k0.w);
      *(uint2*)(p.CKVN + kvr * 256 + lane * 4) = kv;
      p.KR[kvr * 64 + lane] = f2bf(p.cache_kr[(size_t)cr * 64 + lane]);
    }
  }
}

DI void ph_mla_g2(const Params& p, char* smem) {
  EpiMlaQ eq{p.Q};
  EpiMlaKV ekv{p.KN, p.VT};
  const int n1 = 96 * 12, n2 = 104 * 16;
  for (int tile = blockIdx.x; tile < n1 + n2; tile += gridDim.x) {
    if (tile < n1) {
      const int nt = tile / 96, mt = tile - nt * 96;
      gemm_tile(p.CQN, 512, p.Wuq, 512, 512, mt * 128, nt * 128, 0, smem, eq);
    } else {
      const int t2 = tile - n1;
      const int nt = t2 / 104, mt = t2 - nt * 104;
      gemm_tile(p.CKVN, 256, p.Wukv, 256, 256, mt * 128, nt * 128, 0, smem, ekv);
    }
  }
}

DI void ph_mla_attn(const Params& p, char* smem) {
  const int wid = threadIdx.x >> 6, l31 = threadIdx.x & 31;
  for (int u = blockIdx.x; u < 768; u += gridDim.x) {
    int t0, kvrow0, nkeys, Lk, h; size_t vbase;
    if (u < 512) {
      const int xcd = u & 7, slot = u >> 3; const int pair = xcd * 4 + (slot >> 4); const int qb = slot & 15;
      const int b = pair >> 3; h = pair & 7;
      t0 = TC + b * 2048 + qb * 128 + wid * 32; kvrow0 = TC + b * 2304; nkeys = 2304; Lk = 2304;
      vbase = (size_t)16 * 8 * 128 * 256 + (size_t)b * (8 * 128 * 2304) + (size_t)h * 128 * 2304;
    } else {
      const int v = u - 512; const int b = v >> 4; h = (v >> 1) & 7; const int qb = v & 1;
      t0 = b * 256 + qb * 128 + wid * 32; kvrow0 = b * 256; nkeys = 256; Lk = 256;
      vbase = (size_t)b * (8 * 128 * 256) + (size_t)h * 128 * 256;
    }
    const int t = t0 + l31;
    attn_dense_block<8, 4, 4>(smem, p.Q + (size_t)t * 1536 + h * 192, p.KN + (size_t)kvrow0 * 1024 + h * 128, 1024,
                             p.KR + (size_t)kvrow0 * 64, p.VT + vbase, Lk, nkeys,
                             p.SZ + (size_t)t * 1024 + h * 128, p.AO + (size_t)t * 1024 + h * 128);
  }
}

DI void ph_na_g1(const Params& p, char* smem) {
  EpiNaG1 epi{p.NQ, p.NK, p.NVT, p.SZ, p.out + OUT_NAK, p.out + OUT_NAV};
  const int n1 = 96 * 32;
  for (int tile = blockIdx.x; tile < n1 + 64; tile += gridDim.x) {
    if (tile < n1) {
      const int nt = tile / 96, mt = tile - nt * 96;
      gemm_tile(p.H, 1024, p.Wnin, 1024, 1024, mt * 128, nt * 128, 0, smem, epi);
    } else {
      const int ct = tile - n1;
      const int b = ct >> 4, p0 = (ct & 15) * 16;
      const int c4 = threadIdx.x * 4;
      const size_t kvb = (size_t)TC + b * 2304;
      u16* vtb = p.NVT + (size_t)16 * 1024 * 256 + (size_t)b * (1024 * 2304);
      float vv[4][16];
#pragma unroll
      for (int i = 0; i < 16; i++) {
        const size_t src = ((size_t)(b * 256 + p0 + i)) * 1024 + c4;
        const float4 k = *(const float4*)(p.cache_nak + src);
        uint2 kv; kv.x = pk2(k.x, k.y); kv.y = pk2(k.z, k.w);
        *(uint2*)(p.NK + (kvb + p0 + i) * 1024 + c4) = kv;
        const float4 v = *(const float4*)(p.cache_nav + src);
        vv[0][i] = v.x; vv[1][i] = v.y; vv[2][i] = v.z; vv[3][i] = v.w;
      }
#pragma unroll
      for (int e = 0; e < 4; e++) {
        uint4 w0, w1;
        w0.x = pk2(vv[e][0], vv[e][1]); w0.y = pk2(vv[e][2], vv[e][3]); w0.z = pk2(vv[e][4], vv[e][5]); w0.w = pk2(vv[e][6], vv[e][7]);
        w1.x = pk2(vv[e][8], vv[e][9]); w1.y = pk2(vv[e][10], vv[e][11]); w1.z = pk2(vv[e][12], vv[e][13]); w1.w = pk2(vv[e][14], vv[e][15]);
        u16* dp = vtb + (size_t)(c4 + e) * 2304 + p0;
        *(uint4*)dp = w0; *(uint4*)(dp + 8) = w1;
      }
    }
  }
}

DI void ph_na_attn(const Params& p, char* smem) {
  const int wid = threadIdx.x >> 6, l31 = threadIdx.x & 31;
  for (int u = blockIdx.x; u < 512 + 2048; u += gridDim.x) {
    if (u < 512) {
      const int b = u >> 5, h = (u >> 1) & 15, qb = u & 1;
      const int t = b * 256 + qb * 128 + wid * 32 + l31;
      attn_dense_block<4, 0, 2>(smem, p.NQ + (size_t)t * 1024 + h * 64, p.NK + (size_t)(b * 256) * 1024 + h * 64, 1024, nullptr,
                               p.NVT + (size_t)b * (1024 * 256) + (size_t)h * 64 * 256, 256, 256,
                               p.SZ + (size_t)t * 1024 + h * 64, p.NAO + (size_t)t * 1024 + h * 64);
    } else {
      const int v = u - 512;
      const int b = v >> 9, h = (v >> 5) & 15, r = v & 31;
      attn_na_wave(p, b, h, r, wid);
    }
  }
}

template <int ph>
DI void run_phase(const Params& p, char* smem) {
  if constexpr (ph == 0) ph_prep(p, smem);
  else if constexpr (ph == 1) ph_h0(p);
  else if constexpr (ph == 2 || ph == 17) {
    constexpr int j = (ph == 2) ? 0 : 1;
    EpiPoolG1 e{p.U, p.SZ};
    gemm_phase(p.H, 1024, p.Wpin + (size_t)j * 2048 * 1024, 1024, 1024, 96, 16, smem, e);
  }
  else if constexpr (ph == 3 || ph == 18) ph_mix(p);
  else if constexpr (ph == 4 || ph == 19) ph_pool_g2(p, (ph == 4) ? 0 : 1, smem);
  else if constexpr (ph == 5) {
    EpiG3 e{p.x_prompt, p.x_sample, p.out, p.mod};
    gemm_phase(p.PM, 1024, p.Wpout, 1024, 1024, 96, 8, smem, e);
  }
  else if constexpr (ph == 20) {
    EpiG3 e{p.out, p.out + OUT_YS, p.out, p.mod + 3 * 5 * 3072};
    gemm_phase(p.PM, 1024, p.Wpout + (size_t)1024 * 1024, 1024, 1024, 96, 8, smem, e);
  }
  else if constexpr (ph == 6) ph_ln(p, 0);
  else if constexpr (ph == 21) ph_ln(p, 3);
  else if constexpr (ph == 7) {
    EpiMlaG1 e{p.RAW, p.KR, p.SZ, p.out + OUT_KR};
    gemm_phase(p.H, 1024, p.Wmin, 1024, 1024, 96, 15, smem, e);
  }
  else if constexpr (ph == 8) ph_mla_norm(p);
  else if constexpr (ph == 9) ph_mla_g2(p, smem);
  else if constexpr (ph == 10) ph_mla_attn(p, smem);
  else if constexpr (ph == 11) {
    EpiG3 e{p.out, p.out + OUT_YS, p.out, p.mod + 1 * 5 * 3072};
    gemm_phase(p.AO, 1024, p.Wmout, 1024, 1024, 96, 8, smem, e);
  }
  else if constexpr (ph == 12) ph_ln(p, 1);
  else if constexpr (ph == 13) ph_na_g1(p, smem);
  else if constexpr (ph == 14) ph_na_attn(p, smem);
  else if constexpr (ph == 15) {
    EpiG3 e{p.out, p.out + OUT_YS, p.out, p.mod + 2 * 5 * 3072};
    gemm_phase(p.NAO, 1024, p.Wnout, 1024, 1024, 96, 8, smem, e);
  }
  else if constexpr (ph == 16) ph_ln(p, 2);
}

#define RUN_PH(n) if (ph_lo <= (n) && (n) < ph_hi) { run_phase<n>(p, smem); if ((n) + 1 < ph_hi) xcd_barrier(xb); }

__global__ void __launch_bounds__(256, 2) mega(Params p, int ph_lo, int ph_hi) {
  __shared__ __attribute__((aligned(16))) char smem[SMEM_BYTES + 16];
  if (ph_lo < 0) { cg::this_grid().sync(); return; }
  const bool multi = (ph_hi - ph_lo) > 1;
  XcdBarrier xb; xb.bar = p.bar; xb.x = 0; xb.st = (volatile LAS unsigned*)(smem + SMEM_BYTES);
  if (multi) {
    if (threadIdx.x == 0) { *(uint4*)(smem + SMEM_BYTES) = make_uint4(0u, 0u, 0u, 0u); }
    __syncthreads();
    xb = xcd_barrier_post(p.bar, (volatile LAS unsigned*)(smem + SMEM_BYTES));
  }
  RUN_PH(0) RUN_PH(1) RUN_PH(2) RUN_PH(3) RUN_PH(4) RUN_PH(5) RUN_PH(6) RUN_PH(7) RUN_PH(8) RUN_PH(9) RUN_PH(10)
  RUN_PH(11) RUN_PH(12) RUN_PH(13) RUN_PH(14) RUN_PH(15) RUN_PH(16) RUN_PH(17) RUN_PH(18) RUN_PH(19) RUN_PH(20) RUN_PH(21)
}

extern "C" void kernel_launch(void* const* d_in, const int* in_sizes, int n_in, void* d_out, int out_size, void* d_ws, size_t ws_size,
                              hipStream_t stream) {
  Params p;
  memset(&p, 0, sizeof(p));
  const float* const* in = (const float* const*)d_in;
  p.x_prompt = in[0]; p.x_sample = in[1]; p.cache_ckv = in[2]; p.cache_kr = in[3]; p.cache_nak = in[4]; p.cache_nav = in[5];
  p.c = in[6]; p.c_ctx = in[7]; p.ada_w = in[8]; p.ada_b = in[9]; p.ln_g = in[10]; p.ln_b = in[11];
  const float* pool_w_in = in[12]; const float* pool_w_grp = in[13]; p.pool_scale = in[14]; const float* pool_w_out = in[15];
  const float* mla_w_in = in[16]; p.mla_q_norm = in[17]; const float* mla_w_uq = in[18]; p.mla_kv_norm = in[19];
  const float* mla_w_ukv = in[20]; const float* mla_w_out = in[21]; const float* na_w_in = in[22]; p.na_rpb = in[23];
  const float* na_w_out = in[24];
  p.out = (float*)d_out;

  char* ws = (char*)d_ws;
  size_t off = 0;
  auto take = [&](size_t bytes) { char* r = ws + off; off += (bytes + 255) & ~(size_t)255; return r; };
  p.bar = (unsigned*)take(XCD_BAR_WORDS * 4);
  p.mod = (float*)take((size_t)4 * 5 * 3072 * 4);
  p.Wpin = (u16*)take((size_t)2 * 2048 * 1024 * 2);
  p.Wgrp = (u16*)take((size_t)8 * 65536 * 2);
  p.Wpout = (u16*)take((size_t)2 * 1024 * 1024 * 2);
  p.Wmin = (u16*)take((size_t)1920 * 1024 * 2);
  p.Wuq = (u16*)take((size_t)1536 * 512 * 2);
  p.Wukv = (u16*)take((size_t)2048 * 256 * 2);
  p.Wmout = (u16*)take((size_t)1024 * 1024 * 2);
  p.Wnin = (u16*)take((size_t)4096 * 1024 * 2);
  p.Wnout = (u16*)take((size_t)1024 * 1024 * 2);
  p.H = (u16*)take((size_t)T * 1024 * 2);
  p.SZ = (u16*)take((size_t)T * 1024 * 2);
  const size_t arena0 = off;
  p.U = (u16*)take((size_t)T * 1024 * 2);
  p.MIX = (u16*)take((size_t)T * 1024 * 2);
  p.PM = (u16*)take((size_t)T * 1024 * 2);
  off = arena0;
  p.RAW = (float*)take((size_t)T * 768 * 4);
  p.AO = (u16*)p.RAW;
  p.CQN = (u16*)take((size_t)T * 512 * 2);
  p.CKVN = (u16*)take((size_t)KVR * 256 * 2);
  p.KR = (u16*)take((size_t)KVR * 64 * 2);
  p.Q = (u16*)take((size_t)T * 1536 * 2);
  p.KN = (u16*)take((size_t)KVR * 1024 * 2);
  p.VT = (u16*)take((size_t)KVR * 1024 * 2);
  off = arena0;
  p.NQ = (u16*)take((size_t)T * 1024 * 2);
  p.NK = (u16*)take((size_t)KVR * 1024 * 2);
  p.NVT = (u16*)take((size_t)KVR * 1024 * 2);
  p.NAO = (u16*)take((size_t)T * 1024 * 2);

  int nm = 0, tiles = 0;
  auto add = [&](const float* src, u16* dst, int K, int Nsrc, int Ndst) {
    p.mats[nm].src = src; p.mats[nm].dst = dst; p.mats[nm].K = K; p.mats[nm].Nsrc = Nsrc; p.mats[nm].Ndst = Ndst; p.mats[nm].tile0 = tiles;
    tiles += (K / 64) * (Ndst / 64); nm++;
  };
  for (int j = 0; j < 2; j++) add(pool_w_in + (size_t)j * 1024 * 2048, p.Wpin + (size_t)j * 2048 * 1024, 1024, 2048, 2048);
  for (int j = 0; j < 8; j++) add(pool_w_grp + (size_t)j * 65536, p.Wgrp + (size_t)j * 65536, 256, 256, 256);
  for (int j = 0; j < 2; j++) add(pool_w_out + (size_t)j * 1024 * 1024, p.Wpout + (size_t)j * 1024 * 1024, 1024, 1024, 1024);
  add(mla_w_in, p.Wmin, 1024, 1856, 1920);
  add(mla_w_uq, p.Wuq, 512, 1536, 1536);
  add(mla_w_ukv, p.Wukv, 256, 2048, 2048);
  add(mla_w_out, p.Wmout, 1024, 1024, 1024);
  add(na_w_in, p.Wnin, 1024, 4096, 4096);
  add(na_w_out, p.Wnout, 1024, 1024, 1024);
  p.nmat_tiles = tiles;

  (void)hipMemsetAsync(p.bar, 0, XCD_BAR_WORDS * 4, stream);
#if MULTI_LAUNCH
  for (int ph = 0; ph < NPHASE; ph++) hipLaunchKernelGGL(mega, dim3(512), dim3(256), 0, stream, p, ph, ph + 1);
#else
  static int grid_blocks = 0;
  if (!grid_blocks) {
    int dev = 0, cus = 0, per_cu = 0;
    hipGetDevice(&dev);
    hipDeviceGetAttribute(&cus, hipDeviceAttributeMultiprocessorCount, dev);
    hipOccupancyMaxActiveBlocksPerMultiprocessor(&per_cu, mega, 256, 0);
    if (per_cu > 2) per_cu = 2;
    if (per_cu < 1) per_cu = 1;
    grid_blocks = cus * per_cu;
  }
  int lo = 0, hi = NPHASE;
  void* args[] = {&p, &lo, &hi};
  hipError_t e = hipLaunchCooperativeKernel((void*)mega, dim3(grid_blocks), dim3(256), args, 0, stream);
  if (e != hipSuccess) fprintf(stderr, "cooperative launch failed: %s (grid %d)\n", hipGetErrorString(e), grid_blocks);
#endif
}
```

```cpp
#include <hip/hip_runtime.h>
#include <hip/hip_cooperative_groups.h>
#include <stdint.h>
#include <string.h>
#include <stdio.h>
namespace cg = cooperative_groups;

#ifndef MULTI_LAUNCH
#define MULTI_LAUNCH 0
#endif

typedef __attribute__((ext_vector_type(8))) short bf16x8;
typedef __attribute__((ext_vector_type(4))) float f32x4;
typedef __attribute__((ext_vector_type(16))) float f32x16;
typedef __attribute__((ext_vector_type(4))) uint32_t u32x4;
typedef unsigned short u16;
#define DI __device__ __forceinline__
#define MFMA32(a, b, c) __builtin_amdgcn_mfma_f32_32x32x16_bf16((a), (b), (c), 0, 0, 0)
#define MFMA16(a, b, c) __builtin_amdgcn_mfma_f32_16x16x32_bf16((a), (b), (c), 0, 0, 0)

constexpr int TC = 4096, TL = 8192, T = 12288;
constexpr int KVR = 4096 + 4 * 2304;
constexpr float LOG2E = 1.4426950408889634f;
constexpr float ALPHA = 1.681792830507429f;
constexpr float MLA_QS = 0.07216878364870323f * LOG2E;
constexpr float NA_QS = 0.125f * LOG2E;
constexpr int SMEM_BYTES = 73728;
constexpr int NPHASE = 22;

constexpr size_t OUT_YS = 4194304, OUT_CKV = 12582912, OUT_KR = 13631488, OUT_NAK = 13893632, OUT_NAV = 18087936;

struct MatDesc { const float* src; u16* dst; int K, Nsrc, Ndst, tile0; };

struct Params {
  const float *x_prompt, *x_sample, *cache_ckv, *cache_kr, *cache_nak, *cache_nav, *c, *c_ctx, *ada_w, *ada_b, *ln_g, *ln_b;
  const float *pool_scale, *mla_q_norm, *mla_kv_norm, *na_rpb;
  float* out;
  float* mod;
  u16 *H, *SZ;
  u16 *Wpin, *Wgrp, *Wpout, *Wmin, *Wuq, *Wukv, *Wmout, *Wnin, *Wnout;
  u16 *U, *MIX, *PM;
  float* RAW; u16 *AO, *CQN, *CKVN, *KR, *Q, *KN, *VT;
  u16 *NQ, *NK, *NVT, *NAO;
  unsigned* bar;
  MatDesc mats[18];
  int nmat_tiles; int pad0;
};

DI float bf2f(u16 v) { return __uint_as_float(((uint32_t)v) << 16); }
DI u16 f2bf(float x) { uint32_t u = __float_as_uint(x); u += 0x7fffu + ((u >> 16) & 1u); return (u16)(u >> 16); }
DI uint32_t pk2(float a, float b) { return (uint32_t)f2bf(a) | ((uint32_t)f2bf(b) << 16); }
DI float silu(float v) { return v / (1.f + __expf(-v)); }
DI int cond_of(int t) { return t < TC ? 0 : 1 + ((t - TC) >> 11); }
DI int kvrow_of(int t) { return t < TC ? t : TC + ((t - TC) >> 11) * 2304 + 256 + ((t - TC) & 2047); }
DI int perm16(int key) { const int k = key & 15; return (key & ~15) | (k & 3) | ((k >> 1) & 4) | ((k << 1) & 8); }
DI float wave_sum(float v) {
#pragma unroll
  for (int o = 32; o >= 1; o >>= 1) v += __shfl_xor(v, o);
  return v;
}

#define XB_TMO      128
#define XB_XCNT(j)  (256  + 64 * (j))
#define XB_XSUB(j)  (1280 + 64 * (j))
#define XB_XGEN(j)  (2304 + 64 * (j))
#define XB_TOP      3328
#define XB_TOPGEN   3392
#define XCD_BAR_WORDS 3456
#define XB_SPIN_CAP (1u << 22)
#define LAS __attribute__((address_space(3)))
DI unsigned xb_ld(unsigned* p) { return __hip_atomic_load(p, __ATOMIC_RELAXED, __HIP_MEMORY_SCOPE_AGENT); }
DI unsigned xb_add(unsigned* p, unsigned v) { return __hip_atomic_fetch_add(p, v, __ATOMIC_RELAXED, __HIP_MEMORY_SCOPE_AGENT); }
DI unsigned xb_xcc_id() { return (unsigned)__builtin_amdgcn_s_getreg((3 << 11) | 20) & 0xFu; }
#define XB_SPIN(cond, bar) do { unsigned _sp = 0; while (cond) { __builtin_amdgcn_s_sleep(1); \
    if ((++_sp & 255u) == 0u) { if (xb_ld(&(bar)[XB_TMO])) break; if (_sp > XB_SPIN_CAP) { atomicAdd(&(bar)[XB_TMO], 1u); break; } } } } while (0)
struct XcdBarrier { unsigned* bar; unsigned x; volatile LAS unsigned* st; };
DI XcdBarrier xcd_barrier_post(unsigned* bar, volatile LAS unsigned* st) {
  XcdBarrier b; b.bar = bar; b.x = xb_xcc_id(); b.st = st;
  if (threadIdx.x == 0) (void)xb_add(&bar[XB_XCNT(b.x)], 1u);
  return b;
}
DI void xcd_barrier_complete(unsigned* bar, unsigned x, unsigned& nloc, unsigned& nx) {
  const unsigned G = gridDim.x * gridDim.y * gridDim.z;
  unsigned sum, cnt, mine, sp = 0u;
  for (;;) {
    sum = 0u; cnt = 0u; mine = 0u;
#pragma unroll
    for (unsigned j = 0; j < 16; ++j) { const unsigned c = xb_ld(&bar[XB_XCNT(j)]); sum += c; cnt += (c > 0u) ? 1u : 0u; mine = (j == x) ? c : mine; }
    if (sum == G) break;
    __builtin_amdgcn_s_sleep(1);
    if ((++sp & 255u) == 0u) { if (xb_ld(&bar[XB_TMO])) break; if (sp > XB_SPIN_CAP) { atomicAdd(&bar[XB_TMO], 1u); break; } }
  }
  nloc = mine > 0u ? mine : 1u; nx = cnt > 0u ? cnt : 1u;
}
DI void xcd_barrier(const XcdBarrier& b) {
  asm volatile("s_waitcnt vmcnt(0)" ::: "memory");
  __syncthreads();
  if (threadIdx.x == 0) {
    unsigned* bar = b.bar;
    __builtin_amdgcn_s_waitcnt(0);
    unsigned nloc = b.st[0], nx = b.st[1];
    if (nloc == 0u) { xcd_barrier_complete(bar, b.x, nloc, nx); b.st[0] = nloc; b.st[1] = nx; }
    const unsigned old = xb_add(&bar[XB_XSUB(b.x)], 1u);
    const unsigned gen = old / nloc;
    if (old + 1u == (gen + 1u) * nloc) {
      __builtin_amdgcn_fence(__ATOMIC_RELEASE, "agent");
      asm volatile("s_waitcnt vmcnt(0)" ::: "memory");
      const unsigned og = xb_add(&bar[XB_TOP], 1u);
      const unsigned tg = og / nx;
      if (og + 1u == (tg + 1u) * nx) xb_add(&bar[XB_TOPGEN], 1u);
      else XB_SPIN(xb_ld(&bar[XB_TOPGEN]) == tg, bar);
      __builtin_amdgcn_fence(__ATOMIC_ACQUIRE, "agent");
      xb_add(&bar[XB_XGEN(b.x)], 1u);
      asm volatile("s_waitcnt vmcnt(0)" ::: "memory");
    } else {
      XB_SPIN(xb_ld(&bar[XB_XGEN(b.x)]) == gen, bar);
      __builtin_amdgcn_fence(__ATOMIC_ACQUIRE, "agent");
      asm volatile("s_waitcnt vmcnt(0)" ::: "memory");
    }
  }
  __syncthreads();
}

template <class Epi>
DI void gemm_tile(const u16* __restrict__ A, int lda, const u16* __restrict__ Bt, int ldb, int K, int m0, int n0, int nout_off,
                  char* smem, const Epi& epi) {
  const int tid = threadIdx.x, lane = tid & 63, wid = tid >> 6;
  const int wm = wid >> 1, wn = wid & 1, l31 = lane & 31, lh = lane >> 5;
  char* As = smem;
  char* Bs = smem + 32768;
  const int srow = tid >> 3;
  const int scc = ((tid & 7) ^ ((tid >> 4) & 7)) * 8;
  const u16* ag = A + (size_t)(m0 + srow) * lda + scc;
  const u16* bg = Bt + (size_t)(n0 + srow) * ldb + scc;
  LAS char* awr = (LAS char*)(As + wid * 1024);
  LAS char* bwr = (LAS char*)(Bs + wid * 1024);
  f32x16 acc[2][2];
#pragma unroll
  for (int i = 0; i < 2; i++)
#pragma unroll
    for (int j = 0; j < 2; j++)
#pragma unroll
      for (int r = 0; r < 16; r++) acc[i][j][r] = 0.f;
  __syncthreads();
#pragma unroll
  for (int i = 0; i < 4; i++) {
    __builtin_amdgcn_global_load_lds((const void*)(ag + (size_t)(32 * i) * lda), (LAS void*)(awr + i * 4096), 16, 0, 0);
    __builtin_amdgcn_global_load_lds((const void*)(bg + (size_t)(32 * i) * ldb), (LAS void*)(bwr + i * 4096), 16, 0, 0);
  }
  asm volatile("s_waitcnt vmcnt(0)" ::: "memory");
  __syncthreads();
  const int nk = K >> 6;
  const int sw = (l31 >> 1) & 7;
  for (int kt = 0; kt < nk; kt++) {
    const int buf = kt & 1;
    if (kt + 1 < nk) {
#pragma unroll
      for (int i = 0; i < 4; i++) {
        __builtin_amdgcn_global_load_lds((const void*)(ag + (size_t)(32 * i) * lda + (kt + 1) * 64), (LAS void*)(awr + (buf ^ 1) * 16384 + i * 4096), 16, 0, 0);
        __builtin_amdgcn_global_load_lds((const void*)(bg + (size_t)(32 * i) * ldb + (kt + 1) * 64), (LAS void*)(bwr + (buf ^ 1) * 16384 + i * 4096), 16, 0, 0);
      }
    }
    const char* as = As + buf * 16384 + (wm * 64 + l31) * 128;
    const char* bs = Bs + buf * 16384 + (wn * 64 + l31) * 128;
#pragma unroll
    for (int ks = 0; ks < 4; ks++) {
      const int co = ((2 * ks + lh) ^ sw) << 4;
      bf16x8 a0 = *(const bf16x8*)(as + co);
      bf16x8 a1 = *(const bf16x8*)(as + 32 * 128 + co);
      bf16x8 b0 = *(const bf16x8*)(bs + co);
      bf16x8 b1 = *(const bf16x8*)(bs + 32 * 128 + co);
      acc[0][0] = MFMA32(b0, a0, acc[0][0]);
      acc[0][1] = MFMA32(b1, a0, acc[0][1]);
      acc[1][0] = MFMA32(b0, a1, acc[1][0]);
      acc[1][1] = MFMA32(b1, a1, acc[1][1]);
    }
    asm volatile("s_waitcnt vmcnt(0)" ::: "memory");
    __syncthreads();
  }
#pragma unroll
  for (int i = 0; i < 2; i++)
#pragma unroll
    for (int j = 0; j < 2; j++)
      epi(m0 + wm * 64 + i * 32 + l31, nout_off + n0 + wn * 64 + j * 32, lh, acc[i][j]);
}

DI void rope_pair(float x1, float x2, int i, float pos, float& o1, float& o2) {
  const float inv = exp2f(-(float)i * (13.287712379549449f / 16.f));
  const float ang = pos * inv;
  const float c = __cosf(ang), s = __sinf(ang);
  o1 = x1 * c - x2 * s;
  o2 = x1 * s + x2 * c;
}

struct EpiPoolG1 {
  u16 *U, *SZ;
  DI void operator()(int m, int nb, int lh, const f32x16& a) const {
#pragma unroll
    for (int g = 0; g < 4; g++) {
      const int n = nb + 8 * g + 4 * lh;
      if (nb < 1024) {
        uint2 v; v.x = pk2(a[4 * g], a[4 * g + 1]); v.y = pk2(a[4 * g + 2], a[4 * g + 3]);
        *(uint2*)(U + (size_t)m * 1024 + n) = v;
      } else {
        uint2 v; v.x = pk2(silu(a[4 * g]), silu(a[4 * g + 1])); v.y = pk2(silu(a[4 * g + 2]), silu(a[4 * g + 3]));
        *(uint2*)(SZ + (size_t)m * 1024 + n - 1024) = v;
      }
    }
  }
};
struct EpiPoolG2 {
  u16* PM; const u16* SZ; const float* scale;
  DI void operator()(int m, int nb, int lh, const f32x16& a) const {
#pragma unroll
    for (int g = 0; g < 4; g++) {
      const int n = nb + 8 * g + 4 * lh;
      const uint2 z = *(const uint2*)(SZ + (size_t)m * 1024 + n);
      const float4 sc = *(const float4*)(scale + n);
      uint2 v;
      v.x = pk2(a[4 * g] * sc.x * bf2f((u16)(z.x & 0xffff)), a[4 * g + 1] * sc.y * bf2f((u16)(z.x >> 16)));
      v.y = pk2(a[4 * g + 2] * sc.z * bf2f((u16)(z.y & 0xffff)), a[4 * g + 3] * sc.w * bf2f((u16)(z.y >> 16)));
      *(uint2*)(PM + (size_t)m * 1024 + n) = v;
    }
  }
};
struct EpiG3 {
  const float *xp, *xs;
  float* out; const float* mod_layer;
  DI void operator()(int m, int nb, int lh, const f32x16& a) const {
    const float* xr = (m < TC) ? xp + (size_t)m * 1024 : xs + (size_t)(m - TC) * 1024;
    const float* gate = mod_layer + cond_of(m) * 3072 + 2048;
#pragma unroll
    for (int g = 0; g < 4; g++) {
      const int n = nb + 8 * g + 4 * lh;
      const float4 x = *(const float4*)(xr + n);
      const float4 gt = *(const float4*)(gate + n);
      float4 r;
      r.x = ALPHA * x.x + gt.x * a[4 * g]; r.y = ALPHA * x.y + gt.y * a[4 * g + 1];
      r.z = ALPHA * x.z + gt.z * a[4 * g + 2]; r.w = ALPHA * x.w + gt.w * a[4 * g + 3];
      *(float4*)(out + (size_t)m * 1024 + n) = r;
    }
  }
};
struct EpiMlaG1 {
  float* RAW; u16* KR; u16* SZ; float* st_kr;
  DI void operator()(int m, int nb, int lh, const f32x16& a) const {
    if (nb >= 1856) return;
    if (nb < 768) {
#pragma unroll
      for (int g = 0; g < 4; g++) {
        const int n = nb + 8 * g + 4 * lh;
        float4 r; r.x = a[4 * g]; r.y = a[4 * g + 1]; r.z = a[4 * g + 2]; r.w = a[4 * g + 3];
        *(float4*)(RAW + (size_t)m * 768 + n) = r;
      }
    } else if (nb < 832) {
      const int off = nb - 768;
      const bool lat = m >= TC;
      const int tt = (m - TC) & 2047;
      const float pos = (off == 0) ? (float)(tt >> 6) : (float)(tt & 63);
      const size_t kr = (size_t)kvrow_of(m) * 64 + off;
#pragma unroll
      for (int g = 0; g < 2; g++) {
        float o1[4], o2[4];
#pragma unroll
        for (int e = 0; e < 4; e++) {
          const int i = 8 * g + 4 * lh + e;
          const float x1 = a[4 * g + e], x2 = a[4 * (g + 2) + e];
          if (lat) rope_pair(x1, x2, i, pos, o1[e], o2[e]); else { o1[e] = x1; o2[e] = x2; }
        }
        const int i0 = 8 * g + 4 * lh;
        if (!lat) {
          float4 r1; r1.x = o1[0]; r1.y = o1[1]; r1.z = o1[2]; r1.w = o1[3];
          float4 r2; r2.x = o2[0]; r2.y = o2[1]; r2.z = o2[2]; r2.w = o2[3];
          *(float4*)(st_kr + (size_t)m * 64 + off + i0) = r1;
          *(float4*)(st_kr + (size_t)m * 64 + off + i0 + 16) = r2;
        }
        uint2 v1; v1.x = pk2(o1[0], o1[1]); v1.y = pk2(o1[2], o1[3]);
        uint2 v2; v2.x = pk2(o2[0], o2[1]); v2.y = pk2(o2[2], o2[3]);
        *(uint2*)(KR + kr + i0) = v1;
        *(uint2*)(KR + kr + i0 + 16) = v2;
      }
    } else {
#pragma unroll
      for (int g = 0; g < 4; g++) {
        const int n = nb + 8 * g + 4 * lh - 832;
        uint2 v; v.x = pk2(silu(a[4 * g]), silu(a[4 * g + 1])); v.y = pk2(silu(a[4 * g + 2]), silu(a[4 * g + 3]));
        *(uint2*)(SZ + (size_t)m * 1024 + n) = v;
      }
    }
  }
};
struct EpiMlaQ {
  u16* Q;
  DI void operator()(int m, int nb, int lh, const f32x16& a) const {
    const int head = nb / 192, off = nb - head * 192;
    u16* qr = Q + (size_t)m * 1536 + nb;
    if (off < 128) {
#pragma unroll
      for (int g = 0; g < 4; g++) {
        uint2 v; v.x = pk2(a[4 * g] * MLA_QS, a[4 * g + 1] * MLA_QS); v.y = pk2(a[4 * g + 2] * MLA_QS, a[4 * g + 3] * MLA_QS);
        *(uint2*)(qr + 8 * g + 4 * lh) = v;
      }
    } else {
      const bool lat = m >= TC;
      const int tt = (m - TC) & 2047;
      const float pos = (off == 128) ? (float)(tt >> 6) : (float)(tt & 63);
#pragma unroll
      for (int g = 0; g < 2; g++) {
        float o1[4], o2[4];
#pragma unroll
        for (int e = 0; e < 4; e++) {
          const int i = 8 * g + 4 * lh + e;
          const float x1 = a[4 * g + e], x2 = a[4 * (g + 2) + e];
          if (lat) rope_pair(x1, x2, i, pos, o1[e], o2[e]); else { o1[e] = x1; o2[e] = x2; }
        }
        const int i0 = 8 * g + 4 * lh;
        uint2 v1; v1.x = pk2(o1[0] * MLA_QS, o1[1] * MLA_QS); v1.y = pk2(o1[2] * MLA_QS, o1[3] * MLA_QS);
        uint2 v2; v2.x = pk2(o2[0] * MLA_QS, o2[1] * MLA_QS); v2.y = pk2(o2[2] * MLA_QS, o2[3] * MLA_QS);
        *(uint2*)(qr + i0) = v1;
        *(uint2*)(qr + i0 + 16) = v2;
      }
    }
  }
};
struct EpiMlaKV {
  u16 *KN, *VT;
  DI void operator()(int m, int nb, int lh, const f32x16& a) const {
    const int head = nb >> 8, off = nb & 255;
    if (off < 128) {
#pragma unroll
      for (int g = 0; g < 4; g++) {
        uint2 v; v.x = pk2(a[4 * g], a[4 * g + 1]); v.y = pk2(a[4 * g + 2], a[4 * g + 3]);
        *(uint2*)(KN + (size_t)m * 1024 + head * 128 + off + 8 * g + 4 * lh) = v;
      }
    } else {
      size_t base; int Lk, key;
      if (m < TC) { base = (size_t)(m >> 8) * (8 * 128 * 256); Lk = 256; key = m & 255; }
      else { const int r2 = m - TC; const int b = r2 / 2304; key = r2 - b * 2304; Lk = 2304; base = (size_t)16 * 8 * 128 * 256 + (size_t)b * (8 * 128 * 2304); }
      u16* vp = VT + base + (size_t)(head * 128 + off - 128) * Lk + perm16(key);
#pragma unroll
      for (int g = 0; g < 4; g++)
#pragma unroll
        for (int e = 0; e < 4; e++) vp[(size_t)(8 * g + 4 * lh + e) * Lk] = f2bf(a[4 * g + e]);
    }
  }
};
struct EpiNaG1 {
  u16 *NQ, *NK, *NVT, *SZ; float *st_k, *st_v;
  DI void operator()(int m, int nb, int lh, const f32x16& a) const {
    if (nb < 1024) {
#pragma unroll
      for (int g = 0; g < 4; g++) {
        uint2 v; v.x = pk2(a[4 * g] * NA_QS, a[4 * g + 1] * NA_QS); v.y = pk2(a[4 * g + 2] * NA_QS, a[4 * g + 3] * NA_QS);
        *(uint2*)(NQ + (size_t)m * 1024 + nb + 8 * g + 4 * lh) = v;
      }
    } else if (nb < 2048) {
      const size_t kr = (size_t)kvrow_of(m) * 1024 + (nb - 1024);
#pragma unroll
      for (int g = 0; g < 4; g++) {
        uint2 v; v.x = pk2(a[4 * g], a[4 * g + 1]); v.y = pk2(a[4 * g + 2], a[4 * g + 3]);
        *(uint2*)(NK + kr + 8 * g + 4 * lh) = v;
        if (m < TC) { float4 r; r.x = a[4 * g]; r.y = a[4 * g + 1]; r.z = a[4 * g + 2]; r.w = a[4 * g + 3];
          *(float4*)(st_k + (size_t)m * 1024 + (nb - 1024) + 8 * g + 4 * lh) = r; }
      }
    } else if (nb < 3072) {
      const int c0 = nb - 2048;
      size_t base; int Lk, key;
      if (m < TC) { base = (size_t)(m >> 8) * (1024 * 256); Lk = 256; key = perm16(m & 255); }
      else { const int b = (m - TC) >> 11; key = 256 + ((m - TC) & 2047); Lk = 2304; base = (size_t)16 * 1024 * 256 + (size_t)b * (1024 * 2304); }
      u16* vp = NVT + base + (size_t)c0 * Lk + key;
#pragma unroll
      for (int g = 0; g < 4; g++) {
#pragma unroll
        for (int e = 0; e < 4; e++) vp[(size_t)(8 * g + 4 * lh + e) * Lk] = f2bf(a[4 * g + e]);
        if (m < TC) { float4 r; r.x = a[4 * g]; r.y = a[4 * g + 1]; r.z = a[4 * g + 2]; r.w = a[4 * g + 3];
          *(float4*)(st_v + (size_t)m * 1024 + c0 + 8 * g + 4 * lh) = r; }
      }
    } else {
#pragma unroll
      for (int g = 0; g < 4; g++) {
        uint2 v; v.x = pk2(silu(a[4 * g]), silu(a[4 * g + 1])); v.y = pk2(silu(a[4 * g + 2]), silu(a[4 * g + 3]));
        *(uint2*)(SZ + (size_t)m * 1024 + (nb - 3072) + 8 * g + 4 * lh) = v;
      }
    }
  }
};

template <int NSA, int NSB, int NDT>
DI void attn_dense_wave(const u16* __restrict__ qrow, const u16* __restrict__ kA, int kAstride, const u16* __restrict__ kB,
                        const u16* __restrict__ vt, int Lk, int nkeys, const u16* __restrict__ szrow, u16* __restrict__ orow) {
  const int lane = threadIdx.x & 63, l31 = lane & 31, lh = lane >> 5;
  bf16x8 qf[NSA + NSB];
#pragma unroll
  for (int s = 0; s < NSA + NSB; s++) qf[s] = *(const bf16x8*)(qrow + s * 16 + lh * 8);
  f32x16 o[NDT];
#pragma unroll
  for (int d = 0; d < NDT; d++)
#pragma unroll
    for (int r = 0; r < 16; r++) o[d][r] = 0.f;
  float m = -1e30f, l = 0.f;
  for (int k0 = 0; k0 < nkeys; k0 += 32) {
    f32x16 sa;
#pragma unroll
    for (int r = 0; r < 16; r++) sa[r] = 0.f;
    const u16* kp = kA + (size_t)(k0 + l31) * kAstride + lh * 8;
#pragma unroll
    for (int s = 0; s < NSA; s++) sa = MFMA32(*(const bf16x8*)(kp + s * 16), qf[s], sa);
    if (NSB > 0) {
      const u16* kp2 = kB + (size_t)(k0 + l31) * 64 + lh * 8;
#pragma unroll
      for (int s = 0; s < NSB; s++) sa = MFMA32(*(const bf16x8*)(kp2 + s * 16), qf[NSA + s], sa);
    }
    float mx = sa[0];
#pragma unroll
    for (int r = 1; r < 16; r++) mx = fmaxf(mx, sa[r]);
    mx = fmaxf(mx, __shfl_xor(mx, 32));
    const float mn = fmaxf(m, mx);
    const float alpha = exp2f(m - mn);
    m = mn;
    float ps = 0.f;
#pragma unroll
    for (int r = 0; r < 16; r++) { sa[r] = exp2f(sa[r] - mn); ps += sa[r]; }
    l = l * alpha + ps;
#pragma unroll
    for (int d = 0; d < NDT; d++)
#pragma unroll
      for (int r = 0; r < 16; r++) o[d][r] *= alpha;
#pragma unroll
    for (int sp = 0; sp < 2; sp++) {
      u32x4 pw;
      pw[0] = pk2(sa[8 * sp + 0], sa[8 * sp + 1]); pw[1] = pk2(sa[8 * sp + 2], sa[8 * sp + 3]);
      pw[2] = pk2(sa[8 * sp + 4], sa[8 * sp + 5]); pw[3] = pk2(sa[8 * sp + 6], sa[8 * sp + 7]);
      const bf16x8 pf = __builtin_bit_cast(bf16x8, pw);
#pragma unroll
      for (int d = 0; d < NDT; d++) {
        const u16* vp = vt + (size_t)(d * 32 + l31) * Lk + k0 + 16 * sp + 4 * lh;
        const uint2 lo = *(const uint2*)vp, hi = *(const uint2*)(vp + 8);
        u32x4 vw; vw[0] = lo.x; vw[1] = lo.y; vw[2] = hi.x; vw[3] = hi.y;
        o[d] = MFMA32(__builtin_bit_cast(bf16x8, vw), pf, o[d]);
      }
    }
  }
  l += __shfl_xor(l, 32);
  const float inv = 1.f / l;
#pragma unroll
  for (int d = 0; d < NDT; d++)
#pragma unroll
    for (int g = 0; g < 4; g++) {
      const int d0 = d * 32 + 8 * g + 4 * lh;
      const uint2 z = *(const uint2*)(szrow + d0);
      uint2 v;
      v.x = pk2(o[d][4 * g] * inv * bf2f((u16)(z.x & 0xffff)), o[d][4 * g + 1] * inv * bf2f((u16)(z.x >> 16)));
      v.y = pk2(o[d][4 * g + 2] * inv * bf2f((u16)(z.y & 0xffff)), o[d][4 * g + 3] * inv * bf2f((u16)(z.y >> 16)));
      *(uint2*)(orow + d0) = v;
    }
}


template <int NSA, int NSB, int NDT>
DI void attn_dense_block(char* smem, const u16* __restrict__ qrow, const u16* __restrict__ kA, int kAstride, const u16* __restrict__ kB,
                         const u16* __restrict__ vt, int Lk, int nkeys, const u16* __restrict__ szrow, u16* __restrict__ orow) {
  constexpr int NS = NSA + NSB, DK = 16 * NS, KST = DK + 8, DV = 32 * NDT, VST = 72;
  constexpr int CA = NSA * 2, CB = NSB * 2;
  constexpr int NLA = 64 * CA / 256, NLB = 64 * CB / 256, NLV = DV * 8 / 256;
  const int tid = threadIdx.x, lane = tid & 63, l31 = lane & 31, lh = lane >> 5;
  u16* Ks = (u16*)smem;
  u16* Vs = Ks + 64 * KST;
  u32x4 ra[NLA], rb[NLB > 0 ? NLB : 1], rv[NLV];
  bf16x8 qf[NS];
#pragma unroll
  for (int s = 0; s < NS; s++) qf[s] = *(const bf16x8*)(qrow + s * 16 + lh * 8);
  f32x16 o[NDT];
#pragma unroll
  for (int d = 0; d < NDT; d++)
#pragma unroll
    for (int r = 0; r < 16; r++) o[d][r] = 0.f;
  float m = -1e30f, l = 0.f;

    {
#pragma unroll
      for (int i = 0; i < NLA; i++) { const int c = tid + 256 * i; const int row = c / CA, cc = c % CA;
        ra[i] = *(const u32x4*)(kA + (size_t)((0) + row) * kAstride + cc * 8); }
      if constexpr (NLB > 0) {
#pragma unroll
        for (int i = 0; i < NLB; i++) { const int c = tid + 256 * i; const int row = c / CB, cc = c % CB;
          rb[i] = *(const u32x4*)(kB + (size_t)((0) + row) * 64 + cc * 8); }
      }
#pragma unroll
      for (int i = 0; i < NLV; i++) { const int c = tid + 256 * i; const int row = c >> 3, cc = c & 7;
        rv[i] = *(const u32x4*)(vt + (size_t)row * Lk + (0) + cc * 8); }
    }
  __syncthreads();
    {
#pragma unroll
      for (int i = 0; i < NLA; i++) { const int c = tid + 256 * i; const int row = c / CA, cc = c % CA;
        *(u32x4*)(Ks + row * KST + cc * 8) = ra[i]; }
      if constexpr (NLB > 0) {
#pragma unroll
        for (int i = 0; i < NLB; i++) { const int c = tid + 256 * i; const int row = c / CB, cc = c % CB;
          *(u32x4*)(Ks + row * KST + NSA * 16 + cc * 8) = rb[i]; }
      }
#pragma unroll
      for (int i = 0; i < NLV; i++) { const int c = tid + 256 * i; const int row = c >> 3, cc = c & 7;
        *(u32x4*)(Vs + row * VST + cc * 8) = rv[i]; }
    }
  __syncthreads();
  for (int k0 = 0; k0 < nkeys; k0 += 64) {
    const bool more = (k0 + 64) < nkeys;
    const int kn = more ? k0 + 64 : k0;
    {
#pragma unroll
      for (int i = 0; i < NLA; i++) { const int c = tid + 256 * i; const int row = c / CA, cc = c % CA;
        ra[i] = *(const u32x4*)(kA + (size_t)(kn + row) * kAstride + cc * 8); }
      if constexpr (NLB > 0) {
#pragma unroll
        for (int i = 0; i < NLB; i++) { const int c = tid + 256 * i; const int row = c / CB, cc = c % CB;
          rb[i] = *(const u32x4*)(kB + (size_t)(kn + row) * 64 + cc * 8); }
      }
#pragma unroll
      for (int i = 0; i < NLV; i++) { const int c = tid + 256 * i; const int row = c >> 3, cc = c & 7;
        rv[i] = *(const u32x4*)(vt + (size_t)row * Lk + kn + cc * 8); }
    }
#pragma unroll 1
    for (int hh = 0; hh < 2; hh++) {
      f32x16 s0;
#pragma unroll
      for (int r = 0; r < 16; r++) s0[r] = 0.f;
      const u16* kp = Ks + (hh * 32 + l31) * KST + lh * 8;
#pragma unroll
      for (int s = 0; s < NS; s++) {
        s0 = MFMA32(*(const bf16x8*)(kp + s * 16), qf[s], s0);
        if ((s & 3) == 3 && s + 1 < NS) __builtin_amdgcn_sched_barrier(0);
      }
      float mx = s0[0];
#pragma unroll
      for (int r = 1; r < 16; r++) mx = fmaxf(mx, s0[r]);
      mx = fmaxf(mx, __shfl_xor(mx, 32));
      if (__any(mx > m + 8.f)) {
        const float mn = fmaxf(m, mx);
        const float alpha = exp2f(m - mn);
        m = mn;
        l *= alpha;
#pragma unroll
        for (int d = 0; d < NDT; d++)
#pragma unroll
          for (int r = 0; r < 16; r++) o[d][r] *= alpha;
      }
      float ps = 0.f;
#pragma unroll
      for (int r = 0; r < 16; r++) { s0[r] = exp2f(s0[r] - m); ps += s0[r]; }
      l += ps;
      const u16* vp = Vs + l31 * VST + hh * 32 + lh * 8;
#pragma unroll
      for (int sp = 0; sp < 2; sp++) {
        u32x4 pw;
        pw[0] = pk2(s0[8 * sp + 0], s0[8 * sp + 1]); pw[1] = pk2(s0[8 * sp + 2], s0[8 * sp + 3]);
        pw[2] = pk2(s0[8 * sp + 4], s0[8 * sp + 5]); pw[3] = pk2(s0[8 * sp + 6], s0[8 * sp + 7]);
        const bf16x8 pf = __builtin_bit_cast(bf16x8, pw);
#pragma unroll
        for (int d = 0; d < NDT; d++) o[d] = MFMA32(*(const bf16x8*)(vp + d * 32 * VST + sp * 16), pf, o[d]);
      }
    }
    __syncthreads();
    if (more)
    {
#pragma unroll
      for (int i = 0; i < NLA; i++) { const int c = tid + 256 * i; const int row = c / CA, cc = c % CA;
        *(u32x4*)(Ks + row * KST + cc * 8) = ra[i]; }
      if constexpr (NLB > 0) {
#pragma unroll
        for (int i = 0; i < NLB; i++) { const int c = tid + 256 * i; const int row = c / CB, cc = c % CB;
          *(u32x4*)(Ks + row * KST + NSA * 16 + cc * 8) = rb[i]; }
      }
#pragma unroll
      for (int i = 0; i < NLV; i++) { const int c = tid + 256 * i; const int row = c >> 3, cc = c & 7;
        *(u32x4*)(Vs + row * VST + cc * 8) = rv[i]; }
    }
    __syncthreads();
  }
  l += __shfl_xor(l, 32);
  const float inv = 1.f / l;
#pragma unroll
  for (int d = 0; d < NDT; d++)
#pragma unroll
    for (int g = 0; g < 4; g++) {
      const int d0 = d * 32 + 8 * g + 4 * lh;
      const uint2 z = *(const uint2*)(szrow + d0);
      uint2 v;
      v.x = pk2(o[d][4 * g] * inv * bf2f((u16)(z.x & 0xffff)), o[d][4 * g + 1] * inv * bf2f((u16)(z.x >> 16)));
      v.y = pk2(o[d][4 * g + 2] * inv * bf2f((u16)(z.y & 0xffff)), o[d][4 * g + 3] * inv * bf2f((u16)(z.y >> 16)));
      *(uint2*)(orow + d0) = v;
    }
}

DI void attn_na_wave(const Params& p, int b, int h, int r, int j) {
  const int lane = threadIdx.x & 63, l15 = lane & 15, q4 = lane >> 4;
  const int t = TC + b * 2048 + r * 64 + j * 16 + l15;
  const u16* qrow = p.NQ + (size_t)t * 1024 + h * 64;
  const bf16x8 qf0 = *(const bf16x8*)(qrow + q4 * 8);
  const bf16x8 qf1 = *(const bf16x8*)(qrow + 32 + q4 * 8);
  const int rs = min(max(r - 4, 0), 24);
  const int bstart = min(max(j * 16 - 8, 0), 32);
  const int c = j * 16 + l15;
  const int cstart = min(max(c - 8, 0), 48);
  const u16* kb = p.NK + (size_t)(TC + b * 2304) * 1024 + h * 64;
  const u16* vb = p.NVT + (size_t)16 * 1024 * 256 + (size_t)b * (1024 * 2304) + (size_t)(h * 64) * 2304;
  const float* rp = p.na_rpb + h * 465;
  f32x4 o[4];
#pragma unroll
  for (int d = 0; d < 4; d++) { o[d][0] = 0.f; o[d][1] = 0.f; o[d][2] = 0.f; o[d][3] = 0.f; }
  float m = -1e30f, l = 0.f;
  const int krow0 = 8 * (l15 >> 2) + (l15 & 3);
  for (int cg4 = 0; cg4 < 4; cg4++) {
    bf16x8 kf[4][4];
    bf16x8 vf[4][4];
#pragma unroll
    for (int c4 = 0; c4 < 4; c4++) {
      const int ch = cg4 * 4 + c4;
      const int key0 = ch < 8 ? ch * 32 : 256 + (rs + ch - 8) * 64 + bstart;
      const u16* kp = kb + (size_t)(key0 + krow0) * 1024 + q4 * 8;
      kf[c4][0] = *(const bf16x8*)(kp);
      kf[c4][1] = *(const bf16x8*)(kp + 32);
      kf[c4][2] = *(const bf16x8*)(kp + 4 * 1024);
      kf[c4][3] = *(const bf16x8*)(kp + 4 * 1024 + 32);
#pragma unroll
      for (int d = 0; d < 4; d++) vf[c4][d] = *(const bf16x8*)(vb + (size_t)(d * 16 + l15) * 2304 + key0 + q4 * 8);
    }
#pragma unroll
    for (int c4 = 0; c4 < 4; c4++) {
      const int ch = cg4 * 4 + c4;
      f32x4 s0 = {0.f, 0.f, 0.f, 0.f}, s1 = {0.f, 0.f, 0.f, 0.f};
      s0 = MFMA16(kf[c4][0], qf0, s0);
      s0 = MFMA16(kf[c4][1], qf1, s0);
      s1 = MFMA16(kf[c4][2], qf0, s1);
      s1 = MFMA16(kf[c4][3], qf1, s1);
      if (cg4 >= 2) {
        const int dr = rs + (ch - 8) - r + 7;
#pragma unroll
        for (int i = 0; i < 4; i++) {
          const int kc0 = bstart + q4 * 8 + i, kc1 = kc0 + 4;
          const bool v0 = (kc0 >= cstart) && (kc0 < cstart + 16);
          const bool v1 = (kc1 >= cstart) && (kc1 < cstart + 16);
          const int dc0 = min(max(kc0 - c + 15, 0), 30), dc1 = min(max(kc1 - c + 15, 0), 30);
          const float b0 = rp[dr * 31 + dc0] * LOG2E, b1 = rp[dr * 31 + dc1] * LOG2E;
          s0[i] = v0 ? s0[i] + b0 : -1e30f;
          s1[i] = v1 ? s1[i] + b1 : -1e30f;
        }
      }
      float mx = fmaxf(fmaxf(fmaxf(s0[0], s0[1]), fmaxf(s0[2], s0[3])), fmaxf(fmaxf(s1[0], s1[1]), fmaxf(s1[2], s1[3])));
      mx = fmaxf(mx, __shfl_xor(mx, 16));
      mx = fmaxf(mx, __shfl_xor(mx, 32));
      const float mn = fmaxf(m, mx);
      const float alpha = exp2f(m - mn);
      m = mn;
      float ps = 0.f;
#pragma unroll
      for (int i = 0; i < 4; i++) { s0[i] = exp2f(s0[i] - mn); s1[i] = exp2f(s1[i] - mn); ps += s0[i] + s1[i]; }
      l = l * alpha + ps;
      u32x4 pw; pw[0] = pk2(s0[0], s0[1]); pw[1] = pk2(s0[2], s0[3]); pw[2] = pk2(s1[0], s1[1]); pw[3] = pk2(s1[2], s1[3]);
      const bf16x8 pf = __builtin_bit_cast(bf16x8, pw);
#pragma unroll
      for (int d = 0; d < 4; d++) {
        o[d][0] *= alpha; o[d][1] *= alpha; o[d][2] *= alpha; o[d][3] *= alpha;
        o[d] = MFMA16(vf[c4][d], pf, o[d]);
      }
    }
  }
  l += __shfl_xor(l, 16);
  l += __shfl_xor(l, 32);
  const float inv = 1.f / l;
  const u16* szrow = p.SZ + (size_t)t * 1024 + h * 64;
  u16* orow = p.NAO + (size_t)t * 1024 + h * 64;
#pragma unroll
  for (int d = 0; d < 4; d++) {
    const int d0 = d * 16 + q4 * 4;
    const uint2 z = *(const uint2*)(szrow + d0);
    uint2 v;
    v.x = pk2(o[d][0] * inv * bf2f((u16)(z.x & 0xffff)), o[d][1] * inv * bf2f((u16)(z.x >> 16)));
    v.y = pk2(o[d][2] * inv * bf2f((u16)(z.y & 0xffff)), o[d][3] * inv * bf2f((u16)(z.y >> 16)));
    *(uint2*)(orow + d0) = v;
  }
}


DI void attn_na_block(const Params& p, char* smem, int b, int h, int rpair) {
  constexpr int ST = 72;
  const int tid = threadIdx.x, lane = tid & 63, j = tid >> 6, l31 = lane & 31, lh = lane >> 5;
  u16* Kt = (u16*)smem;
  u16* Vt = Kt + 2 * 64 * ST;
  float* bl = (float*)(Vt + 2 * 64 * ST);
  const int r0 = rpair * 2;
  const int qr = r0 + (l31 >> 4), c = j * 16 + (l31 & 15);
  const int t = TC + b * 2048 + qr * 64 + c;
  const int rsq = min(max(qr - 4, 0), 24);
  const int rs0 = min(max(r0 - 4, 0), 24);
  const int nrows = min(max(r0 + 1 - 4, 0), 24) + 8 - rs0;
  const int ntile = 4 + nrows;
  const int bstart = min(max(j * 16 - 8, 0), 32);
  const int cstart = min(max(c - 8, 0), 48);
  const u16* kb = p.NK + (size_t)(TC + b * 2304) * 1024 + h * 64;
  const u16* vb = p.NVT + (size_t)16 * 1024 * 256 + (size_t)b * (1024 * 2304) + (size_t)(h * 64) * 2304;
  const u16* qrow = p.NQ + (size_t)t * 1024 + h * 64;
  bf16x8 qf[4];
#pragma unroll
  for (int s = 0; s < 4; s++) qf[s] = *(const bf16x8*)(qrow + s * 16 + lh * 8);
  f32x16 o[2];
#pragma unroll
  for (int d = 0; d < 2; d++)
#pragma unroll
    for (int r = 0; r < 16; r++) o[d][r] = 0.f;
  float m = -1e30f, l = 0.f;
  const int r16 = l31 & 15;
  const int kap = (l31 & 16) + (r16 & 3) + 4 * ((r16 >> 3) & 1) + 8 * ((r16 >> 2) & 1);
  const int srow = tid >> 3, scc = (tid & 7) * 8;
  u32x4 ra[2], rv[2];
  __syncthreads();
  for (int i = tid; i < 465; i += 256) bl[i] = p.na_rpb[h * 465 + i] * LOG2E;
#pragma unroll
  for (int i = 0; i < 2; i++) {
    ra[i] = *(const u32x4*)(kb + (size_t)(srow + 32 * i) * 1024 + scc);
    rv[i] = *(const u32x4*)(vb + (size_t)(srow + 32 * i) * 2304 + scc);
  }
#pragma unroll
  for (int i = 0; i < 2; i++) {
    *(u32x4*)(Kt + (srow + 32 * i) * ST + scc) = ra[i];
    *(u32x4*)(Vt + (srow + 32 * i) * ST + scc) = rv[i];
  }
  __syncthreads();
  for (int tl = 0; tl < ntile; tl++) {
    const int buf = tl & 1;
    const int tn = (tl + 1 < ntile) ? tl + 1 : tl;
    const int keyn = tn < 4 ? tn * 64 : 256 + (rs0 + tn - 4) * 64;
#pragma unroll
    for (int i = 0; i < 2; i++) {
      ra[i] = *(const u32x4*)(kb + (size_t)(keyn + srow + 32 * i) * 1024 + scc);
      rv[i] = *(const u32x4*)(vb + (size_t)(srow + 32 * i) * 2304 + keyn + scc);
    }
    const u16* Kc = Kt + buf * 64 * ST;
    const u16* Vc = Vt + buf * 64 * ST;
    const bool local = tl >= 4;
    const int gr = rs0 + tl - 4;
    const int nh = local ? 1 : 2;
    for (int hh = 0; hh < nh; hh++) {
      const int koff = local ? bstart : hh * 32;
      f32x16 s0;
#pragma unroll
      for (int r = 0; r < 16; r++) s0[r] = 0.f;
      const u16* kp = Kc + (koff + kap) * ST + lh * 8;
#pragma unroll
      for (int s = 0; s < 4; s++) s0 = MFMA32(*(const bf16x8*)(kp + s * 16), qf[s], s0);
      if (local) {
        const bool rowvalid = (gr >= rsq) && (gr < rsq + 8);
        const int dr = min(max(gr - qr + 7, 0), 14);
#pragma unroll
        for (int i = 0; i < 16; i++) {
          const int kcol = bstart + 16 * (i >> 3) + 8 * lh + (i & 7);
          const bool valid = rowvalid && (kcol >= cstart) && (kcol < cstart + 16);
          const int dc = min(max(kcol - c + 15, 0), 30);
          s0[i] = valid ? s0[i] + bl[dr * 31 + dc] : -1e30f;
        }
      }
      float mx = s0[0];
#pragma unroll
      for (int r = 1; r < 16; r++) mx = fmaxf(mx, s0[r]);
      mx = fmaxf(mx, __shfl_xor(mx, 32));
      if (__any(mx > m + 8.f)) {
        const float mn = fmaxf(m, mx);
        const float alpha = exp2f(m - mn);
        m = mn;
        l *= alpha;
#pragma unroll
        for (int d = 0; d < 2; d++)
#pragma unroll
          for (int r = 0; r < 16; r++) o[d][r] *= alpha;
      }
      float ps = 0.f;
#pragma unroll
      for (int r = 0; r < 16; r++) { s0[r] = exp2f(s0[r] - m); ps += s0[r]; }
      l += ps;
      const u16* vp = Vc + l31 * ST + koff + lh * 8;
#pragma unroll
      for (int sp = 0; sp < 2; sp++) {
        u32x4 pw;
        pw[0] = pk2(s0[8 * sp + 0], s0[8 * sp + 1]); pw[1] = pk2(s0[8 * sp + 2], s0[8 * sp + 3]);
        pw[2] = pk2(s0[8 * sp + 4], s0[8 * sp + 5]); pw[3] = pk2(s0[8 * sp + 6], s0[8 * sp + 7]);
        const bf16x8 pf = __builtin_bit_cast(bf16x8, pw);
#pragma unroll
        for (int d = 0; d < 2; d++) o[d] = MFMA32(*(const bf16x8*)(vp + d * 32 * ST + sp * 16), pf, o[d]);
      }
    }
    if (tl + 1 < ntile) {
#pragma unroll
      for (int i = 0; i < 2; i++) {
        *(u32x4*)(Kt + (buf ^ 1) * 64 * ST + (srow + 32 * i) * ST + scc) = ra[i];
        *(u32x4*)(Vt + (buf ^ 1) * 64 * ST + (srow + 32 * i) * ST + scc) = rv[i];
      }
    }
    __syncthreads();
  }
  l += __shfl_xor(l, 32);
  const float inv = 1.f / l;
  const u16* szrow = p.SZ + (size_t)t * 1024 + h * 64;
  u16* orow = p.NAO + (size_t)t * 1024 + h * 64;
#pragma unroll
  for (int d = 0; d < 2; d++)
#pragma unroll
    for (int g = 0; g < 4; g++) {
      const int d0 = d * 32 + 8 * g + 4 * lh;
      const uint2 z = *(const uint2*)(szrow + d0);
      uint2 v;
      v.x = pk2(o[d][4 * g] * inv * bf2f((u16)(z.x & 0xffff)), o[d][4 * g + 1] * inv * bf2f((u16)(z.x >> 16)));
      v.y = pk2(o[d][4 * g + 2] * inv * bf2f((u16)(z.y & 0xffff)), o[d][4 * g + 3] * inv * bf2f((u16)(z.y >> 16)));
      *(uint2*)(orow + d0) = v;
    }
}

DI void ph_prep(const Params& p, char* smem) {
  const int tid = threadIdx.x;
  const int ntr = p.nmat_tiles;
  const int ntot = ntr + 192;
  for (int tile = blockIdx.x; tile < ntot; tile += gridDim.x) {
    __syncthreads();
    if (tile < ntr) {
      int mi = 0;
      for (int i = 1; i < 18; i++) if (tile >= p.mats[i].tile0) mi = i;
      const float* src = p.mats[mi].src; u16* dst = p.mats[mi].dst;
      const int K = p.mats[mi].K, Nsrc = p.mats[mi].Nsrc, Ndst = p.mats[mi].Ndst;
      const int lt = tile - p.mats[mi].tile0;
      const int ntn = Ndst >> 6;
      const int kt = lt / ntn, nt = lt - kt * ntn;
      float* ts = (float*)smem;
#pragma unroll
      for (int i = 0; i < 4; i++) {
        const int k = i * 16 + (tid >> 4), n4 = (tid & 15) * 4, n = nt * 64 + n4;
        float4 v = {0.f, 0.f, 0.f, 0.f};
        if (n < Nsrc) v = *(const float4*)(src + (size_t)(kt * 64 + k) * Nsrc + n);
        ts[k * 65 + n4] = v.x; ts[k * 65 + n4 + 1] = v.y; ts[k * 65 + n4 + 2] = v.z; ts[k * 65 + n4 + 3] = v.w;
      }
      __syncthreads();
      const int n = tid >> 2, kc = (tid & 3) * 16;
      uint32_t w[8];
#pragma unroll
      for (int e = 0; e < 8; e++) w[e] = pk2(ts[(kc + 2 * e) * 65 + n], ts[(kc + 2 * e + 1) * 65 + n]);
      u16* dp = dst + (size_t)(nt * 64 + n) * K + kt * 64 + kc;
      uint4 v0; v0.x = w[0]; v0.y = w[1]; v0.z = w[2]; v0.w = w[3];
      uint4 v1; v1.x = w[4]; v1.y = w[5]; v1.z = w[6]; v1.w = w[7];
      *(uint4*)dp = v0; *(uint4*)(dp + 8) = v1;
    } else {
      const int at = tile - ntr;
      const int layer = at / 48, c0 = (at - layer * 48) * 64;
      float* sc = (float*)smem;
      float* red = sc + 5 * 1024;
      for (int i = tid; i < 5 * 1024; i += 256) {
        const int n = i >> 10, k = i & 1023;
        const float v = (n == 0) ? p.c_ctx[k] : p.c[(n - 1) * 1024 + k];
        sc[i] = silu(v);
      }
      __syncthreads();
      const int c4 = (tid & 15) * 4, kg = tid >> 4;
      float acc[5][4];
#pragma unroll
      for (int n = 0; n < 5; n++) { acc[n][0] = 0.f; acc[n][1] = 0.f; acc[n][2] = 0.f; acc[n][3] = 0.f; }
      const float* w = p.ada_w + (size_t)layer * 1024 * 3072 + c0 + c4;
#pragma unroll 4
      for (int kk = 0; kk < 64; kk++) {
        const int k = kg * 64 + kk;
        const float4 wv = *(const float4*)(w + (size_t)k * 3072);
#pragma unroll
        for (int n = 0; n < 5; n++) {
          const float s = sc[n * 1024 + k];
          acc[n][0] += s * wv.x; acc[n][1] += s * wv.y; acc[n][2] += s * wv.z; acc[n][3] += s * wv.w;
        }
      }
#pragma unroll
      for (int n = 0; n < 5; n++) {
        float4 r; r.x = acc[n][0]; r.y = acc[n][1]; r.z = acc[n][2]; r.w = acc[n][3];
        *(float4*)(red + (kg * 5 + n) * 64 + c4) = r;
      }
      __syncthreads();
      for (int o = tid; o < 320; o += 256) {
        const int n = o >> 6, cc = o & 63;
        float s = 0.f;
#pragma unroll
        for (int g = 0; g < 16; g++) s += red[(g * 5 + n) * 64 + cc];
        s += p.ada_b[layer * 3072 + c0 + cc];
        p.mod[(layer * 5 + n) * 3072 + c0 + cc] = s;
      }
    }
  }
}

DI void ph_h0(const Params& p) {
  for (int idx = blockIdx.x * 256 + threadIdx.x; idx < T * 128; idx += gridDim.x * 256) {
    const int t = idx >> 7, c0 = (idx & 127) * 8;
    const float* xr = (t < TC) ? p.x_prompt + (size_t)t * 1024 : p.x_sample + (size_t)(t - TC) * 1024;
    const float* md = p.mod + cond_of(t) * 3072;
    const float4 x0 = *(const float4*)(xr + c0), x1 = *(const float4*)(xr + c0 + 4);
    const float4 sh0 = *(const float4*)(md + c0), sh1 = *(const float4*)(md + c0 + 4);
    const float4 sc0 = *(const float4*)(md + 1024 + c0), sc1 = *(const float4*)(md + 1024 + c0 + 4);
    uint4 v;
    v.x = pk2(x0.x * (1.f + sc0.x) + sh0.x, x0.y * (1.f + sc0.y) + sh0.y);
    v.y = pk2(x0.z * (1.f + sc0.z) + sh0.z, x0.w * (1.f + sc0.w) + sh0.w);
    v.z = pk2(x1.x * (1.f + sc1.x) + sh1.x, x1.y * (1.f + sc1.y) + sh1.y);
    v.w = pk2(x1.z * (1.f + sc1.z) + sh1.z, x1.w * (1.f + sc1.w) + sh1.w);
    *(uint4*)(p.H + (size_t)t * 1024 + c0) = v;
  }
}

template <class Epi>
DI void gemm_phase(const u16* A, int lda, const u16* Bt, int ldb, int K, int MT, int NT, char* smem, const Epi& epi) {
  const int ntile = MT * NT;
  for (int tile = blockIdx.x; tile < ntile; tile += gridDim.x) {
    const int nt = tile / MT, mt = tile - nt * MT;
    gemm_tile(A, lda, Bt, ldb, K, mt * 128, nt * 128, 0, smem, epi);
  }
}

DI void unpack8(const u32x4& u, float* f) {
  f[0] = __uint_as_float(u[0] << 16); f[1] = __uint_as_float(u[0] & 0xffff0000u);
  f[2] = __uint_as_float(u[1] << 16); f[3] = __uint_as_float(u[1] & 0xffff0000u);
  f[4] = __uint_as_float(u[2] << 16); f[5] = __uint_as_float(u[2] & 0xffff0000u);
  f[6] = __uint_as_float(u[3] << 16); f[7] = __uint_as_float(u[3] & 0xffff0000u);
}
template <int HW>
DI void mix_item(const Params& p, int rpair) {
  const int lane = threadIdx.x & 63;
  constexpr int g = (HW == 1) ? 0 : (HW == 2) ? 1 : (HW == 4) ? 2 : 3;
  constexpr int NR = 8 + 2 * HW;
  const int c0 = (g * 32 + (lane & 31)) * 8;
  const int t0 = (rpair * 2 + (lane >> 5)) * 8;
  int s0, L, tt0;
  if (t0 < TC) { s0 = t0 & ~255; tt0 = t0 & 255; L = 256; } else { s0 = TC + ((t0 - TC) & ~2047); tt0 = (t0 - TC) & 2047; L = 2048; }
  u32x4 rows[NR];
#pragma unroll
  for (int r = 0; r < NR; r++) {
    const int tt = tt0 - HW + r;
    u32x4 v = {0u, 0u, 0u, 0u};
    if (tt >= 0 && tt < L) v = *(const u32x4*)(p.U + (size_t)(s0 + tt) * 1024 + c0);
    rows[r] = v;
  }
  float sum[8];
#pragma unroll
  for (int k = 0; k < 8; k++) sum[k] = 0.f;
#pragma unroll
  for (int r = 0; r < 2 * HW; r++) {
    float f[8]; unpack8(rows[r], f);
#pragma unroll
    for (int k = 0; k < 8; k++) sum[k] += f[k];
  }
#pragma unroll
  for (int e = 0; e < 8; e++) {
    const int tt = tt0 + e;
    const int lo = max(tt - HW, 0), hi = min(tt + HW, L);
    const float ic = 1.f / (float)(hi - lo);
    float own[8]; unpack8(rows[e + HW], own);
    u32x4 v;
    v[0] = pk2(sum[0] * ic - own[0], sum[1] * ic - own[1]);
    v[1] = pk2(sum[2] * ic - own[2], sum[3] * ic - own[3]);
    v[2] = pk2(sum[4] * ic - own[4], sum[5] * ic - own[5]);
    v[3] = pk2(sum[6] * ic - own[6], sum[7] * ic - own[7]);
    *(u32x4*)(p.MIX + (size_t)(s0 + tt) * 1024 + c0) = v;
    if (e < 7) {
      float fo[8], fi[8]; unpack8(rows[e], fo); unpack8(rows[e + 2 * HW], fi);
#pragma unroll
      for (int k = 0; k < 8; k++) sum[k] += fi[k] - fo[k];
    }
  }
}
DI void ph_mix(const Params& p) {
  const int wid = threadIdx.x >> 6;
  for (int item = blockIdx.x * 4 + wid; item < 768 * 4; item += gridDim.x * 4) {
    const int rpair = item >> 2, g = item & 3;
    if (g == 0) mix_item<1>(p, rpair);
    else if (g == 1) mix_item<2>(p, rpair);
    else if (g == 2) mix_item<4>(p, rpair);
    else mix_item<8>(p, rpair);
  }
}

DI void ph_pool_g2(const Params& p, int j, char* smem) {
  EpiPoolG2 epi{p.PM, p.SZ, p.pool_scale + j * 1024};
  for (int tile = blockIdx.x; tile < 96 * 8; tile += gridDim.x) {
    const int gn = tile / 96, mt = tile - gn * 96;
    const int g = gn >> 1, ns = gn & 1;
    gemm_tile(p.MIX + g * 256, 1024, p.Wgrp + (size_t)(j * 4 + g) * 65536, 256, 256, mt * 128, ns * 128, g * 256, smem, epi);
  }
}

DI void ph_ln(const Params& p, int layer) {
  const int lane = threadIdx.x & 63, wid = threadIdx.x >> 6;
  const float* g = p.ln_g + layer * 1024;
  const float* bb = p.ln_b + layer * 1024;
  for (int row = blockIdx.x * 4 + wid; row < T; row += gridDim.x * 4) {
    float* xr = p.out + (size_t)row * 1024;
    float4 v[4];
    float s = 0.f;
#pragma unroll
    for (int i = 0; i < 4; i++) { v[i] = *(const float4*)(xr + i * 256 + lane * 4); s += v[i].x + v[i].y + v[i].z + v[i].w; }
    const float mu = wave_sum(s) * (1.f / 1024.f);
    float q = 0.f;
#pragma unroll
    for (int i = 0; i < 4; i++) {
      v[i].x -= mu; v[i].y -= mu; v[i].z -= mu; v[i].w -= mu;
      q += v[i].x * v[i].x + v[i].y * v[i].y + v[i].z * v[i].z + v[i].w * v[i].w;
    }
    const float rstd = rsqrtf(wave_sum(q) * (1.f / 1024.f) + 1e-5f);
    const float* md = p.mod + ((layer + 1) * 5 + cond_of(row)) * 3072;
#pragma unroll
    for (int i = 0; i < 4; i++) {
      const int cc = i * 256 + lane * 4;
      const float4 gg = *(const float4*)(g + cc), be = *(const float4*)(bb + cc);
      float4 y;
      y.x = v[i].x * rstd * gg.x + be.x; y.y = v[i].y * rstd * gg.y + be.y;
      y.z = v[i].z * rstd * gg.z + be.z; y.w = v[i].w * rstd * gg.w + be.w;
      *(float4*)(xr + cc) = y;
      if (layer < 3) {
        const float4 sh = *(const float4*)(md + cc), sc = *(const float4*)(md + 1024 + cc);
        uint2 h;
        h.x = pk2(y.x * (1.f + sc.x) + sh.x, y.y * (1.f + sc.y) + sh.y);
        h.y = pk2(y.z * (1.f + sc.z) + sh.z, y.w * (1.f + sc.w) + sh.w);
        *(uint2*)(p.H + (size_t)row * 1024 + cc) = h;
      }
    }
  }
}

DI void ph_mla_norm(const Params& p) {
  const int lane = threadIdx.x & 63, wid = threadIdx.x >> 6;
  for (int row = blockIdx.x * 4 + wid; row < T + 1024; row += gridDim.x * 4) {
    if (row < T) {
      const float* rr = p.RAW + (size_t)row * 768;
      const float4 a0 = *(const float4*)(rr + lane * 8), a1 = *(const float4*)(rr + lane * 8 + 4);
      const float4 k0 = *(const float4*)(rr + 512 + lane * 4);
      float s1 = a0.x * a0.x + a0.y * a0.y + a0.z * a0.z + a0.w * a0.w + a1.x * a1.x + a1.y * a1.y + a1.z * a1.z + a1.w * a1.w;
      float s2 = k0.x * k0.x + k0.y * k0.y + k0.z * k0.z + k0.w * k0.w;
      const float r1 = rsqrtf(wave_sum(s1) * (1.f / 512.f) + 1e-6f);
      const float r2 = rsqrtf(wave_sum(s2) * (1.f / 256.f) + 1e-6f);
      const float4 g0 = *(const float4*)(p.mla_q_norm + lane * 8), g1 = *(const float4*)(p.mla_q_norm + lane * 8 + 4);
      uint4 v;
      v.x = pk2(a0.x * r1 * g0.x, a0.y * r1 * g0.y); v.y = pk2(a0.z * r1 * g0.z, a0.w * r1 * g0.w);
      v.z = pk2(a1.x * r1 * g1.x, a1.y * r1 * g1.y); v.w = pk2(a1.z * r1 * g1.z, a1.w * r1 * g1.w);
      *(uint4*)(p.CQN + (size_t)row * 512 + lane * 8) = v;
      const float4 kg = *(const float4*)(p.mla_kv_norm + lane * 4);
      float4 kn; kn.x = k0.x * r2 * kg.x; kn.y = k0.y * r2 * kg.y; kn.z = k0.z * r2 * kg.z; kn.w = k0.w * r2 * kg.w;
      uint2 kv; kv.x = pk2(kn.x, kn.y); kv.y = pk2(kn.z, kn.w);
      *(uint2*)(p.CKVN + (size_t)kvrow_of(row) * 256 + lane * 4) = kv;
      if (row < TC) *(float4*)(p.out + OUT_CKV + (size_t)row * 256 + lane * 4) = kn;
    } else {
      const int cr = row - T, b = cr >> 8, pp = cr & 255;
      const size_t kvr = (size_t)TC + b * 2304 + pp;
      const float4 k0 = *(const float4*)(p.cache_ckv + (size_t)cr * 256 + lane * 4);
      uint2 kv; kv.x = pk2(k0.x, k0.y); kv.y = pk2(k0.z, k0.w);
      *(uint2*)(p.CKVN + kvr * 256 + lane * 4) = kv;
      p.KR[kvr * 64 + lane] = f2bf(p.cache_kr[(size_t)cr * 64 + lane]);
    }
  }
}

DI void ph_mla_g2(const Params& p, char* smem) {
  EpiMlaQ eq{p.Q};
  EpiMlaKV ekv{p.KN, p.VT};
  const int n1 = 96 * 12, n2 = 104 * 16;
  for (int tile = blockIdx.x; tile < n1 + n2; tile += gridDim.x) {
    if (tile < n1) {
      const int nt = tile / 96, mt = tile - nt * 96;
      gemm_tile(p.CQN, 512, p.Wuq, 512, 512, mt * 128, nt * 128, 0, smem, eq);
    } else {
      const int t2 = tile - n1;
      const int nt = t2 / 104, mt = t2 - nt * 104;
      gemm_tile(p.CKVN, 256, p.Wukv, 256, 256, mt * 128, nt * 128, 0, smem, ekv);
    }
  }
}

DI void ph_mla_attn(const Params& p, char* smem) {
  const int wid = threadIdx.x >> 6, l31 = threadIdx.x & 31;
  for (int u = blockIdx.x; u < 768; u += gridDim.x) {
    int t0, kvrow0, nkeys, Lk, h; size_t vbase;
    if (u < 512) {
      const int xcd = u & 7, slot = u >> 3; const int pair = xcd * 4 + (slot >> 4); const int qb = slot & 15;
      const int b = pair >> 3; h = pair & 7;
      t0 = TC + b * 2048 + qb * 128 + wid * 32; kvrow0 = TC + b * 2304; nkeys = 2304; Lk = 2304;
      vbase = (size_t)16 * 8 * 128 * 256 + (size_t)b * (8 * 128 * 2304) + (size_t)h * 128 * 2304;
    } else {
      const int v = u - 512; const int b = v >> 4; h = (v >> 1) & 7; const int qb = v & 1;
      t0 = b * 256 + qb * 128 + wid * 32; kvrow0 = b * 256; nkeys = 256; Lk = 256;
      vbase = (size_t)b * (8 * 128 * 256) + (size_t)h * 128 * 256;
    }
    const int t = t0 + l31;
    attn_dense_block<8, 4, 4>(smem, p.Q + (size_t)t * 1536 + h * 192, p.KN + (size_t)kvrow0 * 1024 + h * 128, 1024,
                             p.KR + (size_t)kvrow0 * 64, p.VT + vbase, Lk, nkeys,
                             p.SZ + (size_t)t * 1024 + h * 128, p.AO + (size_t)t * 1024 + h * 128);
  }
}

DI void ph_na_g1(const Params& p, char* smem) {
  EpiNaG1 epi{p.NQ, p.NK, p.NVT, p.SZ, p.out + OUT_NAK, p.out + OUT_NAV};
  const int n1 = 96 * 32;
  for (int tile = blockIdx.x; tile < n1 + 64; tile += gridDim.x) {
    if (tile < n1) {
      const int nt = tile / 96, mt = tile - nt * 96;
      gemm_tile(p.H, 1024, p.Wnin, 1024, 1024, mt * 128, nt * 128, 0, smem, epi);
    } else {
      const int ct = tile - n1;
      const int b = ct >> 4, p0 = (ct & 15) * 16;
      const int c4 = threadIdx.x * 4;
      const size_t kvb = (size_t)TC + b * 2304;
      u16* vtb = p.NVT + (size_t)16 * 1024 * 256 + (size_t)b * (1024 * 2304);
      float vv[4][16];
#pragma unroll
      for (int i = 0; i < 16; i++) {
        const size_t src = ((size_t)(b * 256 + p0 + i)) * 1024 + c4;
        const float4 k = *(const float4*)(p.cache_nak + src);
        uint2 kv; kv.x = pk2(k.x, k.y); kv.y = pk2(k.z, k.w);
        *(uint2*)(p.NK + (kvb + p0 + i) * 1024 + c4) = kv;
        const float4 v = *(const float4*)(p.cache_nav + src);
        vv[0][i] = v.x; vv[1][i] = v.y; vv[2][i] = v.z; vv[3][i] = v.w;
      }
#pragma unroll
      for (int e = 0; e < 4; e++) {
        uint4 w0, w1;
        w0.x = pk2(vv[e][0], vv[e][1]); w0.y = pk2(vv[e][2], vv[e][3]); w0.z = pk2(vv[e][4], vv[e][5]); w0.w = pk2(vv[e][6], vv[e][7]);
        w1.x = pk2(vv[e][8], vv[e][9]); w1.y = pk2(vv[e][10], vv[e][11]); w1.z = pk2(vv[e][12], vv[e][13]); w1.w = pk2(vv[e][14], vv[e][15]);
        u16* dp = vtb + (size_t)(c4 + e) * 2304 + p0;
        *(uint4*)dp = w0; *(uint4*)(dp + 8) = w1;
      }
    }
  }
}

DI void ph_na_attn(const Params& p, char* smem) {
  const int wid = threadIdx.x >> 6, l31 = threadIdx.x & 31;
  for (int u = blockIdx.x; u < 1024 + 512; u += gridDim.x) {
    if (u < 1024) {
      const int xcd = u & 7, slot = u >> 3;
      const int pair = xcd * 8 + (slot >> 4), rpair = slot & 15;
      attn_na_block(p, smem, pair >> 4, pair & 15, rpair);
    } else {
      const int v = u - 1024;
      const int b = v >> 5, h = (v >> 1) & 15, qb = v & 1;
      const int t = b * 256 + qb * 128 + wid * 32 + l31;
      attn_dense_block<4, 0, 2>(smem, p.NQ + (size_t)t * 1024 + h * 64, p.NK + (size_t)(b * 256) * 1024 + h * 64, 1024, nullptr,
                               p.NVT + (size_t)b * (1024 * 256) + (size_t)h * 64 * 256, 256, 256,
                               p.SZ + (size_t)t * 1024 + h * 64, p.NAO + (size_t)t * 1024 + h * 64);
    }
  }
}

template <int ph>
DI void run_phase(const Params& p, char* smem) {
  if constexpr (ph == 0) ph_prep(p, smem);
  else if constexpr (ph == 1) ph_h0(p);
  else if constexpr (ph == 2 || ph == 17) {
    constexpr int j = (ph == 2) ? 0 : 1;
    EpiPoolG1 e{p.U, p.SZ};
    gemm_phase(p.H, 1024, p.Wpin + (size_t)j * 2048 * 1024, 1024, 1024, 96, 16, smem, e);
  }
  else if constexpr (ph == 3 || ph == 18) ph_mix(p);
  else if constexpr (ph == 4 || ph == 19) ph_pool_g2(p, (ph == 4) ? 0 : 1, smem);
  else if constexpr (ph == 5) {
    EpiG3 e{p.x_prompt, p.x_sample, p.out, p.mod};
    gemm_phase(p.PM, 1024, p.Wpout, 1024, 1024, 96, 8, smem, e);
  }
  else if constexpr (ph == 20) {
    EpiG3 e{p.out, p.out + OUT_YS, p.out, p.mod + 3 * 5 * 3072};
    gemm_phase(p.PM, 1024, p.Wpout + (size_t)1024 * 1024, 1024, 1024, 96, 8, smem, e);
  }
  else if constexpr (ph == 6) ph_ln(p, 0);
  else if constexpr (ph == 21) ph_ln(p, 3);
  else if constexpr (ph == 7) {
    EpiMlaG1 e{p.RAW, p.KR, p.SZ, p.out + OUT_KR};
    gemm_phase(p.H, 1024, p.Wmin, 1024, 1024, 96, 15, smem, e);
  }
  else if constexpr (ph == 8) ph_mla_norm(p);
  else if constexpr (ph == 9) ph_mla_g2(p, smem);
  else if constexpr (ph == 10) ph_mla_attn(p, smem);
  else if constexpr (ph == 11) {
    EpiG3 e{p.out, p.out + OUT_YS, p.out, p.mod + 1 * 5 * 3072};
    gemm_phase(p.AO, 1024, p.Wmout, 1024, 1024, 96, 8, smem, e);
  }
  else if constexpr (ph == 12) ph_ln(p, 1);
  else if constexpr (ph == 13) ph_na_g1(p, smem);
  else if constexpr (ph == 14) ph_na_attn(p, smem);
  else if constexpr (ph == 15) {
    EpiG3 e{p.out, p.out + OUT_YS, p.out, p.mod + 2 * 5 * 3072};
    gemm_phase(p.NAO, 1024, p.Wnout, 1024, 1024, 96, 8, smem, e);
  }
  else if constexpr (ph == 16) ph_ln(p, 2);
}

#define RUN_PH(n) if (ph_lo <= (n) && (n) < ph_hi) { run_phase<n>(p, smem); if ((n) + 1 < ph_hi) xcd_barrier(xb); }

__global__ void __launch_bounds__(256, 2) mega(Params p, int ph_lo, int ph_hi) {
  __shared__ __attribute__((aligned(16))) char smem[SMEM_BYTES + 16];
  if (ph_lo < 0) { cg::this_grid().sync(); return; }
  const bool multi = (ph_hi - ph_lo) > 1;
  XcdBarrier xb; xb.bar = p.bar; xb.x = 0; xb.st = (volatile LAS unsigned*)(smem + SMEM_BYTES);
  if (multi) {
    if (threadIdx.x == 0) { *(uint4*)(smem + SMEM_BYTES) = make_uint4(0u, 0u, 0u, 0u); }
    __syncthreads();
    xb = xcd_barrier_post(p.bar, (volatile LAS unsigned*)(smem + SMEM_BYTES));
  }
  RUN_PH(0) RUN_PH(1) RUN_PH(2) RUN_PH(3) RUN_PH(4) RUN_PH(5) RUN_PH(6) RUN_PH(7) RUN_PH(8) RUN_PH(9) RUN_PH(10)
  RUN_PH(11) RUN_PH(12) RUN_PH(13) RUN_PH(14) RUN_PH(15) RUN_PH(16) RUN_PH(17) RUN_PH(18) RUN_PH(19) RUN_PH(20) RUN_PH(21)
}

extern "C" void kernel_launch(void* const* d_in, const int* in_sizes, int n_in, void* d_out, int out_size, void* d_ws, size_t ws_size,
                              hipStream_t stream) {
  Params p;
  memset(&p, 0, sizeof(p));
  const float* const* in = (const float* const*)d_in;
  p.x_prompt = in[0]; p.x_sample = in[1]; p.cache_ckv = in[2]; p.cache_kr = in[3]; p.cache_nak = in[4]; p.cache_nav = in[5];
  p.c = in[6]; p.c_ctx = in[7]; p.ada_w = in[8]; p.ada_b = in[9]; p.ln_g = in[10]; p.ln_b = in[11];
  const float* pool_w_in = in[12]; const float* pool_w_grp = in[13]; p.pool_scale = in[14]; const float* pool_w_out = in[15];
  const float* mla_w_in = in[16]; p.mla_q_norm = in[17]; const float* mla_w_uq = in[18]; p.mla_kv_norm = in[19];
  const float* mla_w_ukv = in[20]; const float* mla_w_out = in[21]; const float* na_w_in = in[22]; p.na_rpb = in[23];
  const float* na_w_out = in[24];
  p.out = (float*)d_out;

  char* ws = (char*)d_ws;
  size_t off = 0;
  auto take = [&](size_t bytes) { char* r = ws + off; off += (bytes + 255) & ~(size_t)255; return r; };
  p.bar = (unsigned*)take(XCD_BAR_WORDS * 4);
  p.mod = (float*)take((size_t)4 * 5 * 3072 * 4);
  p.Wpin = (u16*)take((size_t)2 * 2048 * 1024 * 2);
  p.Wgrp = (u16*)take((size_t)8 * 65536 * 2);
  p.Wpout = (u16*)take((size_t)2 * 1024 * 1024 * 2);
  p.Wmin = (u16*)take((size_t)1920 * 1024 * 2);
  p.Wuq = (u16*)take((size_t)1536 * 512 * 2);
  p.Wukv = (u16*)take((size_t)2048 * 256 * 2);
  p.Wmout = (u16*)take((size_t)1024 * 1024 * 2);
  p.Wnin = (u16*)take((size_t)4096 * 1024 * 2);
  p.Wnout = (u16*)take((size_t)1024 * 1024 * 2);
  p.H = (u16*)take((size_t)T * 1024 * 2);
  p.SZ = (u16*)take((size_t)T * 1024 * 2);
  const size_t arena0 = off;
  p.U = (u16*)take((size_t)T * 1024 * 2);
  p.MIX = (u16*)take((size_t)T * 1024 * 2);
  p.PM = (u16*)take((size_t)T * 1024 * 2);
  off = arena0;
  p.RAW = (float*)take((size_t)T * 768 * 4);
  p.AO = (u16*)p.RAW;
  p.CQN = (u16*)take((size_t)T * 512 * 2);
  p.CKVN = (u16*)take((size_t)KVR * 256 * 2);
  p.KR = (u16*)take((size_t)KVR * 64 * 2);
  p.Q = (u16*)take((size_t)T * 1536 * 2);
  p.KN = (u16*)take((size_t)KVR * 1024 * 2);
  p.VT = (u16*)take((size_t)KVR * 1024 * 2);
  off = arena0;
  p.NQ = (u16*)take((size_t)T * 1024 * 2);
  p.NK = (u16*)take((size_t)KVR * 1024 * 2);
  p.NVT = (u16*)take((size_t)KVR * 1024 * 2);
  p.NAO = (u16*)take((size_t)T * 1024 * 2);

  int nm = 0, tiles = 0;
  auto add = [&](const float* src, u16* dst, int K, int Nsrc, int Ndst) {
    p.mats[nm].src = src; p.mats[nm].dst = dst; p.mats[nm].K = K; p.mats[nm].Nsrc = Nsrc; p.mats[nm].Ndst = Ndst; p.mats[nm].tile0 = tiles;
    tiles += (K / 64) * (Ndst / 64); nm++;
  };
  for (int j = 0; j < 2; j++) add(pool_w_in + (size_t)j * 1024 * 2048, p.Wpin + (size_t)j * 2048 * 1024, 1024, 2048, 2048);
  for (int j = 0; j < 8; j++) add(pool_w_grp + (size_t)j * 65536, p.Wgrp + (size_t)j * 65536, 256, 256, 256);
  for (int j = 0; j < 2; j++) add(pool_w_out + (size_t)j * 1024 * 1024, p.Wpout + (size_t)j * 1024 * 1024, 1024, 1024, 1024);
  add(mla_w_in, p.Wmin, 1024, 1856, 1920);
  add(mla_w_uq, p.Wuq, 512, 1536, 1536);
  add(mla_w_ukv, p.Wukv, 256, 2048, 2048);
  add(mla_w_out, p.Wmout, 1024, 1024, 1024);
  add(na_w_in, p.Wnin, 1024, 4096, 4096);
  add(na_w_out, p.Wnout, 1024, 1024, 1024);
  p.nmat_tiles = tiles;

  (void)hipMemsetAsync(p.bar, 0, XCD_BAR_WORDS * 4, stream);
#if MULTI_LAUNCH
  for (int ph = 0; ph < NPHASE; ph++) hipLaunchKernelGGL(mega, dim3(512), dim3(256), 0, stream, p, ph, ph + 1);
#else
  static int grid_blocks = 0;
  if (!grid_blocks) {
    int dev = 0, cus = 0, per_cu = 0;
    hipGetDevice(&dev);
    hipDeviceGetAttribute(&cus, hipDeviceAttributeMultiprocessorCount, dev);
    hipOccupancyMaxActiveBlocksPerMultiprocessor(&per_cu, mega, 256, 0);
    if (per_cu > 2) per_cu = 2;
    if (per_cu < 1) per_cu = 1;
    grid_blocks = cus * per_cu;
  }
  int lo = 0, hi = NPHASE;
  void* args[] = {&p, &lo, &hi};
  hipError_t e = hipLaunchCooperativeKernel((void*)mega, dim3(grid_blocks), dim3(256), args, 0, stream);
  if (e != hipSuccess) fprintf(stderr, "cooperative launch failed: %s (grid %d)\n", hipGetErrorString(e), grid_blocks);
#endif
}
```

```cpp
#include <hip/hip_runtime.h>
#include <hip/hip_cooperative_groups.h>
#include <stdint.h>
#include <string.h>
#include <stdio.h>
namespace cg = cooperative_groups;

#ifndef MULTI_LAUNCH
#define MULTI_LAUNCH 0
#endif

typedef __attribute__((ext_vector_type(8))) short bf16x8;
typedef __attribute__((ext_vector_type(4))) float f32x4;
typedef __attribute__((ext_vector_type(16))) float f32x16;
typedef __attribute__((ext_vector_type(4))) uint32_t u32x4;
typedef unsigned short u16;
#define DI __device__ __forceinline__
#define MFMA32(a, b, c) __builtin_amdgcn_mfma_f32_32x32x16_bf16((a), (b), (c), 0, 0, 0)
#define MFMA16(a, b, c) __builtin_amdgcn_mfma_f32_16x16x32_bf16((a), (b), (c), 0, 0, 0)

constexpr int TC = 4096, TL = 8192, T = 12288;
constexpr int KVR = 4096 + 4 * 2304;
constexpr float LOG2E = 1.4426950408889634f;
constexpr float ALPHA = 1.681792830507429f;
constexpr float MLA_QS = 0.07216878364870323f * LOG2E;
constexpr float NA_QS = 0.125f * LOG2E;
constexpr int SMEM_BYTES = 81920;
constexpr int NPHASE = 22;

constexpr size_t OUT_YS = 4194304, OUT_CKV = 12582912, OUT_KR = 13631488, OUT_NAK = 13893632, OUT_NAV = 18087936;

struct MatDesc { const float* src; u16* dst; int K, Nsrc, Ndst, tile0; };

struct Params {
  const float *x_prompt, *x_sample, *cache_ckv, *cache_kr, *cache_nak, *cache_nav, *c, *c_ctx, *ada_w, *ada_b, *ln_g, *ln_b;
  const float *pool_scale, *mla_q_norm, *mla_kv_norm, *na_rpb;
  float* out;
  float* mod;
  u16 *H, *SZ;
  u16 *Wpin, *Wgrp, *Wpout, *Wmin, *Wuq, *Wukv, *Wmout, *Wnin, *Wnout;
  u16 *U, *MIX, *PM;
  float* RAW; u16 *AO, *CQN, *CKVN, *KR, *Q, *KN, *VT;
  u16 *NQ, *NK, *NVT, *NAO;
  unsigned* bar;
  MatDesc mats[18];
  int nmat_tiles; int pad0;
};

DI float bf2f(u16 v) { return __uint_as_float(((uint32_t)v) << 16); }
DI u16 f2bf(float x) { uint32_t u = __float_as_uint(x); u += 0x7fffu + ((u >> 16) & 1u); return (u16)(u >> 16); }
DI uint32_t pk2(float a, float b) { return (uint32_t)f2bf(a) | ((uint32_t)f2bf(b) << 16); }
DI float silu(float v) { return v / (1.f + __expf(-v)); }
DI int cond_of(int t) { return t < TC ? 0 : 1 + ((t - TC) >> 11); }
DI int kvrow_of(int t) { return t < TC ? t : TC + ((t - TC) >> 11) * 2304 + 256 + ((t - TC) & 2047); }
DI int perm16(int key) { const int k = key & 15; return (key & ~15) | (k & 3) | ((k >> 1) & 4) | ((k << 1) & 8); }
DI float wave_sum(float v) {
#pragma unroll
  for (int o = 32; o >= 1; o >>= 1) v += __shfl_xor(v, o);
  return v;
}

#define XB_TMO      128
#define XB_XCNT(j)  (256  + 64 * (j))
#define XB_XSUB(j)  (1280 + 64 * (j))
#define XB_XGEN(j)  (2304 + 64 * (j))
#define XB_TOP      3328
#define XB_TOPGEN   3392
#define XCD_BAR_WORDS 3456
#define XB_SPIN_CAP (1u << 22)
#define LAS __attribute__((address_space(3)))
DI unsigned xb_ld(unsigned* p) { return __hip_atomic_load(p, __ATOMIC_RELAXED, __HIP_MEMORY_SCOPE_AGENT); }
DI unsigned xb_add(unsigned* p, unsigned v) { return __hip_atomic_fetch_add(p, v, __ATOMIC_RELAXED, __HIP_MEMORY_SCOPE_AGENT); }
DI unsigned xb_xcc_id() { return (unsigned)__builtin_amdgcn_s_getreg((3 << 11) | 20) & 0xFu; }
#define XB_SPIN(cond, bar) do { unsigned _sp = 0; while (cond) { __builtin_amdgcn_s_sleep(1); \
    if ((++_sp & 255u) == 0u) { if (xb_ld(&(bar)[XB_TMO])) break; if (_sp > XB_SPIN_CAP) { atomicAdd(&(bar)[XB_TMO], 1u); break; } } } } while (0)
struct XcdBarrier { unsigned* bar; unsigned x; unsigned nloc, nx; };
DI XcdBarrier xcd_barrier_post(unsigned* bar) {
  XcdBarrier b; b.bar = bar; b.x = xb_xcc_id(); b.nloc = 0u; b.nx = 0u;
  if (threadIdx.x == 0) (void)xb_add(&bar[XB_XCNT(b.x)], 1u);
  return b;
}
DI void xcd_barrier_complete(unsigned* bar, unsigned x, unsigned& nloc, unsigned& nx) {
  const unsigned G = gridDim.x * gridDim.y * gridDim.z;
  unsigned sum, cnt, mine, sp = 0u;
  for (;;) {
    sum = 0u; cnt = 0u; mine = 0u;
#pragma unroll
    for (unsigned j = 0; j < 16; ++j) { const unsigned c = xb_ld(&bar[XB_XCNT(j)]); sum += c; cnt += (c > 0u) ? 1u : 0u; mine = (j == x) ? c : mine; }
    if (sum == G) break;
    __builtin_amdgcn_s_sleep(1);
    if ((++sp & 255u) == 0u) { if (xb_ld(&bar[XB_TMO])) break; if (sp > XB_SPIN_CAP) { atomicAdd(&bar[XB_TMO], 1u); break; } }
  }
  nloc = mine > 0u ? mine : 1u; nx = cnt > 0u ? cnt : 1u;
}
DI void xcd_barrier(XcdBarrier& b) {
  asm volatile("s_waitcnt vmcnt(0)" ::: "memory");
  __syncthreads();
  unsigned nloc = b.nloc, nx = b.nx;
  if (threadIdx.x == 0) {
    unsigned* bar = b.bar;
    __builtin_amdgcn_s_waitcnt(0);
    if (nloc == 0u) { xcd_barrier_complete(bar, b.x, nloc, nx); }
    const unsigned old = xb_add(&bar[XB_XSUB(b.x)], 1u);
    const unsigned gen = old / nloc;
    if (old + 1u == (gen + 1u) * nloc) {
      __builtin_amdgcn_fence(__ATOMIC_RELEASE, "agent");
      asm volatile("s_waitcnt vmcnt(0)" ::: "memory");
      const unsigned og = xb_add(&bar[XB_TOP], 1u);
      const unsigned tg = og / nx;
      if (og + 1u == (tg + 1u) * nx) xb_add(&bar[XB_TOPGEN], 1u);
      else XB_SPIN(xb_ld(&bar[XB_TOPGEN]) == tg, bar);
      __builtin_amdgcn_fence(__ATOMIC_ACQUIRE, "agent");
      xb_add(&bar[XB_XGEN(b.x)], 1u);
      asm volatile("s_waitcnt vmcnt(0)" ::: "memory");
    } else {
      XB_SPIN(xb_ld(&bar[XB_XGEN(b.x)]) == gen, bar);
      __builtin_amdgcn_fence(__ATOMIC_ACQUIRE, "agent");
      asm volatile("s_waitcnt vmcnt(0)" ::: "memory");
    }
  }
  if (threadIdx.x < 64) { b.nloc = __builtin_amdgcn_readfirstlane(nloc); b.nx = __builtin_amdgcn_readfirstlane(nx); }
  __syncthreads();
}

template <int MI, class Epi>
DI void gemm_tile(const u16* __restrict__ A, int lda, const u16* __restrict__ Bt, int ldb, int K, int m0, int n0, int nout_off,
                  char* smem, const Epi& epi) {
  constexpr int BM = 64 * MI, ASTG = BM * 128;
  const int tid = threadIdx.x, lane = tid & 63, wid = tid >> 6;
  const int wm = wid >> 1, wn = wid & 1, l31 = lane & 31, lh = lane >> 5;
  char* As = smem;
  char* Bs = smem + 2 * ASTG;
  const int srow = tid >> 3;
  const int scc = ((tid & 7) ^ ((tid >> 4) & 7)) * 8;
  const u16* ag = A + (size_t)(m0 + srow) * lda + scc;
  const u16* bg = Bt + (size_t)(n0 + srow) * ldb + scc;
  LAS char* awr = (LAS char*)(As + wid * 1024);
  LAS char* bwr = (LAS char*)(Bs + wid * 1024);
  f32x16 acc[MI][2];
#pragma unroll
  for (int i = 0; i < MI; i++)
#pragma unroll
    for (int j = 0; j < 2; j++)
#pragma unroll
      for (int r = 0; r < 16; r++) acc[i][j][r] = 0.f;
  __syncthreads();
#pragma unroll
  for (int i = 0; i < 2 * MI; i++)
    __builtin_amdgcn_global_load_lds((const void*)(ag + (size_t)(32 * i) * lda), (LAS void*)(awr + i * 4096), 16, 0, 0);
#pragma unroll
  for (int i = 0; i < 4; i++)
    __builtin_amdgcn_global_load_lds((const void*)(bg + (size_t)(32 * i) * ldb), (LAS void*)(bwr + i * 4096), 16, 0, 0);
  asm volatile("s_waitcnt vmcnt(0)" ::: "memory");
  __syncthreads();
  const int nk = K >> 6;
  const int sw = (l31 >> 1) & 7;
  for (int kt = 0; kt < nk; kt++) {
    const int buf = kt & 1;
    if (kt + 1 < nk) {
#pragma unroll
      for (int i = 0; i < 2 * MI; i++)
        __builtin_amdgcn_global_load_lds((const void*)(ag + (size_t)(32 * i) * lda + (kt + 1) * 64), (LAS void*)(awr + (buf ^ 1) * ASTG + i * 4096), 16, 0, 0);
#pragma unroll
      for (int i = 0; i < 4; i++)
        __builtin_amdgcn_global_load_lds((const void*)(bg + (size_t)(32 * i) * ldb + (kt + 1) * 64), (LAS void*)(bwr + (buf ^ 1) * 16384 + i * 4096), 16, 0, 0);
    }
    const char* as = As + buf * ASTG + (wm * (32 * MI) + l31) * 128;
    const char* bs = Bs + buf * 16384 + (wn * 64 + l31) * 128;
#pragma unroll
    for (int ks = 0; ks < 4; ks++) {
      const int co = ((2 * ks + lh) ^ sw) << 4;
      const bf16x8 b0 = *(const bf16x8*)(bs + co);
      const bf16x8 b1 = *(const bf16x8*)(bs + 32 * 128 + co);
#pragma unroll
      for (int i = 0; i < MI; i++) {
        const bf16x8 a = *(const bf16x8*)(as + i * 32 * 128 + co);
        acc[i][0] = MFMA32(b0, a, acc[i][0]);
        acc[i][1] = MFMA32(b1, a, acc[i][1]);
      }
    }
    asm volatile("s_waitcnt vmcnt(0)" ::: "memory");
    __syncthreads();
  }
#pragma unroll
  for (int i = 0; i < MI; i++)
#pragma unroll
    for (int j = 0; j < 2; j++)
      epi(m0 + wm * (32 * MI) + i * 32 + l31, nout_off + n0 + wn * 64 + j * 32, lh, acc[i][j]);
}

DI void rope_pair(float x1, float x2, int i, float pos, float& o1, float& o2) {
  const float inv = exp2f(-(float)i * (13.287712379549449f / 16.f));
  const float ang = pos * inv;
  const float c = __cosf(ang), s = __sinf(ang);
  o1 = x1 * c - x2 * s;
  o2 = x1 * s + x2 * c;
}

struct EpiPoolG1 {
  u16 *U, *SZ;
  DI void operator()(int m, int nb, int lh, const f32x16& a) const {
#pragma unroll
    for (int g = 0; g < 4; g++) {
      const int n = nb + 8 * g + 4 * lh;
      if (nb < 1024) {
        uint2 v; v.x = pk2(a[4 * g], a[4 * g + 1]); v.y = pk2(a[4 * g + 2], a[4 * g + 3]);
        *(uint2*)(U + (size_t)m * 1024 + n) = v;
      } else {
        uint2 v; v.x = pk2(silu(a[4 * g]), silu(a[4 * g + 1])); v.y = pk2(silu(a[4 * g + 2]), silu(a[4 * g + 3]));
        *(uint2*)(SZ + (size_t)m * 1024 + n - 1024) = v;
      }
    }
  }
};
struct EpiPoolG2 {
  u16* PM; const u16* SZ; const float* scale;
  DI void operator()(int m, int nb, int lh, const f32x16& a) const {
#pragma unroll
    for (int g = 0; g < 4; g++) {
      const int n = nb + 8 * g + 4 * lh;
      const uint2 z = *(const uint2*)(SZ + (size_t)m * 1024 + n);
      const float4 sc = *(const float4*)(scale + n);
      uint2 v;
      v.x = pk2(a[4 * g] * sc.x * bf2f((u16)(z.x & 0xffff)), a[4 * g + 1] * sc.y * bf2f((u16)(z.x >> 16)));
      v.y = pk2(a[4 * g + 2] * sc.z * bf2f((u16)(z.y & 0xffff)), a[4 * g + 3] * sc.w * bf2f((u16)(z.y >> 16)));
      *(uint2*)(PM + (size_t)m * 1024 + n) = v;
    }
  }
};
struct EpiG3 {
  const float *xp, *xs;
  float* out; const float* mod_layer;
  DI void operator()(int m, int nb, int lh, const f32x16& a) const {
    const float* xr = (m < TC) ? xp + (size_t)m * 1024 : xs + (size_t)(m - TC) * 1024;
    const float* gate = mod_layer + cond_of(m) * 3072 + 2048;
#pragma unroll
    for (int g = 0; g < 4; g++) {
      const int n = nb + 8 * g + 4 * lh;
      const float4 x = *(const float4*)(xr + n);
      const float4 gt = *(const float4*)(gate + n);
      float4 r;
      r.x = ALPHA * x.x + gt.x * a[4 * g]; r.y = ALPHA * x.y + gt.y * a[4 * g + 1];
      r.z = ALPHA * x.z + gt.z * a[4 * g + 2]; r.w = ALPHA * x.w + gt.w * a[4 * g + 3];
      *(float4*)(out + (size_t)m * 1024 + n) = r;
    }
  }
};
struct EpiMlaG1 {
  float* RAW; u16* KR; u16* SZ; float* st_kr;
  DI void operator()(int m, int nb, int lh, const f32x16& a) const {
    if (nb >= 1856) return;
    if (nb < 768) {
#pragma unroll
      for (int g = 0; g < 4; g++) {
        const int n = nb + 8 * g + 4 * lh;
        float4 r; r.x = a[4 * g]; r.y = a[4 * g + 1]; r.z = a[4 * g + 2]; r.w = a[4 * g + 3];
        *(float4*)(RAW + (size_t)m * 768 + n) = r;
      }
    } else if (nb < 832) {
      const int off = nb - 768;
      const bool lat = m >= TC;
      const int tt = (m - TC) & 2047;
      const float pos = (off == 0) ? (float)(tt >> 6) : (float)(tt & 63);
      const size_t kr = (size_t)kvrow_of(m) * 64 + off;
#pragma unroll
      for (int g = 0; g < 2; g++) {
        float o1[4], o2[4];
#pragma unroll
        for (int e = 0; e < 4; e++) {
          const int i = 8 * g + 4 * lh + e;
          const float x1 = a[4 * g + e], x2 = a[4 * (g + 2) + e];
          if (lat) rope_pair(x1, x2, i, pos, o1[e], o2[e]); else { o1[e] = x1; o2[e] = x2; }
        }
        const int i0 = 8 * g + 4 * lh;
        if (!lat) {
          float4 r1; r1.x = o1[0]; r1.y = o1[1]; r1.z = o1[2]; r1.w = o1[3];
          float4 r2; r2.x = o2[0]; r2.y = o2[1]; r2.z = o2[2]; r2.w = o2[3];
          *(float4*)(st_kr + (size_t)m * 64 + off + i0) = r1;
          *(float4*)(st_kr + (size_t)m * 64 + off + i0 + 16) = r2;
        }
        uint2 v1; v1.x = pk2(o1[0], o1[1]); v1.y = pk2(o1[2], o1[3]);
        uint2 v2; v2.x = pk2(o2[0], o2[1]); v2.y = pk2(o2[2], o2[3]);
        *(uint2*)(KR + kr + i0) = v1;
        *(uint2*)(KR + kr + i0 + 16) = v2;
      }
    } else {
#pragma unroll
      for (int g = 0; g < 4; g++) {
        const int n = nb + 8 * g + 4 * lh - 832;
        uint2 v; v.x = pk2(silu(a[4 * g]), silu(a[4 * g + 1])); v.y = pk2(silu(a[4 * g + 2]), silu(a[4 * g + 3]));
        *(uint2*)(SZ + (size_t)m * 1024 + n) = v;
      }
    }
  }
};
struct EpiMlaQ {
  u16* Q;
  DI void operator()(int m, int nb, int lh, const f32x16& a) const {
    const int head = nb / 192, off = nb - head * 192;
    u16* qr = Q + (size_t)m * 1536 + nb;
    if (off < 128) {
#pragma unroll
      for (int g = 0; g < 4; g++) {
        uint2 v; v.x = pk2(a[4 * g] * MLA_QS, a[4 * g + 1] * MLA_QS); v.y = pk2(a[4 * g + 2] * MLA_QS, a[4 * g + 3] * MLA_QS);
        *(uint2*)(qr + 8 * g + 4 * lh) = v;
      }
    } else {
      const bool lat = m >= TC;
      const int tt = (m - TC) & 2047;
      const float pos = (off == 128) ? (float)(tt >> 6) : (float)(tt & 63);
#pragma unroll
      for (int g = 0; g < 2; g++) {
        float o1[4], o2[4];
#pragma unroll
        for (int e = 0; e < 4; e++) {
          const int i = 8 * g + 4 * lh + e;
          const float x1 = a[4 * g + e], x2 = a[4 * (g + 2) + e];
          if (lat) rope_pair(x1, x2, i, pos, o1[e], o2[e]); else { o1[e] = x1; o2[e] = x2; }
        }
        const int i0 = 8 * g + 4 * lh;
        uint2 v1; v1.x = pk2(o1[0] * MLA_QS, o1[1] * MLA_QS); v1.y = pk2(o1[2] * MLA_QS, o1[3] * MLA_QS);
        uint2 v2; v2.x = pk2(o2[0] * MLA_QS, o2[1] * MLA_QS); v2.y = pk2(o2[2] * MLA_QS, o2[3] * MLA_QS);
        *(uint2*)(qr + i0) = v1;
        *(uint2*)(qr + i0 + 16) = v2;
      }
    }
  }
};
struct EpiMlaKV {
  u16 *KN, *VT;
  DI void operator()(int m, int nb, int lh, const f32x16& a) const {
    const int head = nb >> 8, off = nb & 255;
    if (off < 128) {
#pragma unroll
      for (int g = 0; g < 4; g++) {
        uint2 v; v.x = pk2(a[4 * g], a[4 * g + 1]); v.y = pk2(a[4 * g + 2], a[4 * g + 3]);
        *(uint2*)(KN + (size_t)m * 1024 + head * 128 + off + 8 * g + 4 * lh) = v;
      }
    } else {
      size_t base; int Lk, key;
      if (m < TC) { base = (size_t)(m >> 8) * (8 * 128 * 256); Lk = 256; key = m & 255; }
      else { const int r2 = m - TC; const int b = r2 / 2304; key = r2 - b * 2304; Lk = 2304; base = (size_t)16 * 8 * 128 * 256 + (size_t)b * (8 * 128 * 2304); }
      u16* vp = VT + base + (size_t)(head * 128 + off - 128) * Lk + perm16(key);
#pragma unroll
      for (int g = 0; g < 4; g++)
#pragma unroll
        for (int e = 0; e < 4; e++) vp[(size_t)(8 * g + 4 * lh + e) * Lk] = f2bf(a[4 * g + e]);
    }
  }
};
struct EpiNaG1 {
  u16 *NQ, *NK, *NVT, *SZ; float *st_k, *st_v;
  DI void operator()(int m, int nb, int lh, const f32x16& a) const {
    if (nb < 1024) {
#pragma unroll
      for (int g = 0; g < 4; g++) {
        uint2 v; v.x = pk2(a[4 * g] * NA_QS, a[4 * g + 1] * NA_QS); v.y = pk2(a[4 * g + 2] * NA_QS, a[4 * g + 3] * NA_QS);
        *(uint2*)(NQ + (size_t)m * 1024 + nb + 8 * g + 4 * lh) = v;
      }
    } else if (nb < 2048) {
      const size_t kr = (size_t)kvrow_of(m) * 1024 + (nb - 1024);
#pragma unroll
      for (int g = 0; g < 4; g++) {
        uint2 v; v.x = pk2(a[4 * g], a[4 * g + 1]); v.y = pk2(a[4 * g + 2], a[4 * g + 3]);
        *(uint2*)(NK + kr + 8 * g + 4 * lh) = v;
        if (m < TC) { float4 r; r.x = a[4 * g]; r.y = a[4 * g + 1]; r.z = a[4 * g + 2]; r.w = a[4 * g + 3];
          *(float4*)(st_k + (size_t)m * 1024 + (nb - 1024) + 8 * g + 4 * lh) = r; }
      }
    } else if (nb < 3072) {
      const int c0 = nb - 2048;
      size_t base; int Lk, key;
      if (m < TC) { base = (size_t)(m >> 8) * (1024 * 256); Lk = 256; key = perm16(m & 255); }
      else { const int b = (m - TC) >> 11; key = 256 + ((m - TC) & 2047); Lk = 2304; base = (size_t)16 * 1024 * 256 + (size_t)b * (1024 * 2304); }
      u16* vp = NVT + base + (size_t)c0 * Lk + key;
#pragma unroll
      for (int g = 0; g < 4; g++) {
#pragma unroll
        for (int e = 0; e < 4; e++) vp[(size_t)(8 * g + 4 * lh + e) * Lk] = f2bf(a[4 * g + e]);
        if (m < TC) { float4 r; r.x = a[4 * g]; r.y = a[4 * g + 1]; r.z = a[4 * g + 2]; r.w = a[4 * g + 3];
          *(float4*)(st_v + (size_t)m * 1024 + c0 + 8 * g + 4 * lh) = r; }
      }
    } else {
#pragma unroll
      for (int g = 0; g < 4; g++) {
        uint2 v; v.x = pk2(silu(a[4 * g]), silu(a[4 * g + 1])); v.y = pk2(silu(a[4 * g + 2]), silu(a[4 * g + 3]));
        *(uint2*)(SZ + (size_t)m * 1024 + (nb - 3072) + 8 * g + 4 * lh) = v;
      }
    }
  }
};

template <int NSA, int NSB, int NDT>
DI void attn_dense_wave(const u16* __restrict__ qrow, const u16* __restrict__ kA, int kAstride, const u16* __restrict__ kB,
                        const u16* __restrict__ vt, int Lk, int nkeys, const u16* __restrict__ szrow, u16* __restrict__ orow) {
  const int lane = threadIdx.x & 63, l31 = lane & 31, lh = lane >> 5;
  bf16x8 qf[NSA + NSB];
#pragma unroll
  for (int s = 0; s < NSA + NSB; s++) qf[s] = *(const bf16x8*)(qrow + s * 16 + lh * 8);
  f32x16 o[NDT];
#pragma unroll
  for (int d = 0; d < NDT; d++)
#pragma unroll
    for (int r = 0; r < 16; r++) o[d][r] = 0.f;
  float m = -1e30f, l = 0.f;
  for (int k0 = 0; k0 < nkeys; k0 += 32) {
    f32x16 sa;
#pragma unroll
    for (int r = 0; r < 16; r++) sa[r] = 0.f;
    const u16* kp = kA + (size_t)(k0 + l31) * kAstride + lh * 8;
#pragma unroll
    for (int s = 0; s < NSA; s++) sa = MFMA32(*(const bf16x8*)(kp + s * 16), qf[s], sa);
    if (NSB > 0) {
      const u16* kp2 = kB + (size_t)(k0 + l31) * 64 + lh * 8;
#pragma unroll
      for (int s = 0; s < NSB; s++) sa = MFMA32(*(const bf16x8*)(kp2 + s * 16), qf[NSA + s], sa);
    }
    float mx = sa[0];
#pragma unroll
    for (int r = 1; r < 16; r++) mx = fmaxf(mx, sa[r]);
    mx = fmaxf(mx, __shfl_xor(mx, 32));
    const float mn = fmaxf(m, mx);
    const float alpha = exp2f(m - mn);
    m = mn;
    float ps = 0.f;
#pragma unroll
    for (int r = 0; r < 16; r++) { sa[r] = exp2f(sa[r] - mn); ps += sa[r]; }
    l = l * alpha + ps;
#pragma unroll
    for (int d = 0; d < NDT; d++)
#pragma unroll
      for (int r = 0; r < 16; r++) o[d][r] *= alpha;
#pragma unroll
    for (int sp = 0; sp < 2; sp++) {
      u32x4 pw;
      pw[0] = pk2(sa[8 * sp + 0], sa[8 * sp + 1]); pw[1] = pk2(sa[8 * sp + 2], sa[8 * sp + 3]);
      pw[2] = pk2(sa[8 * sp + 4], sa[8 * sp + 5]); pw[3] = pk2(sa[8 * sp + 6], sa[8 * sp + 7]);
      const bf16x8 pf = __builtin_bit_cast(bf16x8, pw);
#pragma unroll
      for (int d = 0; d < NDT; d++) {
        const u16* vp = vt + (size_t)(d * 32 + l31) * Lk + k0 + 16 * sp + 4 * lh;
        const uint2 lo = *(const uint2*)vp, hi = *(const uint2*)(vp + 8);
        u32x4 vw; vw[0] = lo.x; vw[1] = lo.y; vw[2] = hi.x; vw[3] = hi.y;
        o[d] = MFMA32(__builtin_bit_cast(bf16x8, vw), pf, o[d]);
      }
    }
  }
  l += __shfl_xor(l, 32);
  const float inv = 1.f / l;
#pragma unroll
  for (int d = 0; d < NDT; d++)
#pragma unroll
    for (int g = 0; g < 4; g++) {
      const int d0 = d * 32 + 8 * g + 4 * lh;
      const uint2 z = *(const uint2*)(szrow + d0);
      uint2 v;
      v.x = pk2(o[d][4 * g] * inv * bf2f((u16)(z.x & 0xffff)), o[d][4 * g + 1] * inv * bf2f((u16)(z.x >> 16)));
      v.y = pk2(o[d][4 * g + 2] * inv * bf2f((u16)(z.y & 0xffff)), o[d][4 * g + 3] * inv * bf2f((u16)(z.y >> 16)));
      *(uint2*)(orow + d0) = v;
    }
}


template <int NSA, int NSB, int NDT>
DI void attn_dense_block(char* smem, const u16* __restrict__ qrow, const u16* __restrict__ kA, int kAstride, const u16* __restrict__ kB,
                         const u16* __restrict__ vt, int Lk, int nkeys, const u16* __restrict__ szrow, u16* __restrict__ orow) {
  constexpr int NS = NSA + NSB, DK = 16 * NS, KST = DK + 8, DV = 32 * NDT, VST = 72;
  constexpr int CA = NSA * 2, CB = NSB * 2;
  constexpr int NLA = 64 * CA / 256, NLB = 64 * CB / 256, NLV = DV * 8 / 256;
  const int tid = threadIdx.x, lane = tid & 63, l31 = lane & 31, lh = lane >> 5;
  u16* Ks = (u16*)smem;
  u16* Vs = Ks + 64 * KST;
  u32x4 ra[NLA], rb[NLB > 0 ? NLB : 1], rv[NLV];
  bf16x8 qf[NS];
#pragma unroll
  for (int s = 0; s < NS; s++) qf[s] = *(const bf16x8*)(qrow + s * 16 + lh * 8);
  f32x16 o[NDT];
#pragma unroll
  for (int d = 0; d < NDT; d++)
#pragma unroll
    for (int r = 0; r < 16; r++) o[d][r] = 0.f;
  float m = -1e30f, l = 0.f;

    {
#pragma unroll
      for (int i = 0; i < NLA; i++) { const int c = tid + 256 * i; const int row = c / CA, cc = c % CA;
        ra[i] = *(const u32x4*)(kA + (size_t)((0) + row) * kAstride + cc * 8); }
      if constexpr (NLB > 0) {
#pragma unroll
        for (int i = 0; i < NLB; i++) { const int c = tid + 256 * i; const int row = c / CB, cc = c % CB;
          rb[i] = *(const u32x4*)(kB + (size_t)((0) + row) * 64 + cc * 8); }
      }
#pragma unroll
      for (int i = 0; i < NLV; i++) { const int c = tid + 256 * i; const int row = c >> 3, cc = c & 7;
        rv[i] = *(const u32x4*)(vt + (size_t)row * Lk + (0) + cc * 8); }
    }
  __syncthreads();
    {
#pragma unroll
      for (int i = 0; i < NLA; i++) { const int c = tid + 256 * i; const int row = c / CA, cc = c % CA;
        *(u32x4*)(Ks + row * KST + cc * 8) = ra[i]; }
      if constexpr (NLB > 0) {
#pragma unroll
        for (int i = 0; i < NLB; i++) { const int c = tid + 256 * i; const int row = c / CB, cc = c % CB;
          *(u32x4*)(Ks + row * KST + NSA * 16 + cc * 8) = rb[i]; }
      }
#pragma unroll
      for (int i = 0; i < NLV; i++) { const int c = tid + 256 * i; const int row = c >> 3, cc = c & 7;
        *(u32x4*)(Vs + row * VST + cc * 8) = rv[i]; }
    }
  __syncthreads();
  for (int k0 = 0; k0 < nkeys; k0 += 64) {
    const bool more = (k0 + 64) < nkeys;
    const int kn = more ? k0 + 64 : k0;
    {
#pragma unroll
      for (int i = 0; i < NLA; i++) { const int c = tid + 256 * i; const int row = c / CA, cc = c % CA;
        ra[i] = *(const u32x4*)(kA + (size_t)(kn + row) * kAstride + cc * 8); }
      if constexpr (NLB > 0) {
#pragma unroll
        for (int i = 0; i < NLB; i++) { const int c = tid + 256 * i; const int row = c / CB, cc = c % CB;
          rb[i] = *(const u32x4*)(kB + (size_t)(kn + row) * 64 + cc * 8); }
      }
#pragma unroll
      for (int i = 0; i < NLV; i++) { const int c = tid + 256 * i; const int row = c >> 3, cc = c & 7;
        rv[i] = *(const u32x4*)(vt + (size_t)row * Lk + kn + cc * 8); }
    }
#pragma unroll 1
    for (int hh = 0; hh < 2; hh++) {
      f32x16 s0;
#pragma unroll
      for (int r = 0; r < 16; r++) s0[r] = 0.f;
      const u16* kp = Ks + (hh * 32 + l31) * KST + lh * 8;
#pragma unroll
      for (int s = 0; s < NS; s++) {
        s0 = MFMA32(*(const bf16x8*)(kp + s * 16), qf[s], s0);
        if ((s & 3) == 3 && s + 1 < NS) __builtin_amdgcn_sched_barrier(0);
      }
      float mx = s0[0];
#pragma unroll
      for (int r = 1; r < 16; r++) mx = fmaxf(mx, s0[r]);
      mx = fmaxf(mx, __shfl_xor(mx, 32));
      if (__any(mx > m + 8.f)) {
        const float mn = fmaxf(m, mx);
        const float alpha = exp2f(m - mn);
        m = mn;
        l *= alpha;
#pragma unroll
        for (int d = 0; d < NDT; d++)
#pragma unroll
          for (int r = 0; r < 16; r++) o[d][r] *= alpha;
      }
      float ps = 0.f;
#pragma unroll
      for (int r = 0; r < 16; r++) { s0[r] = exp2f(s0[r] - m); ps += s0[r]; }
      l += ps;
      const u16* vp = Vs + l31 * VST + hh * 32 + lh * 8;
#pragma unroll
      for (int sp = 0; sp < 2; sp++) {
        u32x4 pw;
        pw[0] = pk2(s0[8 * sp + 0], s0[8 * sp + 1]); pw[1] = pk2(s0[8 * sp + 2], s0[8 * sp + 3]);
        pw[2] = pk2(s0[8 * sp + 4], s0[8 * sp + 5]); pw[3] = pk2(s0[8 * sp + 6], s0[8 * sp + 7]);
        const bf16x8 pf = __builtin_bit_cast(bf16x8, pw);
#pragma unroll
        for (int d = 0; d < NDT; d++) o[d] = MFMA32(*(const bf16x8*)(vp + d * 32 * VST + sp * 16), pf, o[d]);
      }
    }
    __syncthreads();
    if (more)
    {
#pragma unroll
      for (int i = 0; i < NLA; i++) { const int c = tid + 256 * i; const int row = c / CA, cc = c % CA;
        *(u32x4*)(Ks + row * KST + cc * 8) = ra[i]; }
      if constexpr (NLB > 0) {
#pragma unroll
        for (int i = 0; i < NLB; i++) { const int c = tid + 256 * i; const int row = c / CB, cc = c % CB;
          *(u32x4*)(Ks + row * KST + NSA * 16 + cc * 8) = rb[i]; }
      }
#pragma unroll
      for (int i = 0; i < NLV; i++) { const int c = tid + 256 * i; const int row = c >> 3, cc = c & 7;
        *(u32x4*)(Vs + row * VST + cc * 8) = rv[i]; }
    }
    __syncthreads();
  }
  l += __shfl_xor(l, 32);
  const float inv = 1.f / l;
#pragma unroll
  for (int d = 0; d < NDT; d++)
#pragma unroll
    for (int g = 0; g < 4; g++) {
      const int d0 = d * 32 + 8 * g + 4 * lh;
      const uint2 z = *(const uint2*)(szrow + d0);
      uint2 v;
      v.x = pk2(o[d][4 * g] * inv * bf2f((u16)(z.x & 0xffff)), o[d][4 * g + 1] * inv * bf2f((u16)(z.x >> 16)));
      v.y = pk2(o[d][4 * g + 2] * inv * bf2f((u16)(z.y & 0xffff)), o[d][4 * g + 3] * inv * bf2f((u16)(z.y >> 16)));
      *(uint2*)(orow + d0) = v;
    }
}

DI void attn_na_wave(const Params& p, int b, int h, int r, int j) {
  const int lane = threadIdx.x & 63, l15 = lane & 15, q4 = lane >> 4;
  const int t = TC + b * 2048 + r * 64 + j * 16 + l15;
  const u16* qrow = p.NQ + (size_t)t * 1024 + h * 64;
  const bf16x8 qf0 = *(const bf16x8*)(qrow + q4 * 8);
  const bf16x8 qf1 = *(const bf16x8*)(qrow + 32 + q4 * 8);
  const int rs = min(max(r - 4, 0), 24);
  const int bstart = min(max(j * 16 - 8, 0), 32);
  const int c = j * 16 + l15;
  const int cstart = min(max(c - 8, 0), 48);
  const u16* kb = p.NK + (size_t)(TC + b * 2304) * 1024 + h * 64;
  const u16* vb = p.NVT + (size_t)16 * 1024 * 256 + (size_t)b * (1024 * 2304) + (size_t)(h * 64) * 2304;
  const float* rp = p.na_rpb + h * 465;
  f32x4 o[4];
#pragma unroll
  for (int d = 0; d < 4; d++) { o[d][0] = 0.f; o[d][1] = 0.f; o[d][2] = 0.f; o[d][3] = 0.f; }
  float m = -1e30f, l = 0.f;
  const int krow0 = 8 * (l15 >> 2) + (l15 & 3);
  for (int cg4 = 0; cg4 < 4; cg4++) {
    bf16x8 kf[4][4];
    bf16x8 vf[4][4];
#pragma unroll
    for (int c4 = 0; c4 < 4; c4++) {
      const int ch = cg4 * 4 + c4;
      const int key0 = ch < 8 ? ch * 32 : 256 + (rs + ch - 8) * 64 + bstart;
      const u16* kp = kb + (size_t)(key0 + krow0) * 1024 + q4 * 8;
      kf[c4][0] = *(const bf16x8*)(kp);
      kf[c4][1] = *(const bf16x8*)(kp + 32);
      kf[c4][2] = *(const bf16x8*)(kp + 4 * 1024);
      kf[c4][3] = *(const bf16x8*)(kp + 4 * 1024 + 32);
#pragma unroll
      for (int d = 0; d < 4; d++) vf[c4][d] = *(const bf16x8*)(vb + (size_t)(d * 16 + l15) * 2304 + key0 + q4 * 8);
    }
#pragma unroll
    for (int c4 = 0; c4 < 4; c4++) {
      const int ch = cg4 * 4 + c4;
      f32x4 s0 = {0.f, 0.f, 0.f, 0.f}, s1 = {0.f, 0.f, 0.f, 0.f};
      s0 = MFMA16(kf[c4][0], qf0, s0);
      s0 = MFMA16(kf[c4][1], qf1, s0);
      s1 = MFMA16(kf[c4][2], qf0, s1);
      s1 = MFMA16(kf[c4][3], qf1, s1);
      if (cg4 >= 2) {
        const int dr = rs + (ch - 8) - r + 7;
#pragma unroll
        for (int i = 0; i < 4; i++) {
          const int kc0 = bstart + q4 * 8 + i, kc1 = kc0 + 4;
          const bool v0 = (kc0 >= cstart) && (kc0 < cstart + 16);
          const bool v1 = (kc1 >= cstart) && (kc1 < cstart + 16);
          const int dc0 = min(max(kc0 - c + 15, 0), 30), dc1 = min(max(kc1 - c + 15, 0), 30);
          const float b0 = rp[dr * 31 + dc0] * LOG2E, b1 = rp[dr * 31 + dc1] * LOG2E;
          s0[i] = v0 ? s0[i] + b0 : -1e30f;
          s1[i] = v1 ? s1[i] + b1 : -1e30f;
        }
      }
      float mx = fmaxf(fmaxf(fmaxf(s0[0], s0[1]), fmaxf(s0[2], s0[3])), fmaxf(fmaxf(s1[0], s1[1]), fmaxf(s1[2], s1[3])));
      mx = fmaxf(mx, __shfl_xor(mx, 16));
      mx = fmaxf(mx, __shfl_xor(mx, 32));
      const float mn = fmaxf(m, mx);
      const float alpha = exp2f(m - mn);
      m = mn;
      float ps = 0.f;
#pragma unroll
      for (int i = 0; i < 4; i++) { s0[i] = exp2f(s0[i] - mn); s1[i] = exp2f(s1[i] - mn); ps += s0[i] + s1[i]; }
      l = l * alpha + ps;
      u32x4 pw; pw[0] = pk2(s0[0], s0[1]); pw[1] = pk2(s0[2], s0[3]); pw[2] = pk2(s1[0], s1[1]); pw[3] = pk2(s1[2], s1[3]);
      const bf16x8 pf = __builtin_bit_cast(bf16x8, pw);
#pragma unroll
      for (int d = 0; d < 4; d++) {
        o[d][0] *= alpha; o[d][1] *= alpha; o[d][2] *= alpha; o[d][3] *= alpha;
        o[d] = MFMA16(vf[c4][d], pf, o[d]);
      }
    }
  }
  l += __shfl_xor(l, 16);
  l += __shfl_xor(l, 32);
  const float inv = 1.f / l;
  const u16* szrow = p.SZ + (size_t)t * 1024 + h * 64;
  u16* orow = p.NAO + (size_t)t * 1024 + h * 64;
#pragma unroll
  for (int d = 0; d < 4; d++) {
    const int d0 = d * 16 + q4 * 4;
    const uint2 z = *(const uint2*)(szrow + d0);
    uint2 v;
    v.x = pk2(o[d][0] * inv * bf2f((u16)(z.x & 0xffff)), o[d][1] * inv * bf2f((u16)(z.x >> 16)));
    v.y = pk2(o[d][2] * inv * bf2f((u16)(z.y & 0xffff)), o[d][3] * inv * bf2f((u16)(z.y >> 16)));
    *(uint2*)(orow + d0) = v;
  }
}


DI void attn_na_block(const Params& p, char* smem, int b, int h, int rpair) {
  constexpr int ST = 72;
  const int tid = threadIdx.x, lane = tid & 63, j = tid >> 6, l31 = lane & 31, lh = lane >> 5;
  u16* Kt = (u16*)smem;
  u16* Vt = Kt + 2 * 64 * ST;
  float* bl = (float*)(Vt + 2 * 64 * ST);
  const int r0 = rpair * 2;
  const int qr = r0 + (l31 >> 4), c = j * 16 + (l31 & 15);
  const int t = TC + b * 2048 + qr * 64 + c;
  const int rsq = min(max(qr - 4, 0), 24);
  const int rs0 = min(max(r0 - 4, 0), 24);
  const int nrows = min(max(r0 + 1 - 4, 0), 24) + 8 - rs0;
  const int ntile = 4 + nrows;
  const int bstart = min(max(j * 16 - 8, 0), 32);
  const int cstart = min(max(c - 8, 0), 48);
  const u16* kb = p.NK + (size_t)(TC + b * 2304) * 1024 + h * 64;
  const u16* vb = p.NVT + (size_t)16 * 1024 * 256 + (size_t)b * (1024 * 2304) + (size_t)(h * 64) * 2304;
  const u16* qrow = p.NQ + (size_t)t * 1024 + h * 64;
  bf16x8 qf[4];
#pragma unroll
  for (int s = 0; s < 4; s++) qf[s] = *(const bf16x8*)(qrow + s * 16 + lh * 8);
  f32x16 o[2];
#pragma unroll
  for (int d = 0; d < 2; d++)
#pragma unroll
    for (int r = 0; r < 16; r++) o[d][r] = 0.f;
  float m = -1e30f, l = 0.f;
  const int r16 = l31 & 15;
  const int kap = (l31 & 16) + (r16 & 3) + 4 * ((r16 >> 3) & 1) + 8 * ((r16 >> 2) & 1);
  const int srow = tid >> 3, scc = (tid & 7) * 8;
  u32x4 ra[2], rv[2];
  __syncthreads();
  for (int i = tid; i < 465; i += 256) bl[i] = p.na_rpb[h * 465 + i] * LOG2E;
#pragma unroll
  for (int i = 0; i < 2; i++) {
    ra[i] = *(const u32x4*)(kb + (size_t)(srow + 32 * i) * 1024 + scc);
    rv[i] = *(const u32x4*)(vb + (size_t)(srow + 32 * i) * 2304 + scc);
  }
#pragma unroll
  for (int i = 0; i < 2; i++) {
    *(u32x4*)(Kt + (srow + 32 * i) * ST + scc) = ra[i];
    *(u32x4*)(Vt + (srow + 32 * i) * ST + scc) = rv[i];
  }
  __syncthreads();
  for (int tl = 0; tl < ntile; tl++) {
    const int buf = tl & 1;
    const int tn = (tl + 1 < ntile) ? tl + 1 : tl;
    const int keyn = tn < 4 ? tn * 64 : 256 + (rs0 + tn - 4) * 64;
#pragma unroll
    for (int i = 0; i < 2; i++) {
      ra[i] = *(const u32x4*)(kb + (size_t)(keyn + srow + 32 * i) * 1024 + scc);
      rv[i] = *(const u32x4*)(vb + (size_t)(srow + 32 * i) * 2304 + keyn + scc);
    }
    const u16* Kc = Kt + buf * 64 * ST;
    const u16* Vc = Vt + buf * 64 * ST;
    const bool local = tl >= 4;
    const int gr = rs0 + tl - 4;
    const int nh = local ? 1 : 2;
    for (int hh = 0; hh < nh; hh++) {
      const int koff = local ? bstart : hh * 32;
      f32x16 s0;
#pragma unroll
      for (int r = 0; r < 16; r++) s0[r] = 0.f;
      const u16* kp = Kc + (koff + kap) * ST + lh * 8;
#pragma unroll
      for (int s = 0; s < 4; s++) s0 = MFMA32(*(const bf16x8*)(kp + s * 16), qf[s], s0);
      if (local) {
        const bool rowvalid = (gr >= rsq) && (gr < rsq + 8);
        const int dr = min(max(gr - qr + 7, 0), 14);
#pragma unroll
        for (int i = 0; i < 16; i++) {
          const int kcol = bstart + 16 * (i >> 3) + 8 * lh + (i & 7);
          const bool valid = rowvalid && (kcol >= cstart) && (kcol < cstart + 16);
          const int dc = min(max(kcol - c + 15, 0), 30);
          s0[i] = valid ? s0[i] + bl[dr * 31 + dc] : -1e30f;
        }
      }
      float mx = s0[0];
#pragma unroll
      for (int r = 1; r < 16; r++) mx = fmaxf(mx, s0[r]);
      mx = fmaxf(mx, __shfl_xor(mx, 32));
      if (__any(mx > m + 8.f)) {
        const float mn = fmaxf(m, mx);
        const float alpha = exp2f(m - mn);
        m = mn;
        l *= alpha;
#pragma unroll
        for (int d = 0; d < 2; d++)
#pragma unroll
          for (int r = 0; r < 16; r++) o[d][r] *= alpha;
      }
      float ps = 0.f;
#pragma unroll
      for (int r = 0; r < 16; r++) { s0[r] = exp2f(s0[r] - m); ps += s0[r]; }
      l += ps;
      const u16* vp = Vc + l31 * ST + koff + lh * 8;
#pragma unroll
      for (int sp = 0; sp < 2; sp++) {
        u32x4 pw;
        pw[0] = pk2(s0[8 * sp + 0], s0[8 * sp + 1]); pw[1] = pk2(s0[8 * sp + 2], s0[8 * sp + 3]);
        pw[2] = pk2(s0[8 * sp + 4], s0[8 * sp + 5]); pw[3] = pk2(s0[8 * sp + 6], s0[8 * sp + 7]);
        const bf16x8 pf = __builtin_bit_cast(bf16x8, pw);
#pragma unroll
        for (int d = 0; d < 2; d++) o[d] = MFMA32(*(const bf16x8*)(vp + d * 32 * ST + sp * 16), pf, o[d]);
      }
    }
    if (tl + 1 < ntile) {
#pragma unroll
      for (int i = 0; i < 2; i++) {
        *(u32x4*)(Kt + (buf ^ 1) * 64 * ST + (srow + 32 * i) * ST + scc) = ra[i];
        *(u32x4*)(Vt + (buf ^ 1) * 64 * ST + (srow + 32 * i) * ST + scc) = rv[i];
      }
    }
    __syncthreads();
  }
  l += __shfl_xor(l, 32);
  const float inv = 1.f / l;
  const u16* szrow = p.SZ + (size_t)t * 1024 + h * 64;
  u16* orow = p.NAO + (size_t)t * 1024 + h * 64;
#pragma unroll
  for (int d = 0; d < 2; d++)
#pragma unroll
    for (int g = 0; g < 4; g++) {
      const int d0 = d * 32 + 8 * g + 4 * lh;
      const uint2 z = *(const uint2*)(szrow + d0);
      uint2 v;
      v.x = pk2(o[d][4 * g] * inv * bf2f((u16)(z.x & 0xffff)), o[d][4 * g + 1] * inv * bf2f((u16)(z.x >> 16)));
      v.y = pk2(o[d][4 * g + 2] * inv * bf2f((u16)(z.y & 0xffff)), o[d][4 * g + 3] * inv * bf2f((u16)(z.y >> 16)));
      *(uint2*)(orow + d0) = v;
    }
}

DI void ph_prep(const Params& p, char* smem) {
  const int tid = threadIdx.x;
  const int ntr = p.nmat_tiles;
  const int ntot = ntr + 192;
  for (int tile = blockIdx.x; tile < ntot; tile += gridDim.x) {
    __syncthreads();
    if (tile < ntr) {
      int mi = 0;
      for (int i = 1; i < 18; i++) if (tile >= p.mats[i].tile0) mi = i;
      const float* src = p.mats[mi].src; u16* dst = p.mats[mi].dst;
      const int K = p.mats[mi].K, Nsrc = p.mats[mi].Nsrc, Ndst = p.mats[mi].Ndst;
      const int lt = tile - p.mats[mi].tile0;
      const int ntn = Ndst >> 6;
      const int kt = lt / ntn, nt = lt - kt * ntn;
      float* ts = (float*)smem;
#pragma unroll
      for (int i = 0; i < 4; i++) {
        const int k = i * 16 + (tid >> 4), n4 = (tid & 15) * 4, n = nt * 64 + n4;
        float4 v = {0.f, 0.f, 0.f, 0.f};
        if (n < Nsrc) v = *(const float4*)(src + (size_t)(kt * 64 + k) * Nsrc + n);
        ts[k * 65 + n4] = v.x; ts[k * 65 + n4 + 1] = v.y; ts[k * 65 + n4 + 2] = v.z; ts[k * 65 + n4 + 3] = v.w;
      }
      __syncthreads();
      const int n = tid >> 2, kc = (tid & 3) * 16;
      uint32_t w[8];
#pragma unroll
      for (int e = 0; e < 8; e++) w[e] = pk2(ts[(kc + 2 * e) * 65 + n], ts[(kc + 2 * e + 1) * 65 + n]);
      u16* dp = dst + (size_t)(nt * 64 + n) * K + kt * 64 + kc;
      uint4 v0; v0.x = w[0]; v0.y = w[1]; v0.z = w[2]; v0.w = w[3];
      uint4 v1; v1.x = w[4]; v1.y = w[5]; v1.z = w[6]; v1.w = w[7];
      *(uint4*)dp = v0; *(uint4*)(dp + 8) = v1;
    } else {
      const int at = tile - ntr;
      const int layer = at / 48, c0 = (at - layer * 48) * 64;
      float* sc = (float*)smem;
      float* red = sc + 5 * 1024;
      for (int i = tid; i < 5 * 1024; i += 256) {
        const int n = i >> 10, k = i & 1023;
        const float v = (n == 0) ? p.c_ctx[k] : p.c[(n - 1) * 1024 + k];
        sc[i] = silu(v);
      }
      __syncthreads();
      const int c4 = (tid & 15) * 4, kg = tid >> 4;
      float acc[5][4];
#pragma unroll
      for (int n = 0; n < 5; n++) { acc[n][0] = 0.f; acc[n][1] = 0.f; acc[n][2] = 0.f; acc[n][3] = 0.f; }
      const float* w = p.ada_w + (size_t)layer * 1024 * 3072 + c0 + c4;
#pragma unroll 4
      for (int kk = 0; kk < 64; kk++) {
        const int k = kg * 64 + kk;
        const float4 wv = *(const float4*)(w + (size_t)k * 3072);
#pragma unroll
        for (int n = 0; n < 5; n++) {
          const float s = sc[n * 1024 + k];
          acc[n][0] += s * wv.x; acc[n][1] += s * wv.y; acc[n][2] += s * wv.z; acc[n][3] += s * wv.w;
        }
      }
#pragma unroll
      for (int n = 0; n < 5; n++) {
        float4 r; r.x = acc[n][0]; r.y = acc[n][1]; r.z = acc[n][2]; r.w = acc[n][3];
        *(float4*)(red + (kg * 5 + n) * 64 + c4) = r;
      }
      __syncthreads();
      for (int o = tid; o < 320; o += 256) {
        const int n = o >> 6, cc = o & 63;
        float s = 0.f;
#pragma unroll
        for (int g = 0; g < 16; g++) s += red[(g * 5 + n) * 64 + cc];
        s += p.ada_b[layer * 3072 + c0 + cc];
        p.mod[(layer * 5 + n) * 3072 + c0 + cc] = s;
      }
    }
  }
}

DI void ph_h0(const Params& p) {
  for (int idx = blockIdx.x * 256 + threadIdx.x; idx < T * 128; idx += gridDim.x * 256) {
    const int t = idx >> 7, c0 = (idx & 127) * 8;
    const float* xr = (t < TC) ? p.x_prompt + (size_t)t * 1024 : p.x_sample + (size_t)(t - TC) * 1024;
    const float* md = p.mod + cond_of(t) * 3072;
    const float4 x0 = *(const float4*)(xr + c0), x1 = *(const float4*)(xr + c0 + 4);
    const float4 sh0 = *(const float4*)(md + c0), sh1 = *(const float4*)(md + c0 + 4);
    const float4 sc0 = *(const float4*)(md + 1024 + c0), sc1 = *(const float4*)(md + 1024 + c0 + 4);
    uint4 v;
    v.x = pk2(x0.x * (1.f + sc0.x) + sh0.x, x0.y * (1.f + sc0.y) + sh0.y);
    v.y = pk2(x0.z * (1.f + sc0.z) + sh0.z, x0.w * (1.f + sc0.w) + sh0.w);
    v.z = pk2(x1.x * (1.f + sc1.x) + sh1.x, x1.y * (1.f + sc1.y) + sh1.y);
    v.w = pk2(x1.z * (1.f + sc1.z) + sh1.z, x1.w * (1.f + sc1.w) + sh1.w);
    *(uint4*)(p.H + (size_t)t * 1024 + c0) = v;
  }
}

template <class Epi>
DI void gemm_phase(const u16* A, int lda, const u16* Bt, int ldb, int K, int MT, int NT, char* smem, const Epi& epi) {
  const int ntile = MT * NT;
  for (int tile = blockIdx.x; tile < ntile; tile += gridDim.x) {
    const int nt = tile / MT, mt = tile - nt * MT;
    gemm_tile<3>(A, lda, Bt, ldb, K, mt * 192, nt * 128, 0, smem, epi);
  }
}

DI void unpack8(const u32x4& u, float* f) {
  f[0] = __uint_as_float(u[0] << 16); f[1] = __uint_as_float(u[0] & 0xffff0000u);
  f[2] = __uint_as_float(u[1] << 16); f[3] = __uint_as_float(u[1] & 0xffff0000u);
  f[4] = __uint_as_float(u[2] << 16); f[5] = __uint_as_float(u[2] & 0xffff0000u);
  f[6] = __uint_as_float(u[3] << 16); f[7] = __uint_as_float(u[3] & 0xffff0000u);
}
template <int HW>
DI void mix_item(const Params& p, int rpair) {
  const int lane = threadIdx.x & 63;
  constexpr int g = (HW == 1) ? 0 : (HW == 2) ? 1 : (HW == 4) ? 2 : 3;
  constexpr int NR = 8 + 2 * HW;
  const int c0 = (g * 32 + (lane & 31)) * 8;
  const int t0 = (rpair * 2 + (lane >> 5)) * 8;
  int s0, L, tt0;
  if (t0 < TC) { s0 = t0 & ~255; tt0 = t0 & 255; L = 256; } else { s0 = TC + ((t0 - TC) & ~2047); tt0 = (t0 - TC) & 2047; L = 2048; }
  u32x4 rows[NR];
#pragma unroll
  for (int r = 0; r < NR; r++) {
    const int tt = tt0 - HW + r;
    u32x4 v = {0u, 0u, 0u, 0u};
    if (tt >= 0 && tt < L) v = *(const u32x4*)(p.U + (size_t)(s0 + tt) * 1024 + c0);
    rows[r] = v;
  }
  float sum[8];
#pragma unroll
  for (int k = 0; k < 8; k++) sum[k] = 0.f;
#pragma unroll
  for (int r = 0; r < 2 * HW; r++) {
    float f[8]; unpack8(rows[r], f);
#pragma unroll
    for (int k = 0; k < 8; k++) sum[k] += f[k];
  }
#pragma unroll
  for (int e = 0; e < 8; e++) {
    const int tt = tt0 + e;
    const int lo = max(tt - HW, 0), hi = min(tt + HW, L);
    const float ic = 1.f / (float)(hi - lo);
    float own[8]; unpack8(rows[e + HW], own);
    u32x4 v;
    v[0] = pk2(sum[0] * ic - own[0], sum[1] * ic - own[1]);
    v[1] = pk2(sum[2] * ic - own[2], sum[3] * ic - own[3]);
    v[2] = pk2(sum[4] * ic - own[4], sum[5] * ic - own[5]);
    v[3] = pk2(sum[6] * ic - own[6], sum[7] * ic - own[7]);
    *(u32x4*)(p.MIX + (size_t)(s0 + tt) * 1024 + c0) = v;
    if (e < 7) {
      float fo[8], fi[8]; unpack8(rows[e], fo); unpack8(rows[e + 2 * HW], fi);
#pragma unroll
      for (int k = 0; k < 8; k++) sum[k] += fi[k] - fo[k];
    }
  }
}
DI void ph_mix(const Params& p) {
  const int wid = threadIdx.x >> 6;
  for (int item = blockIdx.x * 4 + wid; item < 768 * 4; item += gridDim.x * 4) {
    const int rpair = item >> 2, g = item & 3;
    if (g == 0) mix_item<1>(p, rpair);
    else if (g == 1) mix_item<2>(p, rpair);
    else if (g == 2) mix_item<4>(p, rpair);
    else mix_item<8>(p, rpair);
  }
}

DI void ph_pool_g2(const Params& p, int j, char* smem) {
  EpiPoolG2 epi{p.PM, p.SZ, p.pool_scale + j * 1024};
  for (int tile = blockIdx.x; tile < 64 * 8; tile += gridDim.x) {
    const int gn = tile / 64, mt = tile - gn * 64;
    const int g = gn >> 1, ns = gn & 1;
    gemm_tile<3>(p.MIX + g * 256, 1024, p.Wgrp + (size_t)(j * 4 + g) * 65536, 256, 256, mt * 192, ns * 128, g * 256, smem, epi);
  }
}

DI void ph_ln(const Params& p, int layer) {
  const int lane = threadIdx.x & 63, wid = threadIdx.x >> 6;
  const float* g = p.ln_g + layer * 1024;
  const float* bb = p.ln_b + layer * 1024;
  for (int row = blockIdx.x * 4 + wid; row < T; row += gridDim.x * 4) {
    float* xr = p.out + (size_t)row * 1024;
    float4 v[4];
    float s = 0.f;
#pragma unroll
    for (int i = 0; i < 4; i++) { v[i] = *(const float4*)(xr + i * 256 + lane * 4); s += v[i].x + v[i].y + v[i].z + v[i].w; }
    const float mu = wave_sum(s) * (1.f / 1024.f);
    float q = 0.f;
#pragma unroll
    for (int i = 0; i < 4; i++) {
      v[i].x -= mu; v[i].y -= mu; v[i].z -= mu; v[i].w -= mu;
      q += v[i].x * v[i].x + v[i].y * v[i].y + v[i].z * v[i].z + v[i].w * v[i].w;
    }
    const float rstd = rsqrtf(wave_sum(q) * (1.f / 1024.f) + 1e-5f);
    const float* md = p.mod + ((layer + 1) * 5 + cond_of(row)) * 3072;
#pragma unroll
    for (int i = 0; i < 4; i++) {
      const int cc = i * 256 + lane * 4;
      const float4 gg = *(const float4*)(g + cc), be = *(const float4*)(bb + cc);
      float4 y;
      y.x = v[i].x * rstd * gg.x + be.x; y.y = v[i].y * rstd * gg.y + be.y;
      y.z = v[i].z * rstd * gg.z + be.z; y.w = v[i].w * rstd * gg.w + be.w;
      *(float4*)(xr + cc) = y;
      if (layer < 3) {
        const float4 sh = *(const float4*)(md + cc), sc = *(const float4*)(md + 1024 + cc);
        uint2 h;
        h.x = pk2(y.x * (1.f + sc.x) + sh.x, y.y * (1.f + sc.y) + sh.y);
        h.y = pk2(y.z * (1.f + sc.z) + sh.z, y.w * (1.f + sc.w) + sh.w);
        *(uint2*)(p.H + (size_t)row * 1024 + cc) = h;
      }
    }
  }
}

DI void ph_mla_norm(const Params& p) {
  const int lane = threadIdx.x & 63, wid = threadIdx.x >> 6;
  for (int row = blockIdx.x * 4 + wid; row < T + 1024; row += gridDim.x * 4) {
    if (row < T) {
      const float* rr = p.RAW + (size_t)row * 768;
      const float4 a0 = *(const float4*)(rr + lane * 8), a1 = *(const float4*)(rr + lane * 8 + 4);
      const float4 k0 = *(const float4*)(rr + 512 + lane * 4);
      float s1 = a0.x * a0.x + a0.y * a0.y + a0.z * a0.z + a0.w * a0.w + a1.x * a1.x + a1.y * a1.y + a1.z * a1.z + a1.w * a1.w;
      float s2 = k0.x * k0.x + k0.y * k0.y + k0.z * k0.z + k0.w * k0.w;
      const float r1 = rsqrtf(wave_sum(s1) * (1.f / 512.f) + 1e-6f);
      const float r2 = rsqrtf(wave_sum(s2) * (1.f / 256.f) + 1e-6f);
      const float4 g0 = *(const float4*)(p.mla_q_norm + lane * 8), g1 = *(const float4*)(p.mla_q_norm + lane * 8 + 4);
      uint4 v;
      v.x = pk2(a0.x * r1 * g0.x, a0.y * r1 * g0.y); v.y = pk2(a0.z * r1 * g0.z, a0.w * r1 * g0.w);
      v.z = pk2(a1.x * r1 * g1.x, a1.y * r1 * g1.y); v.w = pk2(a1.z * r1 * g1.z, a1.w * r1 * g1.w);
      *(uint4*)(p.CQN + (size_t)row * 512 + lane * 8) = v;
      const float4 kg = *(const float4*)(p.mla_kv_norm + lane * 4);
      float4 kn; kn.x = k0.x * r2 * kg.x; kn.y = k0.y * r2 * kg.y; kn.z = k0.z * r2 * kg.z; kn.w = k0.w * r2 * kg.w;
      uint2 kv; kv.x = pk2(kn.x, kn.y); kv.y = pk2(kn.z, kn.w);
      *(uint2*)(p.CKVN + (size_t)kvrow_of(row) * 256 + lane * 4) = kv;
      if (row < TC) *(float4*)(p.out + OUT_CKV + (size_t)row * 256 + lane * 4) = kn;
    } else {
      const int cr = row - T, b = cr >> 8, pp = cr & 255;
      const size_t kvr = (size_t)TC + b * 2304 + pp;
      const float4 k0 = *(const float4*)(p.cache_ckv + (size_t)cr * 256 + lane * 4);
      uint2 kv; kv.x = pk2(k0.x, k0.y); kv.y = pk2(k0.z, k0.w);
      *(uint2*)(p.CKVN + kvr * 256 + lane * 4) = kv;
      p.KR[kvr * 64 + lane] = f2bf(p.cache_kr[(size_t)cr * 64 + lane]);
    }
  }
}

DI void ph_mla_g2(const Params& p, char* smem) {
  EpiMlaQ eq{p.Q};
  EpiMlaKV ekv{p.KN, p.VT};
  const int n1 = 64 * 12, n2 = 104 * 16;
  for (int tile = blockIdx.x; tile < n1 + n2; tile += gridDim.x) {
    if (tile < n1) {
      const int nt = tile / 64, mt = tile - nt * 64;
      gemm_tile<3>(p.CQN, 512, p.Wuq, 512, 512, mt * 192, nt * 128, 0, smem, eq);
    } else {
      const int t2 = tile - n1;
      const int nt = t2 / 104, mt = t2 - nt * 104;
      gemm_tile<2>(p.CKVN, 256, p.Wukv, 256, 256, mt * 128, nt * 128, 0, smem, ekv);
    }
  }
}

DI void ph_mla_attn(const Params& p, char* smem) {
  const int wid = threadIdx.x >> 6, l31 = threadIdx.x & 31;
  for (int u = blockIdx.x; u < 768; u += gridDim.x) {
    int t0, kvrow0, nkeys, Lk, h; size_t vbase;
    if (u < 512) {
      const int xcd = u & 7, slot = u >> 3; const int pair = xcd * 4 + (slot >> 4); const int qb = slot & 15;
      const int b = pair >> 3; h = pair & 7;
      t0 = TC + b * 2048 + qb * 128 + wid * 32; kvrow0 = TC + b * 2304; nkeys = 2304; Lk = 2304;
      vbase = (size_t)16 * 8 * 128 * 256 + (size_t)b * (8 * 128 * 2304) + (size_t)h * 128 * 2304;
    } else {
      const int v = u - 512; const int b = v >> 4; h = (v >> 1) & 7; const int qb = v & 1;
      t0 = b * 256 + qb * 128 + wid * 32; kvrow0 = b * 256; nkeys = 256; Lk = 256;
      vbase = (size_t)b * (8 * 128 * 256) + (size_t)h * 128 * 256;
    }
    const int t = t0 + l31;
    attn_dense_block<8, 4, 4>(smem, p.Q + (size_t)t * 1536 + h * 192, p.KN + (size_t)kvrow0 * 1024 + h * 128, 1024,
                             p.KR + (size_t)kvrow0 * 64, p.VT + vbase, Lk, nkeys,
                             p.SZ + (size_t)t * 1024 + h * 128, p.AO + (size_t)t * 1024 + h * 128);
  }
}

DI void ph_na_g1(const Params& p, char* smem) {
  EpiNaG1 epi{p.NQ, p.NK, p.NVT, p.SZ, p.out + OUT_NAK, p.out + OUT_NAV};
  const int n1 = 64 * 32;
  for (int tile = blockIdx.x; tile < n1 + 64; tile += gridDim.x) {
    if (tile < n1) {
      const int nt = tile / 64, mt = tile - nt * 64;
      gemm_tile<3>(p.H, 1024, p.Wnin, 1024, 1024, mt * 192, nt * 128, 0, smem, epi);
    } else {
      const int ct = tile - n1;
      const int b = ct >> 4, p0 = (ct & 15) * 16;
      const int c4 = threadIdx.x * 4;
      const size_t kvb = (size_t)TC + b * 2304;
      u16* vtb = p.NVT + (size_t)16 * 1024 * 256 + (size_t)b * (1024 * 2304);
      float vv[4][16];
#pragma unroll
      for (int i = 0; i < 16; i++) {
        const size_t src = ((size_t)(b * 256 + p0 + i)) * 1024 + c4;
        const float4 k = *(const float4*)(p.cache_nak + src);
        uint2 kv; kv.x = pk2(k.x, k.y); kv.y = pk2(k.z, k.w);
        *(uint2*)(p.NK + (kvb + p0 + i) * 1024 + c4) = kv;
        const float4 v = *(const float4*)(p.cache_nav + src);
        vv[0][i] = v.x; vv[1][i] = v.y; vv[2][i] = v.z; vv[3][i] = v.w;
      }
#pragma unroll
      for (int e = 0; e < 4; e++) {
        uint4 w0, w1;
        w0.x = pk2(vv[e][0], vv[e][1]); w0.y = pk2(vv[e][2], vv[e][3]); w0.z = pk2(vv[e][4], vv[e][5]); w0.w = pk2(vv[e][6], vv[e][7]);
        w1.x = pk2(vv[e][8], vv[e][9]); w1.y = pk2(vv[e][10], vv[e][11]); w1.z = pk2(vv[e][12], vv[e][13]); w1.w = pk2(vv[e][14], vv[e][15]);
        u16* dp = vtb + (size_t)(c4 + e) * 2304 + p0;
        *(uint4*)dp = w0; *(uint4*)(dp + 8) = w1;
      }
    }
  }
}

DI void ph_na_attn(const Params& p, char* smem) {
  const int wid = threadIdx.x >> 6, l31 = threadIdx.x & 31;
  for (int u = blockIdx.x; u < 1024 + 512; u += gridDim.x) {
    if (u < 1024) {
      const int xcd = u & 7, slot = u >> 3;
      const int pair = xcd * 8 + (slot >> 4), rpair = slot & 15;
      attn_na_block(p, smem, pair >> 4, pair & 15, rpair);
    } else {
      const int v = u - 1024;
      const int b = v >> 5, h = (v >> 1) & 15, qb = v & 1;
      const int t = b * 256 + qb * 128 + wid * 32 + l31;
      attn_dense_block<4, 0, 2>(smem, p.NQ + (size_t)t * 1024 + h * 64, p.NK + (size_t)(b * 256) * 1024 + h * 64, 1024, nullptr,
                               p.NVT + (size_t)b * (1024 * 256) + (size_t)h * 64 * 256, 256, 256,
                               p.SZ + (size_t)t * 1024 + h * 64, p.NAO + (size_t)t * 1024 + h * 64);
    }
  }
}

template <int ph>
DI void run_phase(const Params& p, char* smem) {
  if constexpr (ph == 0) ph_prep(p, smem);
  else if constexpr (ph == 1) ph_h0(p);
  else if constexpr (ph == 2 || ph == 17) {
    constexpr int j = (ph == 2) ? 0 : 1;
    EpiPoolG1 e{p.U, p.SZ};
    gemm_phase(p.H, 1024, p.Wpin + (size_t)j * 2048 * 1024, 1024, 1024, 64, 16, smem, e);
  }
  else if constexpr (ph == 3 || ph == 18) ph_mix(p);
  else if constexpr (ph == 4 || ph == 19) ph_pool_g2(p, (ph == 4) ? 0 : 1, smem);
  else if constexpr (ph == 5) {
    EpiG3 e{p.x_prompt, p.x_sample, p.out, p.mod};
    gemm_phase(p.PM, 1024, p.Wpout, 1024, 1024, 64, 8, smem, e);
  }
  else if constexpr (ph == 20) {
    EpiG3 e{p.out, p.out + OUT_YS, p.out, p.mod + 3 * 5 * 3072};
    gemm_phase(p.PM, 1024, p.Wpout + (size_t)1024 * 1024, 1024, 1024, 64, 8, smem, e);
  }
  else if constexpr (ph == 6) ph_ln(p, 0);
  else if constexpr (ph == 21) ph_ln(p, 3);
  else if constexpr (ph == 7) {
    EpiMlaG1 e{p.RAW, p.KR, p.SZ, p.out + OUT_KR};
    gemm_phase(p.H, 1024, p.Wmin, 1024, 1024, 64, 15, smem, e);
  }
  else if constexpr (ph == 8) ph_mla_norm(p);
  else if constexpr (ph == 9) ph_mla_g2(p, smem);
  else if constexpr (ph == 10) ph_mla_attn(p, smem);
  else if constexpr (ph == 11) {
    EpiG3 e{p.out, p.out + OUT_YS, p.out, p.mod + 1 * 5 * 3072};
    gemm_phase(p.AO, 1024, p.Wmout, 1024, 1024, 64, 8, smem, e);
  }
  else if constexpr (ph == 12) ph_ln(p, 1);
  else if constexpr (ph == 13) ph_na_g1(p, smem);
  else if constexpr (ph == 14) ph_na_attn(p, smem);
  else if constexpr (ph == 15) {
    EpiG3 e{p.out, p.out + OUT_YS, p.out, p.mod + 2 * 5 * 3072};
    gemm_phase(p.NAO, 1024, p.Wnout, 1024, 1024, 64, 8, smem, e);
  }
  else if constexpr (ph == 16) ph_ln(p, 2);
}

#define RUN_PH(n) if (ph_lo <= (n) && (n) < ph_hi) { run_phase<n>(p, smem); if ((n) + 1 < ph_hi) xcd_barrier(xb); }

__global__ void __launch_bounds__(256, 2) mega(Params p, int ph_lo, int ph_hi) {
  __shared__ __attribute__((aligned(16))) char smem[SMEM_BYTES];
  if (ph_lo < 0) { cg::this_grid().sync(); return; }
  const bool multi = (ph_hi - ph_lo) > 1;
  XcdBarrier xb; xb.bar = p.bar; xb.x = 0; xb.nloc = 0u; xb.nx = 0u;
  if (multi) xb = xcd_barrier_post(p.bar);
  RUN_PH(0) RUN_PH(1) RUN_PH(2) RUN_PH(3) RUN_PH(4) RUN_PH(5) RUN_PH(6) RUN_PH(7) RUN_PH(8) RUN_PH(9) RUN_PH(10)
  RUN_PH(11) RUN_PH(12) RUN_PH(13) RUN_PH(14) RUN_PH(15) RUN_PH(16) RUN_PH(17) RUN_PH(18) RUN_PH(19) RUN_PH(20) RUN_PH(21)
}

extern "C" void kernel_launch(void* const* d_in, const int* in_sizes, int n_in, void* d_out, int out_size, void* d_ws, size_t ws_size,
                              hipStream_t stream) {
  Params p;
  memset(&p, 0, sizeof(p));
  const float* const* in = (const float* const*)d_in;
  p.x_prompt = in[0]; p.x_sample = in[1]; p.cache_ckv = in[2]; p.cache_kr = in[3]; p.cache_nak = in[4]; p.cache_nav = in[5];
  p.c = in[6]; p.c_ctx = in[7]; p.ada_w = in[8]; p.ada_b = in[9]; p.ln_g = in[10]; p.ln_b = in[11];
  const float* pool_w_in = in[12]; const float* pool_w_grp = in[13]; p.pool_scale = in[14]; const float* pool_w_out = in[15];
  const float* mla_w_in = in[16]; p.mla_q_norm = in[17]; const float* mla_w_uq = in[18]; p.mla_kv_norm = in[19];
  const float* mla_w_ukv = in[20]; const float* mla_w_out = in[21]; const float* na_w_in = in[22]; p.na_rpb = in[23];
  const float* na_w_out = in[24];
  p.out = (float*)d_out;

  char* ws = (char*)d_ws;
  size_t off = 0;
  auto take = [&](size_t bytes) { char* r = ws + off; off += (bytes + 255) & ~(size_t)255; return r; };
  p.bar = (unsigned*)take(XCD_BAR_WORDS * 4);
  p.mod = (float*)take((size_t)4 * 5 * 3072 * 4);
  p.Wpin = (u16*)take((size_t)2 * 2048 * 1024 * 2);
  p.Wgrp = (u16*)take((size_t)8 * 65536 * 2);
  p.Wpout = (u16*)take((size_t)2 * 1024 * 1024 * 2);
  p.Wmin = (u16*)take((size_t)1920 * 1024 * 2);
  p.Wuq = (u16*)take((size_t)1536 * 512 * 2);
  p.Wukv = (u16*)take((size_t)2048 * 256 * 2);
  p.Wmout = (u16*)take((size_t)1024 * 1024 * 2);
  p.Wnin = (u16*)take((size_t)4096 * 1024 * 2);
  p.Wnout = (u16*)take((size_t)1024 * 1024 * 2);
  p.H = (u16*)take((size_t)T * 1024 * 2);
  p.SZ = (u16*)take((size_t)T * 1024 * 2);
  const size_t arena0 = off;
  p.U = (u16*)take((size_t)T * 1024 * 2);
  p.MIX = (u16*)take((size_t)T * 1024 * 2);
  p.PM = (u16*)take((size_t)T * 1024 * 2);
  off = arena0;
  p.RAW = (float*)take((size_t)T * 768 * 4);
  p.AO = (u16*)p.RAW;
  p.CQN = (u16*)take((size_t)T * 512 * 2);
  p.CKVN = (u16*)take((size_t)KVR * 256 * 2);
  p.KR = (u16*)take((size_t)KVR * 64 * 2);
  p.Q = (u16*)take((size_t)T * 1536 * 2);
  p.KN = (u16*)take((size_t)KVR * 1024 * 2);
  p.VT = (u16*)take((size_t)KVR * 1024 * 2);
  off = arena0;
  p.NQ = (u16*)take((size_t)T * 1024 * 2);
  p.NK = (u16*)take((size_t)KVR * 1024 * 2);
  p.NVT = (u16*)take((size_t)KVR * 1024 * 2);
  p.NAO = (u16*)take((size_t)T * 1024 * 2);

  int nm = 0, tiles = 0;
  auto add = [&](const float* src, u16* dst, int K, int Nsrc, int Ndst) {
    p.mats[nm].src = src; p.mats[nm].dst = dst; p.mats[nm].K = K; p.mats[nm].Nsrc = Nsrc; p.mats[nm].Ndst = Ndst; p.mats[nm].tile0 = tiles;
    tiles += (K / 64) * (Ndst / 64); nm++;
  };
  for (int j = 0; j < 2; j++) add(pool_w_in + (size_t)j * 1024 * 2048, p.Wpin + (size_t)j * 2048 * 1024, 1024, 2048, 2048);
  for (int j = 0; j < 8; j++) add(pool_w_grp + (size_t)j * 65536, p.Wgrp + (size_t)j * 65536, 256, 256, 256);
  for (int j = 0; j < 2; j++) add(pool_w_out + (size_t)j * 1024 * 1024, p.Wpout + (size_t)j * 1024 * 1024, 1024, 1024, 1024);
  add(mla_w_in, p.Wmin, 1024, 1856, 1920);
  add(mla_w_uq, p.Wuq, 512, 1536, 1536);
  add(mla_w_ukv, p.Wukv, 256, 2048, 2048);
  add(mla_w_out, p.Wmout, 1024, 1024, 1024);
  add(na_w_in, p.Wnin, 1024, 4096, 4096);
  add(na_w_out, p.Wnout, 1024, 1024, 1024);
  p.nmat_tiles = tiles;

  (void)hipMemsetAsync(p.bar, 0, XCD_BAR_WORDS * 4, stream);
#if MULTI_LAUNCH
  for (int ph = 0; ph < NPHASE; ph++) hipLaunchKernelGGL(mega, dim3(512), dim3(256), 0, stream, p, ph, ph + 1);
#else
  static int grid_blocks = 0;
  if (!grid_blocks) {
    int dev = 0, cus = 0, per_cu = 0;
    hipGetDevice(&dev);
    hipDeviceGetAttribute(&cus, hipDeviceAttributeMultiprocessorCount, dev);
    hipOccupancyMaxActiveBlocksPerMultiprocessor(&per_cu, mega, 256, 0);
    if (per_cu > 2) per_cu = 2;
    if (per_cu < 1) per_cu = 1;
    grid_blocks = cus * per_cu;
  }
  int lo = 0, hi = NPHASE;
  void* args[] = {&p, &lo, &hi};
  hipError_t e = hipLaunchCooperativeKernel((void*)mega, dim3(grid_blocks), dim3(256), args, 0, stream);
  if (e != hipSuccess) fprintf(stderr, "cooperative launch failed: %s (grid %d)\n", hipGetErrorString(e), grid_blocks);
#endif
}
```

```cpp
#include <hip/hip_runtime.h>
#include <hip/hip_cooperative_groups.h>
#include <stdint.h>
#include <string.h>
#include <stdio.h>
namespace cg = cooperative_groups;

#ifndef MULTI_LAUNCH
#define MULTI_LAUNCH 0
#endif

typedef __attribute__((ext_vector_type(8))) short bf16x8;
typedef __attribute__((ext_vector_type(4))) float f32x4;
typedef __attribute__((ext_vector_type(16))) float f32x16;
typedef __attribute__((ext_vector_type(4))) uint32_t u32x4;
typedef unsigned short u16;
#define DI __device__ __forceinline__
#define MFMA32(a, b, c) __builtin_amdgcn_mfma_f32_32x32x16_bf16((a), (b), (c), 0, 0, 0)
#define MFMA16(a, b, c) __builtin_amdgcn_mfma_f32_16x16x32_bf16((a), (b), (c), 0, 0, 0)

constexpr int TC = 4096, TL = 8192, T = 12288;
constexpr int KVR = 4096 + 4 * 2304;
constexpr float LOG2E = 1.4426950408889634f;
constexpr float ALPHA = 1.681792830507429f;
constexpr float MLA_QS = 0.07216878364870323f * LOG2E;
constexpr float NA_QS = 0.125f * LOG2E;
constexpr int SMEM_BYTES = 81920;
constexpr int NPHASE = 22;

constexpr size_t OUT_YS = 4194304, OUT_CKV = 12582912, OUT_KR = 13631488, OUT_NAK = 13893632, OUT_NAV = 18087936;

struct MatDesc { const float* src; u16* dst; int K, Nsrc, Ndst, tile0; };

struct Params {
  const float *x_prompt, *x_sample, *cache_ckv, *cache_kr, *cache_nak, *cache_nav, *c, *c_ctx, *ada_w, *ada_b, *ln_g, *ln_b;
  const float *pool_scale, *mla_q_norm, *mla_kv_norm, *na_rpb;
  float* out;
  float* mod;
  u16 *H, *SZ;
  u16 *Wpin, *Wgrp, *Wpout, *Wmin, *Wuq, *Wukv, *Wmout, *Wnin, *Wnout;
  u16 *U, *MIX, *PM;
  float* RAW; u16 *AO, *CQN, *CKVN, *KR, *Q, *KN, *VT;
  u16 *NQ, *NK, *NVT, *NAO;
  unsigned* bar;
  MatDesc mats[18];
  int nmat_tiles; int pad0;
};

DI float bf2f(u16 v) { return __uint_as_float(((uint32_t)v) << 16); }
typedef __attribute__((ext_vector_type(2))) float f32x2;
typedef __attribute__((ext_vector_type(2))) __bf16 bf16x2_t;
DI uint32_t pk2(float a, float b) { f32x2 v = {a, b}; return __builtin_bit_cast(uint32_t, __builtin_convertvector(v, bf16x2_t)); }
DI u16 f2bf(float x) { return (u16)(pk2(x, x) & 0xffffu); }
DI float silu(float v) { return v / (1.f + __expf(-v)); }
DI int cond_of(int t) { return t < TC ? 0 : 1 + ((t - TC) >> 11); }
DI int kvrow_of(int t) { return t < TC ? t : TC + ((t - TC) >> 11) * 2304 + 256 + ((t - TC) & 2047); }
DI int perm16(int key) { const int k = key & 15; return (key & ~15) | (k & 3) | ((k >> 1) & 4) | ((k << 1) & 8); }
DI float wave_sum(float v) {
#pragma unroll
  for (int o = 32; o >= 1; o >>= 1) v += __shfl_xor(v, o);
  return v;
}

#define XB_TMO      128
#define XB_XCNT(j)  (256  + 64 * (j))
#define XB_XSUB(j)  (1280 + 64 * (j))
#define XB_XGEN(j)  (2304 + 64 * (j))
#define XB_TOP      3328
#define XB_TOPGEN   3392
#define XCD_BAR_WORDS 3456
#define XB_SPIN_CAP (1u << 22)
#define LAS __attribute__((address_space(3)))
DI unsigned xb_ld(unsigned* p) { return __hip_atomic_load(p, __ATOMIC_RELAXED, __HIP_MEMORY_SCOPE_AGENT); }
DI unsigned xb_add(unsigned* p, unsigned v) { return __hip_atomic_fetch_add(p, v, __ATOMIC_RELAXED, __HIP_MEMORY_SCOPE_AGENT); }
DI unsigned xb_xcc_id() { return (unsigned)__builtin_amdgcn_s_getreg((3 << 11) | 20) & 0xFu; }
#define XB_SPIN(cond, bar) do { unsigned _sp = 0; while (cond) { __builtin_amdgcn_s_sleep(1); \
    if ((++_sp & 255u) == 0u) { if (xb_ld(&(bar)[XB_TMO])) break; if (_sp > XB_SPIN_CAP) { atomicAdd(&(bar)[XB_TMO], 1u); break; } } } } while (0)
struct XcdBarrier { unsigned* bar; unsigned x; unsigned nloc, nx; };
DI XcdBarrier xcd_barrier_post(unsigned* bar) {
  XcdBarrier b; b.bar = bar; b.x = xb_xcc_id(); b.nloc = 0u; b.nx = 0u;
  if (threadIdx.x == 0) (void)xb_add(&bar[XB_XCNT(b.x)], 1u);
  return b;
}
DI void xcd_barrier_complete(unsigned* bar, unsigned x, unsigned& nloc, unsigned& nx) {
  const unsigned G = gridDim.x * gridDim.y * gridDim.z;
  unsigned sum, cnt, mine, sp = 0u;
  for (;;) {
    sum = 0u; cnt = 0u; mine = 0u;
#pragma unroll
    for (unsigned j = 0; j < 16; ++j) { const unsigned c = xb_ld(&bar[XB_XCNT(j)]); sum += c; cnt += (c > 0u) ? 1u : 0u; mine = (j == x) ? c : mine; }
    if (sum == G) break;
    __builtin_amdgcn_s_sleep(1);
    if ((++sp & 255u) == 0u) { if (xb_ld(&bar[XB_TMO])) break; if (sp > XB_SPIN_CAP) { atomicAdd(&bar[XB_TMO], 1u); break; } }
  }
  nloc = mine > 0u ? mine : 1u; nx = cnt > 0u ? cnt : 1u;
}
DI void xcd_barrier(XcdBarrier& b) {
  asm volatile("s_waitcnt vmcnt(0)" ::: "memory");
  __syncthreads();
  unsigned nloc = b.nloc, nx = b.nx;
  if (threadIdx.x == 0) {
    unsigned* bar = b.bar;
    __builtin_amdgcn_s_waitcnt(0);
    if (nloc == 0u) { xcd_barrier_complete(bar, b.x, nloc, nx); }
    const unsigned old = xb_add(&bar[XB_XSUB(b.x)], 1u);
    const unsigned gen = old / nloc;
    if (old + 1u == (gen + 1u) * nloc) {
      __builtin_amdgcn_fence(__ATOMIC_RELEASE, "agent");
      asm volatile("s_waitcnt vmcnt(0)" ::: "memory");
      const unsigned og = xb_add(&bar[XB_TOP], 1u);
      const unsigned tg = og / nx;
      if (og + 1u == (tg + 1u) * nx) xb_add(&bar[XB_TOPGEN], 1u);
      else XB_SPIN(xb_ld(&bar[XB_TOPGEN]) == tg, bar);
      __builtin_amdgcn_fence(__ATOMIC_ACQUIRE, "agent");
      xb_add(&bar[XB_XGEN(b.x)], 1u);
      asm volatile("s_waitcnt vmcnt(0)" ::: "memory");
    } else {
      XB_SPIN(xb_ld(&bar[XB_XGEN(b.x)]) == gen, bar);
      __builtin_amdgcn_fence(__ATOMIC_ACQUIRE, "agent");
      asm volatile("s_waitcnt vmcnt(0)" ::: "memory");
    }
  }
  if (threadIdx.x < 64) { b.nloc = __builtin_amdgcn_readfirstlane(nloc); b.nx = __builtin_amdgcn_readfirstlane(nx); }
  __syncthreads();
}

template <int MI, class Epi>
DI void gemm_tile(const u16* __restrict__ A, int lda, const u16* __restrict__ Bt, int ldb, int K, int m0, int n0, int nout_off,
                  char* smem, const Epi& epi) {
  constexpr int BM = 64 * MI, ASTG = BM * 128;
  const int tid = threadIdx.x, lane = tid & 63, wid = tid >> 6;
  const int wm = wid >> 1, wn = wid & 1, l31 = lane & 31, lh = lane >> 5;
  char* As = smem;
  char* Bs = smem + 2 * ASTG;
  const int srow = tid >> 3;
  const int scc = ((tid & 7) ^ ((tid >> 4) & 7)) * 8;
  const u16* ag = A + (size_t)(m0 + srow) * lda + scc;
  const u16* bg = Bt + (size_t)(n0 + srow) * ldb + scc;
  LAS char* awr = (LAS char*)(As + wid * 1024);
  LAS char* bwr = (LAS char*)(Bs + wid * 1024);
  f32x16 acc[MI][2];
#pragma unroll
  for (int i = 0; i < MI; i++)
#pragma unroll
    for (int j = 0; j < 2; j++)
#pragma unroll
      for (int r = 0; r < 16; r++) acc[i][j][r] = 0.f;
  __syncthreads();
#pragma unroll
  for (int i = 0; i < 2 * MI; i++)
    __builtin_amdgcn_global_load_lds((const void*)(ag + (size_t)(32 * i) * lda), (LAS void*)(awr + i * 4096), 16, 0, 0);
#pragma unroll
  for (int i = 0; i < 4; i++)
    __builtin_amdgcn_global_load_lds((const void*)(bg + (size_t)(32 * i) * ldb), (LAS void*)(bwr + i * 4096), 16, 0, 0);
  asm volatile("s_waitcnt vmcnt(0)" ::: "memory");
  __syncthreads();
  const int nk = K >> 6;
  const int sw = (l31 >> 1) & 7;
  for (int kt = 0; kt < nk; kt++) {
    const int buf = kt & 1;
    if (kt + 1 < nk) {
#pragma unroll
      for (int i = 0; i < 2 * MI; i++)
        __builtin_amdgcn_global_load_lds((const void*)(ag + (size_t)(32 * i) * lda + (kt + 1) * 64), (LAS void*)(awr + (buf ^ 1) * ASTG + i * 4096), 16, 0, 0);
#pragma unroll
      for (int i = 0; i < 4; i++)
        __builtin_amdgcn_global_load_lds((const void*)(bg + (size_t)(32 * i) * ldb + (kt + 1) * 64), (LAS void*)(bwr + (buf ^ 1) * 16384 + i * 4096), 16, 0, 0);
    }
    const char* as = As + buf * ASTG + (wm * (32 * MI) + l31) * 128;
    const char* bs = Bs + buf * 16384 + (wn * 64 + l31) * 128;
#pragma unroll
    for (int ks = 0; ks < 4; ks++) {
      const int co = ((2 * ks + lh) ^ sw) << 4;
      const bf16x8 b0 = *(const bf16x8*)(bs + co);
      const bf16x8 b1 = *(const bf16x8*)(bs + 32 * 128 + co);
#pragma unroll
      for (int i = 0; i < MI; i++) {
        const bf16x8 a = *(const bf16x8*)(as + i * 32 * 128 + co);
        acc[i][0] = MFMA32(b0, a, acc[i][0]);
        acc[i][1] = MFMA32(b1, a, acc[i][1]);
      }
    }
    asm volatile("s_waitcnt vmcnt(0)" ::: "memory");
    __syncthreads();
  }
#pragma unroll
  for (int i = 0; i < MI; i++)
#pragma unroll
    for (int j = 0; j < 2; j++)
      epi(m0 + wm * (32 * MI) + i * 32 + l31, nout_off + n0 + wn * 64 + j * 32, lh, acc[i][j]);
}

DI void rope_pair(float x1, float x2, int i, float pos, float& o1, float& o2) {
  const float inv = exp2f(-(float)i * (13.287712379549449f / 16.f));
  const float ang = pos * inv;
  const float c = __cosf(ang), s = __sinf(ang);
  o1 = x1 * c - x2 * s;
  o2 = x1 * s + x2 * c;
}

struct EpiPoolG1 {
  u16 *U, *SZ;
  DI void operator()(int m, int nb, int lh, const f32x16& a) const {
#pragma unroll
    for (int g = 0; g < 4; g++) {
      const int n = nb + 8 * g + 4 * lh;
      if (nb < 1024) {
        uint2 v; v.x = pk2(a[4 * g], a[4 * g + 1]); v.y = pk2(a[4 * g + 2], a[4 * g + 3]);
        *(uint2*)(U + (size_t)m * 1024 + n) = v;
      } else {
        uint2 v; v.x = pk2(silu(a[4 * g]), silu(a[4 * g + 1])); v.y = pk2(silu(a[4 * g + 2]), silu(a[4 * g + 3]));
        *(uint2*)(SZ + (size_t)m * 1024 + n - 1024) = v;
      }
    }
  }
};
struct EpiPoolG2 {
  u16* PM; const u16* SZ; const float* scale;
  DI void operator()(int m, int nb, int lh, const f32x16& a) const {
#pragma unroll
    for (int g = 0; g < 4; g++) {
      const int n = nb + 8 * g + 4 * lh;
      const uint2 z = *(const uint2*)(SZ + (size_t)m * 1024 + n);
      const float4 sc = *(const float4*)(scale + n);
      uint2 v;
      v.x = pk2(a[4 * g] * sc.x * bf2f((u16)(z.x & 0xffff)), a[4 * g + 1] * sc.y * bf2f((u16)(z.x >> 16)));
      v.y = pk2(a[4 * g + 2] * sc.z * bf2f((u16)(z.y & 0xffff)), a[4 * g + 3] * sc.w * bf2f((u16)(z.y >> 16)));
      *(uint2*)(PM + (size_t)m * 1024 + n) = v;
    }
  }
};
struct EpiG3 {
  const float *xp, *xs;
  float* out; const float* mod_layer;
  DI void operator()(int m, int nb, int lh, const f32x16& a) const {
    const float* xr = (m < TC) ? xp + (size_t)m * 1024 : xs + (size_t)(m - TC) * 1024;
    const float* gate = mod_layer + cond_of(m) * 3072 + 2048;
#pragma unroll
    for (int g = 0; g < 4; g++) {
      const int n = nb + 8 * g + 4 * lh;
      const float4 x = *(const float4*)(xr + n);
      const float4 gt = *(const float4*)(gate + n);
      float4 r;
      r.x = ALPHA * x.x + gt.x * a[4 * g]; r.y = ALPHA * x.y + gt.y * a[4 * g + 1];
      r.z = ALPHA * x.z + gt.z * a[4 * g + 2]; r.w = ALPHA * x.w + gt.w * a[4 * g + 3];
      *(float4*)(out + (size_t)m * 1024 + n) = r;
    }
  }
};
struct EpiMlaG1 {
  float* RAW; u16* KR; u16* SZ; float* st_kr;
  DI void operator()(int m, int nb, int lh, const f32x16& a) const {
    if (nb >= 1856) return;
    if (nb < 768) {
#pragma unroll
      for (int g = 0; g < 4; g++) {
        const int n = nb + 8 * g + 4 * lh;
        float4 r; r.x = a[4 * g]; r.y = a[4 * g + 1]; r.z = a[4 * g + 2]; r.w = a[4 * g + 3];
        *(float4*)(RAW + (size_t)m * 768 + n) = r;
      }
    } else if (nb < 832) {
      const int off = nb - 768;
      const bool lat = m >= TC;
      const int tt = (m - TC) & 2047;
      const float pos = (off == 0) ? (float)(tt >> 6) : (float)(tt & 63);
      const size_t kr = (size_t)kvrow_of(m) * 64 + off;
#pragma unroll
      for (int g = 0; g < 2; g++) {
        float o1[4], o2[4];
#pragma unroll
        for (int e = 0; e < 4; e++) {
          const int i = 8 * g + 4 * lh + e;
          const float x1 = a[4 * g + e], x2 = a[4 * (g + 2) + e];
          if (lat) rope_pair(x1, x2, i, pos, o1[e], o2[e]); else { o1[e] = x1; o2[e] = x2; }
        }
        const int i0 = 8 * g + 4 * lh;
        if (!lat) {
          float4 r1; r1.x = o1[0]; r1.y = o1[1]; r1.z = o1[2]; r1.w = o1[3];
          float4 r2; r2.x = o2[0]; r2.y = o2[1]; r2.z = o2[2]; r2.w = o2[3];
          *(float4*)(st_kr + (size_t)m * 64 + off + i0) = r1;
          *(float4*)(st_kr + (size_t)m * 64 + off + i0 + 16) = r2;
        }
        uint2 v1; v1.x = pk2(o1[0], o1[1]); v1.y = pk2(o1[2], o1[3]);
        uint2 v2; v2.x = pk2(o2[0], o2[1]); v2.y = pk2(o2[2], o2[3]);
        *(uint2*)(KR + kr + i0) = v1;
        *(uint2*)(KR + kr + i0 + 16) = v2;
      }
    } else {
#pragma unroll
      for (int g = 0; g < 4; g++) {
        const int n = nb + 8 * g + 4 * lh - 832;
        uint2 v; v.x = pk2(silu(a[4 * g]), silu(a[4 * g + 1])); v.y = pk2(silu(a[4 * g + 2]), silu(a[4 * g + 3]));
        *(uint2*)(SZ + (size_t)m * 1024 + n) = v;
      }
    }
  }
};
struct EpiMlaQ {
  u16* Q;
  DI void operator()(int m, int nb, int lh, const f32x16& a) const {
    const int head = nb / 192, off = nb - head * 192;
    u16* qr = Q + (size_t)m * 1536 + nb;
    if (off < 128) {
#pragma unroll
      for (int g = 0; g < 4; g++) {
        uint2 v; v.x = pk2(a[4 * g] * MLA_QS, a[4 * g + 1] * MLA_QS); v.y = pk2(a[4 * g + 2] * MLA_QS, a[4 * g + 3] * MLA_QS);
        *(uint2*)(qr + 8 * g + 4 * lh) = v;
      }
    } else {
      const bool lat = m >= TC;
      const int tt = (m - TC) & 2047;
      const float pos = (off == 128) ? (float)(tt >> 6) : (float)(tt & 63);
#pragma unroll
      for (int g = 0; g < 2; g++) {
        float o1[4], o2[4];
#pragma unroll
        for (int e = 0; e < 4; e++) {
          const int i = 8 * g + 4 * lh + e;
          const float x1 = a[4 * g + e], x2 = a[4 * (g + 2) + e];
          if (lat) rope_pair(x1, x2, i, pos, o1[e], o2[e]); else { o1[e] = x1; o2[e] = x2; }
        }
        const int i0 = 8 * g + 4 * lh;
        uint2 v1; v1.x = pk2(o1[0] * MLA_QS, o1[1] * MLA_QS); v1.y = pk2(o1[2] * MLA_QS, o1[3] * MLA_QS);
        uint2 v2; v2.x = pk2(o2[0] * MLA_QS, o2[1] * MLA_QS); v2.y = pk2(o2[2] * MLA_QS, o2[3] * MLA_QS);
        *(uint2*)(qr + i0) = v1;
        *(uint2*)(qr + i0 + 16) = v2;
      }
    }
  }
};
struct EpiMlaKV {
  u16 *KN, *VT;
  DI void operator()(int m, int nb, int lh, const f32x16& a) const {
    const int head = nb >> 8, off = nb & 255;
    if (off < 128) {
#pragma unroll
      for (int g = 0; g < 4; g++) {
        uint2 v; v.x = pk2(a[4 * g], a[4 * g + 1]); v.y = pk2(a[4 * g + 2], a[4 * g + 3]);
        *(uint2*)(KN + (size_t)m * 1024 + head * 128 + off + 8 * g + 4 * lh) = v;
      }
    } else {
      size_t base; int Lk, key;
      if (m < TC) { base = (size_t)(m >> 8) * (8 * 128 * 256); Lk = 256; key = m & 255; }
      else { const int r2 = m - TC; const int b = r2 / 2304; key = r2 - b * 2304; Lk = 2304; base = (size_t)16 * 8 * 128 * 256 + (size_t)b * (8 * 128 * 2304); }
      u16* vp = VT + base + (size_t)(head * 128 + off - 128) * Lk + perm16(key);
#pragma unroll
      for (int g = 0; g < 4; g++)
#pragma unroll
        for (int e = 0; e < 4; e++) vp[(size_t)(8 * g + 4 * lh + e) * Lk] = f2bf(a[4 * g + e]);
    }
  }
};
struct EpiNaG1 {
  u16 *NQ, *NK, *NVT, *SZ; float *st_k, *st_v;
  DI void operator()(int m, int nb, int lh, const f32x16& a) const {
    if (nb < 1024) {
#pragma unroll
      for (int g = 0; g < 4; g++) {
        uint2 v; v.x = pk2(a[4 * g] * NA_QS, a[4 * g + 1] * NA_QS); v.y = pk2(a[4 * g + 2] * NA_QS, a[4 * g + 3] * NA_QS);
        *(uint2*)(NQ + (size_t)m * 1024 + nb + 8 * g + 4 * lh) = v;
      }
    } else if (nb < 2048) {
      const size_t kr = (size_t)kvrow_of(m) * 1024 + (nb - 1024);
#pragma unroll
      for (int g = 0; g < 4; g++) {
        uint2 v; v.x = pk2(a[4 * g], a[4 * g + 1]); v.y = pk2(a[4 * g + 2], a[4 * g + 3]);
        *(uint2*)(NK + kr + 8 * g + 4 * lh) = v;
        if (m < TC) { float4 r; r.x = a[4 * g]; r.y = a[4 * g + 1]; r.z = a[4 * g + 2]; r.w = a[4 * g + 3];
          *(float4*)(st_k + (size_t)m * 1024 + (nb - 1024) + 8 * g + 4 * lh) = r; }
      }
    } else if (nb < 3072) {
      const int c0 = nb - 2048;
      size_t base; int Lk, key;
      if (m < TC) { base = (size_t)(m >> 8) * (1024 * 256); Lk = 256; key = perm16(m & 255); }
      else { const int b = (m - TC) >> 11; key = 256 + ((m - TC) & 2047); Lk = 2304; base = (size_t)16 * 1024 * 256 + (size_t)b * (1024 * 2304); }
      u16* vp = NVT + base + (size_t)c0 * Lk + key;
#pragma unroll
      for (int g = 0; g < 4; g++) {
#pragma unroll
        for (int e = 0; e < 4; e++) vp[(size_t)(8 * g + 4 * lh + e) * Lk] = f2bf(a[4 * g + e]);
        if (m < TC) { float4 r; r.x = a[4 * g]; r.y = a[4 * g + 1]; r.z = a[4 * g + 2]; r.w = a[4 * g + 3];
          *(float4*)(st_v + (size_t)m * 1024 + c0 + 8 * g + 4 * lh) = r; }
      }
    } else {
#pragma unroll
      for (int g = 0; g < 4; g++) {
        uint2 v; v.x = pk2(silu(a[4 * g]), silu(a[4 * g + 1])); v.y = pk2(silu(a[4 * g + 2]), silu(a[4 * g + 3]));
        *(uint2*)(SZ + (size_t)m * 1024 + (nb - 3072) + 8 * g + 4 * lh) = v;
      }
    }
  }
};

template <int NSA, int NSB, int NDT>
DI void attn_dense_wave(const u16* __restrict__ qrow, const u16* __restrict__ kA, int kAstride, const u16* __restrict__ kB,
                        const u16* __restrict__ vt, int Lk, int nkeys, const u16* __restrict__ szrow, u16* __restrict__ orow) {
  const int lane = threadIdx.x & 63, l31 = lane & 31, lh = lane >> 5;
  bf16x8 qf[NSA + NSB];
#pragma unroll
  for (int s = 0; s < NSA + NSB; s++) qf[s] = *(const bf16x8*)(qrow + s * 16 + lh * 8);
  f32x16 o[NDT];
#pragma unroll
  for (int d = 0; d < NDT; d++)
#pragma unroll
    for (int r = 0; r < 16; r++) o[d][r] = 0.f;
  float m = -1e30f, l = 0.f;
  for (int k0 = 0; k0 < nkeys; k0 += 32) {
    f32x16 sa;
#pragma unroll
    for (int r = 0; r < 16; r++) sa[r] = 0.f;
    const u16* kp = kA + (size_t)(k0 + l31) * kAstride + lh * 8;
#pragma unroll
    for (int s = 0; s < NSA; s++) sa = MFMA32(*(const bf16x8*)(kp + s * 16), qf[s], sa);
    if (NSB > 0) {
      const u16* kp2 = kB + (size_t)(k0 + l31) * 64 + lh * 8;
#pragma unroll
      for (int s = 0; s < NSB; s++) sa = MFMA32(*(const bf16x8*)(kp2 + s * 16), qf[NSA + s], sa);
    }
    float mx = sa[0];
#pragma unroll
    for (int r = 1; r < 16; r++) mx = fmaxf(mx, sa[r]);
    mx = fmaxf(mx, __shfl_xor(mx, 32));
    const float mn = fmaxf(m, mx);
    const float alpha = __builtin_amdgcn_exp2f(m - mn);
    m = mn;
    float ps = 0.f;
#pragma unroll
    for (int r = 0; r < 16; r++) { sa[r] = exp2f(sa[r] - mn); ps += sa[r]; }
    l = l * alpha + ps;
#pragma unroll
    for (int d = 0; d < NDT; d++)
#pragma unroll
      for (int r = 0; r < 16; r++) o[d][r] *= alpha;
#pragma unroll
    for (int sp = 0; sp < 2; sp++) {
      u32x4 pw;
      pw[0] = pk2(sa[8 * sp + 0], sa[8 * sp + 1]); pw[1] = pk2(sa[8 * sp + 2], sa[8 * sp + 3]);
      pw[2] = pk2(sa[8 * sp + 4], sa[8 * sp + 5]); pw[3] = pk2(sa[8 * sp + 6], sa[8 * sp + 7]);
      const bf16x8 pf = __builtin_bit_cast(bf16x8, pw);
#pragma unroll
      for (int d = 0; d < NDT; d++) {
        const u16* vp = vt + (size_t)(d * 32 + l31) * Lk + k0 + 16 * sp + 4 * lh;
        const uint2 lo = *(const uint2*)vp, hi = *(const uint2*)(vp + 8);
        u32x4 vw; vw[0] = lo.x; vw[1] = lo.y; vw[2] = hi.x; vw[3] = hi.y;
        o[d] = MFMA32(__builtin_bit_cast(bf16x8, vw), pf, o[d]);
      }
    }
  }
  l += __shfl_xor(l, 32);
  const float inv = 1.f / l;
#pragma unroll
  for (int d = 0; d < NDT; d++)
#pragma unroll
    for (int g = 0; g < 4; g++) {
      const int d0 = d * 32 + 8 * g + 4 * lh;
      const uint2 z = *(const uint2*)(szrow + d0);
      uint2 v;
      v.x = pk2(o[d][4 * g] * inv * bf2f((u16)(z.x & 0xffff)), o[d][4 * g + 1] * inv * bf2f((u16)(z.x >> 16)));
      v.y = pk2(o[d][4 * g + 2] * inv * bf2f((u16)(z.y & 0xffff)), o[d][4 * g + 3] * inv * bf2f((u16)(z.y >> 16)));
      *(uint2*)(orow + d0) = v;
    }
}


template <int NSA, int NSB, int NDT>
DI void attn_dense_block(char* smem, const u16* __restrict__ qrow, const u16* __restrict__ kA, int kAstride, const u16* __restrict__ kB,
                         const u16* __restrict__ vt, int Lk, int nkeys, const u16* __restrict__ szrow, u16* __restrict__ orow) {
  constexpr int NS = NSA + NSB, DV = 32 * NDT, CA = NSA * 2;
  constexpr int KN_B = 64 * CA * 16, KR_B = (NSB > 0) ? 64 * 128 : 0, V_B = DV * 128, STG = KN_B + KR_B + V_B;
  constexpr int NLA = 64 * CA / 256, NLB = (NSB > 0) ? 2 : 0, NLV = DV * 8 / 256;
  const int tid = threadIdx.x, lane = tid & 63, wid = tid >> 6, l31 = lane & 31, lh = lane >> 5;
  const int arow = (CA == 16) ? (tid >> 4) : (tid >> 3);
  const int acc_ = (CA == 16) ? ((tid & 15) ^ ((tid >> 4) & 15)) : ((tid & 7) ^ ((tid >> 4) & 7));
  const int brow = tid >> 3, bcc = (tid & 7) ^ ((tid >> 4) & 7);
  const u16* ka_src = kA + (size_t)arow * kAstride + acc_ * 8;
  const u16* kb_src = (NSB > 0) ? (kB + (size_t)brow * 64 + bcc * 8) : kA;
  const u16* v_src = vt + (size_t)brow * Lk + bcc * 8;
  LAS char* wbase = (LAS char*)(smem + wid * 1024);
  bf16x8 qf[NS];
#pragma unroll
  for (int s = 0; s < NS; s++) qf[s] = *(const bf16x8*)(qrow + s * 16 + lh * 8);
  f32x16 o[NDT];
#pragma unroll
  for (int d = 0; d < NDT; d++)
#pragma unroll
    for (int r = 0; r < 16; r++) o[d][r] = 0.f;
  float m = -1e30f, l = 0.f;
  const int swA = (CA == 16) ? (l31 & 15) : ((l31 >> 1) & 7);
  const int swB = (l31 >> 1) & 7;

  __syncthreads();
#pragma unroll
  for (int i = 0; i < NLA; i++)
    __builtin_amdgcn_global_load_lds((const void*)(ka_src + (size_t)(i * (256 / CA)) * kAstride), (LAS void*)(wbase + i * 4096), 16, 0, 0);
#pragma unroll
  for (int i = 0; i < NLB; i++)
    __builtin_amdgcn_global_load_lds((const void*)(kb_src + (size_t)(32 * i) * 64), (LAS void*)(wbase + KN_B + i * 4096), 16, 0, 0);
#pragma unroll
  for (int i = 0; i < NLV; i++)
    __builtin_amdgcn_global_load_lds((const void*)(v_src + (size_t)(32 * i) * Lk), (LAS void*)(wbase + KN_B + KR_B + i * 4096), 16, 0, 0);
  asm volatile("s_waitcnt vmcnt(0)" ::: "memory");
  __syncthreads();
  int st = 0;
  for (int k0 = 0; k0 < nkeys; k0 += 64, st ^= 1) {
    if (k0 + 64 < nkeys) {
      const int kn = k0 + 64;
      LAS char* wb = wbase + (st ^ 1) * STG;
#pragma unroll
      for (int i = 0; i < NLA; i++)
        __builtin_amdgcn_global_load_lds((const void*)(ka_src + (size_t)(kn + i * (256 / CA)) * kAstride), (LAS void*)(wb + i * 4096), 16, 0, 0);
#pragma unroll
      for (int i = 0; i < NLB; i++)
        __builtin_amdgcn_global_load_lds((const void*)(kb_src + (size_t)(kn + 32 * i) * 64), (LAS void*)(wb + KN_B + i * 4096), 16, 0, 0);
#pragma unroll
      for (int i = 0; i < NLV; i++)
        __builtin_amdgcn_global_load_lds((const void*)(v_src + (size_t)(32 * i) * Lk + kn), (LAS void*)(wb + KN_B + KR_B + i * 4096), 16, 0, 0);
    }
    const char* Kn = smem + st * STG;
    const char* Kr = Kn + KN_B;
    const char* Vs = Kr + KR_B;
#pragma unroll 1
    for (int hh = 0; hh < 2; hh++) {
      f32x16 s0;
#pragma unroll
      for (int r = 0; r < 16; r++) s0[r] = 0.f;
      const char* kpa = Kn + (hh * 32 + l31) * (CA * 16);
#pragma unroll
      for (int s = 0; s < NSA; s++) s0 = MFMA32(*(const bf16x8*)(kpa + (((2 * s + lh) ^ swA) << 4)), qf[s], s0);
      if constexpr (NSB > 0) {
        const char* kpb = Kr + (hh * 32 + l31) * 128;
#pragma unroll
        for (int s = 0; s < NSB; s++) s0 = MFMA32(*(const bf16x8*)(kpb + (((2 * s + lh) ^ swB) << 4)), qf[NSA + s], s0);
      }
      float mx = s0[0];
#pragma unroll
      for (int r = 1; r < 16; r++) mx = fmaxf(mx, s0[r]);
      mx = fmaxf(mx, __shfl_xor(mx, 32));
      if (__any(mx > m + 8.f)) {
        const float mn = fmaxf(m, mx);
        const float alpha = __builtin_amdgcn_exp2f(m - mn);
        m = mn;
        l *= alpha;
#pragma unroll
        for (int d = 0; d < NDT; d++)
#pragma unroll
          for (int r = 0; r < 16; r++) o[d][r] *= alpha;
      }
      float ps = 0.f;
#pragma unroll
      for (int r = 0; r < 16; r++) { s0[r] = __builtin_amdgcn_exp2f(s0[r] - m); ps += s0[r]; }
      l += ps;
      const char* vp = Vs + l31 * 128;
#pragma unroll
      for (int sp = 0; sp < 2; sp++) {
        u32x4 pw;
        pw[0] = pk2(s0[8 * sp + 0], s0[8 * sp + 1]); pw[1] = pk2(s0[8 * sp + 2], s0[8 * sp + 3]);
        pw[2] = pk2(s0[8 * sp + 4], s0[8 * sp + 5]); pw[3] = pk2(s0[8 * sp + 6], s0[8 * sp + 7]);
        const bf16x8 pf = __builtin_bit_cast(bf16x8, pw);
        const int vo = ((hh * 4 + sp * 2 + lh) ^ swB) << 4;
#pragma unroll
        for (int d = 0; d < NDT; d++) o[d] = MFMA32(*(const bf16x8*)(vp + d * 32 * 128 + vo), pf, o[d]);
      }
    }
    asm volatile("s_waitcnt vmcnt(0)" ::: "memory");
    __syncthreads();
  }
  l += __shfl_xor(l, 32);
  const float inv = 1.f / l;
#pragma unroll
  for (int d = 0; d < NDT; d++)
#pragma unroll
    for (int g = 0; g < 4; g++) {
      const int d0 = d * 32 + 8 * g + 4 * lh;
      const uint2 z = *(const uint2*)(szrow + d0);
      uint2 v;
      v.x = pk2(o[d][4 * g] * inv * bf2f((u16)(z.x & 0xffff)), o[d][4 * g + 1] * inv * bf2f((u16)(z.x >> 16)));
      v.y = pk2(o[d][4 * g + 2] * inv * bf2f((u16)(z.y & 0xffff)), o[d][4 * g + 3] * inv * bf2f((u16)(z.y >> 16)));
      *(uint2*)(orow + d0) = v;
    }
}

DI void attn_na_wave(const Params& p, int b, int h, int r, int j) {
  const int lane = threadIdx.x & 63, l15 = lane & 15, q4 = lane >> 4;
  const int t = TC + b * 2048 + r * 64 + j * 16 + l15;
  const u16* qrow = p.NQ + (size_t)t * 1024 + h * 64;
  const bf16x8 qf0 = *(const bf16x8*)(qrow + q4 * 8);
  const bf16x8 qf1 = *(const bf16x8*)(qrow + 32 + q4 * 8);
  const int rs = min(max(r - 4, 0), 24);
  const int bstart = min(max(j * 16 - 8, 0), 32);
  const int c = j * 16 + l15;
  const int cstart = min(max(c - 8, 0), 48);
  const u16* kb = p.NK + (size_t)(TC + b * 2304) * 1024 + h * 64;
  const u16* vb = p.NVT + (size_t)16 * 1024 * 256 + (size_t)b * (1024 * 2304) + (size_t)(h * 64) * 2304;
  const float* rp = p.na_rpb + h * 465;
  f32x4 o[4];
#pragma unroll
  for (int d = 0; d < 4; d++) { o[d][0] = 0.f; o[d][1] = 0.f; o[d][2] = 0.f; o[d][3] = 0.f; }
  float m = -1e30f, l = 0.f;
  const int krow0 = 8 * (l15 >> 2) + (l15 & 3);
  for (int cg4 = 0; cg4 < 4; cg4++) {
    bf16x8 kf[4][4];
    bf16x8 vf[4][4];
#pragma unroll
    for (int c4 = 0; c4 < 4; c4++) {
      const int ch = cg4 * 4 + c4;
      const int key0 = ch < 8 ? ch * 32 : 256 + (rs + ch - 8) * 64 + bstart;
      const u16* kp = kb + (size_t)(key0 + krow0) * 1024 + q4 * 8;
      kf[c4][0] = *(const bf16x8*)(kp);
      kf[c4][1] = *(const bf16x8*)(kp + 32);
      kf[c4][2] = *(const bf16x8*)(kp + 4 * 1024);
      kf[c4][3] = *(const bf16x8*)(kp + 4 * 1024 + 32);
#pragma unroll
      for (int d = 0; d < 4; d++) vf[c4][d] = *(const bf16x8*)(vb + (size_t)(d * 16 + l15) * 2304 + key0 + q4 * 8);
    }
#pragma unroll
    for (int c4 = 0; c4 < 4; c4++) {
      const int ch = cg4 * 4 + c4;
      f32x4 s0 = {0.f, 0.f, 0.f, 0.f}, s1 = {0.f, 0.f, 0.f, 0.f};
      s0 = MFMA16(kf[c4][0], qf0, s0);
      s0 = MFMA16(kf[c4][1], qf1, s0);
      s1 = MFMA16(kf[c4][2], qf0, s1);
      s1 = MFMA16(kf[c4][3], qf1, s1);
      if (cg4 >= 2) {
        const int dr = rs + (ch - 8) - r + 7;
#pragma unroll
        for (int i = 0; i < 4; i++) {
          const int kc0 = bstart + q4 * 8 + i, kc1 = kc0 + 4;
          const bool v0 = (kc0 >= cstart) && (kc0 < cstart + 16);
          const bool v1 = (kc1 >= cstart) && (kc1 < cstart + 16);
          const int dc0 = min(max(kc0 - c + 15, 0), 30), dc1 = min(max(kc1 - c + 15, 0), 30);
          const float b0 = rp[dr * 31 + dc0] * LOG2E, b1 = rp[dr * 31 + dc1] * LOG2E;
          s0[i] = v0 ? s0[i] + b0 : -1e30f;
          s1[i] = v1 ? s1[i] + b1 : -1e30f;
        }
      }
      float mx = fmaxf(fmaxf(fmaxf(s0[0], s0[1]), fmaxf(s0[2], s0[3])), fmaxf(fmaxf(s1[0], s1[1]), fmaxf(s1[2], s1[3])));
      mx = fmaxf(mx, __shfl_xor(mx, 16));
      mx = fmaxf(mx, __shfl_xor(mx, 32));
      const float mn = fmaxf(m, mx);
      const float alpha = __builtin_amdgcn_exp2f(m - mn);
      m = mn;
      float ps = 0.f;
#pragma unroll
      for (int i = 0; i < 4; i++) { s0[i] = exp2f(s0[i] - mn); s1[i] = exp2f(s1[i] - mn); ps += s0[i] + s1[i]; }
      l = l * alpha + ps;
      u32x4 pw; pw[0] = pk2(s0[0], s0[1]); pw[1] = pk2(s0[2], s0[3]); pw[2] = pk2(s1[0], s1[1]); pw[3] = pk2(s1[2], s1[3]);
      const bf16x8 pf = __builtin_bit_cast(bf16x8, pw);
#pragma unroll
      for (int d = 0; d < 4; d++) {
        o[d][0] *= alpha; o[d][1] *= alpha; o[d][2] *= alpha; o[d][3] *= alpha;
        o[d] = MFMA16(vf[c4][d], pf, o[d]);
      }
    }
  }
  l += __shfl_xor(l, 16);
  l += __shfl_xor(l, 32);
  const float inv = 1.f / l;
  const u16* szrow = p.SZ + (size_t)t * 1024 + h * 64;
  u16* orow = p.NAO + (size_t)t * 1024 + h * 64;
#pragma unroll
  for (int d = 0; d < 4; d++) {
    const int d0 = d * 16 + q4 * 4;
    const uint2 z = *(const uint2*)(szrow + d0);
    uint2 v;
    v.x = pk2(o[d][0] * inv * bf2f((u16)(z.x & 0xffff)), o[d][1] * inv * bf2f((u16)(z.x >> 16)));
    v.y = pk2(o[d][2] * inv * bf2f((u16)(z.y & 0xffff)), o[d][3] * inv * bf2f((u16)(z.y >> 16)));
    *(uint2*)(orow + d0) = v;
  }
}


DI void attn_na_block(const Params& p, char* smem, int b, int h, int rpair) {
  constexpr int ST = 72;
  const int tid = threadIdx.x, lane = tid & 63, j = tid >> 6, l31 = lane & 31, lh = lane >> 5;
  u16* Kt = (u16*)smem;
  u16* Vt = Kt + 2 * 64 * ST;
  float* bl = (float*)(Vt + 2 * 64 * ST);
  const int r0 = rpair * 2;
  const int qr = r0 + (l31 >> 4), c = j * 16 + (l31 & 15);
  const int t = TC + b * 2048 + qr * 64 + c;
  const int rsq = min(max(qr - 4, 0), 24);
  const int rs0 = min(max(r0 - 4, 0), 24);
  const int nrows = min(max(r0 + 1 - 4, 0), 24) + 8 - rs0;
  const int ntile = 4 + nrows;
  const int bstart = min(max(j * 16 - 8, 0), 32);
  const int cstart = min(max(c - 8, 0), 48);
  const u16* kb = p.NK + (size_t)(TC + b * 2304) * 1024 + h * 64;
  const u16* vb = p.NVT + (size_t)16 * 1024 * 256 + (size_t)b * (1024 * 2304) + (size_t)(h * 64) * 2304;
  const u16* qrow = p.NQ + (size_t)t * 1024 + h * 64;
  bf16x8 qf[4];
#pragma unroll
  for (int s = 0; s < 4; s++) qf[s] = *(const bf16x8*)(qrow + s * 16 + lh * 8);
  f32x16 o[2];
#pragma unroll
  for (int d = 0; d < 2; d++)
#pragma unroll
    for (int r = 0; r < 16; r++) o[d][r] = 0.f;
  float m = -1e30f, l = 0.f;
  const int r16 = l31 & 15;
  const int kap = (l31 & 16) + (r16 & 3) + 4 * ((r16 >> 3) & 1) + 8 * ((r16 >> 2) & 1);
  const int srow = tid >> 3, scc = (tid & 7) * 8;
  u32x4 ra[2], rv[2];
  __syncthreads();
  for (int i = tid; i < 465; i += 256) bl[i] = p.na_rpb[h * 465 + i] * LOG2E;
#pragma unroll
  for (int i = 0; i < 2; i++) {
    ra[i] = *(const u32x4*)(kb + (size_t)(srow + 32 * i) * 1024 + scc);
    rv[i] = *(const u32x4*)(vb + (size_t)(srow + 32 * i) * 2304 + scc);
  }
#pragma unroll
  for (int i = 0; i < 2; i++) {
    *(u32x4*)(Kt + (srow + 32 * i) * ST + scc) = ra[i];
    *(u32x4*)(Vt + (srow + 32 * i) * ST + scc) = rv[i];
  }
  __syncthreads();
  for (int tl = 0; tl < ntile; tl++) {
    const int buf = tl & 1;
    const int tn = (tl + 1 < ntile) ? tl + 1 : tl;
    const int keyn = tn < 4 ? tn * 64 : 256 + (rs0 + tn - 4) * 64;
#pragma unroll
    for (int i = 0; i < 2; i++) {
      ra[i] = *(const u32x4*)(kb + (size_t)(keyn + srow + 32 * i) * 1024 + scc);
      rv[i] = *(const u32x4*)(vb + (size_t)(srow + 32 * i) * 2304 + keyn + scc);
    }
    const u16* Kc = Kt + buf * 64 * ST;
    const u16* Vc = Vt + buf * 64 * ST;
    const bool local = tl >= 4;
    const int gr = rs0 + tl - 4;
    const int nh = local ? 1 : 2;
    for (int hh = 0; hh < nh; hh++) {
      const int koff = local ? bstart : hh * 32;
      f32x16 s0;
#pragma unroll
      for (int r = 0; r < 16; r++) s0[r] = 0.f;
      const u16* kp = Kc + (koff + kap) * ST + lh * 8;
#pragma unroll
      for (int s = 0; s < 4; s++) s0 = MFMA32(*(const bf16x8*)(kp + s * 16), qf[s], s0);
      if (local) {
        const bool rowvalid = (gr >= rsq) && (gr < rsq + 8);
        const int dr = min(max(gr - qr + 7, 0), 14);
#pragma unroll
        for (int i = 0; i < 16; i++) {
          const int kcol = bstart + 16 * (i >> 3) + 8 * lh + (i & 7);
          const bool valid = rowvalid && (kcol >= cstart) && (kcol < cstart + 16);
          const int dc = min(max(kcol - c + 15, 0), 30);
          s0[i] = valid ? s0[i] + bl[dr * 31 + dc] : -1e30f;
        }
      }
      float mx = s0[0];
#pragma unroll
      for (int r = 1; r < 16; r++) mx = fmaxf(mx, s0[r]);
      mx = fmaxf(mx, __shfl_xor(mx, 32));
      if (__any(mx > m + 8.f)) {
        const float mn = fmaxf(m, mx);
        const float alpha = __builtin_amdgcn_exp2f(m - mn);
        m = mn;
        l *= alpha;
#pragma unroll
        for (int d = 0; d < 2; d++)
#pragma unroll
          for (int r = 0; r < 16; r++) o[d][r] *= alpha;
      }
      float ps = 0.f;
#pragma unroll
      for (int r = 0; r < 16; r++) { s0[r] = __builtin_amdgcn_exp2f(s0[r] - m); ps += s0[r]; }
      l += ps;
      const u16* vp = Vc + l31 * ST + koff + lh * 8;
#pragma unroll
      for (int sp = 0; sp < 2; sp++) {
        u32x4 pw;
        pw[0] = pk2(s0[8 * sp + 0], s0[8 * sp + 1]); pw[1] = pk2(s0[8 * sp + 2], s0[8 * sp + 3]);
        pw[2] = pk2(s0[8 * sp + 4], s0[8 * sp + 5]); pw[3] = pk2(s0[8 * sp + 6], s0[8 * sp + 7]);
        const bf16x8 pf = __builtin_bit_cast(bf16x8, pw);
#pragma unroll
        for (int d = 0; d < 2; d++) o[d] = MFMA32(*(const bf16x8*)(vp + d * 32 * ST + sp * 16), pf, o[d]);
      }
    }
    if (tl + 1 < ntile) {
#pragma unroll
      for (int i = 0; i < 2; i++) {
        *(u32x4*)(Kt + (buf ^ 1) * 64 * ST + (srow + 32 * i) * ST + scc) = ra[i];
        *(u32x4*)(Vt + (buf ^ 1) * 64 * ST + (srow + 32 * i) * ST + scc) = rv[i];
      }
    }
    __syncthreads();
  }
  l += __shfl_xor(l, 32);
  const float inv = 1.f / l;
  const u16* szrow = p.SZ + (size_t)t * 1024 + h * 64;
  u16* orow = p.NAO + (size_t)t * 1024 + h * 64;
#pragma unroll
  for (int d = 0; d < 2; d++)
#pragma unroll
    for (int g = 0; g < 4; g++) {
      const int d0 = d * 32 + 8 * g + 4 * lh;
      const uint2 z = *(const uint2*)(szrow + d0);
      uint2 v;
      v.x = pk2(o[d][4 * g] * inv * bf2f((u16)(z.x & 0xffff)), o[d][4 * g + 1] * inv * bf2f((u16)(z.x >> 16)));
      v.y = pk2(o[d][4 * g + 2] * inv * bf2f((u16)(z.y & 0xffff)), o[d][4 * g + 3] * inv * bf2f((u16)(z.y >> 16)));
      *(uint2*)(orow + d0) = v;
    }
}

DI void ph_prep(const Params& p, char* smem) {
  const int tid = threadIdx.x;
  const int ntr = p.nmat_tiles;
  const int ntot = ntr + 192;
  for (int tile = blockIdx.x; tile < ntot; tile += gridDim.x) {
    __syncthreads();
    if (tile < ntr) {
      int mi = 0;
      for (int i = 1; i < 18; i++) if (tile >= p.mats[i].tile0) mi = i;
      const float* src = p.mats[mi].src; u16* dst = p.mats[mi].dst;
      const int K = p.mats[mi].K, Nsrc = p.mats[mi].Nsrc, Ndst = p.mats[mi].Ndst;
      const int lt = tile - p.mats[mi].tile0;
      const int ntn = Ndst >> 6;
      const int kt = lt / ntn, nt = lt - kt * ntn;
      float* ts = (float*)smem;
#pragma unroll
      for (int i = 0; i < 4; i++) {
        const int k = i * 16 + (tid >> 4), n4 = (tid & 15) * 4, n = nt * 64 + n4;
        float4 v = {0.f, 0.f, 0.f, 0.f};
        if (n < Nsrc) v = *(const float4*)(src + (size_t)(kt * 64 + k) * Nsrc + n);
        ts[k * 65 + n4] = v.x; ts[k * 65 + n4 + 1] = v.y; ts[k * 65 + n4 + 2] = v.z; ts[k * 65 + n4 + 3] = v.w;
      }
      __syncthreads();
      const int n = tid >> 2, kc = (tid & 3) * 16;
      uint32_t w[8];
#pragma unroll
      for (int e = 0; e < 8; e++) w[e] = pk2(ts[(kc + 2 * e) * 65 + n], ts[(kc + 2 * e + 1) * 65 + n]);
      u16* dp = dst + (size_t)(nt * 64 + n) * K + kt * 64 + kc;
      uint4 v0; v0.x = w[0]; v0.y = w[1]; v0.z = w[2]; v0.w = w[3];
      uint4 v1; v1.x = w[4]; v1.y = w[5]; v1.z = w[6]; v1.w = w[7];
      *(uint4*)dp = v0; *(uint4*)(dp + 8) = v1;
    } else {
      const int at = tile - ntr;
      const int layer = at / 48, c0 = (at - layer * 48) * 64;
      float* sc = (float*)smem;
      float* red = sc + 5 * 1024;
      for (int i = tid; i < 5 * 1024; i += 256) {
        const int n = i >> 10, k = i & 1023;
        const float v = (n == 0) ? p.c_ctx[k] : p.c[(n - 1) * 1024 + k];
        sc[i] = silu(v);
      }
      __syncthreads();
      const int c4 = (tid & 15) * 4, kg = tid >> 4;
      float acc[5][4];
#pragma unroll
      for (int n = 0; n < 5; n++) { acc[n][0] = 0.f; acc[n][1] = 0.f; acc[n][2] = 0.f; acc[n][3] = 0.f; }
      const float* w = p.ada_w + (size_t)layer * 1024 * 3072 + c0 + c4;
#pragma unroll 4
      for (int kk = 0; kk < 64; kk++) {
        const int k = kg * 64 + kk;
        const float4 wv = *(const float4*)(w + (size_t)k * 3072);
#pragma unroll
        for (int n = 0; n < 5; n++) {
          const float s = sc[n * 1024 + k];
          acc[n][0] += s * wv.x; acc[n][1] += s * wv.y; acc[n][2] += s * wv.z; acc[n][3] += s * wv.w;
        }
      }
#pragma unroll
      for (int n = 0; n < 5; n++) {
        float4 r; r.x = acc[n][0]; r.y = acc[n][1]; r.z = acc[n][2]; r.w = acc[n][3];
        *(float4*)(red + (kg * 5 + n) * 64 + c4) = r;
      }
      __syncthreads();
      for (int o = tid; o < 320; o += 256) {
        const int n = o >> 6, cc = o & 63;
        float s = 0.f;
#pragma unroll
        for (int g = 0; g < 16; g++) s += red[(g * 5 + n) * 64 + cc];
        s += p.ada_b[layer * 3072 + c0 + cc];
        p.mod[(layer * 5 + n) * 3072 + c0 + cc] = s;
      }
    }
  }
}

DI void ph_h0(const Params& p) {
  for (int idx = blockIdx.x * 256 + threadIdx.x; idx < T * 128; idx += gridDim.x * 256) {
    const int t = idx >> 7, c0 = (idx & 127) * 8;
    const float* xr = (t < TC) ? p.x_prompt + (size_t)t * 1024 : p.x_sample + (size_t)(t - TC) * 1024;
    const float* md = p.mod + cond_of(t) * 3072;
    const float4 x0 = *(const float4*)(xr + c0), x1 = *(const float4*)(xr + c0 + 4);
    const float4 sh0 = *(const float4*)(md + c0), sh1 = *(const float4*)(md + c0 + 4);
    const float4 sc0 = *(const float4*)(md + 1024 + c0), sc1 = *(const float4*)(md + 1024 + c0 + 4);
    uint4 v;
    v.x = pk2(x0.x * (1.f + sc0.x) + sh0.x, x0.y * (1.f + sc0.y) + sh0.y);
    v.y = pk2(x0.z * (1.f + sc0.z) + sh0.z, x0.w * (1.f + sc0.w) + sh0.w);
    v.z = pk2(x1.x * (1.f + sc1.x) + sh1.x, x1.y * (1.f + sc1.y) + sh1.y);
    v.w = pk2(x1.z * (1.f + sc1.z) + sh1.z, x1.w * (1.f + sc1.w) + sh1.w);
    *(uint4*)(p.H + (size_t)t * 1024 + c0) = v;
  }
}

template <class Epi>
DI void gemm_phase(const u16* A, int lda, const u16* Bt, int ldb, int K, int MT, int NT, char* smem, const Epi& epi) {
  const int ntile = MT * NT;
  for (int tile = blockIdx.x; tile < ntile; tile += gridDim.x) {
    const int nt = tile / MT, mt = tile - nt * MT;
    gemm_tile<3>(A, lda, Bt, ldb, K, mt * 192, nt * 128, 0, smem, epi);
  }
}

DI void unpack8(const u32x4& u, float* f) {
  f[0] = __uint_as_float(u[0] << 16); f[1] = __uint_as_float(u[0] & 0xffff0000u);
  f[2] = __uint_as_float(u[1] << 16); f[3] = __uint_as_float(u[1] & 0xffff0000u);
  f[4] = __uint_as_float(u[2] << 16); f[5] = __uint_as_float(u[2] & 0xffff0000u);
  f[6] = __uint_as_float(u[3] << 16); f[7] = __uint_as_float(u[3] & 0xffff0000u);
}
template <int HW>
DI void mix_item(const Params& p, int rpair) {
  const int lane = threadIdx.x & 63;
  constexpr int g = (HW == 1) ? 0 : (HW == 2) ? 1 : (HW == 4) ? 2 : 3;
  constexpr int NR = 8 + 2 * HW;
  const int c0 = (g * 32 + (lane & 31)) * 8;
  const int t0 = (rpair * 2 + (lane >> 5)) * 8;
  int s0, L, tt0;
  if (t0 < TC) { s0 = t0 & ~255; tt0 = t0 & 255; L = 256; } else { s0 = TC + ((t0 - TC) & ~2047); tt0 = (t0 - TC) & 2047; L = 2048; }
  u32x4 rows[NR];
#pragma unroll
  for (int r = 0; r < NR; r++) {
    const int tt = tt0 - HW + r;
    u32x4 v = {0u, 0u, 0u, 0u};
    if (tt >= 0 && tt < L) v = *(const u32x4*)(p.U + (size_t)(s0 + tt) * 1024 + c0);
    rows[r] = v;
  }
  float sum[8];
#pragma unroll
  for (int k = 0; k < 8; k++) sum[k] = 0.f;
#pragma unroll
  for (int r = 0; r < 2 * HW; r++) {
    float f[8]; unpack8(rows[r], f);
#pragma unroll
    for (int k = 0; k < 8; k++) sum[k] += f[k];
  }
#pragma unroll
  for (int e = 0; e < 8; e++) {
    const int tt = tt0 + e;
    const int lo = max(tt - HW, 0), hi = min(tt + HW, L);
    const float ic = 1.f / (float)(hi - lo);
    float own[8]; unpack8(rows[e + HW], own);
    u32x4 v;
    v[0] = pk2(sum[0] * ic - own[0], sum[1] * ic - own[1]);
    v[1] = pk2(sum[2] * ic - own[2], sum[3] * ic - own[3]);
    v[2] = pk2(sum[4] * ic - own[4], sum[5] * ic - own[5]);
    v[3] = pk2(sum[6] * ic - own[6], sum[7] * ic - own[7]);
    *(u32x4*)(p.MIX + (size_t)(s0 + tt) * 1024 + c0) = v;
    if (e < 7) {
      float fo[8], fi[8]; unpack8(rows[e], fo); unpack8(rows[e + 2 * HW], fi);
#pragma unroll
      for (int k = 0; k < 8; k++) sum[k] += fi[k] - fo[k];
    }
  }
}
DI void ph_mix(const Params& p) {
  const int wid = threadIdx.x >> 6;
  for (int item = blockIdx.x * 4 + wid; item < 768 * 4; item += gridDim.x * 4) {
    const int rpair = item >> 2, g = item & 3;
    if (g == 0) mix_item<1>(p, rpair);
    else if (g == 1) mix_item<2>(p, rpair);
    else if (g == 2) mix_item<4>(p, rpair);
    else mix_item<8>(p, rpair);
  }
}

DI void ph_pool_g2(const Params& p, int j, char* smem) {
  EpiPoolG2 epi{p.PM, p.SZ, p.pool_scale + j * 1024};
  for (int tile = blockIdx.x; tile < 64 * 8; tile += gridDim.x) {
    const int gn = tile / 64, mt = tile - gn * 64;
    const int g = gn >> 1, ns = gn & 1;
    gemm_tile<3>(p.MIX + g * 256, 1024, p.Wgrp + (size_t)(j * 4 + g) * 65536, 256, 256, mt * 192, ns * 128, g * 256, smem, epi);
  }
}

DI void ph_ln(const Params& p, int layer) {
  const int lane = threadIdx.x & 63, wid = threadIdx.x >> 6;
  const float* g = p.ln_g + layer * 1024;
  const float* bb = p.ln_b + layer * 1024;
  for (int row = blockIdx.x * 4 + wid; row < T; row += gridDim.x * 4) {
    float* xr = p.out + (size_t)row * 1024;
    float4 v[4];
    float s = 0.f;
#pragma unroll
    for (int i = 0; i < 4; i++) { v[i] = *(const float4*)(xr + i * 256 + lane * 4); s += v[i].x + v[i].y + v[i].z + v[i].w; }
    const float mu = wave_sum(s) * (1.f / 1024.f);
    float q = 0.f;
#pragma unroll
    for (int i = 0; i < 4; i++) {
      v[i].x -= mu; v[i].y -= mu; v[i].z -= mu; v[i].w -= mu;
      q += v[i].x * v[i].x + v[i].y * v[i].y + v[i].z * v[i].z + v[i].w * v[i].w;
    }
    const float rstd = rsqrtf(wave_sum(q) * (1.f / 1024.f) + 1e-5f);
    const float* md = p.mod + ((layer + 1) * 5 + cond_of(row)) * 3072;
#pragma unroll
    for (int i = 0; i < 4; i++) {
      const int cc = i * 256 + lane * 4;
      const float4 gg = *(const float4*)(g + cc), be = *(const float4*)(bb + cc);
      float4 y;
      y.x = v[i].x * rstd * gg.x + be.x; y.y = v[i].y * rstd * gg.y + be.y;
      y.z = v[i].z * rstd * gg.z + be.z; y.w = v[i].w * rstd * gg.w + be.w;
      *(float4*)(xr + cc) = y;
      if (layer < 3) {
        const float4 sh = *(const float4*)(md + cc), sc = *(const float4*)(md + 1024 + cc);
        uint2 h;
        h.x = pk2(y.x * (1.f + sc.x) + sh.x, y.y * (1.f + sc.y) + sh.y);
        h.y = pk2(y.z * (1.f + sc.z) + sh.z, y.w * (1.f + sc.w) + sh.w);
        *(uint2*)(p.H + (size_t)row * 1024 + cc) = h;
      }
    }
  }
}

DI void ph_mla_norm(const Params& p) {
  const int lane = threadIdx.x & 63, wid = threadIdx.x >> 6;
  for (int row = blockIdx.x * 4 + wid; row < T + 1024; row += gridDim.x * 4) {
    if (row < T) {
      const float* rr = p.RAW + (size_t)row * 768;
      const float4 a0 = *(const float4*)(rr + lane * 8), a1 = *(const float4*)(rr + lane * 8 + 4);
      const float4 k0 = *(const float4*)(rr + 512 + lane * 4);
      float s1 = a0.x * a0.x + a0.y * a0.y + a0.z * a0.z + a0.w * a0.w + a1.x * a1.x + a1.y * a1.y + a1.z * a1.z + a1.w * a1.w;
      float s2 = k0.x * k0.x + k0.y * k0.y + k0.z * k0.z + k0.w * k0.w;
      const float r1 = rsqrtf(wave_sum(s1) * (1.f / 512.f) + 1e-6f);
      const float r2 = rsqrtf(wave_sum(s2) * (1.f / 256.f) + 1e-6f);
      const float4 g0 = *(const float4*)(p.mla_q_norm + lane * 8), g1 = *(const float4*)(p.mla_q_norm + lane * 8 + 4);
      uint4 v;
      v.x = pk2(a0.x * r1 * g0.x, a0.y * r1 * g0.y); v.y = pk2(a0.z * r1 * g0.z, a0.w * r1 * g0.w);
      v.z = pk2(a1.x * r1 * g1.x, a1.y * r1 * g1.y); v.w = pk2(a1.z * r1 * g1.z, a1.w * r1 * g1.w);
      *(uint4*)(p.CQN + (size_t)row * 512 + lane * 8) = v;
      const float4 kg = *(const float4*)(p.mla_kv_norm + lane * 4);
      float4 kn; kn.x = k0.x * r2 * kg.x; kn.y = k0.y * r2 * kg.y; kn.z = k0.z * r2 * kg.z; kn.w = k0.w * r2 * kg.w;
      uint2 kv; kv.x = pk2(kn.x, kn.y); kv.y = pk2(kn.z, kn.w);
      *(uint2*)(p.CKVN + (size_t)kvrow_of(row) * 256 + lane * 4) = kv;
      if (row < TC) *(float4*)(p.out + OUT_CKV + (size_t)row * 256 + lane * 4) = kn;
    } else {
      const int cr = row - T, b = cr >> 8, pp = cr & 255;
      const size_t kvr = (size_t)TC + b * 2304 + pp;
      const float4 k0 = *(const float4*)(p.cache_ckv + (size_t)cr * 256 + lane * 4);
      uint2 kv; kv.x = pk2(k0.x, k0.y); kv.y = pk2(k0.z, k0.w);
      *(uint2*)(p.CKVN + kvr * 256 + lane * 4) = kv;
      p.KR[kvr * 64 + lane] = f2bf(p.cache_kr[(size_t)cr * 64 + lane]);
    }
  }
}

DI void ph_mla_g2(const Params& p, char* smem) {
  EpiMlaQ eq{p.Q};
  EpiMlaKV ekv{p.KN, p.VT};
  const int n1 = 64 * 12, n2 = 104 * 16;
  for (int tile = blockIdx.x; tile < n1 + n2; tile += gridDim.x) {
    if (tile < n1) {
      const int nt = tile / 64, mt = tile - nt * 64;
      gemm_tile<3>(p.CQN, 512, p.Wuq, 512, 512, mt * 192, nt * 128, 0, smem, eq);
    } else {
      const int t2 = tile - n1;
      const int nt = t2 / 104, mt = t2 - nt * 104;
      gemm_tile<2>(p.CKVN, 256, p.Wukv, 256, 256, mt * 128, nt * 128, 0, smem, ekv);
    }
  }
}

DI void ph_mla_attn(const Params& p, char* smem) {
  const int wid = threadIdx.x >> 6, l31 = threadIdx.x & 31;
  for (int u = blockIdx.x; u < 768; u += gridDim.x) {
    int t0, kvrow0, nkeys, Lk, h; size_t vbase;
    if (u < 512) {
      const int xcd = u & 7, slot = u >> 3; const int pair = xcd * 4 + (slot >> 4); const int qb = slot & 15;
      const int b = pair >> 3; h = pair & 7;
      t0 = TC + b * 2048 + qb * 128 + wid * 32; kvrow0 = TC + b * 2304; nkeys = 2304; Lk = 2304;
      vbase = (size_t)16 * 8 * 128 * 256 + (size_t)b * (8 * 128 * 2304) + (size_t)h * 128 * 2304;
    } else {
      const int v = u - 512; const int b = v >> 4; h = (v >> 1) & 7; const int qb = v & 1;
      t0 = b * 256 + qb * 128 + wid * 32; kvrow0 = b * 256; nkeys = 256; Lk = 256;
      vbase = (size_t)b * (8 * 128 * 256) + (size_t)h * 128 * 256;
    }
    const int t = t0 + l31;
    attn_dense_block<8, 4, 4>(smem, p.Q + (size_t)t * 1536 + h * 192, p.KN + (size_t)kvrow0 * 1024 + h * 128, 1024,
                             p.KR + (size_t)kvrow0 * 64, p.VT + vbase, Lk, nkeys,
                             p.SZ + (size_t)t * 1024 + h * 128, p.AO + (size_t)t * 1024 + h * 128);
  }
}

DI void ph_na_g1(const Params& p, char* smem) {
  EpiNaG1 epi{p.NQ, p.NK, p.NVT, p.SZ, p.out + OUT_NAK, p.out + OUT_NAV};
  const int n1 = 64 * 32;
  for (int tile = blockIdx.x; tile < n1 + 64; tile += gridDim.x) {
    if (tile < n1) {
      const int nt = tile / 64, mt = tile - nt * 64;
      gemm_tile<3>(p.H, 1024, p.Wnin, 1024, 1024, mt * 192, nt * 128, 0, smem, epi);
    } else {
      const int ct = tile - n1;
      const int b = ct >> 4, p0 = (ct & 15) * 16;
      const int c4 = threadIdx.x * 4;
      const size_t kvb = (size_t)TC + b * 2304;
      u16* vtb = p.NVT + (size_t)16 * 1024 * 256 + (size_t)b * (1024 * 2304);
      float vv[4][16];
#pragma unroll
      for (int i = 0; i < 16; i++) {
        const size_t src = ((size_t)(b * 256 + p0 + i)) * 1024 + c4;
        const float4 k = *(const float4*)(p.cache_nak + src);
        uint2 kv; kv.x = pk2(k.x, k.y); kv.y = pk2(k.z, k.w);
        *(uint2*)(p.NK + (kvb + p0 + i) * 1024 + c4) = kv;
        const float4 v = *(const float4*)(p.cache_nav + src);
        vv[0][i] = v.x; vv[1][i] = v.y; vv[2][i] = v.z; vv[3][i] = v.w;
      }
#pragma unroll
      for (int e = 0; e < 4; e++) {
        uint4 w0, w1;
        w0.x = pk2(vv[e][0], vv[e][1]); w0.y = pk2(vv[e][2], vv[e][3]); w0.z = pk2(vv[e][4], vv[e][5]); w0.w = pk2(vv[e][6], vv[e][7]);
        w1.x = pk2(vv[e][8], vv[e][9]); w1.y = pk2(vv[e][10], vv[e][11]); w1.z = pk2(vv[e][12], vv[e][13]); w1.w = pk2(vv[e][14], vv[e][15]);
        u16* dp = vtb + (size_t)(c4 + e) * 2304 + p0;
        *(uint4*)dp = w0; *(uint4*)(dp + 8) = w1;
      }
    }
  }
}

DI void ph_na_attn(const Params& p, char* smem) {
  const int wid = threadIdx.x >> 6, l31 = threadIdx.x & 31;
  for (int u = blockIdx.x; u < 1024 + 512; u += gridDim.x) {
    if (u < 1024) {
      const int xcd = u & 7, slot = u >> 3;
      const int pair = xcd * 8 + (slot >> 4), rpair = slot & 15;
      attn_na_block(p, smem, pair >> 4, pair & 15, rpair);
    } else {
      const int v = u - 1024;
      const int b = v >> 5, h = (v >> 1) & 15, qb = v & 1;
      const int t = b * 256 + qb * 128 + wid * 32 + l31;
      attn_dense_block<4, 0, 2>(smem, p.NQ + (size_t)t * 1024 + h * 64, p.NK + (size_t)(b * 256) * 1024 + h * 64, 1024, nullptr,
                               p.NVT + (size_t)b * (1024 * 256) + (size_t)h * 64 * 256, 256, 256,
                               p.SZ + (size_t)t * 1024 + h * 64, p.NAO + (size_t)t * 1024 + h * 64);
    }
  }
}

template <int ph>
DI void run_phase(const Params& p, char* smem) {
  if constexpr (ph == 0) ph_prep(p, smem);
  else if constexpr (ph == 1) ph_h0(p);
  else if constexpr (ph == 2 || ph == 17) {
    constexpr int j = (ph == 2) ? 0 : 1;
    EpiPoolG1 e{p.U, p.SZ};
    gemm_phase(p.H, 1024, p.Wpin + (size_t)j * 2048 * 1024, 1024, 1024, 64, 16, smem, e);
  }
  else if constexpr (ph == 3 || ph == 18) ph_mix(p);
  else if constexpr (ph == 4 || ph == 19) ph_pool_g2(p, (ph == 4) ? 0 : 1, smem);
  else if constexpr (ph == 5) {
    EpiG3 e{p.x_prompt, p.x_sample, p.out, p.mod};
    gemm_phase(p.PM, 1024, p.Wpout, 1024, 1024, 64, 8, smem, e);
  }
  else if constexpr (ph == 20) {
    EpiG3 e{p.out, p.out + OUT_YS, p.out, p.mod + 3 * 5 * 3072};
    gemm_phase(p.PM, 1024, p.Wpout + (size_t)1024 * 1024, 1024, 1024, 64, 8, smem, e);
  }
  else if constexpr (ph == 6) ph_ln(p, 0);
  else if constexpr (ph == 21) ph_ln(p, 3);
  else if constexpr (ph == 7) {
    EpiMlaG1 e{p.RAW, p.KR, p.SZ, p.out + OUT_KR};
    gemm_phase(p.H, 1024, p.Wmin, 1024, 1024, 64, 15, smem, e);
  }
  else if constexpr (ph == 8) ph_mla_norm(p);
  else if constexpr (ph == 9) ph_mla_g2(p, smem);
  else if constexpr (ph == 10) ph_mla_attn(p, smem);
  else if constexpr (ph == 11) {
    EpiG3 e{p.out, p.out + OUT_YS, p.out, p.mod + 1 * 5 * 3072};
    gemm_phase(p.AO, 1024, p.Wmout, 1024, 1024, 64, 8, smem, e);
  }
  else if constexpr (ph == 12) ph_ln(p, 1);
  else if constexpr (ph == 13) ph_na_g1(p, smem);
  else if constexpr (ph == 14) ph_na_attn(p, smem);
  else if constexpr (ph == 15) {
    EpiG3 e{p.out, p.out + OUT_YS, p.out, p.mod + 2 * 5 * 3072};
    gemm_phase(p.NAO, 1024, p.Wnout, 1024, 1024, 64, 8, smem, e);
  }
  else if constexpr (ph == 16) ph_ln(p, 2);
}

#define RUN_PH(n) if (ph_lo <= (n) && (n) < ph_hi) { run_phase<n>(p, smem); if ((n) + 1 < ph_hi) xcd_barrier(xb); }

__global__ void __launch_bounds__(256, 2) mega(Params p, int ph_lo, int ph_hi) {
  __shared__ __attribute__((aligned(16))) char smem[SMEM_BYTES];
  if (ph_lo < 0) { cg::this_grid().sync(); return; }
  const bool multi = (ph_hi - ph_lo) > 1;
  XcdBarrier xb; xb.bar = p.bar; xb.x = 0; xb.nloc = 0u; xb.nx = 0u;
  if (multi) xb = xcd_barrier_post(p.bar);
  RUN_PH(0) RUN_PH(1) RUN_PH(2) RUN_PH(3) RUN_PH(4) RUN_PH(5) RUN_PH(6) RUN_PH(7) RUN_PH(8) RUN_PH(9) RUN_PH(10)
  RUN_PH(11) RUN_PH(12) RUN_PH(13) RUN_PH(14) RUN_PH(15) RUN_PH(16) RUN_PH(17) RUN_PH(18) RUN_PH(19) RUN_PH(20) RUN_PH(21)
}

extern "C" void kernel_launch(void* const* d_in, const int* in_sizes, int n_in, void* d_out, int out_size, void* d_ws, size_t ws_size,
                              hipStream_t stream) {
  Params p;
  memset(&p, 0, sizeof(p));
  const float* const* in = (const float* const*)d_in;
  p.x_prompt = in[0]; p.x_sample = in[1]; p.cache_ckv = in[2]; p.cache_kr = in[3]; p.cache_nak = in[4]; p.cache_nav = in[5];
  p.c = in[6]; p.c_ctx = in[7]; p.ada_w = in[8]; p.ada_b = in[9]; p.ln_g = in[10]; p.ln_b = in[11];
  const float* pool_w_in = in[12]; const float* pool_w_grp = in[13]; p.pool_scale = in[14]; const float* pool_w_out = in[15];
  const float* mla_w_in = in[16]; p.mla_q_norm = in[17]; const float* mla_w_uq = in[18]; p.mla_kv_norm = in[19];
  const float* mla_w_ukv = in[20]; const float* mla_w_out = in[21]; const float* na_w_in = in[22]; p.na_rpb = in[23];
  const float* na_w_out = in[24];
  p.out = (float*)d_out;

  char* ws = (char*)d_ws;
  size_t off = 0;
  auto take = [&](size_t bytes) { char* r = ws + off; off += (bytes + 255) & ~(size_t)255; return r; };
  p.bar = (unsigned*)take(XCD_BAR_WORDS * 4);
  p.mod = (float*)take((size_t)4 * 5 * 3072 * 4);
  p.Wpin = (u16*)take((size_t)2 * 2048 * 1024 * 2);
  p.Wgrp = (u16*)take((size_t)8 * 65536 * 2);
  p.Wpout = (u16*)take((size_t)2 * 1024 * 1024 * 2);
  p.Wmin = (u16*)take((size_t)1920 * 1024 * 2);
  p.Wuq = (u16*)take((size_t)1536 * 512 * 2);
  p.Wukv = (u16*)take((size_t)2048 * 256 * 2);
  p.Wmout = (u16*)take((size_t)1024 * 1024 * 2);
  p.Wnin = (u16*)take((size_t)4096 * 1024 * 2);
  p.Wnout = (u16*)take((size_t)1024 * 1024 * 2);
  p.H = (u16*)take((size_t)T * 1024 * 2);
  p.SZ = (u16*)take((size_t)T * 1024 * 2);
  const size_t arena0 = off;
  p.U = (u16*)take((size_t)T * 1024 * 2);
  p.MIX = (u16*)take((size_t)T * 1024 * 2);
  p.PM = (u16*)take((size_t)T * 1024 * 2);
  off = arena0;
  p.RAW = (float*)take((size_t)T * 768 * 4);
  p.AO = (u16*)p.RAW;
  p.CQN = (u16*)take((size_t)T * 512 * 2);
  p.CKVN = (u16*)take((size_t)KVR * 256 * 2);
  p.KR = (u16*)take((size_t)KVR * 64 * 2);
  p.Q = (u16*)take((size_t)T * 1536 * 2);
  p.KN = (u16*)take((size_t)KVR * 1024 * 2);
  p.VT = (u16*)take((size_t)KVR * 1024 * 2);
  off = arena0;
  p.NQ = (u16*)take((size_t)T * 1024 * 2);
  p.NK = (u16*)take((size_t)KVR * 1024 * 2);
  p.NVT = (u16*)take((size_t)KVR * 1024 * 2);
  p.NAO = (u16*)take((size_t)T * 1024 * 2);

  int nm = 0, tiles = 0;
  auto add = [&](const float* src, u16* dst, int K, int Nsrc, int Ndst) {
    p.mats[nm].src = src; p.mats[nm].dst = dst; p.mats[nm].K = K; p.mats[nm].Nsrc = Nsrc; p.mats[nm].Ndst = Ndst; p.mats[nm].tile0 = tiles;
    tiles += (K / 64) * (Ndst / 64); nm++;
  };
  for (int j = 0; j < 2; j++) add(pool_w_in + (size_t)j * 1024 * 2048, p.Wpin + (size_t)j * 2048 * 1024, 1024, 2048, 2048);
  for (int j = 0; j < 8; j++) add(pool_w_grp + (size_t)j * 65536, p.Wgrp + (size_t)j * 65536, 256, 256, 256);
  for (int j = 0; j < 2; j++) add(pool_w_out + (size_t)j * 1024 * 1024, p.Wpout + (size_t)j * 1024 * 1024, 1024, 1024, 1024);
  add(mla_w_in, p.Wmin, 1024, 1856, 1920);
  add(mla_w_uq, p.Wuq, 512, 1536, 1536);
  add(mla_w_ukv, p.Wukv, 256, 2048, 2048);
  add(mla_w_out, p.Wmout, 1024, 1024, 1024);
  add(na_w_in, p.Wnin, 1024, 4096, 4096);
  add(na_w_out, p.Wnout, 1024, 1024, 1024);
  p.nmat_tiles = tiles;

  (void)hipMemsetAsync(p.bar, 0, XCD_BAR_WORDS * 4, stream);
#if MULTI_LAUNCH
  for (int ph = 0; ph < NPHASE; ph++) hipLaunchKernelGGL(mega, dim3(512), dim3(256), 0, stream, p, ph, ph + 1);
#else
  static int grid_blocks = 0;
  if (!grid_blocks) {
    int dev = 0, cus = 0, per_cu = 0;
    hipGetDevice(&dev);
    hipDeviceGetAttribute(&cus, hipDeviceAttributeMultiprocessorCount, dev);
    hipOccupancyMaxActiveBlocksPerMultiprocessor(&per_cu, mega, 256, 0);
    if (per_cu > 2) per_cu = 2;
    if (per_cu < 1) per_cu = 1;
    grid_blocks = cus * per_cu;
  }
  int lo = 0, hi = NPHASE;
  void* args[] = {&p, &lo, &hi};
  hipError_t e = hipLaunchCooperativeKernel((void*)mega, dim3(grid_blocks), dim3(256), args, 0, stream);
  if (e != hipSuccess) fprintf(stderr, "cooperative launch failed: %s (grid %d)\n", hipGetErrorString(e), grid_blocks);
#endif
}
```

```cpp
#include <hip/hip_runtime.h>
#include <hip/hip_cooperative_groups.h>
#include <stdint.h>
#include <string.h>
#include <stdio.h>
namespace cg = cooperative_groups;

#ifndef MULTI_LAUNCH
#define MULTI_LAUNCH 0
#endif

typedef __attribute__((ext_vector_type(8))) short bf16x8;
typedef __attribute__((ext_vector_type(4))) float f32x4;
typedef __attribute__((ext_vector_type(16))) float f32x16;
typedef __attribute__((ext_vector_type(4))) uint32_t u32x4;
typedef unsigned short u16;
#define DI __device__ __forceinline__
#define MFMA32(a, b, c) __builtin_amdgcn_mfma_f32_32x32x16_bf16((a), (b), (c), 0, 0, 0)
#define MFMA16(a, b, c) __builtin_amdgcn_mfma_f32_16x16x32_bf16((a), (b), (c), 0, 0, 0)

constexpr int TC = 4096, TL = 8192, T = 12288;
constexpr int KVR = 4096 + 4 * 2304;
constexpr float LOG2E = 1.4426950408889634f;
constexpr float ALPHA = 1.681792830507429f;
constexpr float MLA_QS = 0.07216878364870323f * LOG2E;
constexpr float NA_QS = 0.125f * LOG2E;
constexpr int SMEM_BYTES = 81920;
constexpr int NPHASE = 22;

constexpr size_t OUT_YS = 4194304, OUT_CKV = 12582912, OUT_KR = 13631488, OUT_NAK = 13893632, OUT_NAV = 18087936;

struct MatDesc { const float* src; u16* dst; int K, Nsrc, Ndst, tile0; };

struct Params {
  const float *x_prompt, *x_sample, *cache_ckv, *cache_kr, *cache_nak, *cache_nav, *c, *c_ctx, *ada_w, *ada_b, *ln_g, *ln_b;
  const float *pool_scale, *mla_q_norm, *mla_kv_norm, *na_rpb;
  float* out;
  float* mod;
  u16 *H, *SZ;
  u16 *Wpin, *Wgrp, *Wpout, *Wmin, *Wuq, *Wukv, *Wmout, *Wnin, *Wnout;
  u16 *U, *MIX, *PM;
  float* RAW; u16 *AO, *CQN, *CKVN, *KR, *Q, *KN, *VT;
  u16 *NQ, *NK, *NVT, *NAO;
  unsigned* bar;
  MatDesc mats[18];
  int nmat_tiles; int pad0;
};

DI float bf2f(u16 v) { return __uint_as_float(((uint32_t)v) << 16); }
typedef __attribute__((ext_vector_type(2))) float f32x2;
typedef __attribute__((ext_vector_type(2))) __bf16 bf16x2_t;
DI uint32_t pk2(float a, float b) { f32x2 v = {a, b}; return __builtin_bit_cast(uint32_t, __builtin_convertvector(v, bf16x2_t)); }
DI u16 f2bf(float x) { return (u16)(pk2(x, x) & 0xffffu); }
DI float silu(float v) { return v / (1.f + __expf(-v)); }
DI int cond_of(int t) { return t < TC ? 0 : 1 + ((t - TC) >> 11); }
DI int kvrow_of(int t) { return t < TC ? t : TC + ((t - TC) >> 11) * 2304 + 256 + ((t - TC) & 2047); }
DI int perm16(int key) { const int k = key & 15; return (key & ~15) | (k & 3) | ((k >> 1) & 4) | ((k << 1) & 8); }
DI float wave_sum(float v) {
#pragma unroll
  for (int o = 32; o >= 1; o >>= 1) v += __shfl_xor(v, o);
  return v;
}

#define XB_TMO      128
#define XB_XCNT(j)  (256  + 64 * (j))
#define XB_XSUB(j)  (1280 + 64 * (j))
#define XB_XGEN(j)  (2304 + 64 * (j))
#define XB_TOP      3328
#define XB_TOPGEN   3392
#define XCD_BAR_WORDS 3456
#define XB_SPIN_CAP (1u << 22)
#define LAS __attribute__((address_space(3)))
DI unsigned xb_ld(unsigned* p) { return __hip_atomic_load(p, __ATOMIC_RELAXED, __HIP_MEMORY_SCOPE_AGENT); }
DI unsigned xb_add(unsigned* p, unsigned v) { return __hip_atomic_fetch_add(p, v, __ATOMIC_RELAXED, __HIP_MEMORY_SCOPE_AGENT); }
DI unsigned xb_xcc_id() { return (unsigned)__builtin_amdgcn_s_getreg((3 << 11) | 20) & 0xFu; }
#define XB_SPIN(cond, bar) do { unsigned _sp = 0; while (cond) { __builtin_amdgcn_s_sleep(1); \
    if ((++_sp & 255u) == 0u) { if (xb_ld(&(bar)[XB_TMO])) break; if (_sp > XB_SPIN_CAP) { atomicAdd(&(bar)[XB_TMO], 1u); break; } } } } while (0)
struct XcdBarrier { unsigned* bar; unsigned x; unsigned nloc, nx; };
DI XcdBarrier xcd_barrier_post(unsigned* bar) {
  XcdBarrier b; b.bar = bar; b.x = xb_xcc_id(); b.nloc = 0u; b.nx = 0u;
  if (threadIdx.x == 0) (void)xb_add(&bar[XB_XCNT(b.x)], 1u);
  return b;
}
DI void xcd_barrier_complete(unsigned* bar, unsigned x, unsigned& nloc, unsigned& nx) {
  const unsigned G = gridDim.x * gridDim.y * gridDim.z;
  unsigned sum, cnt, mine, sp = 0u;
  for (;;) {
    sum = 0u; cnt = 0u; mine = 0u;
#pragma unroll
    for (unsigned j = 0; j < 16; ++j) { const unsigned c = xb_ld(&bar[XB_XCNT(j)]); sum += c; cnt += (c > 0u) ? 1u : 0u; mine = (j == x) ? c : mine; }
    if (sum == G) break;
    __builtin_amdgcn_s_sleep(1);
    if ((++sp & 255u) == 0u) { if (xb_ld(&bar[XB_TMO])) break; if (sp > XB_SPIN_CAP) { atomicAdd(&bar[XB_TMO], 1u); break; } }
  }
  nloc = mine > 0u ? mine : 1u; nx = cnt > 0u ? cnt : 1u;
}
DI void xcd_barrier(XcdBarrier& b) {
  asm volatile("s_waitcnt vmcnt(0)" ::: "memory");
  __syncthreads();
  unsigned nloc = b.nloc, nx = b.nx;
  if (threadIdx.x == 0) {
    unsigned* bar = b.bar;
    __builtin_amdgcn_s_waitcnt(0);
    if (nloc == 0u) { xcd_barrier_complete(bar, b.x, nloc, nx); }
    const unsigned old = xb_add(&bar[XB_XSUB(b.x)], 1u);
    const unsigned gen = old / nloc;
    if (old + 1u == (gen + 1u) * nloc) {
      __builtin_amdgcn_fence(__ATOMIC_RELEASE, "agent");
      asm volatile("s_waitcnt vmcnt(0)" ::: "memory");
      const unsigned og = xb_add(&bar[XB_TOP], 1u);
      const unsigned tg = og / nx;
      if (og + 1u == (tg + 1u) * nx) xb_add(&bar[XB_TOPGEN], 1u);
      else XB_SPIN(xb_ld(&bar[XB_TOPGEN]) == tg, bar);
      __builtin_amdgcn_fence(__ATOMIC_ACQUIRE, "agent");
      xb_add(&bar[XB_XGEN(b.x)], 1u);
      asm volatile("s_waitcnt vmcnt(0)" ::: "memory");
    } else {
      XB_SPIN(xb_ld(&bar[XB_XGEN(b.x)]) == gen, bar);
      __builtin_amdgcn_fence(__ATOMIC_ACQUIRE, "agent");
      asm volatile("s_waitcnt vmcnt(0)" ::: "memory");
    }
  }
  if (threadIdx.x < 64) { b.nloc = __builtin_amdgcn_readfirstlane(nloc); b.nx = __builtin_amdgcn_readfirstlane(nx); }
  __syncthreads();
}

template <int MI, class Epi>
DI void gemm_tile(const u16* __restrict__ A, int lda, const u16* __restrict__ Bt, int ldb, int K, int m0, int n0, int nout_off,
                  char* smem, const Epi& epi) {
  constexpr int BM = 64 * MI, ASTG = BM * 128, NG = 2 * MI + 4;
  const int tid = threadIdx.x, lane = tid & 63, wid = tid >> 6;
  const int wm = wid >> 1, wn = wid & 1, l31 = lane & 31, lh = lane >> 5;
  char* As = smem;
  char* Bs = smem + 2 * ASTG;
  const int srow = tid >> 3;
  const int scc = ((tid & 7) ^ ((tid >> 4) & 7)) * 8;
  const u16* ag = A + (size_t)(m0 + srow) * lda + scc;
  const u16* bg = Bt + (size_t)(n0 + srow) * ldb + scc;
  LAS char* awr = (LAS char*)(As + wid * 1024);
  LAS char* bwr = (LAS char*)(Bs + wid * 1024);
  f32x16 acc[MI][2];
#pragma unroll
  for (int i = 0; i < MI; i++)
#pragma unroll
    for (int j = 0; j < 2; j++)
#pragma unroll
      for (int r = 0; r < 16; r++) acc[i][j][r] = 0.f;
  const int nk = K >> 6;
  __syncthreads();
#pragma unroll
  for (int t = 0; t < 2; t++) {
#pragma unroll
    for (int i = 0; i < 2 * MI; i++)
      __builtin_amdgcn_global_load_lds((const void*)(ag + (size_t)(32 * i) * lda + t * 64), (LAS void*)(awr + t * ASTG + i * 4096), 16, 0, 0);
#pragma unroll
    for (int i = 0; i < 4; i++)
      __builtin_amdgcn_global_load_lds((const void*)(bg + (size_t)(32 * i) * ldb + t * 64), (LAS void*)(bwr + t * 16384 + i * 4096), 16, 0, 0);
  }
  const int sw = (l31 >> 1) & 7;
  for (int kt = 0; kt < nk; kt++) {
    const int buf = kt & 1;
    if (kt + 1 < nk) asm volatile("s_waitcnt vmcnt(%0)" :: "n"(NG) : "memory");
    else asm volatile("s_waitcnt vmcnt(0)" ::: "memory");
    __builtin_amdgcn_s_barrier();
    const char* as = As + buf * ASTG + (wm * (32 * MI) + l31) * 128;
    const char* bs = Bs + buf * 16384 + (wn * 64 + l31) * 128;
    bf16x8 fa[4][MI], fb[4][2];
#pragma unroll
    for (int ks = 0; ks < 4; ks++) {
      const int co = ((2 * ks + lh) ^ sw) << 4;
      fb[ks][0] = *(const bf16x8*)(bs + co);
      fb[ks][1] = *(const bf16x8*)(bs + 32 * 128 + co);
#pragma unroll
      for (int i = 0; i < MI; i++) fa[ks][i] = *(const bf16x8*)(as + i * 32 * 128 + co);
    }
    asm volatile("s_waitcnt lgkmcnt(0)" ::: "memory");
    __builtin_amdgcn_s_barrier();
    if (kt + 2 < nk) {
#pragma unroll
      for (int i = 0; i < 2 * MI; i++)
        __builtin_amdgcn_global_load_lds((const void*)(ag + (size_t)(32 * i) * lda + (kt + 2) * 64), (LAS void*)(awr + buf * ASTG + i * 4096), 16, 0, 0);
#pragma unroll
      for (int i = 0; i < 4; i++)
        __builtin_amdgcn_global_load_lds((const void*)(bg + (size_t)(32 * i) * ldb + (kt + 2) * 64), (LAS void*)(bwr + buf * 16384 + i * 4096), 16, 0, 0);
    }
#pragma unroll
    for (int ks = 0; ks < 4; ks++)
#pragma unroll
      for (int i = 0; i < MI; i++) {
        acc[i][0] = MFMA32(fb[ks][0], fa[ks][i], acc[i][0]);
        acc[i][1] = MFMA32(fb[ks][1], fa[ks][i], acc[i][1]);
      }
  }
#pragma unroll
  for (int i = 0; i < MI; i++)
#pragma unroll
    for (int j = 0; j < 2; j++)
      epi(m0 + wm * (32 * MI) + i * 32 + l31, nout_off + n0 + wn * 64 + j * 32, lh, acc[i][j]);
}

DI void rope_pair(float x1, float x2, int i, float pos, float& o1, float& o2) {
  const float inv = exp2f(-(float)i * (13.287712379549449f / 16.f));
  const float ang = pos * inv;
  const float c = __cosf(ang), s = __sinf(ang);
  o1 = x1 * c - x2 * s;
  o2 = x1 * s + x2 * c;
}

struct EpiPoolG1 {
  u16 *U, *SZ;
  DI void operator()(int m, int nb, int lh, const f32x16& a) const {
#pragma unroll
    for (int g = 0; g < 4; g++) {
      const int n = nb + 8 * g + 4 * lh;
      if (nb < 1024) {
        uint2 v; v.x = pk2(a[4 * g], a[4 * g + 1]); v.y = pk2(a[4 * g + 2], a[4 * g + 3]);
        *(uint2*)(U + (size_t)m * 1024 + n) = v;
      } else {
        uint2 v; v.x = pk2(silu(a[4 * g]), silu(a[4 * g + 1])); v.y = pk2(silu(a[4 * g + 2]), silu(a[4 * g + 3]));
        *(uint2*)(SZ + (size_t)m * 1024 + n - 1024) = v;
      }
    }
  }
};
struct EpiPoolG2 {
  u16* PM; const u16* SZ; const float* scale;
  DI void operator()(int m, int nb, int lh, const f32x16& a) const {
#pragma unroll
    for (int g = 0; g < 4; g++) {
      const int n = nb + 8 * g + 4 * lh;
      const uint2 z = *(const uint2*)(SZ + (size_t)m * 1024 + n);
      const float4 sc = *(const float4*)(scale + n);
      uint2 v;
      v.x = pk2(a[4 * g] * sc.x * bf2f((u16)(z.x & 0xffff)), a[4 * g + 1] * sc.y * bf2f((u16)(z.x >> 16)));
      v.y = pk2(a[4 * g + 2] * sc.z * bf2f((u16)(z.y & 0xffff)), a[4 * g + 3] * sc.w * bf2f((u16)(z.y >> 16)));
      *(uint2*)(PM + (size_t)m * 1024 + n) = v;
    }
  }
};
struct EpiG3 {
  const float *xp, *xs;
  float* out; const float* mod_layer;
  DI void operator()(int m, int nb, int lh, const f32x16& a) const {
    const float* xr = (m < TC) ? xp + (size_t)m * 1024 : xs + (size_t)(m - TC) * 1024;
    const float* gate = mod_layer + cond_of(m) * 3072 + 2048;
#pragma unroll
    for (int g = 0; g < 4; g++) {
      const int n = nb + 8 * g + 4 * lh;
      const float4 x = *(const float4*)(xr + n);
      const float4 gt = *(const float4*)(gate + n);
      float4 r;
      r.x = ALPHA * x.x + gt.x * a[4 * g]; r.y = ALPHA * x.y + gt.y * a[4 * g + 1];
      r.z = ALPHA * x.z + gt.z * a[4 * g + 2]; r.w = ALPHA * x.w + gt.w * a[4 * g + 3];
      *(float4*)(out + (size_t)m * 1024 + n) = r;
    }
  }
};
struct EpiMlaG1 {
  float* RAW; u16* KR; u16* SZ; float* st_kr;
  DI void operator()(int m, int nb, int lh, const f32x16& a) const {
    if (nb >= 1856) return;
    if (nb < 768) {
#pragma unroll
      for (int g = 0; g < 4; g++) {
        const int n = nb + 8 * g + 4 * lh;
        float4 r; r.x = a[4 * g]; r.y = a[4 * g + 1]; r.z = a[4 * g + 2]; r.w = a[4 * g + 3];
        *(float4*)(RAW + (size_t)m * 768 + n) = r;
      }
    } else if (nb < 832) {
      const int off = nb - 768;
      const bool lat = m >= TC;
      const int tt = (m - TC) & 2047;
      const float pos = (off == 0) ? (float)(tt >> 6) : (float)(tt & 63);
      const size_t kr = (size_t)kvrow_of(m) * 64 + off;
#pragma unroll
      for (int g = 0; g < 2; g++) {
        float o1[4], o2[4];
#pragma unroll
        for (int e = 0; e < 4; e++) {
          const int i = 8 * g + 4 * lh + e;
          const float x1 = a[4 * g + e], x2 = a[4 * (g + 2) + e];
          if (lat) rope_pair(x1, x2, i, pos, o1[e], o2[e]); else { o1[e] = x1; o2[e] = x2; }
        }
        const int i0 = 8 * g + 4 * lh;
        if (!lat) {
          float4 r1; r1.x = o1[0]; r1.y = o1[1]; r1.z = o1[2]; r1.w = o1[3];
          float4 r2; r2.x = o2[0]; r2.y = o2[1]; r2.z = o2[2]; r2.w = o2[3];
          *(float4*)(st_kr + (size_t)m * 64 + off + i0) = r1;
          *(float4*)(st_kr + (size_t)m * 64 + off + i0 + 16) = r2;
        }
        uint2 v1; v1.x = pk2(o1[0], o1[1]); v1.y = pk2(o1[2], o1[3]);
        uint2 v2; v2.x = pk2(o2[0], o2[1]); v2.y = pk2(o2[2], o2[3]);
        *(uint2*)(KR + kr + i0) = v1;
        *(uint2*)(KR + kr + i0 + 16) = v2;
      }
    } else {
#pragma unroll
      for (int g = 0; g < 4; g++) {
        const int n = nb + 8 * g + 4 * lh - 832;
        uint2 v; v.x = pk2(silu(a[4 * g]), silu(a[4 * g + 1])); v.y = pk2(silu(a[4 * g + 2]), silu(a[4 * g + 3]));
        *(uint2*)(SZ + (size_t)m * 1024 + n) = v;
      }
    }
  }
};
struct EpiMlaQ {
  u16* Q;
  DI void operator()(int m, int nb, int lh, const f32x16& a) const {
    const int head = nb / 192, off = nb - head * 192;
    u16* qr = Q + (size_t)m * 1536 + nb;
    if (off < 128) {
#pragma unroll
      for (int g = 0; g < 4; g++) {
        uint2 v; v.x = pk2(a[4 * g] * MLA_QS, a[4 * g + 1] * MLA_QS); v.y = pk2(a[4 * g + 2] * MLA_QS, a[4 * g + 3] * MLA_QS);
        *(uint2*)(qr + 8 * g + 4 * lh) = v;
      }
    } else {
      const bool lat = m >= TC;
      const int tt = (m - TC) & 2047;
      const float pos = (off == 128) ? (float)(tt >> 6) : (float)(tt & 63);
#pragma unroll
      for (int g = 0; g < 2; g++) {
        float o1[4], o2[4];
#pragma unroll
        for (int e = 0; e < 4; e++) {
          const int i = 8 * g + 4 * lh + e;
          const float x1 = a[4 * g + e], x2 = a[4 * (g + 2) + e];
          if (lat) rope_pair(x1, x2, i, pos, o1[e], o2[e]); else { o1[e] = x1; o2[e] = x2; }
        }
        const int i0 = 8 * g + 4 * lh;
        uint2 v1; v1.x = pk2(o1[0] * MLA_QS, o1[1] * MLA_QS); v1.y = pk2(o1[2] * MLA_QS, o1[3] * MLA_QS);
        uint2 v2; v2.x = pk2(o2[0] * MLA_QS, o2[1] * MLA_QS); v2.y = pk2(o2[2] * MLA_QS, o2[3] * MLA_QS);
        *(uint2*)(qr + i0) = v1;
        *(uint2*)(qr + i0 + 16) = v2;
      }
    }
  }
};
struct EpiMlaKV {
  u16 *KN, *VT;
  DI void operator()(int m, int nb, int lh, const f32x16& a) const {
    const int head = nb >> 8, off = nb & 255;
    if (off < 128) {
#pragma unroll
      for (int g = 0; g < 4; g++) {
        uint2 v; v.x = pk2(a[4 * g], a[4 * g + 1]); v.y = pk2(a[4 * g + 2], a[4 * g + 3]);
        *(uint2*)(KN + (size_t)m * 1024 + head * 128 + off + 8 * g + 4 * lh) = v;
      }
    } else {
      size_t base; int Lk, key;
      if (m < TC) { base = (size_t)(m >> 8) * (8 * 128 * 256); Lk = 256; key = m & 255; }
      else { const int r2 = m - TC; const int b = r2 / 2304; key = r2 - b * 2304; Lk = 2304; base = (size_t)16 * 8 * 128 * 256 + (size_t)b * (8 * 128 * 2304); }
      u16* vp = VT + base + (size_t)(head * 128 + off - 128) * Lk + perm16(key);
#pragma unroll
      for (int g = 0; g < 4; g++)
#pragma unroll
        for (int e = 0; e < 4; e++) vp[(size_t)(8 * g + 4 * lh + e) * Lk] = f2bf(a[4 * g + e]);
    }
  }
};
struct EpiNaG1 {
  u16 *NQ, *NK, *NVT, *SZ; float *st_k, *st_v;
  DI void operator()(int m, int nb, int lh, const f32x16& a) const {
    if (nb < 1024) {
#pragma unroll
      for (int g = 0; g < 4; g++) {
        uint2 v; v.x = pk2(a[4 * g] * NA_QS, a[4 * g + 1] * NA_QS); v.y = pk2(a[4 * g + 2] * NA_QS, a[4 * g + 3] * NA_QS);
        *(uint2*)(NQ + (size_t)m * 1024 + nb + 8 * g + 4 * lh) = v;
      }
    } else if (nb < 2048) {
      const size_t kr = (size_t)kvrow_of(m) * 1024 + (nb - 1024);
#pragma unroll
      for (int g = 0; g < 4; g++) {
        uint2 v; v.x = pk2(a[4 * g], a[4 * g + 1]); v.y = pk2(a[4 * g + 2], a[4 * g + 3]);
        *(uint2*)(NK + kr + 8 * g + 4 * lh) = v;
        if (m < TC) { float4 r; r.x = a[4 * g]; r.y = a[4 * g + 1]; r.z = a[4 * g + 2]; r.w = a[4 * g + 3];
          *(float4*)(st_k + (size_t)m * 1024 + (nb - 1024) + 8 * g + 4 * lh) = r; }
      }
    } else if (nb < 3072) {
      const int c0 = nb - 2048;
      size_t base; int Lk, key;
      if (m < TC) { base = (size_t)(m >> 8) * (1024 * 256); Lk = 256; key = perm16(m & 255); }
      else { const int b = (m - TC) >> 11; key = 256 + ((m - TC) & 2047); Lk = 2304; base = (size_t)16 * 1024 * 256 + (size_t)b * (1024 * 2304); }
      u16* vp = NVT + base + (size_t)c0 * Lk + key;
#pragma unroll
      for (int g = 0; g < 4; g++) {
#pragma unroll
        for (int e = 0; e < 4; e++) vp[(size_t)(8 * g + 4 * lh + e) * Lk] = f2bf(a[4 * g + e]);
        if (m < TC) { float4 r; r.x = a[4 * g]; r.y = a[4 * g + 1]; r.z = a[4 * g + 2]; r.w = a[4 * g + 3];
          *(float4*)(st_v + (size_t)m * 1024 + c0 + 8 * g + 4 * lh) = r; }
      }
    } else {
#pragma unroll
      for (int g = 0; g < 4; g++) {
        uint2 v; v.x = pk2(silu(a[4 * g]), silu(a[4 * g + 1])); v.y = pk2(silu(a[4 * g + 2]), silu(a[4 * g + 3]));
        *(uint2*)(SZ + (size_t)m * 1024 + (nb - 3072) + 8 * g + 4 * lh) = v;
      }
    }
  }
};

template <int NSA, int NSB, int NDT>
DI void attn_dense_wave(const u16* __restrict__ qrow, const u16* __restrict__ kA, int kAstride, const u16* __restrict__ kB,
                        const u16* __restrict__ vt, int Lk, int nkeys, const u16* __restrict__ szrow, u16* __restrict__ orow) {
  const int lane = threadIdx.x & 63, l31 = lane & 31, lh = lane >> 5;
  bf16x8 qf[NSA + NSB];
#pragma unroll
  for (int s = 0; s < NSA + NSB; s++) qf[s] = *(const bf16x8*)(qrow + s * 16 + lh * 8);
  f32x16 o[NDT];
#pragma unroll
  for (int d = 0; d < NDT; d++)
#pragma unroll
    for (int r = 0; r < 16; r++) o[d][r] = 0.f;
  float m = -1e30f, l = 0.f;
  for (int k0 = 0; k0 < nkeys; k0 += 32) {
    f32x16 sa;
#pragma unroll
    for (int r = 0; r < 16; r++) sa[r] = 0.f;
    const u16* kp = kA + (size_t)(k0 + l31) * kAstride + lh * 8;
#pragma unroll
    for (int s = 0; s < NSA; s++) sa = MFMA32(*(const bf16x8*)(kp + s * 16), qf[s], sa);
    if (NSB > 0) {
      const u16* kp2 = kB + (size_t)(k0 + l31) * 64 + lh * 8;
#pragma unroll
      for (int s = 0; s < NSB; s++) sa = MFMA32(*(const bf16x8*)(kp2 + s * 16), qf[NSA + s], sa);
    }
    float mx = sa[0];
#pragma unroll
    for (int r = 1; r < 16; r++) mx = fmaxf(mx, sa[r]);
    mx = fmaxf(mx, __shfl_xor(mx, 32));
    const float mn = fmaxf(m, mx);
    const float alpha = __builtin_amdgcn_exp2f(m - mn);
    m = mn;
    float ps = 0.f;
#pragma unroll
    for (int r = 0; r < 16; r++) { sa[r] = exp2f(sa[r] - mn); ps += sa[r]; }
    l = l * alpha + ps;
#pragma unroll
    for (int d = 0; d < NDT; d++)
#pragma unroll
      for (int r = 0; r < 16; r++) o[d][r] *= alpha;
#pragma unroll
    for (int sp = 0; sp < 2; sp++) {
      u32x4 pw;
      pw[0] = pk2(sa[8 * sp + 0], sa[8 * sp + 1]); pw[1] = pk2(sa[8 * sp + 2], sa[8 * sp + 3]);
      pw[2] = pk2(sa[8 * sp + 4], sa[8 * sp + 5]); pw[3] = pk2(sa[8 * sp + 6], sa[8 * sp + 7]);
      const bf16x8 pf = __builtin_bit_cast(bf16x8, pw);
#pragma unroll
      for (int d = 0; d < NDT; d++) {
        const u16* vp = vt + (size_t)(d * 32 + l31) * Lk + k0 + 16 * sp + 4 * lh;
        const uint2 lo = *(const uint2*)vp, hi = *(const uint2*)(vp + 8);
        u32x4 vw; vw[0] = lo.x; vw[1] = lo.y; vw[2] = hi.x; vw[3] = hi.y;
        o[d] = MFMA32(__builtin_bit_cast(bf16x8, vw), pf, o[d]);
      }
    }
  }
  l += __shfl_xor(l, 32);
  const float inv = 1.f / l;
#pragma unroll
  for (int d = 0; d < NDT; d++)
#pragma unroll
    for (int g = 0; g < 4; g++) {
      const int d0 = d * 32 + 8 * g + 4 * lh;
      const uint2 z = *(const uint2*)(szrow + d0);
      uint2 v;
      v.x = pk2(o[d][4 * g] * inv * bf2f((u16)(z.x & 0xffff)), o[d][4 * g + 1] * inv * bf2f((u16)(z.x >> 16)));
      v.y = pk2(o[d][4 * g + 2] * inv * bf2f((u16)(z.y & 0xffff)), o[d][4 * g + 3] * inv * bf2f((u16)(z.y >> 16)));
      *(uint2*)(orow + d0) = v;
    }
}


template <int NSA, int NSB, int NDT>
DI void attn_dense_block(char* smem, const u16* __restrict__ qrow, const u16* __restrict__ kA, int kAstride, const u16* __restrict__ kB,
                         const u16* __restrict__ vt, int Lk, int nkeys, const u16* __restrict__ szrow, u16* __restrict__ orow) {
  constexpr int NS = NSA + NSB, DV = 32 * NDT, CA = NSA * 2;
  constexpr int KN_B = 64 * CA * 16, KR_B = (NSB > 0) ? 64 * 128 : 0, V_B = DV * 128, STG = KN_B + KR_B + V_B;
  constexpr int NLA = 64 * CA / 256, NLB = (NSB > 0) ? 2 : 0, NLV = DV * 8 / 256;
  const int tid = threadIdx.x, lane = tid & 63, wid = tid >> 6, l31 = lane & 31, lh = lane >> 5;
  const int arow = (CA == 16) ? (tid >> 4) : (tid >> 3);
  const int acc_ = (CA == 16) ? ((tid & 15) ^ ((tid >> 4) & 15)) : ((tid & 7) ^ ((tid >> 4) & 7));
  const int brow = tid >> 3, bcc = (tid & 7) ^ ((tid >> 4) & 7);
  const u16* ka_src = kA + (size_t)arow * kAstride + acc_ * 8;
  const u16* kb_src = (NSB > 0) ? (kB + (size_t)brow * 64 + bcc * 8) : kA;
  const u16* v_src = vt + (size_t)brow * Lk + bcc * 8;
  LAS char* wbase = (LAS char*)(smem + wid * 1024);
  bf16x8 qf[NS];
#pragma unroll
  for (int s = 0; s < NS; s++) qf[s] = *(const bf16x8*)(qrow + s * 16 + lh * 8);
  f32x16 o[NDT];
#pragma unroll
  for (int d = 0; d < NDT; d++)
#pragma unroll
    for (int r = 0; r < 16; r++) o[d][r] = 0.f;
  float m = -1e30f, l = 0.f;
  const int swA = (CA == 16) ? (l31 & 15) : ((l31 >> 1) & 7);
  const int swB = (l31 >> 1) & 7;

  __syncthreads();
#pragma unroll
  for (int i = 0; i < NLA; i++)
    __builtin_amdgcn_global_load_lds((const void*)(ka_src + (size_t)(i * (256 / CA)) * kAstride), (LAS void*)(wbase + i * 4096), 16, 0, 0);
#pragma unroll
  for (int i = 0; i < NLB; i++)
    __builtin_amdgcn_global_load_lds((const void*)(kb_src + (size_t)(32 * i) * 64), (LAS void*)(wbase + KN_B + i * 4096), 16, 0, 0);
#pragma unroll
  for (int i = 0; i < NLV; i++)
    __builtin_amdgcn_global_load_lds((const void*)(v_src + (size_t)(32 * i) * Lk), (LAS void*)(wbase + KN_B + KR_B + i * 4096), 16, 0, 0);
  asm volatile("s_waitcnt vmcnt(0)" ::: "memory");
  __syncthreads();
  int st = 0;
  for (int k0 = 0; k0 < nkeys; k0 += 64, st ^= 1) {
    if (k0 + 64 < nkeys) {
      const int kn = k0 + 64;
      LAS char* wb = wbase + (st ^ 1) * STG;
#pragma unroll
      for (int i = 0; i < NLA; i++)
        __builtin_amdgcn_global_load_lds((const void*)(ka_src + (size_t)(kn + i * (256 / CA)) * kAstride), (LAS void*)(wb + i * 4096), 16, 0, 0);
#pragma unroll
      for (int i = 0; i < NLB; i++)
        __builtin_amdgcn_global_load_lds((const void*)(kb_src + (size_t)(kn + 32 * i) * 64), (LAS void*)(wb + KN_B + i * 4096), 16, 0, 0);
#pragma unroll
      for (int i = 0; i < NLV; i++)
        __builtin_amdgcn_global_load_lds((const void*)(v_src + (size_t)(32 * i) * Lk + kn), (LAS void*)(wb + KN_B + KR_B + i * 4096), 16, 0, 0);
    }
    const char* Kn = smem + st * STG;
    const char* Kr = Kn + KN_B;
    const char* Vs = Kr + KR_B;
#pragma unroll 1
    for (int hh = 0; hh < 2; hh++) {
      f32x16 s0;
#pragma unroll
      for (int r = 0; r < 16; r++) s0[r] = 0.f;
      const char* kpa = Kn + (hh * 32 + l31) * (CA * 16);
#pragma unroll
      for (int s = 0; s < NSA; s++) s0 = MFMA32(*(const bf16x8*)(kpa + (((2 * s + lh) ^ swA) << 4)), qf[s], s0);
      if constexpr (NSB > 0) {
        const char* kpb = Kr + (hh * 32 + l31) * 128;
#pragma unroll
        for (int s = 0; s < NSB; s++) s0 = MFMA32(*(const bf16x8*)(kpb + (((2 * s + lh) ^ swB) << 4)), qf[NSA + s], s0);
      }
      float mx = s0[0];
#pragma unroll
      for (int r = 1; r < 16; r++) mx = fmaxf(mx, s0[r]);
      mx = fmaxf(mx, __shfl_xor(mx, 32));
      if (__any(mx > m + 8.f)) {
        const float mn = fmaxf(m, mx);
        const float alpha = __builtin_amdgcn_exp2f(m - mn);
        m = mn;
        l *= alpha;
#pragma unroll
        for (int d = 0; d < NDT; d++)
#pragma unroll
          for (int r = 0; r < 16; r++) o[d][r] *= alpha;
      }
      float ps = 0.f;
#pragma unroll
      for (int r = 0; r < 16; r++) { s0[r] = __builtin_amdgcn_exp2f(s0[r] - m); ps += s0[r]; }
      l += ps;
      const char* vp = Vs + l31 * 128;
#pragma unroll
      for (int sp = 0; sp < 2; sp++) {
        u32x4 pw;
        pw[0] = pk2(s0[8 * sp + 0], s0[8 * sp + 1]); pw[1] = pk2(s0[8 * sp + 2], s0[8 * sp + 3]);
        pw[2] = pk2(s0[8 * sp + 4], s0[8 * sp + 5]); pw[3] = pk2(s0[8 * sp + 6], s0[8 * sp + 7]);
        const bf16x8 pf = __builtin_bit_cast(bf16x8, pw);
        const int vo = ((hh * 4 + sp * 2 + lh) ^ swB) << 4;
#pragma unroll
        for (int d = 0; d < NDT; d++) o[d] = MFMA32(*(const bf16x8*)(vp + d * 32 * 128 + vo), pf, o[d]);
      }
    }
    asm volatile("s_waitcnt vmcnt(0)" ::: "memory");
    __syncthreads();
  }
  l += __shfl_xor(l, 32);
  const float inv = 1.f / l;
#pragma unroll
  for (int d = 0; d < NDT; d++)
#pragma unroll
    for (int g = 0; g < 4; g++) {
      const int d0 = d * 32 + 8 * g + 4 * lh;
      const uint2 z = *(const uint2*)(szrow + d0);
      uint2 v;
      v.x = pk2(o[d][4 * g] * inv * bf2f((u16)(z.x & 0xffff)), o[d][4 * g + 1] * inv * bf2f((u16)(z.x >> 16)));
      v.y = pk2(o[d][4 * g + 2] * inv * bf2f((u16)(z.y & 0xffff)), o[d][4 * g + 3] * inv * bf2f((u16)(z.y >> 16)));
      *(uint2*)(orow + d0) = v;
    }
}

DI void attn_na_wave(const Params& p, int b, int h, int r, int j) {
  const int lane = threadIdx.x & 63, l15 = lane & 15, q4 = lane >> 4;
  const int t = TC + b * 2048 + r * 64 + j * 16 + l15;
  const u16* qrow = p.NQ + (size_t)t * 1024 + h * 64;
  const bf16x8 qf0 = *(const bf16x8*)(qrow + q4 * 8);
  const bf16x8 qf1 = *(const bf16x8*)(qrow + 32 + q4 * 8);
  const int rs = min(max(r - 4, 0), 24);
  const int bstart = min(max(j * 16 - 8, 0), 32);
  const int c = j * 16 + l15;
  const int cstart = min(max(c - 8, 0), 48);
  const u16* kb = p.NK + (size_t)(TC + b * 2304) * 1024 + h * 64;
  const u16* vb = p.NVT + (size_t)16 * 1024 * 256 + (size_t)b * (1024 * 2304) + (size_t)(h * 64) * 2304;
  const float* rp = p.na_rpb + h * 465;
  f32x4 o[4];
#pragma unroll
  for (int d = 0; d < 4; d++) { o[d][0] = 0.f; o[d][1] = 0.f; o[d][2] = 0.f; o[d][3] = 0.f; }
  float m = -1e30f, l = 0.f;
  const int krow0 = 8 * (l15 >> 2) + (l15 & 3);
  for (int cg4 = 0; cg4 < 4; cg4++) {
    bf16x8 kf[4][4];
    bf16x8 vf[4][4];
#pragma unroll
    for (int c4 = 0; c4 < 4; c4++) {
      const int ch = cg4 * 4 + c4;
      const int key0 = ch < 8 ? ch * 32 : 256 + (rs + ch - 8) * 64 + bstart;
      const u16* kp = kb + (size_t)(key0 + krow0) * 1024 + q4 * 8;
      kf[c4][0] = *(const bf16x8*)(kp);
      kf[c4][1] = *(const bf16x8*)(kp + 32);
      kf[c4][2] = *(const bf16x8*)(kp + 4 * 1024);
      kf[c4][3] = *(const bf16x8*)(kp + 4 * 1024 + 32);
#pragma unroll
      for (int d = 0; d < 4; d++) vf[c4][d] = *(const bf16x8*)(vb + (size_t)(d * 16 + l15) * 2304 + key0 + q4 * 8);
    }
#pragma unroll
    for (int c4 = 0; c4 < 4; c4++) {
      const int ch = cg4 * 4 + c4;
      f32x4 s0 = {0.f, 0.f, 0.f, 0.f}, s1 = {0.f, 0.f, 0.f, 0.f};
      s0 = MFMA16(kf[c4][0], qf0, s0);
      s0 = MFMA16(kf[c4][1], qf1, s0);
      s1 = MFMA16(kf[c4][2], qf0, s1);
      s1 = MFMA16(kf[c4][3], qf1, s1);
      if (cg4 >= 2) {
        const int dr = rs + (ch - 8) - r + 7;
#pragma unroll
        for (int i = 0; i < 4; i++) {
          const int kc0 = bstart + q4 * 8 + i, kc1 = kc0 + 4;
          const bool v0 = (kc0 >= cstart) && (kc0 < cstart + 16);
          const bool v1 = (kc1 >= cstart) && (kc1 < cstart + 16);
          const int dc0 = min(max(kc0 - c + 15, 0), 30), dc1 = min(max(kc1 - c + 15, 0), 30);
          const float b0 = rp[dr * 31 + dc0] * LOG2E, b1 = rp[dr * 31 + dc1] * LOG2E;
          s0[i] = v0 ? s0[i] + b0 : -1e30f;
          s1[i] = v1 ? s1[i] + b1 : -1e30f;
        }
      }
      float mx = fmaxf(fmaxf(fmaxf(s0[0], s0[1]), fmaxf(s0[2], s0[3])), fmaxf(fmaxf(s1[0], s1[1]), fmaxf(s1[2], s1[3])));
      mx = fmaxf(mx, __shfl_xor(mx, 16));
      mx = fmaxf(mx, __shfl_xor(mx, 32));
      const float mn = fmaxf(m, mx);
      const float alpha = __builtin_amdgcn_exp2f(m - mn);
      m = mn;
      float ps = 0.f;
#pragma unroll
      for (int i = 0; i < 4; i++) { s0[i] = exp2f(s0[i] - mn); s1[i] = exp2f(s1[i] - mn); ps += s0[i] + s1[i]; }
      l = l * alpha + ps;
      u32x4 pw; pw[0] = pk2(s0[0], s0[1]); pw[1] = pk2(s0[2], s0[3]); pw[2] = pk2(s1[0], s1[1]); pw[3] = pk2(s1[2], s1[3]);
      const bf16x8 pf = __builtin_bit_cast(bf16x8, pw);
#pragma unroll
      for (int d = 0; d < 4; d++) {
        o[d][0] *= alpha; o[d][1] *= alpha; o[d][2] *= alpha; o[d][3] *= alpha;
        o[d] = MFMA16(vf[c4][d], pf, o[d]);
      }
    }
  }
  l += __shfl_xor(l, 16);
  l += __shfl_xor(l, 32);
  const float inv = 1.f / l;
  const u16* szrow = p.SZ + (size_t)t * 1024 + h * 64;
  u16* orow = p.NAO + (size_t)t * 1024 + h * 64;
#pragma unroll
  for (int d = 0; d < 4; d++) {
    const int d0 = d * 16 + q4 * 4;
    const uint2 z = *(const uint2*)(szrow + d0);
    uint2 v;
    v.x = pk2(o[d][0] * inv * bf2f((u16)(z.x & 0xffff)), o[d][1] * inv * bf2f((u16)(z.x >> 16)));
    v.y = pk2(o[d][2] * inv * bf2f((u16)(z.y & 0xffff)), o[d][3] * inv * bf2f((u16)(z.y >> 16)));
    *(uint2*)(orow + d0) = v;
  }
}


DI void attn_na_block(const Params& p, char* smem, int b, int h, int rpair) {
  const int tid = threadIdx.x, lane = tid & 63, j = tid >> 6, l31 = lane & 31, lh = lane >> 5;
  float* bl = (float*)(smem + 65536);
  const int r0 = rpair * 2;
  const int qr = r0 + (l31 >> 4), c = j * 16 + (l31 & 15);
  const int t = TC + b * 2048 + qr * 64 + c;
  const int rsq = min(max(qr - 4, 0), 24);
  const int rs0 = min(max(r0 - 4, 0), 24);
  const int nrows = min(max(r0 + 1 - 4, 0), 24) + 8 - rs0;
  const int ntile = 4 + nrows;
  const int bstart = min(max(j * 16 - 8, 0), 32);
  const int cstart = min(max(c - 8, 0), 48);
  const u16* kb = p.NK + (size_t)(TC + b * 2304) * 1024 + h * 64;
  const u16* vb = p.NVT + (size_t)16 * 1024 * 256 + (size_t)b * (1024 * 2304) + (size_t)(h * 64) * 2304;
  const u16* qrow = p.NQ + (size_t)t * 1024 + h * 64;
  bf16x8 qf[4];
#pragma unroll
  for (int s = 0; s < 4; s++) qf[s] = *(const bf16x8*)(qrow + s * 16 + lh * 8);
  f32x16 o[2];
#pragma unroll
  for (int d = 0; d < 2; d++)
#pragma unroll
    for (int r = 0; r < 16; r++) o[d][r] = 0.f;
  float m = -1e30f, l = 0.f;
  const int r16 = l31 & 15;
  const int kap = (l31 & 16) + (r16 & 3) + 4 * ((r16 >> 3) & 1) + 8 * ((r16 >> 2) & 1);
  const int srow = tid >> 3, scc = ((tid & 7) ^ ((tid >> 4) & 7)) * 8;
  const u16* ksrc = kb + (size_t)srow * 1024 + scc;
  const u16* vsrc = vb + (size_t)srow * 2304 + scc;
  LAS char* wbase = (LAS char*)(smem + (tid >> 6) * 1024);
  const int swV = (l31 >> 1) & 7;
  __syncthreads();
  for (int idx = tid; idx < 1024; idx += 256) {
    const int dr = idx >> 6, off = (idx & 63) - 16;
    const float v = p.na_rpb[h * 465 + min(dr, 14) * 31 + min(max(off, 0), 30)] * LOG2E;
    bl[idx] = (dr == 15) ? -1e30f : ((off >= 0 && off < 31) ? v : 0.f);
  }
  float am[16];
#pragma unroll
  for (int i = 0; i < 16; i++) {
    const int kcol = bstart + 16 * (i >> 3) + 8 * lh + (i & 7);
    am[i] = ((kcol >= cstart) && (kcol < cstart + 16)) ? 0.f : -1e30f;
  }
  const int ab = 16 + bstart + 8 * lh - c + 15;
#pragma unroll
  for (int tl = 0; tl < 3; tl++) {
    const int key0 = tl * 64;
    LAS char* wb = wbase + tl * 16384;
    __builtin_amdgcn_global_load_lds((const void*)(ksrc + (size_t)key0 * 1024), (LAS void*)(wb), 16, 0, 0);
    __builtin_amdgcn_global_load_lds((const void*)(ksrc + (size_t)(key0 + 32) * 1024), (LAS void*)(wb + 4096), 16, 0, 0);
    __builtin_amdgcn_global_load_lds((const void*)(vsrc + key0), (LAS void*)(wb + 8192), 16, 0, 0);
    __builtin_amdgcn_global_load_lds((const void*)(vsrc + (size_t)32 * 2304 + key0), (LAS void*)(wb + 8192 + 4096), 16, 0, 0);
  }
  asm volatile("s_waitcnt vmcnt(8)" ::: "memory");
  asm volatile("s_waitcnt lgkmcnt(0)" ::: "memory");
  __builtin_amdgcn_s_barrier();
  for (int tl = 0; tl < ntile; tl++) {
    if (tl + 3 < ntile) {
      const int tn = tl + 3;
      const int key0 = tn < 4 ? tn * 64 : 256 + (rs0 + tn - 4) * 64;
      LAS char* wb = wbase + (tn & 3) * 16384;
      __builtin_amdgcn_global_load_lds((const void*)(ksrc + (size_t)key0 * 1024), (LAS void*)(wb), 16, 0, 0);
      __builtin_amdgcn_global_load_lds((const void*)(ksrc + (size_t)(key0 + 32) * 1024), (LAS void*)(wb + 4096), 16, 0, 0);
      __builtin_amdgcn_global_load_lds((const void*)(vsrc + key0), (LAS void*)(wb + 8192), 16, 0, 0);
      __builtin_amdgcn_global_load_lds((const void*)(vsrc + (size_t)32 * 2304 + key0), (LAS void*)(wb + 8192 + 4096), 16, 0, 0);
    }
    const char* Kc = smem + (tl & 3) * 16384;
    const char* Vc = Kc + 8192;
    const bool local = tl >= 4;
    const int gr = rs0 + tl - 4;
    const int nh = local ? 1 : 2;
    for (int hh = 0; hh < nh; hh++) {
      const int koff = local ? bstart : hh * 32;
      f32x16 s0;
#pragma unroll
      for (int r = 0; r < 16; r++) s0[r] = 0.f;
      const int krow = koff + kap;
      const char* kp = Kc + krow * 128;
      const int swK = (krow >> 1) & 7;
#pragma unroll
      for (int s = 0; s < 4; s++) s0 = MFMA32(*(const bf16x8*)(kp + (((2 * s + lh) ^ swK) << 4)), qf[s], s0);
      if (local) {
        const bool rowvalid = (gr >= rsq) && (gr < rsq + 8);
        const int dr = rowvalid ? min(max(gr - qr + 7, 0), 14) : 15;
        const float* bp = bl + dr * 64 + ab;
#pragma unroll
        for (int i = 0; i < 16; i++) s0[i] += bp[16 * (i >> 3) + (i & 7)] + am[i];
      }
      float mx = s0[0];
#pragma unroll
      for (int r = 1; r < 16; r++) mx = fmaxf(mx, s0[r]);
      mx = fmaxf(mx, __shfl_xor(mx, 32));
      if (__any(mx > m + 8.f)) {
        const float mn = fmaxf(m, mx);
        const float alpha = __builtin_amdgcn_exp2f(m - mn);
        m = mn;
        l *= alpha;
#pragma unroll
        for (int d = 0; d < 2; d++)
#pragma unroll
          for (int r = 0; r < 16; r++) o[d][r] *= alpha;
      }
      float ps = 0.f;
#pragma unroll
      for (int r = 0; r < 16; r++) { s0[r] = __builtin_amdgcn_exp2f(s0[r] - m); ps += s0[r]; }
      l += ps;
      const char* vp = Vc + l31 * 128;
      const int vch = (koff >> 3) + lh;
#pragma unroll
      for (int sp = 0; sp < 2; sp++) {
        u32x4 pw;
        pw[0] = pk2(s0[8 * sp + 0], s0[8 * sp + 1]); pw[1] = pk2(s0[8 * sp + 2], s0[8 * sp + 3]);
        pw[2] = pk2(s0[8 * sp + 4], s0[8 * sp + 5]); pw[3] = pk2(s0[8 * sp + 6], s0[8 * sp + 7]);
        const bf16x8 pf = __builtin_bit_cast(bf16x8, pw);
        const int vo = ((vch + 2 * sp) ^ swV) << 4;
#pragma unroll
        for (int d = 0; d < 2; d++) o[d] = MFMA32(*(const bf16x8*)(vp + d * 32 * 128 + vo), pf, o[d]);
      }
    }
    if (tl + 3 < ntile) asm volatile("s_waitcnt vmcnt(8)" ::: "memory");
    else if (tl + 2 < ntile) asm volatile("s_waitcnt vmcnt(4)" ::: "memory");
    else asm volatile("s_waitcnt vmcnt(0)" ::: "memory");
    asm volatile("s_waitcnt lgkmcnt(0)" ::: "memory");
    __builtin_amdgcn_s_barrier();
  }
  l += __shfl_xor(l, 32);
  const float inv = 1.f / l;
  const u16* szrow = p.SZ + (size_t)t * 1024 + h * 64;
  u16* orow = p.NAO + (size_t)t * 1024 + h * 64;
#pragma unroll
  for (int d = 0; d < 2; d++)
#pragma unroll
    for (int g = 0; g < 4; g++) {
      const int d0 = d * 32 + 8 * g + 4 * lh;
      const uint2 z = *(const uint2*)(szrow + d0);
      uint2 v;
      v.x = pk2(o[d][4 * g] * inv * bf2f((u16)(z.x & 0xffff)), o[d][4 * g + 1] * inv * bf2f((u16)(z.x >> 16)));
      v.y = pk2(o[d][4 * g + 2] * inv * bf2f((u16)(z.y & 0xffff)), o[d][4 * g + 3] * inv * bf2f((u16)(z.y >> 16)));
      *(uint2*)(orow + d0) = v;
    }
}

DI void ph_prep(const Params& p, char* smem) {
  const int tid = threadIdx.x;
  const int ntr = p.nmat_tiles;
  const int ntot = ntr + 192;
  for (int tile = blockIdx.x; tile < ntot; tile += gridDim.x) {
    __syncthreads();
    if (tile >= 192) {
      const int ttile = tile - 192;
      int mi = 0;
      for (int i = 1; i < 18; i++) if (ttile >= p.mats[i].tile0) mi = i;
      const float* src = p.mats[mi].src; u16* dst = p.mats[mi].dst;
      const int K = p.mats[mi].K, Nsrc = p.mats[mi].Nsrc, Ndst = p.mats[mi].Ndst;
      const int lt = ttile - p.mats[mi].tile0;
      const int ntn = Ndst >> 6;
      const int kt = lt / ntn, nt = lt - kt * ntn;
      float* ts = (float*)smem;
#pragma unroll
      for (int i = 0; i < 4; i++) {
        const int k = i * 16 + (tid >> 4), n4 = (tid & 15) * 4, n = nt * 64 + n4;
        float4 v = {0.f, 0.f, 0.f, 0.f};
        if (n < Nsrc) v = *(const float4*)(src + (size_t)(kt * 64 + k) * Nsrc + n);
        ts[k * 65 + n4] = v.x; ts[k * 65 + n4 + 1] = v.y; ts[k * 65 + n4 + 2] = v.z; ts[k * 65 + n4 + 3] = v.w;
      }
      __syncthreads();
      const int n = tid >> 2, kc = (tid & 3) * 16;
      uint32_t w[8];
#pragma unroll
      for (int e = 0; e < 8; e++) w[e] = pk2(ts[(kc + 2 * e) * 65 + n], ts[(kc + 2 * e + 1) * 65 + n]);
      u16* dp = dst + (size_t)(nt * 64 + n) * K + kt * 64 + kc;
      uint4 v0; v0.x = w[0]; v0.y = w[1]; v0.z = w[2]; v0.w = w[3];
      uint4 v1; v1.x = w[4]; v1.y = w[5]; v1.z = w[6]; v1.w = w[7];
      *(uint4*)dp = v0; *(uint4*)(dp + 8) = v1;
    } else {
      const int at = tile;
      const int layer = at / 48, c0 = (at - layer * 48) * 64;
      float* sc = (float*)smem;
      float* red = sc + 5 * 1024;
      for (int i = tid; i < 5 * 1024; i += 256) {
        const int n = i >> 10, k = i & 1023;
        const float v = (n == 0) ? p.c_ctx[k] : p.c[(n - 1) * 1024 + k];
        sc[i] = silu(v);
      }
      __syncthreads();
      const int c4 = (tid & 15) * 4, kg = tid >> 4;
      float acc[5][4];
#pragma unroll
      for (int n = 0; n < 5; n++) { acc[n][0] = 0.f; acc[n][1] = 0.f; acc[n][2] = 0.f; acc[n][3] = 0.f; }
      const float* w = p.ada_w + (size_t)layer * 1024 * 3072 + c0 + c4;
#pragma unroll 4
      for (int kk = 0; kk < 64; kk++) {
        const int k = kg * 64 + kk;
        const float4 wv = *(const float4*)(w + (size_t)k * 3072);
#pragma unroll
        for (int n = 0; n < 5; n++) {
          const float s = sc[n * 1024 + k];
          acc[n][0] += s * wv.x; acc[n][1] += s * wv.y; acc[n][2] += s * wv.z; acc[n][3] += s * wv.w;
        }
      }
#pragma unroll
      for (int n = 0; n < 5; n++) {
        float4 r; r.x = acc[n][0]; r.y = acc[n][1]; r.z = acc[n][2]; r.w = acc[n][3];
        *(float4*)(red + (kg * 5 + n) * 64 + c4) = r;
      }
      __syncthreads();
      for (int o = tid; o < 320; o += 256) {
        const int n = o >> 6, cc = o & 63;
        float s = 0.f;
#pragma unroll
        for (int g = 0; g < 16; g++) s += red[(g * 5 + n) * 64 + cc];
        s += p.ada_b[layer * 3072 + c0 + cc];
        p.mod[(layer * 5 + n) * 3072 + c0 + cc] = s;
      }
    }
  }
}

DI void ph_h0(const Params& p) {
  for (int idx = blockIdx.x * 256 + threadIdx.x; idx < T * 128; idx += gridDim.x * 256) {
    const int t = idx >> 7, c0 = (idx & 127) * 8;
    const float* xr = (t < TC) ? p.x_prompt + (size_t)t * 1024 : p.x_sample + (size_t)(t - TC) * 1024;
    const float* md = p.mod + cond_of(t) * 3072;
    const float4 x0 = *(const float4*)(xr + c0), x1 = *(const float4*)(xr + c0 + 4);
    const float4 sh0 = *(const float4*)(md + c0), sh1 = *(const float4*)(md + c0 + 4);
    const float4 sc0 = *(const float4*)(md + 1024 + c0), sc1 = *(const float4*)(md + 1024 + c0 + 4);
    uint4 v;
    v.x = pk2(x0.x * (1.f + sc0.x) + sh0.x, x0.y * (1.f + sc0.y) + sh0.y);
    v.y = pk2(x0.z * (1.f + sc0.z) + sh0.z, x0.w * (1.f + sc0.w) + sh0.w);
    v.z = pk2(x1.x * (1.f + sc1.x) + sh1.x, x1.y * (1.f + sc1.y) + sh1.y);
    v.w = pk2(x1.z * (1.f + sc1.z) + sh1.z, x1.w * (1.f + sc1.w) + sh1.w);
    *(uint4*)(p.H + (size_t)t * 1024 + c0) = v;
  }
}

template <class Epi>
DI void gemm_phase(const u16* A, int lda, const u16* Bt, int ldb, int K, int MT, int NT, char* smem, const Epi& epi) {
  const int ntile = MT * NT;
  for (int tile = blockIdx.x; tile < ntile; tile += gridDim.x) {
    const int nt = tile / MT, mt = tile - nt * MT;
    gemm_tile<3>(A, lda, Bt, ldb, K, mt * 192, nt * 128, 0, smem, epi);
  }
}

DI void unpack8(const u32x4& u, float* f) {
  f[0] = __uint_as_float(u[0] << 16); f[1] = __uint_as_float(u[0] & 0xffff0000u);
  f[2] = __uint_as_float(u[1] << 16); f[3] = __uint_as_float(u[1] & 0xffff0000u);
  f[4] = __uint_as_float(u[2] << 16); f[5] = __uint_as_float(u[2] & 0xffff0000u);
  f[6] = __uint_as_float(u[3] << 16); f[7] = __uint_as_float(u[3] & 0xffff0000u);
}
template <int HW>
DI void mix_item(const Params& p, int rpair) {
  const int lane = threadIdx.x & 63;
  constexpr int g = (HW == 1) ? 0 : (HW == 2) ? 1 : (HW == 4) ? 2 : 3;
  constexpr int NR = 8 + 2 * HW;
  const int c0 = (g * 32 + (lane & 31)) * 8;
  const int t0 = (rpair * 2 + (lane >> 5)) * 8;
  int s0, L, tt0;
  if (t0 < TC) { s0 = t0 & ~255; tt0 = t0 & 255; L = 256; } else { s0 = TC + ((t0 - TC) & ~2047); tt0 = (t0 - TC) & 2047; L = 2048; }
  u32x4 rows[NR];
#pragma unroll
  for (int r = 0; r < NR; r++) {
    const int tt = tt0 - HW + r;
    u32x4 v = {0u, 0u, 0u, 0u};
    if (tt >= 0 && tt < L) v = *(const u32x4*)(p.U + (size_t)(s0 + tt) * 1024 + c0);
    rows[r] = v;
  }
  float sum[8];
#pragma unroll
  for (int k = 0; k < 8; k++) sum[k] = 0.f;
#pragma unroll
  for (int r = 0; r < 2 * HW; r++) {
    float f[8]; unpack8(rows[r], f);
#pragma unroll
    for (int k = 0; k < 8; k++) sum[k] += f[k];
  }
#pragma unroll
  for (int e = 0; e < 8; e++) {
    const int tt = tt0 + e;
    const int lo = max(tt - HW, 0), hi = min(tt + HW, L);
    const float ic = 1.f / (float)(hi - lo);
    float own[8]; unpack8(rows[e + HW], own);
    u32x4 v;
    v[0] = pk2(sum[0] * ic - own[0], sum[1] * ic - own[1]);
    v[1] = pk2(sum[2] * ic - own[2], sum[3] * ic - own[3]);
    v[2] = pk2(sum[4] * ic - own[4], sum[5] * ic - own[5]);
    v[3] = pk2(sum[6] * ic - own[6], sum[7] * ic - own[7]);
    *(u32x4*)(p.MIX + (size_t)(s0 + tt) * 1024 + c0) = v;
    if (e < 7) {
      float fo[8], fi[8]; unpack8(rows[e], fo); unpack8(rows[e + 2 * HW], fi);
#pragma unroll
      for (int k = 0; k < 8; k++) sum[k] += fi[k] - fo[k];
    }
  }
}
DI void ph_mix(const Params& p) {
  const int wid = threadIdx.x >> 6;
  for (int item = blockIdx.x * 4 + wid; item < 768 * 4; item += gridDim.x * 4) {
    const int rpair = item >> 2, g = item & 3;
    if (g == 0) mix_item<1>(p, rpair);
    else if (g == 1) mix_item<2>(p, rpair);
    else if (g == 2) mix_item<4>(p, rpair);
    else mix_item<8>(p, rpair);
  }
}

DI void ph_pool_g2(const Params& p, int j, char* smem) {
  EpiPoolG2 epi{p.PM, p.SZ, p.pool_scale + j * 1024};
  for (int tile = blockIdx.x; tile < 64 * 8; tile += gridDim.x) {
    const int gn = tile / 64, mt = tile - gn * 64;
    const int g = gn >> 1, ns = gn & 1;
    gemm_tile<3>(p.MIX + g * 256, 1024, p.Wgrp + (size_t)(j * 4 + g) * 65536, 256, 256, mt * 192, ns * 128, g * 256, smem, epi);
  }
}

DI void ph_ln(const Params& p, int layer) {
  const int lane = threadIdx.x & 63, wid = threadIdx.x >> 6;
  const float* g = p.ln_g + layer * 1024;
  const float* bb = p.ln_b + layer * 1024;
  for (int row = blockIdx.x * 4 + wid; row < T; row += gridDim.x * 4) {
    float* xr = p.out + (size_t)row * 1024;
    float4 v[4];
    float s = 0.f;
#pragma unroll
    for (int i = 0; i < 4; i++) { v[i] = *(const float4*)(xr + i * 256 + lane * 4); s += v[i].x + v[i].y + v[i].z + v[i].w; }
    const float mu = wave_sum(s) * (1.f / 1024.f);
    float q = 0.f;
#pragma unroll
    for (int i = 0; i < 4; i++) {
      v[i].x -= mu; v[i].y -= mu; v[i].z -= mu; v[i].w -= mu;
      q += v[i].x * v[i].x + v[i].y * v[i].y + v[i].z * v[i].z + v[i].w * v[i].w;
    }
    const float rstd = rsqrtf(wave_sum(q) * (1.f / 1024.f) + 1e-5f);
    const float* md = p.mod + ((layer + 1) * 5 + cond_of(row)) * 3072;
#pragma unroll
    for (int i = 0; i < 4; i++) {
      const int cc = i * 256 + lane * 4;
      const float4 gg = *(const float4*)(g + cc), be = *(const float4*)(bb + cc);
      float4 y;
      y.x = v[i].x * rstd * gg.x + be.x; y.y = v[i].y * rstd * gg.y + be.y;
      y.z = v[i].z * rstd * gg.z + be.z; y.w = v[i].w * rstd * gg.w + be.w;
      *(float4*)(xr + cc) = y;
      if (layer < 3) {
        const float4 sh = *(const float4*)(md + cc), sc = *(const float4*)(md + 1024 + cc);
        uint2 h;
        h.x = pk2(y.x * (1.f + sc.x) + sh.x, y.y * (1.f + sc.y) + sh.y);
        h.y = pk2(y.z * (1.f + sc.z) + sh.z, y.w * (1.f + sc.w) + sh.w);
        *(uint2*)(p.H + (size_t)row * 1024 + cc) = h;
      }
    }
  }
}

DI void ph_mla_norm(const Params& p) {
  const int lane = threadIdx.x & 63, wid = threadIdx.x >> 6;
  for (int row = blockIdx.x * 4 + wid; row < T + 1024; row += gridDim.x * 4) {
    if (row < T) {
      const float* rr = p.RAW + (size_t)row * 768;
      const float4 a0 = *(const float4*)(rr + lane * 8), a1 = *(const float4*)(rr + lane * 8 + 4);
      const float4 k0 = *(const float4*)(rr + 512 + lane * 4);
      float s1 = a0.x * a0.x + a0.y * a0.y + a0.z * a0.z + a0.w * a0.w + a1.x * a1.x + a1.y * a1.y + a1.z * a1.z + a1.w * a1.w;
      float s2 = k0.x * k0.x + k0.y * k0.y + k0.z * k0.z + k0.w * k0.w;
      const float r1 = rsqrtf(wave_sum(s1) * (1.f / 512.f) + 1e-6f);
      const float r2 = rsqrtf(wave_sum(s2) * (1.f / 256.f) + 1e-6f);
      const float4 g0 = *(const float4*)(p.mla_q_norm + lane * 8), g1 = *(const float4*)(p.mla_q_norm + lane * 8 + 4);
      uint4 v;
      v.x = pk2(a0.x * r1 * g0.x, a0.y * r1 * g0.y); v.y = pk2(a0.z * r1 * g0.z, a0.w * r1 * g0.w);
      v.z = pk2(a1.x * r1 * g1.x, a1.y * r1 * g1.y); v.w = pk2(a1.z * r1 * g1.z, a1.w * r1 * g1.w);
      *(uint4*)(p.CQN + (size_t)row * 512 + lane * 8) = v;
      const float4 kg = *(const float4*)(p.mla_kv_norm + lane * 4);
      float4 kn; kn.x = k0.x * r2 * kg.x; kn.y = k0.y * r2 * kg.y; kn.z = k0.z * r2 * kg.z; kn.w = k0.w * r2 * kg.w;
      uint2 kv; kv.x = pk2(kn.x, kn.y); kv.y = pk2(kn.z, kn.w);
      *(uint2*)(p.CKVN + (size_t)kvrow_of(row) * 256 + lane * 4) = kv;
      if (row < TC) *(float4*)(p.out + OUT_CKV + (size_t)row * 256 + lane * 4) = kn;
    } else {
      const int cr = row - T, b = cr >> 8, pp = cr & 255;
      const size_t kvr = (size_t)TC + b * 2304 + pp;
      const float4 k0 = *(const float4*)(p.cache_ckv + (size_t)cr * 256 + lane * 4);
      uint2 kv; kv.x = pk2(k0.x, k0.y); kv.y = pk2(k0.z, k0.w);
      *(uint2*)(p.CKVN + kvr * 256 + lane * 4) = kv;
      p.KR[kvr * 64 + lane] = f2bf(p.cache_kr[(size_t)cr * 64 + lane]);
    }
  }
}

DI void ph_mla_g2(const Params& p, char* smem) {
  EpiMlaQ eq{p.Q};
  EpiMlaKV ekv{p.KN, p.VT};
  const int n1 = 64 * 12, n2 = 104 * 16;
  for (int tile = blockIdx.x; tile < n1 + n2; tile += gridDim.x) {
    if (tile < n1) {
      const int nt = tile / 64, mt = tile - nt * 64;
      gemm_tile<3>(p.CQN, 512, p.Wuq, 512, 512, mt * 192, nt * 128, 0, smem, eq);
    } else {
      const int t2 = tile - n1;
      const int nt = t2 / 104, mt = t2 - nt * 104;
      gemm_tile<2>(p.CKVN, 256, p.Wukv, 256, 256, mt * 128, nt * 128, 0, smem, ekv);
    }
  }
}

DI void ph_mla_attn(const Params& p, char* smem) {
  const int wid = threadIdx.x >> 6, l31 = threadIdx.x & 31;
  for (int u = blockIdx.x; u < 768; u += gridDim.x) {
    int t0, kvrow0, nkeys, Lk, h; size_t vbase;
    if (u < 512) {
      const int xcd = u & 7, slot = u >> 3; const int pair = xcd * 4 + (slot >> 4); const int qb = slot & 15;
      const int b = pair >> 3; h = pair & 7;
      t0 = TC + b * 2048 + qb * 128 + wid * 32; kvrow0 = TC + b * 2304; nkeys = 2304; Lk = 2304;
      vbase = (size_t)16 * 8 * 128 * 256 + (size_t)b * (8 * 128 * 2304) + (size_t)h * 128 * 2304;
    } else {
      const int v = u - 512; const int b = v >> 4; h = (v >> 1) & 7; const int qb = v & 1;
      t0 = b * 256 + qb * 128 + wid * 32; kvrow0 = b * 256; nkeys = 256; Lk = 256;
      vbase = (size_t)b * (8 * 128 * 256) + (size_t)h * 128 * 256;
    }
    const int t = t0 + l31;
    attn_dense_block<8, 4, 4>(smem, p.Q + (size_t)t * 1536 + h * 192, p.KN + (size_t)kvrow0 * 1024 + h * 128, 1024,
                             p.KR + (size_t)kvrow0 * 64, p.VT + vbase, Lk, nkeys,
                             p.SZ + (size_t)t * 1024 + h * 128, p.AO + (size_t)t * 1024 + h * 128);
  }
}

DI void ph_na_g1(const Params& p, char* smem) {
  EpiNaG1 epi{p.NQ, p.NK, p.NVT, p.SZ, p.out + OUT_NAK, p.out + OUT_NAV};
  const int n1 = 64 * 32;
  for (int tile = blockIdx.x; tile < n1 + 64; tile += gridDim.x) {
    if (tile < n1) {
      const int nt = tile / 64, mt = tile - nt * 64;
      gemm_tile<3>(p.H, 1024, p.Wnin, 1024, 1024, mt * 192, nt * 128, 0, smem, epi);
    } else {
      const int ct = tile - n1;
      const int b = ct >> 4, p0 = (ct & 15) * 16;
      const int c4 = threadIdx.x * 4;
      const size_t kvb = (size_t)TC + b * 2304;
      u16* vtb = p.NVT + (size_t)16 * 1024 * 256 + (size_t)b * (1024 * 2304);
      float vv[4][16];
#pragma unroll
      for (int i = 0; i < 16; i++) {
        const size_t src = ((size_t)(b * 256 + p0 + i)) * 1024 + c4;
        const float4 k = *(const float4*)(p.cache_nak + src);
        uint2 kv; kv.x = pk2(k.x, k.y); kv.y = pk2(k.z, k.w);
        *(uint2*)(p.NK + (kvb + p0 + i) * 1024 + c4) = kv;
        const float4 v = *(const float4*)(p.cache_nav + src);
        vv[0][i] = v.x; vv[1][i] = v.y; vv[2][i] = v.z; vv[3][i] = v.w;
      }
#pragma unroll
      for (int e = 0; e < 4; e++) {
        uint4 w0, w1;
        w0.x = pk2(vv[e][0], vv[e][1]); w0.y = pk2(vv[e][2], vv[e][3]); w0.z = pk2(vv[e][4], vv[e][5]); w0.w = pk2(vv[e][6], vv[e][7]);
        w1.x = pk2(vv[e][8], vv[e][9]); w1.y = pk2(vv[e][10], vv[e][11]); w1.z = pk2(vv[e][12], vv[e][13]); w1.w = pk2(vv[e][14], vv[e][15]);
        u16* dp = vtb + (size_t)(c4 + e) * 2304 + p0;
        *(uint4*)dp = w0; *(uint4*)(dp + 8) = w1;
      }
    }
  }
}

DI void ph_na_attn(const Params& p, char* smem) {
  const int wid = threadIdx.x >> 6, l31 = threadIdx.x & 31;
  for (int u = blockIdx.x; u < 1024 + 512; u += gridDim.x) {
    if (u < 1024) {
      const int xcd = u & 7, slot = u >> 3;
      const int pair = xcd * 8 + (slot >> 4), rpair = slot & 15;
      attn_na_block(p, smem, pair >> 4, pair & 15, rpair);
    } else {
      const int v = u - 1024;
      const int b = v >> 5, h = (v >> 1) & 15, qb = v & 1;
      const int t = b * 256 + qb * 128 + wid * 32 + l31;
      attn_dense_block<4, 0, 2>(smem, p.NQ + (size_t)t * 1024 + h * 64, p.NK + (size_t)(b * 256) * 1024 + h * 64, 1024, nullptr,
                               p.NVT + (size_t)b * (1024 * 256) + (size_t)h * 64 * 256, 256, 256,
                               p.SZ + (size_t)t * 1024 + h * 64, p.NAO + (size_t)t * 1024 + h * 64);
    }
  }
}

template <int ph>
DI void run_phase(const Params& p, char* smem) {
  if constexpr (ph == 0) ph_prep(p, smem);
  else if constexpr (ph == 1) ph_h0(p);
  else if constexpr (ph == 2 || ph == 17) {
    constexpr int j = (ph == 2) ? 0 : 1;
    EpiPoolG1 e{p.U, p.SZ};
    gemm_phase(p.H, 1024, p.Wpin + (size_t)j * 2048 * 1024, 1024, 1024, 64, 16, smem, e);
  }
  else if constexpr (ph == 3 || ph == 18) ph_mix(p);
  else if constexpr (ph == 4 || ph == 19) ph_pool_g2(p, (ph == 4) ? 0 : 1, smem);
  else if constexpr (ph == 5) {
    EpiG3 e{p.x_prompt, p.x_sample, p.out, p.mod};
    gemm_phase(p.PM, 1024, p.Wpout, 1024, 1024, 64, 8, smem, e);
  }
  else if constexpr (ph == 20) {
    EpiG3 e{p.out, p.out + OUT_YS, p.out, p.mod + 3 * 5 * 3072};
    gemm_phase(p.PM, 1024, p.Wpout + (size_t)1024 * 1024, 1024, 1024, 64, 8, smem, e);
  }
  else if constexpr (ph == 6) ph_ln(p, 0);
  else if constexpr (ph == 21) ph_ln(p, 3);
  else if constexpr (ph == 7) {
    EpiMlaG1 e{p.RAW, p.KR, p.SZ, p.out + OUT_KR};
    gemm_phase(p.H, 1024, p.Wmin, 1024, 1024, 64, 15, smem, e);
  }
  else if constexpr (ph == 8) ph_mla_norm(p);
  else if constexpr (ph == 9) ph_mla_g2(p, smem);
  else if constexpr (ph == 10) ph_mla_attn(p, smem);
  else if constexpr (ph == 11) {
    EpiG3 e{p.out, p.out + OUT_YS, p.out, p.mod + 1 * 5 * 3072};
    gemm_phase(p.AO, 1024, p.Wmout, 1024, 1024, 64, 8, smem, e);
  }
  else if constexpr (ph == 12) ph_ln(p, 1);
  else if constexpr (ph == 13) ph_na_g1(p, smem);
  else if constexpr (ph == 14) ph_na_attn(p, smem);
  else if constexpr (ph == 15) {
    EpiG3 e{p.out, p.out + OUT_YS, p.out, p.mod + 2 * 5 * 3072};
    gemm_phase(p.NAO, 1024, p.Wnout, 1024, 1024, 64, 8, smem, e);
  }
  else if constexpr (ph == 16) ph_ln(p, 2);
}

#define RUN_PH(n) if (ph_lo <= (n) && (n) < ph_hi) { run_phase<n>(p, smem); if ((n) + 1 < ph_hi) xcd_barrier(xb); }

__global__ void __launch_bounds__(256, 2) mega(Params p, int ph_lo, int ph_hi) {
  __shared__ __attribute__((aligned(16))) char smem[SMEM_BYTES];
  if (ph_lo < 0) { cg::this_grid().sync(); return; }
  const bool multi = (ph_hi - ph_lo) > 1;
  XcdBarrier xb; xb.bar = p.bar; xb.x = 0; xb.nloc = 0u; xb.nx = 0u;
  if (multi) xb = xcd_barrier_post(p.bar);
  RUN_PH(0) RUN_PH(1) RUN_PH(2) RUN_PH(3) RUN_PH(4) RUN_PH(5) RUN_PH(6) RUN_PH(7) RUN_PH(8) RUN_PH(9) RUN_PH(10)
  RUN_PH(11) RUN_PH(12) RUN_PH(13) RUN_PH(14) RUN_PH(15) RUN_PH(16) RUN_PH(17) RUN_PH(18) RUN_PH(19) RUN_PH(20) RUN_PH(21)
}

extern "C" void kernel_launch(void* const* d_in, const int* in_sizes, int n_in, void* d_out, int out_size, void* d_ws, size_t ws_size,
                              hipStream_t stream) {
  Params p;
  memset(&p, 0, sizeof(p));
  const float* const* in = (const float* const*)d_in;
  p.x_prompt = in[0]; p.x_sample = in[1]; p.cache_ckv = in[2]; p.cache_kr = in[3]; p.cache_nak = in[4]; p.cache_nav = in[5];
  p.c = in[6]; p.c_ctx = in[7]; p.ada_w = in[8]; p.ada_b = in[9]; p.ln_g = in[10]; p.ln_b = in[11];
  const float* pool_w_in = in[12]; const float* pool_w_grp = in[13]; p.pool_scale = in[14]; const float* pool_w_out = in[15];
  const float* mla_w_in = in[16]; p.mla_q_norm = in[17]; const float* mla_w_uq = in[18]; p.mla_kv_norm = in[19];
  const float* mla_w_ukv = in[20]; const float* mla_w_out = in[21]; const float* na_w_in = in[22]; p.na_rpb = in[23];
  const float* na_w_out = in[24];
  p.out = (float*)d_out;

  char* ws = (char*)d_ws;
  size_t off = 0;
  auto take = [&](size_t bytes) { char* r = ws + off; off += (bytes + 255) & ~(size_t)255; return r; };
  p.bar = (unsigned*)take(XCD_BAR_WORDS * 4);
  p.mod = (float*)take((size_t)4 * 5 * 3072 * 4);
  p.Wpin = (u16*)take((size_t)2 * 2048 * 1024 * 2);
  p.Wgrp = (u16*)take((size_t)8 * 65536 * 2);
  p.Wpout = (u16*)take((size_t)2 * 1024 * 1024 * 2);
  p.Wmin = (u16*)take((size_t)1920 * 1024 * 2);
  p.Wuq = (u16*)take((size_t)1536 * 512 * 2);
  p.Wukv = (u16*)take((size_t)2048 * 256 * 2);
  p.Wmout = (u16*)take((size_t)1024 * 1024 * 2);
  p.Wnin = (u16*)take((size_t)4096 * 1024 * 2);
  p.Wnout = (u16*)take((size_t)1024 * 1024 * 2);
  p.H = (u16*)take((size_t)T * 1024 * 2);
  p.SZ = (u16*)take((size_t)T * 1024 * 2);
  const size_t arena0 = off;
  p.U = (u16*)take((size_t)T * 1024 * 2);
  p.MIX = (u16*)take((size_t)T * 1024 * 2);
  p.PM = (u16*)take((size_t)T * 1024 * 2);
  off = arena0;
  p.RAW = (float*)take((size_t)T * 768 * 4);
  p.AO = (u16*)p.RAW;
  p.CQN = (u16*)take((size_t)T * 512 * 2);
  p.CKVN = (u16*)take((size_t)KVR * 256 * 2);
  p.KR = (u16*)take((size_t)KVR * 64 * 2);
  p.Q = (u16*)take((size_t)T * 1536 * 2);
  p.KN = (u16*)take((size_t)KVR * 1024 * 2);
  p.VT = (u16*)take((size_t)KVR * 1024 * 2);
  off = arena0;
  p.NQ = (u16*)take((size_t)T * 1024 * 2);
  p.NK = (u16*)take((size_t)KVR * 1024 * 2);
  p.NVT = (u16*)take((size_t)KVR * 1024 * 2);
  p.NAO = (u16*)take((size_t)T * 1024 * 2);

  int nm = 0, tiles = 0;
  auto add = [&](const float* src, u16* dst, int K, int Nsrc, int Ndst) {
    p.mats[nm].src = src; p.mats[nm].dst = dst; p.mats[nm].K = K; p.mats[nm].Nsrc = Nsrc; p.mats[nm].Ndst = Ndst; p.mats[nm].tile0 = tiles;
    tiles += (K / 64) * (Ndst / 64); nm++;
  };
  for (int j = 0; j < 2; j++) add(pool_w_in + (size_t)j * 1024 * 2048, p.Wpin + (size_t)j * 2048 * 1024, 1024, 2048, 2048);
  for (int j = 0; j < 8; j++) add(pool_w_grp + (size_t)j * 65536, p.Wgrp + (size_t)j * 65536, 256, 256, 256);
  for (int j = 0; j < 2; j++) add(pool_w_out + (size_t)j * 1024 * 1024, p.Wpout + (size_t)j * 1024 * 1024, 1024, 1024, 1024);
  add(mla_w_in, p.Wmin, 1024, 1856, 1920);
  add(mla_w_uq, p.Wuq, 512, 1536, 1536);
  add(mla_w_ukv, p.Wukv, 256, 2048, 2048);
  add(mla_w_out, p.Wmout, 1024, 1024, 1024);
  add(na_w_in, p.Wnin, 1024, 4096, 4096);
  add(na_w_out, p.Wnout, 1024, 1024, 1024);
  p.nmat_tiles = tiles;

  (void)hipMemsetAsync(p.bar, 0, XCD_BAR_WORDS * 4, stream);
#if MULTI_LAUNCH
  for (int ph = 0; ph < NPHASE; ph++) hipLaunchKernelGGL(mega, dim3(512), dim3(256), 0, stream, p, ph, ph + 1);
#else
  static int grid_blocks = 0;
  if (!grid_blocks) {
    int dev = 0, cus = 0, per_cu = 0;
    hipGetDevice(&dev);
    hipDeviceGetAttribute(&cus, hipDeviceAttributeMultiprocessorCount, dev);
    hipOccupancyMaxActiveBlocksPerMultiprocessor(&per_cu, mega, 256, 0);
    if (per_cu > 2) per_cu = 2;
    if (per_cu < 1) per_cu = 1;
    grid_blocks = cus * per_cu;
  }
  int lo = 0, hi = NPHASE;
  void* args[] = {&p, &lo, &hi};
  hipError_t e = hipLaunchCooperativeKernel((void*)mega, dim3(grid_blocks), dim3(256), args, 0, stream);
  if (e != hipSuccess) fprintf(stderr, "cooperative launch failed: %s (grid %d)\n", hipGetErrorString(e), grid_blocks);
#endif
}
```

```cpp
#include <hip/hip_runtime.h>
#include <hip/hip_cooperative_groups.h>
#include <stdint.h>
#include <string.h>
#include <stdio.h>
namespace cg = cooperative_groups;

#ifndef MULTI_LAUNCH
#define MULTI_LAUNCH 0
#endif

typedef __attribute__((ext_vector_type(8))) short bf16x8;
typedef __attribute__((ext_vector_type(4))) float f32x4;
typedef __attribute__((ext_vector_type(16))) float f32x16;
typedef __attribute__((ext_vector_type(4))) uint32_t u32x4;
typedef unsigned short u16;
#define DI __device__ __forceinline__
#define MFMA32(a, b, c) __builtin_amdgcn_mfma_f32_32x32x16_bf16((a), (b), (c), 0, 0, 0)
#define MFMA16(a, b, c) __builtin_amdgcn_mfma_f32_16x16x32_bf16((a), (b), (c), 0, 0, 0)

constexpr int TC = 4096, TL = 8192, T = 12288;
constexpr int KVR = 4096 + 4 * 2304;
constexpr float LOG2E = 1.4426950408889634f;
constexpr float ALPHA = 1.681792830507429f;
constexpr float MLA_QS = 0.07216878364870323f * LOG2E;
constexpr float NA_QS = 0.125f * LOG2E;
constexpr int SMEM_BYTES = 81920;
constexpr int NPHASE = 22;

constexpr size_t OUT_YS = 4194304, OUT_CKV = 12582912, OUT_KR = 13631488, OUT_NAK = 13893632, OUT_NAV = 18087936;

struct MatDesc { const float* src; u16* dst; int K, Nsrc, Ndst, tile0; };

struct Params {
  const float *x_prompt, *x_sample, *cache_ckv, *cache_kr, *cache_nak, *cache_nav, *c, *c_ctx, *ada_w, *ada_b, *ln_g, *ln_b;
  const float *pool_scale, *mla_q_norm, *mla_kv_norm, *na_rpb;
  float* out;
  float* mod;
  u16 *H, *SZ, *GO;
  u16 *Wpin, *Wgrp, *Wpout, *Wmin, *Wuq, *Wukv, *Wmout, *Wnin, *Wnout;
  u16 *U, *MIX, *PM;
  float* RAW; u16 *AO, *CQN, *CKVN, *KR, *Q, *KN, *VT;
  u16 *NQ, *NK, *NVT, *NAO;
  unsigned* bar;
  MatDesc mats[18];
  int nmat_tiles; int pad0;
};

DI float bf2f(u16 v) { return __uint_as_float(((uint32_t)v) << 16); }
typedef __attribute__((ext_vector_type(2))) float f32x2;
typedef __attribute__((ext_vector_type(2))) __bf16 bf16x2_t;
DI uint32_t pk2(float a, float b) { f32x2 v = {a, b}; return __builtin_bit_cast(uint32_t, __builtin_convertvector(v, bf16x2_t)); }
DI u16 f2bf(float x) { return (u16)(pk2(x, x) & 0xffffu); }
DI float silu(float v) { return v / (1.f + __expf(-v)); }
DI int cond_of(int t) { return t < TC ? 0 : 1 + ((t - TC) >> 11); }
DI int kvrow_of(int t) { return t < TC ? t : TC + ((t - TC) >> 11) * 2304 + 256 + ((t - TC) & 2047); }
DI int perm16(int key) { const int k = key & 15; return (key & ~15) | (k & 3) | ((k >> 1) & 4) | ((k << 1) & 8); }
DI float wave_sum(float v) {
#pragma unroll
  for (int o = 32; o >= 1; o >>= 1) v += __shfl_xor(v, o);
  return v;
}

#define XB_TMO      128
#define XB_XCNT(j)  (256  + 64 * (j))
#define XB_XSUB(j)  (1280 + 64 * (j))
#define XB_XGEN(j)  (2304 + 64 * (j))
#define XB_TOP      3328
#define XB_TOPGEN   3392
#define XCD_BAR_WORDS 3456
#define XB_SPIN_CAP (1u << 22)
#define LAS __attribute__((address_space(3)))
DI unsigned xb_ld(unsigned* p) { return __hip_atomic_load(p, __ATOMIC_RELAXED, __HIP_MEMORY_SCOPE_AGENT); }
DI unsigned xb_add(unsigned* p, unsigned v) { return __hip_atomic_fetch_add(p, v, __ATOMIC_RELAXED, __HIP_MEMORY_SCOPE_AGENT); }
DI unsigned xb_xcc_id() { return (unsigned)__builtin_amdgcn_s_getreg((3 << 11) | 20) & 0xFu; }
#define XB_SPIN(cond, bar) do { unsigned _sp = 0; while (cond) { __builtin_amdgcn_s_sleep(1); \
    if ((++_sp & 255u) == 0u) { if (xb_ld(&(bar)[XB_TMO])) break; if (_sp > XB_SPIN_CAP) { atomicAdd(&(bar)[XB_TMO], 1u); break; } } } } while (0)
struct XcdBarrier { unsigned* bar; unsigned x; unsigned nloc, nx; };
DI XcdBarrier xcd_barrier_post(unsigned* bar) {
  XcdBarrier b; b.bar = bar; b.x = xb_xcc_id(); b.nloc = 0u; b.nx = 0u;
  if (threadIdx.x == 0) (void)xb_add(&bar[XB_XCNT(b.x)], 1u);
  return b;
}
DI void xcd_barrier_complete(unsigned* bar, unsigned x, unsigned& nloc, unsigned& nx) {
  const unsigned G = gridDim.x * gridDim.y * gridDim.z;
  unsigned sum, cnt, mine, sp = 0u;
  for (;;) {
    sum = 0u; cnt = 0u; mine = 0u;
#pragma unroll
    for (unsigned j = 0; j < 16; ++j) { const unsigned c = xb_ld(&bar[XB_XCNT(j)]); sum += c; cnt += (c > 0u) ? 1u : 0u; mine = (j == x) ? c : mine; }
    if (sum == G) break;
    __builtin_amdgcn_s_sleep(1);
    if ((++sp & 255u) == 0u) { if (xb_ld(&bar[XB_TMO])) break; if (sp > XB_SPIN_CAP) { atomicAdd(&bar[XB_TMO], 1u); break; } }
  }
  nloc = mine > 0u ? mine : 1u; nx = cnt > 0u ? cnt : 1u;
}
DI void xcd_barrier(XcdBarrier& b) {
  asm volatile("s_waitcnt vmcnt(0)" ::: "memory");
  __syncthreads();
  unsigned nloc = b.nloc, nx = b.nx;
  if (threadIdx.x == 0) {
    unsigned* bar = b.bar;
    __builtin_amdgcn_s_waitcnt(0);
    if (nloc == 0u) { xcd_barrier_complete(bar, b.x, nloc, nx); }
    const unsigned old = xb_add(&bar[XB_XSUB(b.x)], 1u);
    const unsigned gen = old / nloc;
    if (old + 1u == (gen + 1u) * nloc) {
      __builtin_amdgcn_fence(__ATOMIC_RELEASE, "agent");
      asm volatile("s_waitcnt vmcnt(0)" ::: "memory");
      const unsigned og = xb_add(&bar[XB_TOP], 1u);
      const unsigned tg = og / nx;
      if (og + 1u == (tg + 1u) * nx) xb_add(&bar[XB_TOPGEN], 1u);
      else XB_SPIN(xb_ld(&bar[XB_TOPGEN]) == tg, bar);
      __builtin_amdgcn_fence(__ATOMIC_ACQUIRE, "agent");
      xb_add(&bar[XB_XGEN(b.x)], 1u);
      asm volatile("s_waitcnt vmcnt(0)" ::: "memory");
    } else {
      XB_SPIN(xb_ld(&bar[XB_XGEN(b.x)]) == gen, bar);
      __builtin_amdgcn_fence(__ATOMIC_ACQUIRE, "agent");
      asm volatile("s_waitcnt vmcnt(0)" ::: "memory");
    }
  }
  if (threadIdx.x < 64) { b.nloc = __builtin_amdgcn_readfirstlane(nloc); b.nx = __builtin_amdgcn_readfirstlane(nx); }
  __syncthreads();
}

template <int MI, class Epi, bool STAGED = false>
DI void gemm_tile(const u16* __restrict__ A, int lda, const u16* __restrict__ Bt, int ldb, int K, int m0, int n0, int nout_off,
                  char* smem, const Epi& epi) {
  constexpr int BM = 64 * MI, ASTG = BM * 128, NG = 2 * MI + 4;
  const int tid = threadIdx.x, lane = tid & 63, wid = tid >> 6;
  const int wm = wid >> 1, wn = wid & 1, l31 = lane & 31, lh = lane >> 5;
  char* As = smem;
  char* Bs = smem + 2 * ASTG;
  const int srow = tid >> 3;
  const int scc = ((tid & 7) ^ ((tid >> 4) & 7)) * 8;
  const u16* ag = A + (size_t)(m0 + srow) * lda + scc;
  const u16* bg = Bt + (size_t)(n0 + srow) * ldb + scc;
  LAS char* awr = (LAS char*)(As + wid * 1024);
  LAS char* bwr = (LAS char*)(Bs + wid * 1024);
  f32x16 acc[MI][2];
#pragma unroll
  for (int i = 0; i < MI; i++)
#pragma unroll
    for (int j = 0; j < 2; j++)
#pragma unroll
      for (int r = 0; r < 16; r++) acc[i][j][r] = 0.f;
  const int nk = K >> 6;
  __syncthreads();
#pragma unroll
  for (int t = 0; t < 2; t++) {
#pragma unroll
    for (int i = 0; i < 2 * MI; i++)
      __builtin_amdgcn_global_load_lds((const void*)(ag + (size_t)(32 * i) * lda + t * 64), (LAS void*)(awr + t * ASTG + i * 4096), 16, 0, 0);
#pragma unroll
    for (int i = 0; i < 4; i++)
      __builtin_amdgcn_global_load_lds((const void*)(bg + (size_t)(32 * i) * ldb + t * 64), (LAS void*)(bwr + t * 16384 + i * 4096), 16, 0, 0);
  }
  const int sw = (l31 >> 1) & 7;
  for (int kt = 0; kt < nk; kt++) {
    const int buf = kt & 1;
    if (kt + 1 < nk) asm volatile("s_waitcnt vmcnt(%0)" :: "n"(NG) : "memory");
    else asm volatile("s_waitcnt vmcnt(0)" ::: "memory");
    __builtin_amdgcn_s_barrier();
    const char* as = As + buf * ASTG + (wm * (32 * MI) + l31) * 128;
    const char* bs = Bs + buf * 16384 + (wn * 64 + l31) * 128;
    bf16x8 fa[4][MI], fb[4][2];
#pragma unroll
    for (int ks = 0; ks < 4; ks++) {
      const int co = ((2 * ks + lh) ^ sw) << 4;
      fb[ks][0] = *(const bf16x8*)(bs + co);
      fb[ks][1] = *(const bf16x8*)(bs + 32 * 128 + co);
#pragma unroll
      for (int i = 0; i < MI; i++) fa[ks][i] = *(const bf16x8*)(as + i * 32 * 128 + co);
    }
    asm volatile("s_waitcnt lgkmcnt(0)" ::: "memory");
    __builtin_amdgcn_s_barrier();
    if (kt + 2 < nk) {
#pragma unroll
      for (int i = 0; i < 2 * MI; i++)
        __builtin_amdgcn_global_load_lds((const void*)(ag + (size_t)(32 * i) * lda + (kt + 2) * 64), (LAS void*)(awr + buf * ASTG + i * 4096), 16, 0, 0);
#pragma unroll
      for (int i = 0; i < 4; i++)
        __builtin_amdgcn_global_load_lds((const void*)(bg + (size_t)(32 * i) * ldb + (kt + 2) * 64), (LAS void*)(bwr + buf * 16384 + i * 4096), 16, 0, 0);
    }
#pragma unroll
    for (int ks = 0; ks < 4; ks++)
#pragma unroll
      for (int i = 0; i < MI; i++) {
        acc[i][0] = MFMA32(fb[ks][0], fa[ks][i], acc[i][0]);
        acc[i][1] = MFMA32(fb[ks][1], fa[ks][i], acc[i][1]);
      }
  }
  if constexpr (STAGED) {
    float* stg = (float*)(smem + wid * 8704);
#pragma unroll
    for (int i = 0; i < MI; i++) {
#pragma unroll
      for (int j = 0; j < 2; j++)
#pragma unroll
        for (int g = 0; g < 4; g++) {
          float4 v; v.x = acc[i][j][4 * g]; v.y = acc[i][j][4 * g + 1]; v.z = acc[i][j][4 * g + 2]; v.w = acc[i][j][4 * g + 3];
          *(float4*)(stg + l31 * 68 + j * 32 + 8 * g + 4 * lh) = v;
        }
      asm volatile("s_waitcnt lgkmcnt(0)" ::: "memory");
      __builtin_amdgcn_wave_barrier();
#pragma unroll
      for (int it = 0; it < 8; it++) {
        const int row = it * 4 + (lane >> 4), col = (lane & 15) * 4;
        const float4 v = *(const float4*)(stg + row * 68 + col);
        epi.row4(m0 + wm * (32 * MI) + i * 32 + row, nout_off + n0 + wn * 64 + col, v);
      }
      asm volatile("s_waitcnt lgkmcnt(0)" ::: "memory");
      __builtin_amdgcn_wave_barrier();
    }
  } else {
#pragma unroll
    for (int i = 0; i < MI; i++)
#pragma unroll
      for (int j = 0; j < 2; j++)
        epi(m0 + wm * (32 * MI) + i * 32 + l31, nout_off + n0 + wn * 64 + j * 32, lh, acc[i][j]);
  }
}

DI void rope_pair(float x1, float x2, int i, float pos, float& o1, float& o2) {
  const float inv = exp2f(-(float)i * (13.287712379549449f / 16.f));
  const float ang = pos * inv;
  const float c = __cosf(ang), s = __sinf(ang);
  o1 = x1 * c - x2 * s;
  o2 = x1 * s + x2 * c;
}

struct EpiPoolG1 {
  u16 *U, *SZ;
  DI void operator()(int m, int nb, int lh, const f32x16& a) const {
#pragma unroll
    for (int g = 0; g < 4; g++) {
      const int n = nb + 8 * g + 4 * lh;
      if (nb < 1024) {
        uint2 v; v.x = pk2(a[4 * g], a[4 * g + 1]); v.y = pk2(a[4 * g + 2], a[4 * g + 3]);
        *(uint2*)(U + (size_t)m * 1024 + n) = v;
      } else {
        uint2 v; v.x = pk2(silu(a[4 * g]), silu(a[4 * g + 1])); v.y = pk2(silu(a[4 * g + 2]), silu(a[4 * g + 3]));
        *(uint2*)(SZ + (size_t)m * 1024 + n - 1024) = v;
      }
    }
  }
};
struct EpiPoolG2 {
  u16* PM; const u16* SZ; const float* scale;
  DI void operator()(int m, int nb, int lh, const f32x16& a) const {
#pragma unroll
    for (int g = 0; g < 4; g++) {
      const int n = nb + 8 * g + 4 * lh;
      const uint2 z = *(const uint2*)(SZ + (size_t)m * 1024 + n);
      const float4 sc = *(const float4*)(scale + n);
      uint2 v;
      v.x = pk2(a[4 * g] * sc.x * bf2f((u16)(z.x & 0xffff)), a[4 * g + 1] * sc.y * bf2f((u16)(z.x >> 16)));
      v.y = pk2(a[4 * g + 2] * sc.z * bf2f((u16)(z.y & 0xffff)), a[4 * g + 3] * sc.w * bf2f((u16)(z.y >> 16)));
      *(uint2*)(PM + (size_t)m * 1024 + n) = v;
    }
  }
};
struct EpiG3 {
  u16* GO; const float* mod_layer;
  DI void row4(int m, int n, const float4& a) const {
    const float4 gt = *(const float4*)(mod_layer + cond_of(m) * 3072 + 2048 + n);
    uint2 v; v.x = pk2(gt.x * a.x, gt.y * a.y); v.y = pk2(gt.z * a.z, gt.w * a.w);
    *(uint2*)(GO + (size_t)m * 1024 + n) = v;
  }
  DI void operator()(int m, int nb, int lh, const f32x16& a) const {
    const float* gate = mod_layer + cond_of(m) * 3072 + 2048;
#pragma unroll
    for (int g = 0; g < 4; g++) {
      const int n = nb + 8 * g + 4 * lh;
      const float4 gt = *(const float4*)(gate + n);
      uint2 v; v.x = pk2(gt.x * a[4 * g], gt.y * a[4 * g + 1]); v.y = pk2(gt.z * a[4 * g + 2], gt.w * a[4 * g + 3]);
      *(uint2*)(GO + (size_t)m * 1024 + n) = v;
    }
  }
};
struct EpiMlaG1 {
  float* RAW; u16* KR; u16* SZ; float* st_kr;
  DI void operator()(int m, int nb, int lh, const f32x16& a) const {
    if (nb >= 1856) return;
    if (nb < 768) {
#pragma unroll
      for (int g = 0; g < 4; g++) {
        const int n = nb + 8 * g + 4 * lh;
        float4 r; r.x = a[4 * g]; r.y = a[4 * g + 1]; r.z = a[4 * g + 2]; r.w = a[4 * g + 3];
        *(float4*)(RAW + (size_t)m * 768 + n) = r;
      }
    } else if (nb < 832) {
      const int off = nb - 768;
      const bool lat = m >= TC;
      const int tt = (m - TC) & 2047;
      const float pos = (off == 0) ? (float)(tt >> 6) : (float)(tt & 63);
      const size_t kr = (size_t)kvrow_of(m) * 64 + off;
#pragma unroll
      for (int g = 0; g < 2; g++) {
        float o1[4], o2[4];
#pragma unroll
        for (int e = 0; e < 4; e++) {
          const int i = 8 * g + 4 * lh + e;
          const float x1 = a[4 * g + e], x2 = a[4 * (g + 2) + e];
          if (lat) rope_pair(x1, x2, i, pos, o1[e], o2[e]); else { o1[e] = x1; o2[e] = x2; }
        }
        const int i0 = 8 * g + 4 * lh;
        if (!lat) {
          float4 r1; r1.x = o1[0]; r1.y = o1[1]; r1.z = o1[2]; r1.w = o1[3];
          float4 r2; r2.x = o2[0]; r2.y = o2[1]; r2.z = o2[2]; r2.w = o2[3];
          *(float4*)(st_kr + (size_t)m * 64 + off + i0) = r1;
          *(float4*)(st_kr + (size_t)m * 64 + off + i0 + 16) = r2;
        }
        uint2 v1; v1.x = pk2(o1[0], o1[1]); v1.y = pk2(o1[2], o1[3]);
        uint2 v2; v2.x = pk2(o2[0], o2[1]); v2.y = pk2(o2[2], o2[3]);
        *(uint2*)(KR + kr + i0) = v1;
        *(uint2*)(KR + kr + i0 + 16) = v2;
      }
    } else {
#pragma unroll
      for (int g = 0; g < 4; g++) {
        const int n = nb + 8 * g + 4 * lh - 832;
        uint2 v; v.x = pk2(silu(a[4 * g]), silu(a[4 * g + 1])); v.y = pk2(silu(a[4 * g + 2]), silu(a[4 * g + 3]));
        *(uint2*)(SZ + (size_t)m * 1024 + n) = v;
      }
    }
  }
};
struct EpiMlaQ {
  u16* Q;
  DI void operator()(int m, int nb, int lh, const f32x16& a) const {
    const int head = nb / 192, off = nb - head * 192;
    u16* qr = Q + (size_t)m * 1536 + nb;
    if (off < 128) {
#pragma unroll
      for (int g = 0; g < 4; g++) {
        uint2 v; v.x = pk2(a[4 * g] * MLA_QS, a[4 * g + 1] * MLA_QS); v.y = pk2(a[4 * g + 2] * MLA_QS, a[4 * g + 3] * MLA_QS);
        *(uint2*)(qr + 8 * g + 4 * lh) = v;
      }
    } else {
      const bool lat = m >= TC;
      const int tt = (m - TC) & 2047;
      const float pos = (off == 128) ? (float)(tt >> 6) : (float)(tt & 63);
#pragma unroll
      for (int g = 0; g < 2; g++) {
        float o1[4], o2[4];
#pragma unroll
        for (int e = 0; e < 4; e++) {
          const int i = 8 * g + 4 * lh + e;
          const float x1 = a[4 * g + e], x2 = a[4 * (g + 2) + e];
          if (lat) rope_pair(x1, x2, i, pos, o1[e], o2[e]); else { o1[e] = x1; o2[e] = x2; }
        }
        const int i0 = 8 * g + 4 * lh;
        uint2 v1; v1.x = pk2(o1[0] * MLA_QS, o1[1] * MLA_QS); v1.y = pk2(o1[2] * MLA_QS, o1[3] * MLA_QS);
        uint2 v2; v2.x = pk2(o2[0] * MLA_QS, o2[1] * MLA_QS); v2.y = pk2(o2[2] * MLA_QS, o2[3] * MLA_QS);
        *(uint2*)(qr + i0) = v1;
        *(uint2*)(qr + i0 + 16) = v2;
      }
    }
  }
};
struct EpiMlaKV {
  u16 *KN, *VT;
  DI void operator()(int m, int nb, int lh, const f32x16& a) const {
    const int head = nb >> 8, off = nb & 255;
    if (off < 128) {
#pragma unroll
      for (int g = 0; g < 4; g++) {
        uint2 v; v.x = pk2(a[4 * g], a[4 * g + 1]); v.y = pk2(a[4 * g + 2], a[4 * g + 3]);
        *(uint2*)(KN + (size_t)m * 1024 + head * 128 + off + 8 * g + 4 * lh) = v;
      }
    } else {
      size_t base; int Lk, key;
      if (m < TC) { base = (size_t)(m >> 8) * (8 * 128 * 256); Lk = 256; key = m & 255; }
      else { const int r2 = m - TC; const int b = r2 / 2304; key = r2 - b * 2304; Lk = 2304; base = (size_t)16 * 8 * 128 * 256 + (size_t)b * (8 * 128 * 2304); }
      u16* vp = VT + base + (size_t)(head * 128 + off - 128) * Lk + perm16(key);
#pragma unroll
      for (int g = 0; g < 4; g++)
#pragma unroll
        for (int e = 0; e < 4; e++) vp[(size_t)(8 * g + 4 * lh + e) * Lk] = f2bf(a[4 * g + e]);
    }
  }
};
struct EpiNaG1 {
  u16 *NQ, *NK, *NVT, *SZ; float *st_k, *st_v;
  DI void operator()(int m, int nb, int lh, const f32x16& a) const {
    if (nb < 1024) {
#pragma unroll
      for (int g = 0; g < 4; g++) {
        uint2 v; v.x = pk2(a[4 * g] * NA_QS, a[4 * g + 1] * NA_QS); v.y = pk2(a[4 * g + 2] * NA_QS, a[4 * g + 3] * NA_QS);
        *(uint2*)(NQ + (size_t)m * 1024 + nb + 8 * g + 4 * lh) = v;
      }
    } else if (nb < 2048) {
      const size_t kr = (size_t)kvrow_of(m) * 1024 + (nb - 1024);
#pragma unroll
      for (int g = 0; g < 4; g++) {
        uint2 v; v.x = pk2(a[4 * g], a[4 * g + 1]); v.y = pk2(a[4 * g + 2], a[4 * g + 3]);
        *(uint2*)(NK + kr + 8 * g + 4 * lh) = v;
        if (m < TC) { float4 r; r.x = a[4 * g]; r.y = a[4 * g + 1]; r.z = a[4 * g + 2]; r.w = a[4 * g + 3];
          *(float4*)(st_k + (size_t)m * 1024 + (nb - 1024) + 8 * g + 4 * lh) = r; }
      }
    } else if (nb < 3072) {
      const int c0 = nb - 2048;
      size_t base; int Lk, key;
      if (m < TC) { base = (size_t)(m >> 8) * (1024 * 256); Lk = 256; key = perm16(m & 255); }
      else { const int b = (m - TC) >> 11; key = 256 + ((m - TC) & 2047); Lk = 2304; base = (size_t)16 * 1024 * 256 + (size_t)b * (1024 * 2304); }
      u16* vp = NVT + base + (size_t)c0 * Lk + key;
#pragma unroll
      for (int g = 0; g < 4; g++) {
#pragma unroll
        for (int e = 0; e < 4; e++) vp[(size_t)(8 * g + 4 * lh + e) * Lk] = f2bf(a[4 * g + e]);
        if (m < TC) { float4 r; r.x = a[4 * g]; r.y = a[4 * g + 1]; r.z = a[4 * g + 2]; r.w = a[4 * g + 3];
          *(float4*)(st_v + (size_t)m * 1024 + c0 + 8 * g + 4 * lh) = r; }
      }
    } else {
#pragma unroll
      for (int g = 0; g < 4; g++) {
        uint2 v; v.x = pk2(silu(a[4 * g]), silu(a[4 * g + 1])); v.y = pk2(silu(a[4 * g + 2]), silu(a[4 * g + 3]));
        *(uint2*)(SZ + (size_t)m * 1024 + (nb - 3072) + 8 * g + 4 * lh) = v;
      }
    }
  }
};

template <int NSA, int NSB, int NDT>
DI void attn_dense_wave(const u16* __restrict__ qrow, const u16* __restrict__ kA, int kAstride, const u16* __restrict__ kB,
                        const u16* __restrict__ vt, int Lk, int nkeys, const u16* __restrict__ szrow, u16* __restrict__ orow) {
  const int lane = threadIdx.x & 63, l31 = lane & 31, lh = lane >> 5;
  bf16x8 qf[NSA + NSB];
#pragma unroll
  for (int s = 0; s < NSA + NSB; s++) qf[s] = *(const bf16x8*)(qrow + s * 16 + lh * 8);
  f32x16 o[NDT];
#pragma unroll
  for (int d = 0; d < NDT; d++)
#pragma unroll
    for (int r = 0; r < 16; r++) o[d][r] = 0.f;
  float m = -1e30f, l = 0.f;
  for (int k0 = 0; k0 < nkeys; k0 += 32) {
    f32x16 sa;
#pragma unroll
    for (int r = 0; r < 16; r++) sa[r] = 0.f;
    const u16* kp = kA + (size_t)(k0 + l31) * kAstride + lh * 8;
#pragma unroll
    for (int s = 0; s < NSA; s++) sa = MFMA32(*(const bf16x8*)(kp + s * 16), qf[s], sa);
    if (NSB > 0) {
      const u16* kp2 = kB + (size_t)(k0 + l31) * 64 + lh * 8;
#pragma unroll
      for (int s = 0; s < NSB; s++) sa = MFMA32(*(const bf16x8*)(kp2 + s * 16), qf[NSA + s], sa);
    }
    float mx = sa[0];
#pragma unroll
    for (int r = 1; r < 16; r++) mx = fmaxf(mx, sa[r]);
    mx = fmaxf(mx, __shfl_xor(mx, 32));
    const float mn = fmaxf(m, mx);
    const float alpha = __builtin_amdgcn_exp2f(m - mn);
    m = mn;
    float ps = 0.f;
#pragma unroll
    for (int r = 0; r < 16; r++) { sa[r] = exp2f(sa[r] - mn); ps += sa[r]; }
    l = l * alpha + ps;
#pragma unroll
    for (int d = 0; d < NDT; d++)
#pragma unroll
      for (int r = 0; r < 16; r++) o[d][r] *= alpha;
#pragma unroll
    for (int sp = 0; sp < 2; sp++) {
      u32x4 pw;
      pw[0] = pk2(sa[8 * sp + 0], sa[8 * sp + 1]); pw[1] = pk2(sa[8 * sp + 2], sa[8 * sp + 3]);
      pw[2] = pk2(sa[8 * sp + 4], sa[8 * sp + 5]); pw[3] = pk2(sa[8 * sp + 6], sa[8 * sp + 7]);
      const bf16x8 pf = __builtin_bit_cast(bf16x8, pw);
#pragma unroll
      for (int d = 0; d < NDT; d++) {
        const u16* vp = vt + (size_t)(d * 32 + l31) * Lk + k0 + 16 * sp + 4 * lh;
        const uint2 lo = *(const uint2*)vp, hi = *(const uint2*)(vp + 8);
        u32x4 vw; vw[0] = lo.x; vw[1] = lo.y; vw[2] = hi.x; vw[3] = hi.y;
        o[d] = MFMA32(__builtin_bit_cast(bf16x8, vw), pf, o[d]);
      }
    }
  }
  l += __shfl_xor(l, 32);
  const float inv = 1.f / l;
#pragma unroll
  for (int d = 0; d < NDT; d++)
#pragma unroll
    for (int g = 0; g < 4; g++) {
      const int d0 = d * 32 + 8 * g + 4 * lh;
      const uint2 z = *(const uint2*)(szrow + d0);
      uint2 v;
      v.x = pk2(o[d][4 * g] * inv * bf2f((u16)(z.x & 0xffff)), o[d][4 * g + 1] * inv * bf2f((u16)(z.x >> 16)));
      v.y = pk2(o[d][4 * g + 2] * inv * bf2f((u16)(z.y & 0xffff)), o[d][4 * g + 3] * inv * bf2f((u16)(z.y >> 16)));
      *(uint2*)(orow + d0) = v;
    }
}


template <int NSA, int NSB, int NDT>
DI void attn_dense_block(char* smem, const u16* __restrict__ qrow, const u16* __restrict__ kA, int kAstride, const u16* __restrict__ kB,
                         const u16* __restrict__ vt, int Lk, int nkeys, const u16* __restrict__ szrow, u16* __restrict__ orow) {
  constexpr int NS = NSA + NSB, DV = 32 * NDT, CA = NSA * 2;
  constexpr int KN_B = 64 * CA * 16, KR_B = (NSB > 0) ? 64 * 128 : 0, V_B = DV * 128, STG = KN_B + KR_B + V_B;
  constexpr int NLA = 64 * CA / 256, NLB = (NSB > 0) ? 2 : 0, NLV = DV * 8 / 256;
  const int tid = threadIdx.x, lane = tid & 63, wid = tid >> 6, l31 = lane & 31, lh = lane >> 5;
  const int arow = (CA == 16) ? (tid >> 4) : (tid >> 3);
  const int acc_ = (CA == 16) ? ((tid & 15) ^ ((tid >> 4) & 15)) : ((tid & 7) ^ ((tid >> 4) & 7));
  const int brow = tid >> 3, bcc = (tid & 7) ^ ((tid >> 4) & 7);
  const u16* ka_src = kA + (size_t)arow * kAstride + acc_ * 8;
  const u16* kb_src = (NSB > 0) ? (kB + (size_t)brow * 64 + bcc * 8) : kA;
  const u16* v_src = vt + (size_t)brow * Lk + bcc * 8;
  LAS char* wbase = (LAS char*)(smem + wid * 1024);
  bf16x8 qf[NS];
#pragma unroll
  for (int s = 0; s < NS; s++) qf[s] = *(const bf16x8*)(qrow + s * 16 + lh * 8);
  f32x16 o[NDT];
#pragma unroll
  for (int d = 0; d < NDT; d++)
#pragma unroll
    for (int r = 0; r < 16; r++) o[d][r] = 0.f;
  float m = -1e30f, l = 0.f;
  const int swA = (CA == 16) ? (l31 & 15) : ((l31 >> 1) & 7);
  const int swB = (l31 >> 1) & 7;

  __syncthreads();
#pragma unroll
  for (int i = 0; i < NLA; i++)
    __builtin_amdgcn_global_load_lds((const void*)(ka_src + (size_t)(i * (256 / CA)) * kAstride), (LAS void*)(wbase + i * 4096), 16, 0, 0);
#pragma unroll
  for (int i = 0; i < NLB; i++)
    __builtin_amdgcn_global_load_lds((const void*)(kb_src + (size_t)(32 * i) * 64), (LAS void*)(wbase + KN_B + i * 4096), 16, 0, 0);
#pragma unroll
  for (int i = 0; i < NLV; i++)
    __builtin_amdgcn_global_load_lds((const void*)(v_src + (size_t)(32 * i) * Lk), (LAS void*)(wbase + KN_B + KR_B + i * 4096), 16, 0, 0);
  asm volatile("s_waitcnt vmcnt(0)" ::: "memory");
  __syncthreads();
  int st = 0;
  for (int k0 = 0; k0 < nkeys; k0 += 64, st ^= 1) {
    if (k0 + 64 < nkeys) {
      const int kn = k0 + 64;
      LAS char* wb = wbase + (st ^ 1) * STG;
#pragma unroll
      for (int i = 0; i < NLA; i++)
        __builtin_amdgcn_global_load_lds((const void*)(ka_src + (size_t)(kn + i * (256 / CA)) * kAstride), (LAS void*)(wb + i * 4096), 16, 0, 0);
#pragma unroll
      for (int i = 0; i < NLB; i++)
        __builtin_amdgcn_global_load_lds((const void*)(kb_src + (size_t)(kn + 32 * i) * 64), (LAS void*)(wb + KN_B + i * 4096), 16, 0, 0);
#pragma unroll
      for (int i = 0; i < NLV; i++)
        __builtin_amdgcn_global_load_lds((const void*)(v_src + (size_t)(32 * i) * Lk + kn), (LAS void*)(wb + KN_B + KR_B + i * 4096), 16, 0, 0);
    }
    const char* Kn = smem + st * STG;
    const char* Kr = Kn + KN_B;
    const char* Vs = Kr + KR_B;
#pragma unroll 1
    for (int hh = 0; hh < 2; hh++) {
      f32x16 s0;
#pragma unroll
      for (int r = 0; r < 16; r++) s0[r] = 0.f;
      const char* kpa = Kn + (hh * 32 + l31) * (CA * 16);
#pragma unroll
      for (int s = 0; s < NSA; s++) s0 = MFMA32(*(const bf16x8*)(kpa + (((2 * s + lh) ^ swA) << 4)), qf[s], s0);
      if constexpr (NSB > 0) {
        const char* kpb = Kr + (hh * 32 + l31) * 128;
#pragma unroll
        for (int s = 0; s < NSB; s++) s0 = MFMA32(*(const bf16x8*)(kpb + (((2 * s + lh) ^ swB) << 4)), qf[NSA + s], s0);
      }
      float mx = s0[0];
#pragma unroll
      for (int r = 1; r < 16; r++) mx = fmaxf(mx, s0[r]);
      mx = fmaxf(mx, __shfl_xor(mx, 32));
      if (__any(mx > m + 8.f)) {
        const float mn = fmaxf(m, mx);
        const float alpha = __builtin_amdgcn_exp2f(m - mn);
        m = mn;
        l *= alpha;
#pragma unroll
        for (int d = 0; d < NDT; d++)
#pragma unroll
          for (int r = 0; r < 16; r++) o[d][r] *= alpha;
      }
      float ps = 0.f;
#pragma unroll
      for (int r = 0; r < 16; r++) { s0[r] = __builtin_amdgcn_exp2f(s0[r] - m); ps += s0[r]; }
      l += ps;
      const char* vp = Vs + l31 * 128;
#pragma unroll
      for (int sp = 0; sp < 2; sp++) {
        u32x4 pw;
        pw[0] = pk2(s0[8 * sp + 0], s0[8 * sp + 1]); pw[1] = pk2(s0[8 * sp + 2], s0[8 * sp + 3]);
        pw[2] = pk2(s0[8 * sp + 4], s0[8 * sp + 5]); pw[3] = pk2(s0[8 * sp + 6], s0[8 * sp + 7]);
        const bf16x8 pf = __builtin_bit_cast(bf16x8, pw);
        const int vo = ((hh * 4 + sp * 2 + lh) ^ swB) << 4;
#pragma unroll
        for (int d = 0; d < NDT; d++) o[d] = MFMA32(*(const bf16x8*)(vp + d * 32 * 128 + vo), pf, o[d]);
      }
    }
    asm volatile("s_waitcnt vmcnt(0)" ::: "memory");
    __syncthreads();
  }
  l += __shfl_xor(l, 32);
  const float inv = 1.f / l;
#pragma unroll
  for (int d = 0; d < NDT; d++)
#pragma unroll
    for (int g = 0; g < 4; g++) {
      const int d0 = d * 32 + 8 * g + 4 * lh;
      const uint2 z = *(const uint2*)(szrow + d0);
      uint2 v;
      v.x = pk2(o[d][4 * g] * inv * bf2f((u16)(z.x & 0xffff)), o[d][4 * g + 1] * inv * bf2f((u16)(z.x >> 16)));
      v.y = pk2(o[d][4 * g + 2] * inv * bf2f((u16)(z.y & 0xffff)), o[d][4 * g + 3] * inv * bf2f((u16)(z.y >> 16)));
      *(uint2*)(orow + d0) = v;
    }
}

DI void attn_na_wave(const Params& p, int b, int h, int r, int j) {
  const int lane = threadIdx.x & 63, l15 = lane & 15, q4 = lane >> 4;
  const int t = TC + b * 2048 + r * 64 + j * 16 + l15;
  const u16* qrow = p.NQ + (size_t)t * 1024 + h * 64;
  const bf16x8 qf0 = *(const bf16x8*)(qrow + q4 * 8);
  const bf16x8 qf1 = *(const bf16x8*)(qrow + 32 + q4 * 8);
  const int rs = min(max(r - 4, 0), 24);
  const int bstart = min(max(j * 16 - 8, 0), 32);
  const int c = j * 16 + l15;
  const int cstart = min(max(c - 8, 0), 48);
  const u16* kb = p.NK + (size_t)(TC + b * 2304) * 1024 + h * 64;
  const u16* vb = p.NVT + (size_t)16 * 1024 * 256 + (size_t)b * (1024 * 2304) + (size_t)(h * 64) * 2304;
  const float* rp = p.na_rpb + h * 465;
  f32x4 o[4];
#pragma unroll
  for (int d = 0; d < 4; d++) { o[d][0] = 0.f; o[d][1] = 0.f; o[d][2] = 0.f; o[d][3] = 0.f; }
  float m = -1e30f, l = 0.f;
  const int krow0 = 8 * (l15 >> 2) + (l15 & 3);
  for (int cg4 = 0; cg4 < 4; cg4++) {
    bf16x8 kf[4][4];
    bf16x8 vf[4][4];
#pragma unroll
    for (int c4 = 0; c4 < 4; c4++) {
      const int ch = cg4 * 4 + c4;
      const int key0 = ch < 8 ? ch * 32 : 256 + (rs + ch - 8) * 64 + bstart;
      const u16* kp = kb + (size_t)(key0 + krow0) * 1024 + q4 * 8;
      kf[c4][0] = *(const bf16x8*)(kp);
      kf[c4][1] = *(const bf16x8*)(kp + 32);
      kf[c4][2] = *(const bf16x8*)(kp + 4 * 1024);
      kf[c4][3] = *(const bf16x8*)(kp + 4 * 1024 + 32);
#pragma unroll
      for (int d = 0; d < 4; d++) vf[c4][d] = *(const bf16x8*)(vb + (size_t)(d * 16 + l15) * 2304 + key0 + q4 * 8);
    }
#pragma unroll
    for (int c4 = 0; c4 < 4; c4++) {
      const int ch = cg4 * 4 + c4;
      f32x4 s0 = {0.f, 0.f, 0.f, 0.f}, s1 = {0.f, 0.f, 0.f, 0.f};
      s0 = MFMA16(kf[c4][0], qf0, s0);
      s0 = MFMA16(kf[c4][1], qf1, s0);
      s1 = MFMA16(kf[c4][2], qf0, s1);
      s1 = MFMA16(kf[c4][3], qf1, s1);
      if (cg4 >= 2) {
        const int dr = rs + (ch - 8) - r + 7;
#pragma unroll
        for (int i = 0; i < 4; i++) {
          const int kc0 = bstart + q4 * 8 + i, kc1 = kc0 + 4;
          const bool v0 = (kc0 >= cstart) && (kc0 < cstart + 16);
          const bool v1 = (kc1 >= cstart) && (kc1 < cstart + 16);
          const int dc0 = min(max(kc0 - c + 15, 0), 30), dc1 = min(max(kc1 - c + 15, 0), 30);
          const float b0 = rp[dr * 31 + dc0] * LOG2E, b1 = rp[dr * 31 + dc1] * LOG2E;
          s0[i] = v0 ? s0[i] + b0 : -1e30f;
          s1[i] = v1 ? s1[i] + b1 : -1e30f;
        }
      }
      float mx = fmaxf(fmaxf(fmaxf(s0[0], s0[1]), fmaxf(s0[2], s0[3])), fmaxf(fmaxf(s1[0], s1[1]), fmaxf(s1[2], s1[3])));
      mx = fmaxf(mx, __shfl_xor(mx, 16));
      mx = fmaxf(mx, __shfl_xor(mx, 32));
      const float mn = fmaxf(m, mx);
      const float alpha = __builtin_amdgcn_exp2f(m - mn);
      m = mn;
      float ps = 0.f;
#pragma unroll
      for (int i = 0; i < 4; i++) { s0[i] = exp2f(s0[i] - mn); s1[i] = exp2f(s1[i] - mn); ps += s0[i] + s1[i]; }
      l = l * alpha + ps;
      u32x4 pw; pw[0] = pk2(s0[0], s0[1]); pw[1] = pk2(s0[2], s0[3]); pw[2] = pk2(s1[0], s1[1]); pw[3] = pk2(s1[2], s1[3]);
      const bf16x8 pf = __builtin_bit_cast(bf16x8, pw);
#pragma unroll
      for (int d = 0; d < 4; d++) {
        o[d][0] *= alpha; o[d][1] *= alpha; o[d][2] *= alpha; o[d][3] *= alpha;
        o[d] = MFMA16(vf[c4][d], pf, o[d]);
      }
    }
  }
  l += __shfl_xor(l, 16);
  l += __shfl_xor(l, 32);
  const float inv = 1.f / l;
  const u16* szrow = p.SZ + (size_t)t * 1024 + h * 64;
  u16* orow = p.NAO + (size_t)t * 1024 + h * 64;
#pragma unroll
  for (int d = 0; d < 4; d++) {
    const int d0 = d * 16 + q4 * 4;
    const uint2 z = *(const uint2*)(szrow + d0);
    uint2 v;
    v.x = pk2(o[d][0] * inv * bf2f((u16)(z.x & 0xffff)), o[d][1] * inv * bf2f((u16)(z.x >> 16)));
    v.y = pk2(o[d][2] * inv * bf2f((u16)(z.y & 0xffff)), o[d][3] * inv * bf2f((u16)(z.y >> 16)));
    *(uint2*)(orow + d0) = v;
  }
}


DI void attn_na_block(const Params& p, char* smem, int b, int h, int rpair) {
  const int tid = threadIdx.x, lane = tid & 63, j = tid >> 6, l31 = lane & 31, lh = lane >> 5;
  float* bl = (float*)(smem + 65536);
  const int r0 = rpair * 2;
  const int qr = r0 + (l31 >> 4), c = j * 16 + (l31 & 15);
  const int t = TC + b * 2048 + qr * 64 + c;
  const int rsq = min(max(qr - 4, 0), 24);
  const int rs0 = min(max(r0 - 4, 0), 24);
  const int nrows = min(max(r0 + 1 - 4, 0), 24) + 8 - rs0;
  const int ntile = 4 + nrows;
  const int bstart = min(max(j * 16 - 8, 0), 32);
  const int cstart = min(max(c - 8, 0), 48);
  const u16* kb = p.NK + (size_t)(TC + b * 2304) * 1024 + h * 64;
  const u16* vb = p.NVT + (size_t)16 * 1024 * 256 + (size_t)b * (1024 * 2304) + (size_t)(h * 64) * 2304;
  const u16* qrow = p.NQ + (size_t)t * 1024 + h * 64;
  bf16x8 qf[4];
#pragma unroll
  for (int s = 0; s < 4; s++) qf[s] = *(const bf16x8*)(qrow + s * 16 + lh * 8);
  f32x16 o[2];
#pragma unroll
  for (int d = 0; d < 2; d++)
#pragma unroll
    for (int r = 0; r < 16; r++) o[d][r] = 0.f;
  float m = -1e30f, l = 0.f;
  const int r16 = l31 & 15;
  const int kap = (l31 & 16) + (r16 & 3) + 4 * ((r16 >> 3) & 1) + 8 * ((r16 >> 2) & 1);
  const int srow = tid >> 3, scc = ((tid & 7) ^ ((tid >> 4) & 7)) * 8;
  const u16* ksrc = kb + (size_t)srow * 1024 + scc;
  const u16* vsrc = vb + (size_t)srow * 2304 + scc;
  LAS char* wbase = (LAS char*)(smem + (tid >> 6) * 1024);
  const int swV = (l31 >> 1) & 7;
  __syncthreads();
  for (int idx = tid; idx < 1024; idx += 256) {
    const int dr = idx >> 6, off = (idx & 63) - 16;
    const float v = p.na_rpb[h * 465 + min(dr, 14) * 31 + min(max(off, 0), 30)] * LOG2E;
    bl[idx] = (dr == 15) ? -1e30f : ((off >= 0 && off < 31) ? v : 0.f);
  }
  float am[16];
#pragma unroll
  for (int i = 0; i < 16; i++) {
    const int kcol = bstart + 16 * (i >> 3) + 8 * lh + (i & 7);
    am[i] = ((kcol >= cstart) && (kcol < cstart + 16)) ? 0.f : -1e30f;
  }
  const int ab = 16 + bstart + 8 * lh - c + 15;
#pragma unroll
  for (int tl = 0; tl < 3; tl++) {
    const int key0 = tl * 64;
    LAS char* wb = wbase + tl * 16384;
    __builtin_amdgcn_global_load_lds((const void*)(ksrc + (size_t)key0 * 1024), (LAS void*)(wb), 16, 0, 0);
    __builtin_amdgcn_global_load_lds((const void*)(ksrc + (size_t)(key0 + 32) * 1024), (LAS void*)(wb + 4096), 16, 0, 0);
    __builtin_amdgcn_global_load_lds((const void*)(vsrc + key0), (LAS void*)(wb + 8192), 16, 0, 0);
    __builtin_amdgcn_global_load_lds((const void*)(vsrc + (size_t)32 * 2304 + key0), (LAS void*)(wb + 8192 + 4096), 16, 0, 0);
  }
  asm volatile("s_waitcnt vmcnt(8)" ::: "memory");
  asm volatile("s_waitcnt lgkmcnt(0)" ::: "memory");
  __builtin_amdgcn_s_barrier();
  for (int tl = 0; tl < ntile; tl++) {
    if (tl + 3 < ntile) {
      const int tn = tl + 3;
      const int key0 = tn < 4 ? tn * 64 : 256 + (rs0 + tn - 4) * 64;
      LAS char* wb = wbase + (tn & 3) * 16384;
      __builtin_amdgcn_global_load_lds((const void*)(ksrc + (size_t)key0 * 1024), (LAS void*)(wb), 16, 0, 0);
      __builtin_amdgcn_global_load_lds((const void*)(ksrc + (size_t)(key0 + 32) * 1024), (LAS void*)(wb + 4096), 16, 0, 0);
      __builtin_amdgcn_global_load_lds((const void*)(vsrc + key0), (LAS void*)(wb + 8192), 16, 0, 0);
      __builtin_amdgcn_global_load_lds((const void*)(vsrc + (size_t)32 * 2304 + key0), (LAS void*)(wb + 8192 + 4096), 16, 0, 0);
    }
    const char* Kc = smem + (tl & 3) * 16384;
    const char* Vc = Kc + 8192;
    const bool local = tl >= 4;
    const int gr = rs0 + tl - 4;
    const int nh = local ? 1 : 2;
    for (int hh = 0; hh < nh; hh++) {
      const int koff = local ? bstart : hh * 32;
      f32x16 s0;
#pragma unroll
      for (int r = 0; r < 16; r++) s0[r] = 0.f;
      const int krow = koff + kap;
      const char* kp = Kc + krow * 128;
      const int swK = (krow >> 1) & 7;
#pragma unroll
      for (int s = 0; s < 4; s++) s0 = MFMA32(*(const bf16x8*)(kp + (((2 * s + lh) ^ swK) << 4)), qf[s], s0);
      if (local) {
        const bool rowvalid = (gr >= rsq) && (gr < rsq + 8);
        const int dr = rowvalid ? min(max(gr - qr + 7, 0), 14) : 15;
        const float* bp = bl + dr * 64 + ab;
#pragma unroll
        for (int i = 0; i < 16; i++) s0[i] += bp[16 * (i >> 3) + (i & 7)] + am[i];
      }
      float mx = s0[0];
#pragma unroll
      for (int r = 1; r < 16; r++) mx = fmaxf(mx, s0[r]);
      mx = fmaxf(mx, __shfl_xor(mx, 32));
      if (__any(mx > m + 8.f)) {
        const float mn = fmaxf(m, mx);
        const float alpha = __builtin_amdgcn_exp2f(m - mn);
        m = mn;
        l *= alpha;
#pragma unroll
        for (int d = 0; d < 2; d++)
#pragma unroll
          for (int r = 0; r < 16; r++) o[d][r] *= alpha;
      }
      float ps = 0.f;
#pragma unroll
      for (int r = 0; r < 16; r++) { s0[r] = __builtin_amdgcn_exp2f(s0[r] - m); ps += s0[r]; }
      l += ps;
      const char* vp = Vc + l31 * 128;
      const int vch = (koff >> 3) + lh;
#pragma unroll
      for (int sp = 0; sp < 2; sp++) {
        u32x4 pw;
        pw[0] = pk2(s0[8 * sp + 0], s0[8 * sp + 1]); pw[1] = pk2(s0[8 * sp + 2], s0[8 * sp + 3]);
        pw[2] = pk2(s0[8 * sp + 4], s0[8 * sp + 5]); pw[3] = pk2(s0[8 * sp + 6], s0[8 * sp + 7]);
        const bf16x8 pf = __builtin_bit_cast(bf16x8, pw);
        const int vo = ((vch + 2 * sp) ^ swV) << 4;
#pragma unroll
        for (int d = 0; d < 2; d++) o[d] = MFMA32(*(const bf16x8*)(vp + d * 32 * 128 + vo), pf, o[d]);
      }
    }
    if (tl + 3 < ntile) asm volatile("s_waitcnt vmcnt(8)" ::: "memory");
    else if (tl + 2 < ntile) asm volatile("s_waitcnt vmcnt(4)" ::: "memory");
    else asm volatile("s_waitcnt vmcnt(0)" ::: "memory");
    asm volatile("s_waitcnt lgkmcnt(0)" ::: "memory");
    __builtin_amdgcn_s_barrier();
  }
  l += __shfl_xor(l, 32);
  const float inv = 1.f / l;
  const u16* szrow = p.SZ + (size_t)t * 1024 + h * 64;
  u16* orow = p.NAO + (size_t)t * 1024 + h * 64;
#pragma unroll
  for (int d = 0; d < 2; d++)
#pragma unroll
    for (int g = 0; g < 4; g++) {
      const int d0 = d * 32 + 8 * g + 4 * lh;
      const uint2 z = *(const uint2*)(szrow + d0);
      uint2 v;
      v.x = pk2(o[d][4 * g] * inv * bf2f((u16)(z.x & 0xffff)), o[d][4 * g + 1] * inv * bf2f((u16)(z.x >> 16)));
      v.y = pk2(o[d][4 * g + 2] * inv * bf2f((u16)(z.y & 0xffff)), o[d][4 * g + 3] * inv * bf2f((u16)(z.y >> 16)));
      *(uint2*)(orow + d0) = v;
    }
}

DI void ph_prep(const Params& p, char* smem) {
  const int tid = threadIdx.x;
  const int ntr = p.nmat_tiles;
  const int ntot = ntr + 192;
  for (int tile = blockIdx.x; tile < ntot; tile += gridDim.x) {
    __syncthreads();
    if (tile >= 192) {
      const int ttile = tile - 192;
      int mi = 0;
      for (int i = 1; i < 18; i++) if (ttile >= p.mats[i].tile0) mi = i;
      const float* src = p.mats[mi].src; u16* dst = p.mats[mi].dst;
      const int K = p.mats[mi].K, Nsrc = p.mats[mi].Nsrc, Ndst = p.mats[mi].Ndst;
      const int lt = ttile - p.mats[mi].tile0;
      const int ntn = Ndst >> 6;
      const int kt = lt / ntn, nt = lt - kt * ntn;
      float* ts = (float*)smem;
#pragma unroll
      for (int i = 0; i < 4; i++) {
        const int k = i * 16 + (tid >> 4), n4 = (tid & 15) * 4, n = nt * 64 + n4;
        float4 v = {0.f, 0.f, 0.f, 0.f};
        if (n < Nsrc) v = *(const float4*)(src + (size_t)(kt * 64 + k) * Nsrc + n);
        ts[k * 65 + n4] = v.x; ts[k * 65 + n4 + 1] = v.y; ts[k * 65 + n4 + 2] = v.z; ts[k * 65 + n4 + 3] = v.w;
      }
      __syncthreads();
      const int n = tid >> 2, kc = (tid & 3) * 16;
      uint32_t w[8];
#pragma unroll
      for (int e = 0; e < 8; e++) w[e] = pk2(ts[(kc + 2 * e) * 65 + n], ts[(kc + 2 * e + 1) * 65 + n]);
      u16* dp = dst + (size_t)(nt * 64 + n) * K + kt * 64 + kc;
      uint4 v0; v0.x = w[0]; v0.y = w[1]; v0.z = w[2]; v0.w = w[3];
      uint4 v1; v1.x = w[4]; v1.y = w[5]; v1.z = w[6]; v1.w = w[7];
      *(uint4*)dp = v0; *(uint4*)(dp + 8) = v1;
    } else {
      const int at = tile;
      const int layer = at / 48, c0 = (at - layer * 48) * 64;
      float* sc = (float*)smem;
      float* red = sc + 5 * 1024;
      for (int i = tid; i < 5 * 1024; i += 256) {
        const int n = i >> 10, k = i & 1023;
        const float v = (n == 0) ? p.c_ctx[k] : p.c[(n - 1) * 1024 + k];
        sc[i] = silu(v);
      }
      __syncthreads();
      const int c4 = (tid & 15) * 4, kg = tid >> 4;
      float acc[5][4];
#pragma unroll
      for (int n = 0; n < 5; n++) { acc[n][0] = 0.f; acc[n][1] = 0.f; acc[n][2] = 0.f; acc[n][3] = 0.f; }
      const float* w = p.ada_w + (size_t)layer * 1024 * 3072 + c0 + c4;
#pragma unroll 4
      for (int kk = 0; kk < 64; kk++) {
        const int k = kg * 64 + kk;
        const float4 wv = *(const float4*)(w + (size_t)k * 3072);
#pragma unroll
        for (int n = 0; n < 5; n++) {
          const float s = sc[n * 1024 + k];
          acc[n][0] += s * wv.x; acc[n][1] += s * wv.y; acc[n][2] += s * wv.z; acc[n][3] += s * wv.w;
        }
      }
#pragma unroll
      for (int n = 0; n < 5; n++) {
        float4 r; r.x = acc[n][0]; r.y = acc[n][1]; r.z = acc[n][2]; r.w = acc[n][3];
        *(float4*)(red + (kg * 5 + n) * 64 + c4) = r;
      }
      __syncthreads();
      for (int o = tid; o < 320; o += 256) {
        const int n = o >> 6, cc = o & 63;
        float s = 0.f;
#pragma unroll
        for (int g = 0; g < 16; g++) s += red[(g * 5 + n) * 64 + cc];
        s += p.ada_b[layer * 3072 + c0 + cc];
        p.mod[(layer * 5 + n) * 3072 + c0 + cc] = s;
      }
    }
  }
}

DI void ph_h0(const Params& p) {
  for (int idx = blockIdx.x * 256 + threadIdx.x; idx < T * 128; idx += gridDim.x * 256) {
    const int t = idx >> 7, c0 = (idx & 127) * 8;
    const float* xr = (t < TC) ? p.x_prompt + (size_t)t * 1024 : p.x_sample + (size_t)(t - TC) * 1024;
    const float* md = p.mod + cond_of(t) * 3072;
    const float4 x0 = *(const float4*)(xr + c0), x1 = *(const float4*)(xr + c0 + 4);
    const float4 sh0 = *(const float4*)(md + c0), sh1 = *(const float4*)(md + c0 + 4);
    const float4 sc0 = *(const float4*)(md + 1024 + c0), sc1 = *(const float4*)(md + 1024 + c0 + 4);
    uint4 v;
    v.x = pk2(x0.x * (1.f + sc0.x) + sh0.x, x0.y * (1.f + sc0.y) + sh0.y);
    v.y = pk2(x0.z * (1.f + sc0.z) + sh0.z, x0.w * (1.f + sc0.w) + sh0.w);
    v.z = pk2(x1.x * (1.f + sc1.x) + sh1.x, x1.y * (1.f + sc1.y) + sh1.y);
    v.w = pk2(x1.z * (1.f + sc1.z) + sh1.z, x1.w * (1.f + sc1.w) + sh1.w);
    *(uint4*)(p.H + (size_t)t * 1024 + c0) = v;
  }
}

template <class Epi>
DI void gemm_phase(const u16* A, int lda, const u16* Bt, int ldb, int K, int MT, int NT, char* smem, const Epi& epi) {
  const int ntile = MT * NT;
  for (int tile = blockIdx.x; tile < ntile; tile += gridDim.x) {
    const int nt = tile / MT, mt = tile - nt * MT;
    gemm_tile<3>(A, lda, Bt, ldb, K, mt * 192, nt * 128, 0, smem, epi);
  }
}

template <class Epi>
DI void gemm_phase_st(const u16* A, int lda, const u16* Bt, int ldb, int K, int MT, int NT, char* smem, const Epi& epi) {
  const int ntile = MT * NT;
  for (int tile = blockIdx.x; tile < ntile; tile += gridDim.x) {
    const int nt = tile / MT, mt = tile - nt * MT;
    gemm_tile<3, Epi, true>(A, lda, Bt, ldb, K, mt * 192, nt * 128, 0, smem, epi);
  }
}

DI void unpack8(const u32x4& u, float* f) {
  f[0] = __uint_as_float(u[0] << 16); f[1] = __uint_as_float(u[0] & 0xffff0000u);
  f[2] = __uint_as_float(u[1] << 16); f[3] = __uint_as_float(u[1] & 0xffff0000u);
  f[4] = __uint_as_float(u[2] << 16); f[5] = __uint_as_float(u[2] & 0xffff0000u);
  f[6] = __uint_as_float(u[3] << 16); f[7] = __uint_as_float(u[3] & 0xffff0000u);
}
template <int HW>
DI void mix_item(const Params& p, int rpair) {
  const int lane = threadIdx.x & 63;
  constexpr int g = (HW == 1) ? 0 : (HW == 2) ? 1 : (HW == 4) ? 2 : 3;
  constexpr int NR = 8 + 2 * HW;
  const int c0 = (g * 32 + (lane & 31)) * 8;
  const int t0 = (rpair * 2 + (lane >> 5)) * 8;
  int s0, L, tt0;
  if (t0 < TC) { s0 = t0 & ~255; tt0 = t0 & 255; L = 256; } else { s0 = TC + ((t0 - TC) & ~2047); tt0 = (t0 - TC) & 2047; L = 2048; }
  u32x4 rows[NR];
#pragma unroll
  for (int r = 0; r < NR; r++) {
    const int tt = tt0 - HW + r;
    u32x4 v = {0u, 0u, 0u, 0u};
    if (tt >= 0 && tt < L) v = *(const u32x4*)(p.U + (size_t)(s0 + tt) * 1024 + c0);
    rows[r] = v;
  }
  float sum[8];
#pragma unroll
  for (int k = 0; k < 8; k++) sum[k] = 0.f;
#pragma unroll
  for (int r = 0; r < 2 * HW; r++) {
    float f[8]; unpack8(rows[r], f);
#pragma unroll
    for (int k = 0; k < 8; k++) sum[k] += f[k];
  }
#pragma unroll
  for (int e = 0; e < 8; e++) {
    const int tt = tt0 + e;
    const int lo = max(tt - HW, 0), hi = min(tt + HW, L);
    const float ic = 1.f / (float)(hi - lo);
    float own[8]; unpack8(rows[e + HW], own);
    u32x4 v;
    v[0] = pk2(sum[0] * ic - own[0], sum[1] * ic - own[1]);
    v[1] = pk2(sum[2] * ic - own[2], sum[3] * ic - own[3]);
    v[2] = pk2(sum[4] * ic - own[4], sum[5] * ic - own[5]);
    v[3] = pk2(sum[6] * ic - own[6], sum[7] * ic - own[7]);
    *(u32x4*)(p.MIX + (size_t)(s0 + tt) * 1024 + c0) = v;
    if (e < 7) {
      float fo[8], fi[8]; unpack8(rows[e], fo); unpack8(rows[e + 2 * HW], fi);
#pragma unroll
      for (int k = 0; k < 8; k++) sum[k] += fi[k] - fo[k];
    }
  }
}
DI void ph_mix(const Params& p) {
  const int wid = threadIdx.x >> 6;
  for (int item = blockIdx.x * 4 + wid; item < 768 * 4; item += gridDim.x * 4) {
    const int rpair = item >> 2, g = item & 3;
    if (g == 0) mix_item<1>(p, rpair);
    else if (g == 1) mix_item<2>(p, rpair);
    else if (g == 2) mix_item<4>(p, rpair);
    else mix_item<8>(p, rpair);
  }
}

DI void ph_pool_g2(const Params& p, int j, char* smem) {
  EpiPoolG2 epi{p.PM, p.SZ, p.pool_scale + j * 1024};
  for (int tile = blockIdx.x; tile < 64 * 8; tile += gridDim.x) {
    const int gn = tile / 64, mt = tile - gn * 64;
    const int g = gn >> 1, ns = gn & 1;
    gemm_tile<3>(p.MIX + g * 256, 1024, p.Wgrp + (size_t)(j * 4 + g) * 65536, 256, 256, mt * 192, ns * 128, g * 256, smem, epi);
  }
}

DI void ph_ln(const Params& p, int layer) {
  const int lane = threadIdx.x & 63, wid = threadIdx.x >> 6;
  const float* g = p.ln_g + layer * 1024;
  const float* bb = p.ln_b + layer * 1024;
  const int nw = gridDim.x * 4;
  for (int row0 = blockIdx.x * 4 + wid; row0 < T; row0 += 2 * nw) {
    const int row1 = row0 + nw;
    const bool has1 = row1 < T;
    const int r1 = has1 ? row1 : row0;
    float* xr0 = p.out + (size_t)row0 * 1024;
    float* xr1 = p.out + (size_t)r1 * 1024;
    const float* xi0 = (layer > 0) ? xr0 : ((row0 < TC) ? p.x_prompt + (size_t)row0 * 1024 : p.x_sample + (size_t)(row0 - TC) * 1024);
    const float* xi1 = (layer > 0) ? xr1 : ((r1 < TC) ? p.x_prompt + (size_t)r1 * 1024 : p.x_sample + (size_t)(r1 - TC) * 1024);
    float4 v0[4], v1[4];
#pragma unroll
    for (int i = 0; i < 4; i++) {
      v0[i] = *(const float4*)(xi0 + i * 256 + lane * 4); v1[i] = *(const float4*)(xi1 + i * 256 + lane * 4);
      const uint2 g0 = *(const uint2*)(p.GO + (size_t)row0 * 1024 + i * 256 + lane * 4);
      const uint2 g1 = *(const uint2*)(p.GO + (size_t)r1 * 1024 + i * 256 + lane * 4);
      v0[i].x = ALPHA * v0[i].x + bf2f((u16)(g0.x & 0xffff)); v0[i].y = ALPHA * v0[i].y + bf2f((u16)(g0.x >> 16));
      v0[i].z = ALPHA * v0[i].z + bf2f((u16)(g0.y & 0xffff)); v0[i].w = ALPHA * v0[i].w + bf2f((u16)(g0.y >> 16));
      v1[i].x = ALPHA * v1[i].x + bf2f((u16)(g1.x & 0xffff)); v1[i].y = ALPHA * v1[i].y + bf2f((u16)(g1.x >> 16));
      v1[i].z = ALPHA * v1[i].z + bf2f((u16)(g1.y & 0xffff)); v1[i].w = ALPHA * v1[i].w + bf2f((u16)(g1.y >> 16));
    }
    float s0 = 0.f, s1 = 0.f;
#pragma unroll
    for (int i = 0; i < 4; i++) { s0 += v0[i].x + v0[i].y + v0[i].z + v0[i].w; s1 += v1[i].x + v1[i].y + v1[i].z + v1[i].w; }
    const float mu0 = wave_sum(s0) * (1.f / 1024.f), mu1 = wave_sum(s1) * (1.f / 1024.f);
    float q0 = 0.f, q1 = 0.f;
#pragma unroll
    for (int i = 0; i < 4; i++) {
      v0[i].x -= mu0; v0[i].y -= mu0; v0[i].z -= mu0; v0[i].w -= mu0;
      v1[i].x -= mu1; v1[i].y -= mu1; v1[i].z -= mu1; v1[i].w -= mu1;
      q0 += v0[i].x * v0[i].x + v0[i].y * v0[i].y + v0[i].z * v0[i].z + v0[i].w * v0[i].w;
      q1 += v1[i].x * v1[i].x + v1[i].y * v1[i].y + v1[i].z * v1[i].z + v1[i].w * v1[i].w;
    }
    const float rs0 = rsqrtf(wave_sum(q0) * (1.f / 1024.f) + 1e-5f);
    const float rs1 = rsqrtf(wave_sum(q1) * (1.f / 1024.f) + 1e-5f);
    const float* md0 = p.mod + ((layer + 1) * 5 + cond_of(row0)) * 3072;
    const float* md1 = p.mod + ((layer + 1) * 5 + cond_of(has1 ? row1 : row0)) * 3072;
#pragma unroll
    for (int i = 0; i < 4; i++) {
      const int cc = i * 256 + lane * 4;
      const float4 gg = *(const float4*)(g + cc), be = *(const float4*)(bb + cc);
      float4 y0, y1;
      y0.x = v0[i].x * rs0 * gg.x + be.x; y0.y = v0[i].y * rs0 * gg.y + be.y; y0.z = v0[i].z * rs0 * gg.z + be.z; y0.w = v0[i].w * rs0 * gg.w + be.w;
      y1.x = v1[i].x * rs1 * gg.x + be.x; y1.y = v1[i].y * rs1 * gg.y + be.y; y1.z = v1[i].z * rs1 * gg.z + be.z; y1.w = v1[i].w * rs1 * gg.w + be.w;
      *(float4*)(xr0 + cc) = y0;
      if (has1) *(float4*)(xr1 + cc) = y1;
      if (layer < 3) {
        const float4 sh0 = *(const float4*)(md0 + cc), sc0 = *(const float4*)(md0 + 1024 + cc);
        const float4 sh1 = *(const float4*)(md1 + cc), sc1 = *(const float4*)(md1 + 1024 + cc);
        uint2 h0, h1;
        h0.x = pk2(y0.x * (1.f + sc0.x) + sh0.x, y0.y * (1.f + sc0.y) + sh0.y);
        h0.y = pk2(y0.z * (1.f + sc0.z) + sh0.z, y0.w * (1.f + sc0.w) + sh0.w);
        h1.x = pk2(y1.x * (1.f + sc1.x) + sh1.x, y1.y * (1.f + sc1.y) + sh1.y);
        h1.y = pk2(y1.z * (1.f + sc1.z) + sh1.z, y1.w * (1.f + sc1.w) + sh1.w);
        *(uint2*)(p.H + (size_t)row0 * 1024 + cc) = h0;
        if (has1) *(uint2*)(p.H + (size_t)row1 * 1024 + cc) = h1;
      }
    }
  }
}

DI void ph_mla_norm(const Params& p) {
  const int lane = threadIdx.x & 63, wid = threadIdx.x >> 6;
  for (int row = blockIdx.x * 4 + wid; row < T + 1024; row += gridDim.x * 4) {
    if (row < T) {
      const float* rr = p.RAW + (size_t)row * 768;
      const float4 a0 = *(const float4*)(rr + lane * 8), a1 = *(const float4*)(rr + lane * 8 + 4);
      const float4 k0 = *(const float4*)(rr + 512 + lane * 4);
      float s1 = a0.x * a0.x + a0.y * a0.y + a0.z * a0.z + a0.w * a0.w + a1.x * a1.x + a1.y * a1.y + a1.z * a1.z + a1.w * a1.w;
      float s2 = k0.x * k0.x + k0.y * k0.y + k0.z * k0.z + k0.w * k0.w;
      const float r1 = rsqrtf(wave_sum(s1) * (1.f / 512.f) + 1e-6f);
      const float r2 = rsqrtf(wave_sum(s2) * (1.f / 256.f) + 1e-6f);
      const float4 g0 = *(const float4*)(p.mla_q_norm + lane * 8), g1 = *(const float4*)(p.mla_q_norm + lane * 8 + 4);
      uint4 v;
      v.x = pk2(a0.x * r1 * g0.x, a0.y * r1 * g0.y); v.y = pk2(a0.z * r1 * g0.z, a0.w * r1 * g0.w);
      v.z = pk2(a1.x * r1 * g1.x, a1.y * r1 * g1.y); v.w = pk2(a1.z * r1 * g1.z, a1.w * r1 * g1.w);
      *(uint4*)(p.CQN + (size_t)row * 512 + lane * 8) = v;
      const float4 kg = *(const float4*)(p.mla_kv_norm + lane * 4);
      float4 kn; kn.x = k0.x * r2 * kg.x; kn.y = k0.y * r2 * kg.y; kn.z = k0.z * r2 * kg.z; kn.w = k0.w * r2 * kg.w;
      uint2 kv; kv.x = pk2(kn.x, kn.y); kv.y = pk2(kn.z, kn.w);
      *(uint2*)(p.CKVN + (size_t)kvrow_of(row) * 256 + lane * 4) = kv;
      if (row < TC) *(float4*)(p.out + OUT_CKV + (size_t)row * 256 + lane * 4) = kn;
    } else {
      const int cr = row - T, b = cr >> 8, pp = cr & 255;
      const size_t kvr = (size_t)TC + b * 2304 + pp;
      const float4 k0 = *(const float4*)(p.cache_ckv + (size_t)cr * 256 + lane * 4);
      uint2 kv; kv.x = pk2(k0.x, k0.y); kv.y = pk2(k0.z, k0.w);
      *(uint2*)(p.CKVN + kvr * 256 + lane * 4) = kv;
      p.KR[kvr * 64 + lane] = f2bf(p.cache_kr[(size_t)cr * 64 + lane]);
    }
  }
}

DI void ph_mla_g2(const Params& p, char* smem) {
  EpiMlaQ eq{p.Q};
  EpiMlaKV ekv{p.KN, p.VT};
  const int n1 = 64 * 12, n2 = 104 * 16;
  for (int tile = blockIdx.x; tile < n1 + n2; tile += gridDim.x) {
    if (tile < n1) {
      const int nt = tile / 64, mt = tile - nt * 64;
      gemm_tile<3>(p.CQN, 512, p.Wuq, 512, 512, mt * 192, nt * 128, 0, smem, eq);
    } else {
      const int t2 = tile - n1;
      const int nt = t2 / 104, mt = t2 - nt * 104;
      gemm_tile<2>(p.CKVN, 256, p.Wukv, 256, 256, mt * 128, nt * 128, 0, smem, ekv);
    }
  }
}

DI void ph_mla_attn(const Params& p, char* smem) {
  const int wid = threadIdx.x >> 6, l31 = threadIdx.x & 31;
  for (int u = blockIdx.x; u < 768; u += gridDim.x) {
    int t0, kvrow0, nkeys, Lk, h; size_t vbase;
    if (u < 512) {
      const int xcd = u & 7, slot = u >> 3; const int pair = xcd * 4 + (slot >> 4); const int qb = slot & 15;
      const int b = pair >> 3; h = pair & 7;
      t0 = TC + b * 2048 + qb * 128 + wid * 32; kvrow0 = TC + b * 2304; nkeys = 2304; Lk = 2304;
      vbase = (size_t)16 * 8 * 128 * 256 + (size_t)b * (8 * 128 * 2304) + (size_t)h * 128 * 2304;
    } else {
      const int v = u - 512; const int b = v >> 4; h = (v >> 1) & 7; const int qb = v & 1;
      t0 = b * 256 + qb * 128 + wid * 32; kvrow0 = b * 256; nkeys = 256; Lk = 256;
      vbase = (size_t)b * (8 * 128 * 256) + (size_t)h * 128 * 256;
    }
    const int t = t0 + l31;
    attn_dense_block<8, 4, 4>(smem, p.Q + (size_t)t * 1536 + h * 192, p.KN + (size_t)kvrow0 * 1024 + h * 128, 1024,
                             p.KR + (size_t)kvrow0 * 64, p.VT + vbase, Lk, nkeys,
                             p.SZ + (size_t)t * 1024 + h * 128, p.AO + (size_t)t * 1024 + h * 128);
  }
}

DI void ph_na_g1(const Params& p, char* smem) {
  EpiNaG1 epi{p.NQ, p.NK, p.NVT, p.SZ, p.out + OUT_NAK, p.out + OUT_NAV};
  const int n1 = 64 * 32;
  for (int tile = blockIdx.x; tile < n1 + 64; tile += gridDim.x) {
    if (tile < n1) {
      const int nt = tile / 64, mt = tile - nt * 64;
      gemm_tile<3>(p.H, 1024, p.Wnin, 1024, 1024, mt * 192, nt * 128, 0, smem, epi);
    } else {
      const int ct = tile - n1;
      const int b = ct >> 4, p0 = (ct & 15) * 16;
      const int c4 = threadIdx.x * 4;
      const size_t kvb = (size_t)TC + b * 2304;
      u16* vtb = p.NVT + (size_t)16 * 1024 * 256 + (size_t)b * (1024 * 2304);
      float vv[4][16];
#pragma unroll
      for (int i = 0; i < 16; i++) {
        const size_t src = ((size_t)(b * 256 + p0 + i)) * 1024 + c4;
        const float4 k = *(const float4*)(p.cache_nak + src);
        uint2 kv; kv.x = pk2(k.x, k.y); kv.y = pk2(k.z, k.w);
        *(uint2*)(p.NK + (kvb + p0 + i) * 1024 + c4) = kv;
        const float4 v = *(const float4*)(p.cache_nav + src);
        vv[0][i] = v.x; vv[1][i] = v.y; vv[2][i] = v.z; vv[3][i] = v.w;
      }
#pragma unroll
      for (int e = 0; e < 4; e++) {
        uint4 w0, w1;
        w0.x = pk2(vv[e][0], vv[e][1]); w0.y = pk2(vv[e][2], vv[e][3]); w0.z = pk2(vv[e][4], vv[e][5]); w0.w = pk2(vv[e][6], vv[e][7]);
        w1.x = pk2(vv[e][8], vv[e][9]); w1.y = pk2(vv[e][10], vv[e][11]); w1.z = pk2(vv[e][12], vv[e][13]); w1.w = pk2(vv[e][14], vv[e][15]);
        u16* dp = vtb + (size_t)(c4 + e) * 2304 + p0;
        *(uint4*)dp = w0; *(uint4*)(dp + 8) = w1;
      }
    }
  }
}

DI void ph_na_attn(const Params& p, char* smem) {
  const int wid = threadIdx.x >> 6, l31 = threadIdx.x & 31;
  for (int u = blockIdx.x; u < 1024 + 512; u += gridDim.x) {
    if (u < 1024) {
      const int xcd = u & 7, slot = u >> 3;
      const int pair = xcd * 8 + (slot >> 4), rpair = slot & 15;
      attn_na_block(p, smem, pair >> 4, pair & 15, rpair);
    } else {
      const int v = u - 1024;
      const int b = v >> 5, h = (v >> 1) & 15, qb = v & 1;
      const int t = b * 256 + qb * 128 + wid * 32 + l31;
      attn_dense_block<4, 0, 2>(smem, p.NQ + (size_t)t * 1024 + h * 64, p.NK + (size_t)(b * 256) * 1024 + h * 64, 1024, nullptr,
                               p.NVT + (size_t)b * (1024 * 256) + (size_t)h * 64 * 256, 256, 256,
                               p.SZ + (size_t)t * 1024 + h * 64, p.NAO + (size_t)t * 1024 + h * 64);
    }
  }
}

template <int ph>
DI void run_phase(const Params& p, char* smem) {
  if constexpr (ph == 0) ph_prep(p, smem);
  else if constexpr (ph == 1) ph_h0(p);
  else if constexpr (ph == 2 || ph == 17) {
    constexpr int j = (ph == 2) ? 0 : 1;
    EpiPoolG1 e{p.U, p.SZ};
    gemm_phase(p.H, 1024, p.Wpin + (size_t)j * 2048 * 1024, 1024, 1024, 64, 16, smem, e);
  }
  else if constexpr (ph == 3 || ph == 18) ph_mix(p);
  else if constexpr (ph == 4 || ph == 19) ph_pool_g2(p, (ph == 4) ? 0 : 1, smem);
  else if constexpr (ph == 5) {
    EpiG3 e{p.GO, p.mod};
    gemm_phase_st(p.PM, 1024, p.Wpout, 1024, 1024, 64, 8, smem, e);
  }
  else if constexpr (ph == 20) {
    EpiG3 e{p.GO, p.mod + 3 * 5 * 3072};
    gemm_phase_st(p.PM, 1024, p.Wpout + (size_t)1024 * 1024, 1024, 1024, 64, 8, smem, e);
  }
  else if constexpr (ph == 6) ph_ln(p, 0);
  else if constexpr (ph == 21) ph_ln(p, 3);
  else if constexpr (ph == 7) {
    EpiMlaG1 e{p.RAW, p.KR, p.SZ, p.out + OUT_KR};
    gemm_phase(p.H, 1024, p.Wmin, 1024, 1024, 64, 15, smem, e);
  }
  else if constexpr (ph == 8) ph_mla_norm(p);
  else if constexpr (ph == 9) ph_mla_g2(p, smem);
  else if constexpr (ph == 10) ph_mla_attn(p, smem);
  else if constexpr (ph == 11) {
    EpiG3 e{p.GO, p.mod + 1 * 5 * 3072};
    gemm_phase_st(p.AO, 1024, p.Wmout, 1024, 1024, 64, 8, smem, e);
  }
  else if constexpr (ph == 12) ph_ln(p, 1);
  else if constexpr (ph == 13) ph_na_g1(p, smem);
  else if constexpr (ph == 14) ph_na_attn(p, smem);
  else if constexpr (ph == 15) {
    EpiG3 e{p.GO, p.mod + 2 * 5 * 3072};
    gemm_phase_st(p.NAO, 1024, p.Wnout, 1024, 1024, 64, 8, smem, e);
  }
  else if constexpr (ph == 16) ph_ln(p, 2);
}

#define RUN_PH(n) if (ph_lo <= (n) && (n) < ph_hi) { run_phase<n>(p, smem); if ((n) + 1 < ph_hi) xcd_barrier(xb); }

__global__ void __launch_bounds__(256, 2) mega(Params p, int ph_lo, int ph_hi) {
  __shared__ __attribute__((aligned(16))) char smem[SMEM_BYTES];
  if (ph_lo < 0) { cg::this_grid().sync(); return; }
  const bool multi = (ph_hi - ph_lo) > 1;
  XcdBarrier xb; xb.bar = p.bar; xb.x = 0; xb.nloc = 0u; xb.nx = 0u;
  if (multi) xb = xcd_barrier_post(p.bar);
  RUN_PH(0) RUN_PH(1) RUN_PH(2) RUN_PH(3) RUN_PH(4) RUN_PH(5) RUN_PH(6) RUN_PH(7) RUN_PH(8) RUN_PH(9) RUN_PH(10)
  RUN_PH(11) RUN_PH(12) RUN_PH(13) RUN_PH(14) RUN_PH(15) RUN_PH(16) RUN_PH(17) RUN_PH(18) RUN_PH(19) RUN_PH(20) RUN_PH(21)
}

extern "C" void kernel_launch(void* const* d_in, const int* in_sizes, int n_in, void* d_out, int out_size, void* d_ws, size_t ws_size,
                              hipStream_t stream) {
  Params p;
  memset(&p, 0, sizeof(p));
  const float* const* in = (const float* const*)d_in;
  p.x_prompt = in[0]; p.x_sample = in[1]; p.cache_ckv = in[2]; p.cache_kr = in[3]; p.cache_nak = in[4]; p.cache_nav = in[5];
  p.c = in[6]; p.c_ctx = in[7]; p.ada_w = in[8]; p.ada_b = in[9]; p.ln_g = in[10]; p.ln_b = in[11];
  const float* pool_w_in = in[12]; const float* pool_w_grp = in[13]; p.pool_scale = in[14]; const float* pool_w_out = in[15];
  const float* mla_w_in = in[16]; p.mla_q_norm = in[17]; const float* mla_w_uq = in[18]; p.mla_kv_norm = in[19];
  const float* mla_w_ukv = in[20]; const float* mla_w_out = in[21]; const float* na_w_in = in[22]; p.na_rpb = in[23];
  const float* na_w_out = in[24];
  p.out = (float*)d_out;

  char* ws = (char*)d_ws;
  size_t off = 0;
  auto take = [&](size_t bytes) { char* r = ws + off; off += (bytes + 255) & ~(size_t)255; return r; };
  p.bar = (unsigned*)take(XCD_BAR_WORDS * 4);
  p.mod = (float*)take((size_t)4 * 5 * 3072 * 4);
  p.Wpin = (u16*)take((size_t)2 * 2048 * 1024 * 2);
  p.Wgrp = (u16*)take((size_t)8 * 65536 * 2);
  p.Wpout = (u16*)take((size_t)2 * 1024 * 1024 * 2);
  p.Wmin = (u16*)take((size_t)1920 * 1024 * 2);
  p.Wuq = (u16*)take((size_t)1536 * 512 * 2);
  p.Wukv = (u16*)take((size_t)2048 * 256 * 2);
  p.Wmout = (u16*)take((size_t)1024 * 1024 * 2);
  p.Wnin = (u16*)take((size_t)4096 * 1024 * 2);
  p.Wnout = (u16*)take((size_t)1024 * 1024 * 2);
  p.H = (u16*)take((size_t)T * 1024 * 2);
  p.SZ = (u16*)take((size_t)T * 1024 * 2);
  p.GO = (u16*)take((size_t)T * 1024 * 2);
  const size_t arena0 = off;
  p.U = (u16*)take((size_t)T * 1024 * 2);
  p.MIX = (u16*)take((size_t)T * 1024 * 2);
  p.PM = (u16*)take((size_t)T * 1024 * 2);
  off = arena0;
  p.RAW = (float*)take((size_t)T * 768 * 4);
  p.AO = (u16*)p.RAW;
  p.CQN = (u16*)take((size_t)T * 512 * 2);
  p.CKVN = (u16*)take((size_t)KVR * 256 * 2);
  p.KR = (u16*)take((size_t)KVR * 64 * 2);
  p.Q = (u16*)take((size_t)T * 1536 * 2);
  p.KN = (u16*)take((size_t)KVR * 1024 * 2);
  p.VT = (u16*)take((size_t)KVR * 1024 * 2);
  off = arena0;
  p.NQ = (u16*)take((size_t)T * 1024 * 2);
  p.NK = (u16*)take((size_t)KVR * 1024 * 2);
  p.NVT = (u16*)take((size_t)KVR * 1024 * 2);
  p.NAO = (u16*)take((size_t)T * 1024 * 2);

  int nm = 0, tiles = 0;
  auto add = [&](const float* src, u16* dst, int K, int Nsrc, int Ndst) {
    p.mats[nm].src = src; p.mats[nm].dst = dst; p.mats[nm].K = K; p.mats[nm].Nsrc = Nsrc; p.mats[nm].Ndst = Ndst; p.mats[nm].tile0 = tiles;
    tiles += (K / 64) * (Ndst / 64); nm++;
  };
  for (int j = 0; j < 2; j++) add(pool_w_in + (size_t)j * 1024 * 2048, p.Wpin + (size_t)j * 2048 * 1024, 1024, 2048, 2048);
  for (int j = 0; j < 8; j++) add(pool_w_grp + (size_t)j * 65536, p.Wgrp + (size_t)j * 65536, 256, 256, 256);
  for (int j = 0; j < 2; j++) add(pool_w_out + (size_t)j * 1024 * 1024, p.Wpout + (size_t)j * 1024 * 1024, 1024, 1024, 1024);
  add(mla_w_in, p.Wmin, 1024, 1856, 1920);
  add(mla_w_uq, p.Wuq, 512, 1536, 1536);
  add(mla_w_ukv, p.Wukv, 256, 2048, 2048);
  add(mla_w_out, p.Wmout, 1024, 1024, 1024);
  add(na_w_in, p.Wnin, 1024, 4096, 4096);
  add(na_w_out, p.Wnout, 1024, 1024, 1024);
  p.nmat_tiles = tiles;

  (void)hipMemsetAsync(p.bar, 0, XCD_BAR_WORDS * 4, stream);
#if MULTI_LAUNCH
  for (int ph = 0; ph < NPHASE; ph++) hipLaunchKernelGGL(mega, dim3(512), dim3(256), 0, stream, p, ph, ph + 1);
#else
  static int grid_blocks = 0;
  if (!grid_blocks) {
    int dev = 0, cus = 0, per_cu = 0;
    hipGetDevice(&dev);
    hipDeviceGetAttribute(&cus, hipDeviceAttributeMultiprocessorCount, dev);
    hipOccupancyMaxActiveBlocksPerMultiprocessor(&per_cu, mega, 256, 0);
    if (per_cu > 2) per_cu = 2;
    if (per_cu < 1) per_cu = 1;
    grid_blocks = cus * per_cu;
  }
  int lo = 0, hi = NPHASE;
  void* args[] = {&p, &lo, &hi};
  hipError_t e = hipLaunchCooperativeKernel((void*)mega, dim3(grid_blocks), dim3(256), args, 0, stream);
  if (e != hipSuccess) fprintf(stderr, "cooperative launch failed: %s (grid %d)\n", hipGetErrorString(e), grid_blocks);
#endif
}
```

```cpp
#include <hip/hip_runtime.h>
#include <hip/hip_cooperative_groups.h>
#include <stdint.h>
#include <string.h>
#include <stdio.h>
namespace cg = cooperative_groups;

#ifndef MULTI_LAUNCH
#define MULTI_LAUNCH 0
#endif

typedef __attribute__((ext_vector_type(8))) short bf16x8;
typedef __attribute__((ext_vector_type(4))) float f32x4;
typedef __attribute__((ext_vector_type(16))) float f32x16;
typedef __attribute__((ext_vector_type(4))) uint32_t u32x4;
typedef unsigned short u16;
#define DI __device__ __forceinline__
#define MFMA32(a, b, c) __builtin_amdgcn_mfma_f32_32x32x16_bf16((a), (b), (c), 0, 0, 0)
#define MFMA16(a, b, c) __builtin_amdgcn_mfma_f32_16x16x32_bf16((a), (b), (c), 0, 0, 0)

constexpr int TC = 4096, TL = 8192, T = 12288;
constexpr int KVR = 4096 + 4 * 2304;
constexpr float LOG2E = 1.4426950408889634f;
constexpr float ALPHA = 1.681792830507429f;
constexpr float MLA_QS = 0.07216878364870323f * LOG2E;
constexpr float NA_QS = 0.125f * LOG2E;
constexpr int SMEM_BYTES = 81920;
constexpr int NPHASE = 22;

constexpr size_t OUT_YS = 4194304, OUT_CKV = 12582912, OUT_KR = 13631488, OUT_NAK = 13893632, OUT_NAV = 18087936;

struct MatDesc { const float* src; u16* dst; int K, Nsrc, Ndst, tile0; };

struct Params {
  const float *x_prompt, *x_sample, *cache_ckv, *cache_kr, *cache_nak, *cache_nav, *c, *c_ctx, *ada_w, *ada_b, *ln_g, *ln_b;
  const float *pool_scale, *mla_q_norm, *mla_kv_norm, *na_rpb;
  float* out;
  float* mod;
  u16 *H, *SZ, *GO;
  u16 *Wpin, *Wgrp, *Wpout, *Wmin, *Wuq, *Wukv, *Wmout, *Wnin, *Wnout;
  u16 *U, *MIX, *PM;
  float* RAW; u16 *AO, *CQN, *CKVN, *KR, *Q, *KN, *VT;
  u16 *NQ, *NK, *NVT, *NAO;
  unsigned* bar;
  MatDesc mats[18];
  int nmat_tiles; int pad0;
};

DI float bf2f(u16 v) { return __uint_as_float(((uint32_t)v) << 16); }
typedef __attribute__((ext_vector_type(2))) float f32x2;
typedef __attribute__((ext_vector_type(2))) __bf16 bf16x2_t;
DI uint32_t pk2(float a, float b) { f32x2 v = {a, b}; return __builtin_bit_cast(uint32_t, __builtin_convertvector(v, bf16x2_t)); }
DI u16 f2bf(float x) { return (u16)(pk2(x, x) & 0xffffu); }
DI float silu(float v) { return v / (1.f + __expf(-v)); }
DI int cond_of(int t) { return t < TC ? 0 : 1 + ((t - TC) >> 11); }
DI int kvrow_of(int t) { return t < TC ? t : TC + ((t - TC) >> 11) * 2304 + 256 + ((t - TC) & 2047); }
DI int perm16(int key) { const int k = key & 15; return (key & ~15) | (k & 3) | ((k >> 1) & 4) | ((k << 1) & 8); }
DI float wave_sum(float v) {
#pragma unroll
  for (int o = 32; o >= 1; o >>= 1) v += __shfl_xor(v, o);
  return v;
}

#define XB_TMO      128
#define XB_XCNT(j)  (256  + 64 * (j))
#define XB_XSUB(j)  (1280 + 64 * (j))
#define XB_XGEN(j)  (2304 + 64 * (j))
#define XB_TOP      3328
#define XB_TOPGEN   3392
#define XCD_BAR_WORDS 3456
#define XB_SPIN_CAP (1u << 22)
#define LAS __attribute__((address_space(3)))
DI unsigned xb_ld(unsigned* p) { return __hip_atomic_load(p, __ATOMIC_RELAXED, __HIP_MEMORY_SCOPE_AGENT); }
DI unsigned xb_add(unsigned* p, unsigned v) { return __hip_atomic_fetch_add(p, v, __ATOMIC_RELAXED, __HIP_MEMORY_SCOPE_AGENT); }
DI unsigned xb_xcc_id() { return (unsigned)__builtin_amdgcn_s_getreg((3 << 11) | 20) & 0xFu; }
#define XB_SPIN(cond, bar) do { unsigned _sp = 0; while (cond) { __builtin_amdgcn_s_sleep(1); \
    if ((++_sp & 255u) == 0u) { if (xb_ld(&(bar)[XB_TMO])) break; if (_sp > XB_SPIN_CAP) { atomicAdd(&(bar)[XB_TMO], 1u); break; } } } } while (0)
struct XcdBarrier { unsigned* bar; unsigned x; unsigned nloc, nx; };
DI XcdBarrier xcd_barrier_post(unsigned* bar) {
  XcdBarrier b; b.bar = bar; b.x = xb_xcc_id(); b.nloc = 0u; b.nx = 0u;
  if (threadIdx.x == 0) (void)xb_add(&bar[XB_XCNT(b.x)], 1u);
  return b;
}
DI void xcd_barrier_complete(unsigned* bar, unsigned x, unsigned& nloc, unsigned& nx) {
  const unsigned G = gridDim.x * gridDim.y * gridDim.z;
  unsigned sum, cnt, mine, sp = 0u;
  for (;;) {
    sum = 0u; cnt = 0u; mine = 0u;
#pragma unroll
    for (unsigned j = 0; j < 16; ++j) { const unsigned c = xb_ld(&bar[XB_XCNT(j)]); sum += c; cnt += (c > 0u) ? 1u : 0u; mine = (j == x) ? c : mine; }
    if (sum == G) break;
    __builtin_amdgcn_s_sleep(1);
    if ((++sp & 255u) == 0u) { if (xb_ld(&bar[XB_TMO])) break; if (sp > XB_SPIN_CAP) { atomicAdd(&bar[XB_TMO], 1u); break; } }
  }
  nloc = mine > 0u ? mine : 1u; nx = cnt > 0u ? cnt : 1u;
}
DI void xcd_barrier(XcdBarrier& b) {
  asm volatile("s_waitcnt vmcnt(0)" ::: "memory");
  __syncthreads();
  unsigned nloc = b.nloc, nx = b.nx;
  if (threadIdx.x == 0) {
    unsigned* bar = b.bar;
    __builtin_amdgcn_s_waitcnt(0);
    if (nloc == 0u) { xcd_barrier_complete(bar, b.x, nloc, nx); }
    const unsigned old = xb_add(&bar[XB_XSUB(b.x)], 1u);
    const unsigned gen = old / nloc;
    if (old + 1u == (gen + 1u) * nloc) {
      __builtin_amdgcn_fence(__ATOMIC_RELEASE, "agent");
      asm volatile("s_waitcnt vmcnt(0)" ::: "memory");
      const unsigned og = xb_add(&bar[XB_TOP], 1u);
      const unsigned tg = og / nx;
      if (og + 1u == (tg + 1u) * nx) xb_add(&bar[XB_TOPGEN], 1u);
      else XB_SPIN(xb_ld(&bar[XB_TOPGEN]) == tg, bar);
      __builtin_amdgcn_fence(__ATOMIC_ACQUIRE, "agent");
      xb_add(&bar[XB_XGEN(b.x)], 1u);
      asm volatile("s_waitcnt vmcnt(0)" ::: "memory");
    } else {
      XB_SPIN(xb_ld(&bar[XB_XGEN(b.x)]) == gen, bar);
      __builtin_amdgcn_fence(__ATOMIC_ACQUIRE, "agent");
      asm volatile("s_waitcnt vmcnt(0)" ::: "memory");
    }
  }
  if (threadIdx.x < 64) { b.nloc = __builtin_amdgcn_readfirstlane(nloc); b.nx = __builtin_amdgcn_readfirstlane(nx); }
  __syncthreads();
}

template <int MI, class Epi, bool STAGED = false>
DI void gemm_tile(const u16* __restrict__ A, int lda, const u16* __restrict__ Bt, int ldb, int K, int m0, int n0, int nout_off,
                  char* smem, const Epi& epi) {
  constexpr int BM = 64 * MI, ASTG = BM * 128, NG = 2 * MI + 4;
  const int tid = threadIdx.x, lane = tid & 63, wid = tid >> 6;
  const int wm = wid >> 1, wn = wid & 1, l31 = lane & 31, lh = lane >> 5;
  char* As = smem;
  char* Bs = smem + 2 * ASTG;
  const int srow = tid >> 3;
  const int scc = ((tid & 7) ^ ((tid >> 4) & 7)) * 8;
  const u16* ag = A + (size_t)(m0 + srow) * lda + scc;
  const u16* bg = Bt + (size_t)(n0 + srow) * ldb + scc;
  LAS char* awr = (LAS char*)(As + wid * 1024);
  LAS char* bwr = (LAS char*)(Bs + wid * 1024);
  f32x16 acc[MI][2];
#pragma unroll
  for (int i = 0; i < MI; i++)
#pragma unroll
    for (int j = 0; j < 2; j++)
#pragma unroll
      for (int r = 0; r < 16; r++) acc[i][j][r] = 0.f;
  const int nk = K >> 6;
  const int rot = (n0 >> 7) + (m0 >> 6);
  __syncthreads();
#pragma unroll
  for (int t = 0; t < 2; t++) {
#pragma unroll
    for (int i = 0; i < 2 * MI; i++)
      __builtin_amdgcn_global_load_lds((const void*)(ag + (size_t)(32 * i) * lda + ((t + rot) & (nk - 1)) * 64), (LAS void*)(awr + t * ASTG + i * 4096), 16, 0, 0);
#pragma unroll
    for (int i = 0; i < 4; i++)
      __builtin_amdgcn_global_load_lds((const void*)(bg + (size_t)(32 * i) * ldb + ((t + rot) & (nk - 1)) * 64), (LAS void*)(bwr + t * 16384 + i * 4096), 16, 0, 0);
  }
  const int sw = (l31 >> 1) & 7;
  for (int kt = 0; kt < nk; kt++) {
    const int buf = kt & 1;
    if (kt + 1 < nk) asm volatile("s_waitcnt vmcnt(%0)" :: "n"(NG) : "memory");
    else asm volatile("s_waitcnt vmcnt(0)" ::: "memory");
    __builtin_amdgcn_s_barrier();
    const char* as = As + buf * ASTG + (wm * (32 * MI) + l31) * 128;
    const char* bs = Bs + buf * 16384 + (wn * 64 + l31) * 128;
    bf16x8 fa[4][MI], fb[4][2];
#pragma unroll
    for (int ks = 0; ks < 4; ks++) {
      const int co = ((2 * ks + lh) ^ sw) << 4;
      fb[ks][0] = *(const bf16x8*)(bs + co);
      fb[ks][1] = *(const bf16x8*)(bs + 32 * 128 + co);
#pragma unroll
      for (int i = 0; i < MI; i++) fa[ks][i] = *(const bf16x8*)(as + i * 32 * 128 + co);
    }
    asm volatile("s_waitcnt lgkmcnt(0)" ::: "memory");
    __builtin_amdgcn_s_barrier();
    if (kt + 2 < nk) {
#pragma unroll
      for (int i = 0; i < 2 * MI; i++)
        __builtin_amdgcn_global_load_lds((const void*)(ag + (size_t)(32 * i) * lda + ((kt + 2 + rot) & (nk - 1)) * 64), (LAS void*)(awr + buf * ASTG + i * 4096), 16, 0, 0);
#pragma unroll
      for (int i = 0; i < 4; i++)
        __builtin_amdgcn_global_load_lds((const void*)(bg + (size_t)(32 * i) * ldb + ((kt + 2 + rot) & (nk - 1)) * 64), (LAS void*)(bwr + buf * 16384 + i * 4096), 16, 0, 0);
    }
#pragma unroll
    for (int ks = 0; ks < 4; ks++)
#pragma unroll
      for (int i = 0; i < MI; i++) {
        acc[i][0] = MFMA32(fb[ks][0], fa[ks][i], acc[i][0]);
        acc[i][1] = MFMA32(fb[ks][1], fa[ks][i], acc[i][1]);
      }
  }
  if constexpr (STAGED) {
    float* stg = (float*)(smem + wid * 8704);
    const int nbw = nout_off + n0 + wn * 64;
#pragma unroll
    for (int i = 0; i < MI; i++) {
      const int mb = m0 + wm * (32 * MI) + i * 32;
#pragma unroll
      for (int j = 0; j < 2; j++)
#pragma unroll
        for (int g = 0; g < 4; g++) {
          float4 v; v.x = acc[i][j][4 * g]; v.y = acc[i][j][4 * g + 1]; v.z = acc[i][j][4 * g + 2]; v.w = acc[i][j][4 * g + 3];
          *(float4*)(stg + l31 * 68 + j * 32 + 8 * g + 4 * lh) = v;
        }
      asm volatile("s_waitcnt lgkmcnt(0)" ::: "memory");
      __builtin_amdgcn_wave_barrier();
      bool rows = true;
      if constexpr (Epi::HAS_VT) {
        if (epi.is_vt(nbw)) {
          rows = epi.vt_rows(mb);
          const bool perm = epi.vt_perm(mb);
#pragma unroll
          for (int it = 0; it < 4; it++) {
            const int n = lane, q = it;
            float v[8];
            int pos;
            if (perm) {
              const int rb = (q >> 1) * 16 + (q & 1) * 4;
#pragma unroll
              for (int k = 0; k < 8; k++) v[k] = stg[(rb + (k & 3) + 8 * (k >> 2)) * 68 + n];
              pos = (q >> 1) * 16 + (q & 1) * 8;
            } else {
#pragma unroll
              for (int k = 0; k < 8; k++) v[k] = stg[(q * 8 + k) * 68 + n];
              pos = q * 8;
            }
            epi.vt8(mb, nbw + n, pos, v);
          }
        }
      }
      if (rows) {
#pragma unroll
        for (int it = 0; it < 8; it++) {
          const int row = it * 4 + (lane >> 4), col = (lane & 15) * 4;
          const float4 v = *(const float4*)(stg + row * 68 + col);
          epi.row4(mb + row, nbw + col, v);
        }
      }
      asm volatile("s_waitcnt lgkmcnt(0)" ::: "memory");
      __builtin_amdgcn_wave_barrier();
    }
  } else {
#pragma unroll
    for (int i = 0; i < MI; i++)
#pragma unroll
      for (int j = 0; j < 2; j++)
        epi(m0 + wm * (32 * MI) + i * 32 + l31, nout_off + n0 + wn * 64 + j * 32, lh, acc[i][j]);
  }
}

DI void rope_pair(float x1, float x2, int i, float pos, float& o1, float& o2) {
  const float inv = exp2f(-(float)i * (13.287712379549449f / 16.f));
  const float ang = pos * inv;
  const float c = __cosf(ang), s = __sinf(ang);
  o1 = x1 * c - x2 * s;
  o2 = x1 * s + x2 * c;
}

struct EpiPoolG1 {
  u16 *U, *SZ;
  DI void operator()(int m, int nb, int lh, const f32x16& a) const {
#pragma unroll
    for (int g = 0; g < 4; g++) {
      const int n = nb + 8 * g + 4 * lh;
      if (nb < 1024) {
        uint2 v; v.x = pk2(a[4 * g], a[4 * g + 1]); v.y = pk2(a[4 * g + 2], a[4 * g + 3]);
        *(uint2*)(U + (size_t)m * 1024 + n) = v;
      } else {
        uint2 v; v.x = pk2(silu(a[4 * g]), silu(a[4 * g + 1])); v.y = pk2(silu(a[4 * g + 2]), silu(a[4 * g + 3]));
        *(uint2*)(SZ + (size_t)m * 1024 + n - 1024) = v;
      }
    }
  }
};
struct EpiPoolG2 {
  u16* PM; const u16* SZ; const float* scale;
  DI void operator()(int m, int nb, int lh, const f32x16& a) const {
#pragma unroll
    for (int g = 0; g < 4; g++) {
      const int n = nb + 8 * g + 4 * lh;
      const uint2 z = *(const uint2*)(SZ + (size_t)m * 1024 + n);
      const float4 sc = *(const float4*)(scale + n);
      uint2 v;
      v.x = pk2(a[4 * g] * sc.x * bf2f((u16)(z.x & 0xffff)), a[4 * g + 1] * sc.y * bf2f((u16)(z.x >> 16)));
      v.y = pk2(a[4 * g + 2] * sc.z * bf2f((u16)(z.y & 0xffff)), a[4 * g + 3] * sc.w * bf2f((u16)(z.y >> 16)));
      *(uint2*)(PM + (size_t)m * 1024 + n) = v;
    }
  }
};
struct EpiG3 {
  static constexpr bool HAS_VT = false;
  u16* GO; const float* mod_layer;
  DI void row4(int m, int n, const float4& a) const {
    const float4 gt = *(const float4*)(mod_layer + cond_of(m) * 3072 + 2048 + n);
    uint2 v; v.x = pk2(gt.x * a.x, gt.y * a.y); v.y = pk2(gt.z * a.z, gt.w * a.w);
    *(uint2*)(GO + (size_t)m * 1024 + n) = v;
  }
  DI void operator()(int m, int nb, int lh, const f32x16& a) const {
    const float* gate = mod_layer + cond_of(m) * 3072 + 2048;
#pragma unroll
    for (int g = 0; g < 4; g++) {
      const int n = nb + 8 * g + 4 * lh;
      const float4 gt = *(const float4*)(gate + n);
      uint2 v; v.x = pk2(gt.x * a[4 * g], gt.y * a[4 * g + 1]); v.y = pk2(gt.z * a[4 * g + 2], gt.w * a[4 * g + 3]);
      *(uint2*)(GO + (size_t)m * 1024 + n) = v;
    }
  }
};
struct EpiMlaG1 {
  float* RAW; u16* KR; u16* SZ; float* st_kr;
  DI void operator()(int m, int nb, int lh, const f32x16& a) const {
    if (nb >= 1856) return;
    if (nb < 768) {
#pragma unroll
      for (int g = 0; g < 4; g++) {
        const int n = nb + 8 * g + 4 * lh;
        float4 r; r.x = a[4 * g]; r.y = a[4 * g + 1]; r.z = a[4 * g + 2]; r.w = a[4 * g + 3];
        *(float4*)(RAW + (size_t)m * 768 + n) = r;
      }
    } else if (nb < 832) {
      const int off = nb - 768;
      const bool lat = m >= TC;
      const int tt = (m - TC) & 2047;
      const float pos = (off == 0) ? (float)(tt >> 6) : (float)(tt & 63);
      const size_t kr = (size_t)kvrow_of(m) * 64 + off;
#pragma unroll
      for (int g = 0; g < 2; g++) {
        float o1[4], o2[4];
#pragma unroll
        for (int e = 0; e < 4; e++) {
          const int i = 8 * g + 4 * lh + e;
          const float x1 = a[4 * g + e], x2 = a[4 * (g + 2) + e];
          if (lat) rope_pair(x1, x2, i, pos, o1[e], o2[e]); else { o1[e] = x1; o2[e] = x2; }
        }
        const int i0 = 8 * g + 4 * lh;
        if (!lat) {
          float4 r1; r1.x = o1[0]; r1.y = o1[1]; r1.z = o1[2]; r1.w = o1[3];
          float4 r2; r2.x = o2[0]; r2.y = o2[1]; r2.z = o2[2]; r2.w = o2[3];
          *(float4*)(st_kr + (size_t)m * 64 + off + i0) = r1;
          *(float4*)(st_kr + (size_t)m * 64 + off + i0 + 16) = r2;
        }
        uint2 v1; v1.x = pk2(o1[0], o1[1]); v1.y = pk2(o1[2], o1[3]);
        uint2 v2; v2.x = pk2(o2[0], o2[1]); v2.y = pk2(o2[2], o2[3]);
        *(uint2*)(KR + kr + i0) = v1;
        *(uint2*)(KR + kr + i0 + 16) = v2;
      }
    } else {
#pragma unroll
      for (int g = 0; g < 4; g++) {
        const int n = nb + 8 * g + 4 * lh - 832;
        uint2 v; v.x = pk2(silu(a[4 * g]), silu(a[4 * g + 1])); v.y = pk2(silu(a[4 * g + 2]), silu(a[4 * g + 3]));
        *(uint2*)(SZ + (size_t)m * 1024 + n) = v;
      }
    }
  }
};
struct EpiMlaQ {
  u16* Q;
  DI void operator()(int m, int nb, int lh, const f32x16& a) const {
    const int head = nb / 192, off = nb - head * 192;
    u16* qr = Q + (size_t)m * 1536 + nb;
    if (off < 128) {
#pragma unroll
      for (int g = 0; g < 4; g++) {
        uint2 v; v.x = pk2(a[4 * g] * MLA_QS, a[4 * g + 1] * MLA_QS); v.y = pk2(a[4 * g + 2] * MLA_QS, a[4 * g + 3] * MLA_QS);
        *(uint2*)(qr + 8 * g + 4 * lh) = v;
      }
    } else {
      const bool lat = m >= TC;
      const int tt = (m - TC) & 2047;
      const float pos = (off == 128) ? (float)(tt >> 6) : (float)(tt & 63);
#pragma unroll
      for (int g = 0; g < 2; g++) {
        float o1[4], o2[4];
#pragma unroll
        for (int e = 0; e < 4; e++) {
          const int i = 8 * g + 4 * lh + e;
          const float x1 = a[4 * g + e], x2 = a[4 * (g + 2) + e];
          if (lat) rope_pair(x1, x2, i, pos, o1[e], o2[e]); else { o1[e] = x1; o2[e] = x2; }
        }
        const int i0 = 8 * g + 4 * lh;
        uint2 v1; v1.x = pk2(o1[0] * MLA_QS, o1[1] * MLA_QS); v1.y = pk2(o1[2] * MLA_QS, o1[3] * MLA_QS);
        uint2 v2; v2.x = pk2(o2[0] * MLA_QS, o2[1] * MLA_QS); v2.y = pk2(o2[2] * MLA_QS, o2[3] * MLA_QS);
        *(uint2*)(qr + i0) = v1;
        *(uint2*)(qr + i0 + 16) = v2;
      }
    }
  }
};
struct EpiMlaKV {
  u16 *KN, *VT;
  static constexpr bool HAS_VT = true;
  DI bool is_vt(int nb) const { return (nb & 255) >= 128; }
  DI bool vt_perm(int mb) const { return true; }
  DI bool vt_rows(int mb) const { return false; }
  DI void row4(int m, int n, const float4& a) const {
    const int head = n >> 8, off = n & 255;
    uint2 v; v.x = pk2(a.x, a.y); v.y = pk2(a.z, a.w);
    *(uint2*)(KN + (size_t)m * 1024 + head * 128 + off) = v;
  }
  DI void vt8(int mb, int n, int pos, const float* v) const {
    const int head = n >> 8, d = (n & 255) - 128;
    size_t base; int Lk, key0;
    if (mb < TC) { base = (size_t)(mb >> 8) * (8 * 128 * 256); Lk = 256; key0 = mb & 255; }
    else { const int r2 = mb - TC; const int b = r2 / 2304; key0 = r2 - b * 2304; Lk = 2304; base = (size_t)16 * 8 * 128 * 256 + (size_t)b * (8 * 128 * 2304); }
    uint4 w; w.x = pk2(v[0], v[1]); w.y = pk2(v[2], v[3]); w.z = pk2(v[4], v[5]); w.w = pk2(v[6], v[7]);
    *(uint4*)(VT + base + (size_t)(head * 128 + d) * Lk + key0 + pos) = w;
  }
  DI void operator()(int m, int nb, int lh, const f32x16& a) const {
    const int head = nb >> 8, off = nb & 255;
    if (off < 128) {
#pragma unroll
      for (int g = 0; g < 4; g++) {
        uint2 v; v.x = pk2(a[4 * g], a[4 * g + 1]); v.y = pk2(a[4 * g + 2], a[4 * g + 3]);
        *(uint2*)(KN + (size_t)m * 1024 + head * 128 + off + 8 * g + 4 * lh) = v;
      }
    } else {
      size_t base; int Lk, key;
      if (m < TC) { base = (size_t)(m >> 8) * (8 * 128 * 256); Lk = 256; key = m & 255; }
      else { const int r2 = m - TC; const int b = r2 / 2304; key = r2 - b * 2304; Lk = 2304; base = (size_t)16 * 8 * 128 * 256 + (size_t)b * (8 * 128 * 2304); }
      u16* vp = VT + base + (size_t)(head * 128 + off - 128) * Lk + perm16(key);
#pragma unroll
      for (int g = 0; g < 4; g++)
#pragma unroll
        for (int e = 0; e < 4; e++) vp[(size_t)(8 * g + 4 * lh + e) * Lk] = f2bf(a[4 * g + e]);
    }
  }
};
struct EpiNaG1 {
  u16 *NQ, *NK, *NVT, *SZ; float *st_k, *st_v;
  static constexpr bool HAS_VT = true;
  DI bool is_vt(int nb) const { return nb >= 2048 && nb < 3072; }
  DI bool vt_perm(int mb) const { return mb < TC; }
  DI bool vt_rows(int mb) const { return mb < TC; }
  DI void row4(int m, int n, const float4& a) const {
    if (n < 1024) {
      uint2 v; v.x = pk2(a.x * NA_QS, a.y * NA_QS); v.y = pk2(a.z * NA_QS, a.w * NA_QS);
      *(uint2*)(NQ + (size_t)m * 1024 + n) = v;
    } else if (n < 2048) {
      uint2 v; v.x = pk2(a.x, a.y); v.y = pk2(a.z, a.w);
      *(uint2*)(NK + (size_t)kvrow_of(m) * 1024 + (n - 1024)) = v;
      if (m < TC) *(float4*)(st_k + (size_t)m * 1024 + (n - 1024)) = a;
    } else if (n < 3072) {
      if (m < TC) *(float4*)(st_v + (size_t)m * 1024 + (n - 2048)) = a;
    } else {
      uint2 v; v.x = pk2(silu(a.x), silu(a.y)); v.y = pk2(silu(a.z), silu(a.w));
      *(uint2*)(SZ + (size_t)m * 1024 + (n - 3072)) = v;
    }
  }
  DI void vt8(int mb, int n, int pos, const float* v) const {
    const int c0 = n - 2048;
    size_t base; int Lk, key0;
    if (mb < TC) { base = (size_t)(mb >> 8) * (1024 * 256); Lk = 256; key0 = mb & 255; }
    else { const int b = (mb - TC) >> 11; key0 = 256 + ((mb - TC) & 2047); Lk = 2304; base = (size_t)16 * 1024 * 256 + (size_t)b * (1024 * 2304); }
    uint4 w; w.x = pk2(v[0], v[1]); w.y = pk2(v[2], v[3]); w.z = pk2(v[4], v[5]); w.w = pk2(v[6], v[7]);
    *(uint4*)(NVT + base + (size_t)c0 * Lk + key0 + pos) = w;
  }
  DI void operator()(int m, int nb, int lh, const f32x16& a) const {
    if (nb < 1024) {
#pragma unroll
      for (int g = 0; g < 4; g++) {
        uint2 v; v.x = pk2(a[4 * g] * NA_QS, a[4 * g + 1] * NA_QS); v.y = pk2(a[4 * g + 2] * NA_QS, a[4 * g + 3] * NA_QS);
        *(uint2*)(NQ + (size_t)m * 1024 + nb + 8 * g + 4 * lh) = v;
      }
    } else if (nb < 2048) {
      const size_t kr = (size_t)kvrow_of(m) * 1024 + (nb - 1024);
#pragma unroll
      for (int g = 0; g < 4; g++) {
        uint2 v; v.x = pk2(a[4 * g], a[4 * g + 1]); v.y = pk2(a[4 * g + 2], a[4 * g + 3]);
        *(uint2*)(NK + kr + 8 * g + 4 * lh) = v;
        if (m < TC) { float4 r; r.x = a[4 * g]; r.y = a[4 * g + 1]; r.z = a[4 * g + 2]; r.w = a[4 * g + 3];
          *(float4*)(st_k + (size_t)m * 1024 + (nb - 1024) + 8 * g + 4 * lh) = r; }
      }
    } else if (nb < 3072) {
      const int c0 = nb - 2048;
      size_t base; int Lk, key;
      if (m < TC) { base = (size_t)(m >> 8) * (1024 * 256); Lk = 256; key = perm16(m & 255); }
      else { const int b = (m - TC) >> 11; key = 256 + ((m - TC) & 2047); Lk = 2304; base = (size_t)16 * 1024 * 256 + (size_t)b * (1024 * 2304); }
      u16* vp = NVT + base + (size_t)c0 * Lk + key;
#pragma unroll
      for (int g = 0; g < 4; g++) {
#pragma unroll
        for (int e = 0; e < 4; e++) vp[(size_t)(8 * g + 4 * lh + e) * Lk] = f2bf(a[4 * g + e]);
        if (m < TC) { float4 r; r.x = a[4 * g]; r.y = a[4 * g + 1]; r.z = a[4 * g + 2]; r.w = a[4 * g + 3];
          *(float4*)(st_v + (size_t)m * 1024 + c0 + 8 * g + 4 * lh) = r; }
      }
    } else {
#pragma unroll
      for (int g = 0; g < 4; g++) {
        uint2 v; v.x = pk2(silu(a[4 * g]), silu(a[4 * g + 1])); v.y = pk2(silu(a[4 * g + 2]), silu(a[4 * g + 3]));
        *(uint2*)(SZ + (size_t)m * 1024 + (nb - 3072) + 8 * g + 4 * lh) = v;
      }
    }
  }
};

template <int NSA, int NSB, int NDT>
DI void attn_dense_wave(const u16* __restrict__ qrow, const u16* __restrict__ kA, int kAstride, const u16* __restrict__ kB,
                        const u16* __restrict__ vt, int Lk, int nkeys, const u16* __restrict__ szrow, u16* __restrict__ orow) {
  const int lane = threadIdx.x & 63, l31 = lane & 31, lh = lane >> 5;
  bf16x8 qf[NSA + NSB];
#pragma unroll
  for (int s = 0; s < NSA + NSB; s++) qf[s] = *(const bf16x8*)(qrow + s * 16 + lh * 8);
  f32x16 o[NDT];
#pragma unroll
  for (int d = 0; d < NDT; d++)
#pragma unroll
    for (int r = 0; r < 16; r++) o[d][r] = 0.f;
  float m = -1e30f, l = 0.f;
  for (int k0 = 0; k0 < nkeys; k0 += 32) {
    f32x16 sa;
#pragma unroll
    for (int r = 0; r < 16; r++) sa[r] = 0.f;
    const u16* kp = kA + (size_t)(k0 + l31) * kAstride + lh * 8;
#pragma unroll
    for (int s = 0; s < NSA; s++) sa = MFMA32(*(const bf16x8*)(kp + s * 16), qf[s], sa);
    if (NSB > 0) {
      const u16* kp2 = kB + (size_t)(k0 + l31) * 64 + lh * 8;
#pragma unroll
      for (int s = 0; s < NSB; s++) sa = MFMA32(*(const bf16x8*)(kp2 + s * 16), qf[NSA + s], sa);
    }
    float mx = sa[0];
#pragma unroll
    for (int r = 1; r < 16; r++) mx = fmaxf(mx, sa[r]);
    mx = fmaxf(mx, __shfl_xor(mx, 32));
    const float mn = fmaxf(m, mx);
    const float alpha = __builtin_amdgcn_exp2f(m - mn);
    m = mn;
    float ps = 0.f;
#pragma unroll
    for (int r = 0; r < 16; r++) { sa[r] = exp2f(sa[r] - mn); ps += sa[r]; }
    l = l * alpha + ps;
#pragma unroll
    for (int d = 0; d < NDT; d++)
#pragma unroll
      for (int r = 0; r < 16; r++) o[d][r] *= alpha;
#pragma unroll
    for (int sp = 0; sp < 2; sp++) {
      u32x4 pw;
      pw[0] = pk2(sa[8 * sp + 0], sa[8 * sp + 1]); pw[1] = pk2(sa[8 * sp + 2], sa[8 * sp + 3]);
      pw[2] = pk2(sa[8 * sp + 4], sa[8 * sp + 5]); pw[3] = pk2(sa[8 * sp + 6], sa[8 * sp + 7]);
      const bf16x8 pf = __builtin_bit_cast(bf16x8, pw);
#pragma unroll
      for (int d = 0; d < NDT; d++) {
        const u16* vp = vt + (size_t)(d * 32 + l31) * Lk + k0 + 16 * sp + 4 * lh;
        const uint2 lo = *(const uint2*)vp, hi = *(const uint2*)(vp + 8);
        u32x4 vw; vw[0] = lo.x; vw[1] = lo.y; vw[2] = hi.x; vw[3] = hi.y;
        o[d] = MFMA32(__builtin_bit_cast(bf16x8, vw), pf, o[d]);
      }
    }
  }
  l += __shfl_xor(l, 32);
  const float inv = 1.f / l;
#pragma unroll
  for (int d = 0; d < NDT; d++)
#pragma unroll
    for (int g = 0; g < 4; g++) {
      const int d0 = d * 32 + 8 * g + 4 * lh;
      const uint2 z = *(const uint2*)(szrow + d0);
      uint2 v;
      v.x = pk2(o[d][4 * g] * inv * bf2f((u16)(z.x & 0xffff)), o[d][4 * g + 1] * inv * bf2f((u16)(z.x >> 16)));
      v.y = pk2(o[d][4 * g + 2] * inv * bf2f((u16)(z.y & 0xffff)), o[d][4 * g + 3] * inv * bf2f((u16)(z.y >> 16)));
      *(uint2*)(orow + d0) = v;
    }
}


template <int NSA, int NSB, int NDT>
DI void attn_dense_block(char* smem, const u16* __restrict__ qrow, const u16* __restrict__ kA, int kAstride, const u16* __restrict__ kB,
                         const u16* __restrict__ vt, int Lk, int nkeys, const u16* __restrict__ szrow, u16* __restrict__ orow) {
  constexpr int NS = NSA + NSB, DV = 32 * NDT, CA = NSA * 2;
  constexpr int KN_B = 64 * CA * 16, KR_B = (NSB > 0) ? 64 * 128 : 0, V_B = DV * 128, STG = KN_B + KR_B + V_B;
  constexpr int NLA = 64 * CA / 256, NLB = (NSB > 0) ? 2 : 0, NLV = DV * 8 / 256;
  const int tid = threadIdx.x, lane = tid & 63, wid = tid >> 6, l31 = lane & 31, lh = lane >> 5;
  const int arow = (CA == 16) ? (tid >> 4) : (tid >> 3);
  const int acc_ = (CA == 16) ? ((tid & 15) ^ ((tid >> 4) & 15)) : ((tid & 7) ^ ((tid >> 4) & 7));
  const int brow = tid >> 3, bcc = (tid & 7) ^ ((tid >> 4) & 7);
  const u16* ka_src = kA + (size_t)arow * kAstride + acc_ * 8;
  const u16* kb_src = (NSB > 0) ? (kB + (size_t)brow * 64 + bcc * 8) : kA;
  const u16* v_src = vt + (size_t)brow * Lk + bcc * 8;
  LAS char* wbase = (LAS char*)(smem + wid * 1024);
  bf16x8 qf[NS];
#pragma unroll
  for (int s = 0; s < NS; s++) qf[s] = *(const bf16x8*)(qrow + s * 16 + lh * 8);
  f32x16 o[NDT];
#pragma unroll
  for (int d = 0; d < NDT; d++)
#pragma unroll
    for (int r = 0; r < 16; r++) o[d][r] = 0.f;
  float m = -1e30f, l = 0.f;
  const int swA = (CA == 16) ? (l31 & 15) : ((l31 >> 1) & 7);
  const int swB = (l31 >> 1) & 7;

  __syncthreads();
#pragma unroll
  for (int i = 0; i < NLA; i++)
    __builtin_amdgcn_global_load_lds((const void*)(ka_src + (size_t)(i * (256 / CA)) * kAstride), (LAS void*)(wbase + i * 4096), 16, 0, 0);
#pragma unroll
  for (int i = 0; i < NLB; i++)
    __builtin_amdgcn_global_load_lds((const void*)(kb_src + (size_t)(32 * i) * 64), (LAS void*)(wbase + KN_B + i * 4096), 16, 0, 0);
#pragma unroll
  for (int i = 0; i < NLV; i++)
    __builtin_amdgcn_global_load_lds((const void*)(v_src + (size_t)(32 * i) * Lk), (LAS void*)(wbase + KN_B + KR_B + i * 4096), 16, 0, 0);
  asm volatile("s_waitcnt vmcnt(0)" ::: "memory");
  __syncthreads();
  int st = 0;
  for (int k0 = 0; k0 < nkeys; k0 += 64, st ^= 1) {
    if (k0 + 64 < nkeys) {
      const int kn = k0 + 64;
      LAS char* wb = wbase + (st ^ 1) * STG;
#pragma unroll
      for (int i = 0; i < NLA; i++)
        __builtin_amdgcn_global_load_lds((const void*)(ka_src + (size_t)(kn + i * (256 / CA)) * kAstride), (LAS void*)(wb + i * 4096), 16, 0, 0);
#pragma unroll
      for (int i = 0; i < NLB; i++)
        __builtin_amdgcn_global_load_lds((const void*)(kb_src + (size_t)(kn + 32 * i) * 64), (LAS void*)(wb + KN_B + i * 4096), 16, 0, 0);
#pragma unroll
      for (int i = 0; i < NLV; i++)
        __builtin_amdgcn_global_load_lds((const void*)(v_src + (size_t)(32 * i) * Lk + kn), (LAS void*)(wb + KN_B + KR_B + i * 4096), 16, 0, 0);
    }
    const char* Kn = smem + st * STG;
    const char* Kr = Kn + KN_B;
    const char* Vs = Kr + KR_B;
#pragma unroll 1
    for (int hh = 0; hh < 2; hh++) {
      f32x16 s0;
#pragma unroll
      for (int r = 0; r < 16; r++) s0[r] = 0.f;
      const char* kpa = Kn + (hh * 32 + l31) * (CA * 16);
#pragma unroll
      for (int s = 0; s < NSA; s++) s0 = MFMA32(*(const bf16x8*)(kpa + (((2 * s + lh) ^ swA) << 4)), qf[s], s0);
      if constexpr (NSB > 0) {
        const char* kpb = Kr + (hh * 32 + l31) * 128;
#pragma unroll
        for (int s = 0; s < NSB; s++) s0 = MFMA32(*(const bf16x8*)(kpb + (((2 * s + lh) ^ swB) << 4)), qf[NSA + s], s0);
      }
      float mx = s0[0];
#pragma unroll
      for (int r = 1; r < 16; r++) mx = fmaxf(mx, s0[r]);
      mx = fmaxf(mx, __shfl_xor(mx, 32));
      if (__any(mx > m + 8.f)) {
        const float mn = fmaxf(m, mx);
        const float alpha = __builtin_amdgcn_exp2f(m - mn);
        m = mn;
        l *= alpha;
#pragma unroll
        for (int d = 0; d < NDT; d++)
#pragma unroll
          for (int r = 0; r < 16; r++) o[d][r] *= alpha;
      }
      float ps = 0.f;
#pragma unroll
      for (int r = 0; r < 16; r++) { s0[r] = __builtin_amdgcn_exp2f(s0[r] - m); ps += s0[r]; }
      l += ps;
      const char* vp = Vs + l31 * 128;
#pragma unroll
      for (int sp = 0; sp < 2; sp++) {
        u32x4 pw;
        pw[0] = pk2(s0[8 * sp + 0], s0[8 * sp + 1]); pw[1] = pk2(s0[8 * sp + 2], s0[8 * sp + 3]);
        pw[2] = pk2(s0[8 * sp + 4], s0[8 * sp + 5]); pw[3] = pk2(s0[8 * sp + 6], s0[8 * sp + 7]);
        const bf16x8 pf = __builtin_bit_cast(bf16x8, pw);
        const int vo = ((hh * 4 + sp * 2 + lh) ^ swB) << 4;
#pragma unroll
        for (int d = 0; d < NDT; d++) o[d] = MFMA32(*(const bf16x8*)(vp + d * 32 * 128 + vo), pf, o[d]);
      }
    }
    asm volatile("s_waitcnt vmcnt(0)" ::: "memory");
    __syncthreads();
  }
  l += __shfl_xor(l, 32);
  const float inv = 1.f / l;
#pragma unroll
  for (int d = 0; d < NDT; d++)
#pragma unroll
    for (int g = 0; g < 4; g++) {
      const int d0 = d * 32 + 8 * g + 4 * lh;
      const uint2 z = *(const uint2*)(szrow + d0);
      uint2 v;
      v.x = pk2(o[d][4 * g] * inv * bf2f((u16)(z.x & 0xffff)), o[d][4 * g + 1] * inv * bf2f((u16)(z.x >> 16)));
      v.y = pk2(o[d][4 * g + 2] * inv * bf2f((u16)(z.y & 0xffff)), o[d][4 * g + 3] * inv * bf2f((u16)(z.y >> 16)));
      *(uint2*)(orow + d0) = v;
    }
}

DI void attn_na_wave(const Params& p, int b, int h, int r, int j) {
  const int lane = threadIdx.x & 63, l15 = lane & 15, q4 = lane >> 4;
  const int t = TC + b * 2048 + r * 64 + j * 16 + l15;
  const u16* qrow = p.NQ + (size_t)t * 1024 + h * 64;
  const bf16x8 qf0 = *(const bf16x8*)(qrow + q4 * 8);
  const bf16x8 qf1 = *(const bf16x8*)(qrow + 32 + q4 * 8);
  const int rs = min(max(r - 4, 0), 24);
  const int bstart = min(max(j * 16 - 8, 0), 32);
  const int c = j * 16 + l15;
  const int cstart = min(max(c - 8, 0), 48);
  const u16* kb = p.NK + (size_t)(TC + b * 2304) * 1024 + h * 64;
  const u16* vb = p.NVT + (size_t)16 * 1024 * 256 + (size_t)b * (1024 * 2304) + (size_t)(h * 64) * 2304;
  const float* rp = p.na_rpb + h * 465;
  f32x4 o[4];
#pragma unroll
  for (int d = 0; d < 4; d++) { o[d][0] = 0.f; o[d][1] = 0.f; o[d][2] = 0.f; o[d][3] = 0.f; }
  float m = -1e30f, l = 0.f;
  const int krow0 = 8 * (l15 >> 2) + (l15 & 3);
  for (int cg4 = 0; cg4 < 4; cg4++) {
    bf16x8 kf[4][4];
    bf16x8 vf[4][4];
#pragma unroll
    for (int c4 = 0; c4 < 4; c4++) {
      const int ch = cg4 * 4 + c4;
      const int key0 = ch < 8 ? ch * 32 : 256 + (rs + ch - 8) * 64 + bstart;
      const u16* kp = kb + (size_t)(key0 + krow0) * 1024 + q4 * 8;
      kf[c4][0] = *(const bf16x8*)(kp);
      kf[c4][1] = *(const bf16x8*)(kp + 32);
      kf[c4][2] = *(const bf16x8*)(kp + 4 * 1024);
      kf[c4][3] = *(const bf16x8*)(kp + 4 * 1024 + 32);
#pragma unroll
      for (int d = 0; d < 4; d++) vf[c4][d] = *(const bf16x8*)(vb + (size_t)(d * 16 + l15) * 2304 + key0 + q4 * 8);
    }
#pragma unroll
    for (int c4 = 0; c4 < 4; c4++) {
      const int ch = cg4 * 4 + c4;
      f32x4 s0 = {0.f, 0.f, 0.f, 0.f}, s1 = {0.f, 0.f, 0.f, 0.f};
      s0 = MFMA16(kf[c4][0], qf0, s0);
      s0 = MFMA16(kf[c4][1], qf1, s0);
      s1 = MFMA16(kf[c4][2], qf0, s1);
      s1 = MFMA16(kf[c4][3], qf1, s1);
      if (cg4 >= 2) {
        const int dr = rs + (ch - 8) - r + 7;
#pragma unroll
        for (int i = 0; i < 4; i++) {
          const int kc0 = bstart + q4 * 8 + i, kc1 = kc0 + 4;
          const bool v0 = (kc0 >= cstart) && (kc0 < cstart + 16);
          const bool v1 = (kc1 >= cstart) && (kc1 < cstart + 16);
          const int dc0 = min(max(kc0 - c + 15, 0), 30), dc1 = min(max(kc1 - c + 15, 0), 30);
          const float b0 = rp[dr * 31 + dc0] * LOG2E, b1 = rp[dr * 31 + dc1] * LOG2E;
          s0[i] = v0 ? s0[i] + b0 : -1e30f;
          s1[i] = v1 ? s1[i] + b1 : -1e30f;
        }
      }
      float mx = fmaxf(fmaxf(fmaxf(s0[0], s0[1]), fmaxf(s0[2], s0[3])), fmaxf(fmaxf(s1[0], s1[1]), fmaxf(s1[2], s1[3])));
      mx = fmaxf(mx, __shfl_xor(mx, 16));
      mx = fmaxf(mx, __shfl_xor(mx, 32));
      const float mn = fmaxf(m, mx);
      const float alpha = __builtin_amdgcn_exp2f(m - mn);
      m = mn;
      float ps = 0.f;
#pragma unroll
      for (int i = 0; i < 4; i++) { s0[i] = exp2f(s0[i] - mn); s1[i] = exp2f(s1[i] - mn); ps += s0[i] + s1[i]; }
      l = l * alpha + ps;
      u32x4 pw; pw[0] = pk2(s0[0], s0[1]); pw[1] = pk2(s0[2], s0[3]); pw[2] = pk2(s1[0], s1[1]); pw[3] = pk2(s1[2], s1[3]);
      const bf16x8 pf = __builtin_bit_cast(bf16x8, pw);
#pragma unroll
      for (int d = 0; d < 4; d++) {
        o[d][0] *= alpha; o[d][1] *= alpha; o[d][2] *= alpha; o[d][3] *= alpha;
        o[d] = MFMA16(vf[c4][d], pf, o[d]);
      }
    }
  }
  l += __shfl_xor(l, 16);
  l += __shfl_xor(l, 32);
  const float inv = 1.f / l;
  const u16* szrow = p.SZ + (size_t)t * 1024 + h * 64;
  u16* orow = p.NAO + (size_t)t * 1024 + h * 64;
#pragma unroll
  for (int d = 0; d < 4; d++) {
    const int d0 = d * 16 + q4 * 4;
    const uint2 z = *(const uint2*)(szrow + d0);
    uint2 v;
    v.x = pk2(o[d][0] * inv * bf2f((u16)(z.x & 0xffff)), o[d][1] * inv * bf2f((u16)(z.x >> 16)));
    v.y = pk2(o[d][2] * inv * bf2f((u16)(z.y & 0xffff)), o[d][3] * inv * bf2f((u16)(z.y >> 16)));
    *(uint2*)(orow + d0) = v;
  }
}


DI void attn_na_block(const Params& p, char* smem, int b, int h, int rpair) {
  const int tid = threadIdx.x, lane = tid & 63, j = tid >> 6, l31 = lane & 31, lh = lane >> 5;
  float* bl = (float*)(smem + 65536);
  const int r0 = rpair * 2;
  const int qr = r0 + (l31 >> 4), c = j * 16 + (l31 & 15);
  const int t = TC + b * 2048 + qr * 64 + c;
  const int rsq = min(max(qr - 4, 0), 24);
  const int rs0 = min(max(r0 - 4, 0), 24);
  const int nrows = min(max(r0 + 1 - 4, 0), 24) + 8 - rs0;
  const int ntile = 4 + nrows;
  const int bstart = min(max(j * 16 - 8, 0), 32);
  const int cstart = min(max(c - 8, 0), 48);
  const u16* kb = p.NK + (size_t)(TC + b * 2304) * 1024 + h * 64;
  const u16* vb = p.NVT + (size_t)16 * 1024 * 256 + (size_t)b * (1024 * 2304) + (size_t)(h * 64) * 2304;
  const u16* qrow = p.NQ + (size_t)t * 1024 + h * 64;
  bf16x8 qf[4];
#pragma unroll
  for (int s = 0; s < 4; s++) qf[s] = *(const bf16x8*)(qrow + s * 16 + lh * 8);
  f32x16 o[2];
#pragma unroll
  for (int d = 0; d < 2; d++)
#pragma unroll
    for (int r = 0; r < 16; r++) o[d][r] = 0.f;
  float m = -1e30f, l = 0.f;
  const int r16 = l31 & 15;
  const int kap = (l31 & 16) + (r16 & 3) + 4 * ((r16 >> 3) & 1) + 8 * ((r16 >> 2) & 1);
  const int srow = tid >> 3, scc = ((tid & 7) ^ ((tid >> 4) & 7)) * 8;
  const u16* ksrc = kb + (size_t)srow * 1024 + scc;
  const u16* vsrc = vb + (size_t)srow * 2304 + scc;
  LAS char* wbase = (LAS char*)(smem + (tid >> 6) * 1024);
  const int swV = (l31 >> 1) & 7;
  __syncthreads();
  for (int idx = tid; idx < 1024; idx += 256) {
    const int dr = idx >> 6, off = (idx & 63) - 16;
    const float v = p.na_rpb[h * 465 + min(dr, 14) * 31 + min(max(off, 0), 30)] * LOG2E;
    bl[idx] = (dr == 15) ? -1e30f : ((off >= 0 && off < 31) ? v : 0.f);
  }
  float am[16];
#pragma unroll
  for (int i = 0; i < 16; i++) {
    const int kcol = bstart + 16 * (i >> 3) + 8 * lh + (i & 7);
    am[i] = ((kcol >= cstart) && (kcol < cstart + 16)) ? 0.f : -1e30f;
  }
  const int ab = 16 + bstart + 8 * lh - c + 15;
#pragma unroll
  for (int tl = 0; tl < 3; tl++) {
    const int key0 = tl * 64;
    LAS char* wb = wbase + tl * 16384;
    __builtin_amdgcn_global_load_lds((const void*)(ksrc + (size_t)key0 * 1024), (LAS void*)(wb), 16, 0, 0);
    __builtin_amdgcn_global_load_lds((const void*)(ksrc + (size_t)(key0 + 32) * 1024), (LAS void*)(wb + 4096), 16, 0, 0);
    __builtin_amdgcn_global_load_lds((const void*)(vsrc + key0), (LAS void*)(wb + 8192), 16, 0, 0);
    __builtin_amdgcn_global_load_lds((const void*)(vsrc + (size_t)32 * 2304 + key0), (LAS void*)(wb + 8192 + 4096), 16, 0, 0);
  }
  asm volatile("s_waitcnt vmcnt(8)" ::: "memory");
  asm volatile("s_waitcnt lgkmcnt(0)" ::: "memory");
  __builtin_amdgcn_s_barrier();
  for (int tl = 0; tl < ntile; tl++) {
    if (tl + 3 < ntile) {
      const int tn = tl + 3;
      const int key0 = tn < 4 ? tn * 64 : 256 + (rs0 + tn - 4) * 64;
      LAS char* wb = wbase + (tn & 3) * 16384;
      __builtin_amdgcn_global_load_lds((const void*)(ksrc + (size_t)key0 * 1024), (LAS void*)(wb), 16, 0, 0);
      __builtin_amdgcn_global_load_lds((const void*)(ksrc + (size_t)(key0 + 32) * 1024), (LAS void*)(wb + 4096), 16, 0, 0);
      __builtin_amdgcn_global_load_lds((const void*)(vsrc + key0), (LAS void*)(wb + 8192), 16, 0, 0);
      __builtin_amdgcn_global_load_lds((const void*)(vsrc + (size_t)32 * 2304 + key0), (LAS void*)(wb + 8192 + 4096), 16, 0, 0);
    }
    const char* Kc = smem + (tl & 3) * 16384;
    const char* Vc = Kc + 8192;
    const bool local = tl >= 4;
    const int gr = rs0 + tl - 4;
    const int nh = local ? 1 : 2;
    for (int hh = 0; hh < nh; hh++) {
      const int koff = local ? bstart : hh * 32;
      f32x16 s0;
#pragma unroll
      for (int r = 0; r < 16; r++) s0[r] = 0.f;
      const int krow = koff + kap;
      const char* kp = Kc + krow * 128;
      const int swK = (krow >> 1) & 7;
#pragma unroll
      for (int s = 0; s < 4; s++) s0 = MFMA32(*(const bf16x8*)(kp + (((2 * s + lh) ^ swK) << 4)), qf[s], s0);
      if (local) {
        const bool rowvalid = (gr >= rsq) && (gr < rsq + 8);
        const int dr = rowvalid ? min(max(gr - qr + 7, 0), 14) : 15;
        const float* bp = bl + dr * 64 + ab;
#pragma unroll
        for (int i = 0; i < 16; i++) s0[i] += bp[16 * (i >> 3) + (i & 7)] + am[i];
      }
      float mx = s0[0];
#pragma unroll
      for (int r = 1; r < 16; r++) mx = fmaxf(mx, s0[r]);
      mx = fmaxf(mx, __shfl_xor(mx, 32));
      if (__any(mx > m + 8.f)) {
        const float mn = fmaxf(m, mx);
        const float alpha = __builtin_amdgcn_exp2f(m - mn);
        m = mn;
        l *= alpha;
#pragma unroll
        for (int d = 0; d < 2; d++)
#pragma unroll
          for (int r = 0; r < 16; r++) o[d][r] *= alpha;
      }
      float ps = 0.f;
#pragma unroll
      for (int r = 0; r < 16; r++) { s0[r] = __builtin_amdgcn_exp2f(s0[r] - m); ps += s0[r]; }
      l += ps;
      const char* vp = Vc + l31 * 128;
      const int vch = (koff >> 3) + lh;
#pragma unroll
      for (int sp = 0; sp < 2; sp++) {
        u32x4 pw;
        pw[0] = pk2(s0[8 * sp + 0], s0[8 * sp + 1]); pw[1] = pk2(s0[8 * sp + 2], s0[8 * sp + 3]);
        pw[2] = pk2(s0[8 * sp + 4], s0[8 * sp + 5]); pw[3] = pk2(s0[8 * sp + 6], s0[8 * sp + 7]);
        const bf16x8 pf = __builtin_bit_cast(bf16x8, pw);
        const int vo = ((vch + 2 * sp) ^ swV) << 4;
#pragma unroll
        for (int d = 0; d < 2; d++) o[d] = MFMA32(*(const bf16x8*)(vp + d * 32 * 128 + vo), pf, o[d]);
      }
    }
    if (tl + 3 < ntile) asm volatile("s_waitcnt vmcnt(8)" ::: "memory");
    else if (tl + 2 < ntile) asm volatile("s_waitcnt vmcnt(4)" ::: "memory");
    else asm volatile("s_waitcnt vmcnt(0)" ::: "memory");
    asm volatile("s_waitcnt lgkmcnt(0)" ::: "memory");
    __builtin_amdgcn_s_barrier();
  }
  l += __shfl_xor(l, 32);
  const float inv = 1.f / l;
  const u16* szrow = p.SZ + (size_t)t * 1024 + h * 64;
  u16* orow = p.NAO + (size_t)t * 1024 + h * 64;
#pragma unroll
  for (int d = 0; d < 2; d++)
#pragma unroll
    for (int g = 0; g < 4; g++) {
      const int d0 = d * 32 + 8 * g + 4 * lh;
      const uint2 z = *(const uint2*)(szrow + d0);
      uint2 v;
      v.x = pk2(o[d][4 * g] * inv * bf2f((u16)(z.x & 0xffff)), o[d][4 * g + 1] * inv * bf2f((u16)(z.x >> 16)));
      v.y = pk2(o[d][4 * g + 2] * inv * bf2f((u16)(z.y & 0xffff)), o[d][4 * g + 3] * inv * bf2f((u16)(z.y >> 16)));
      *(uint2*)(orow + d0) = v;
    }
}

DI void ph_prep(const Params& p, char* smem) {
  const int tid = threadIdx.x;
  const int ntr = p.nmat_tiles;
  const int ntot = ntr + 192;
  for (int tile = blockIdx.x; tile < ntot; tile += gridDim.x) {
    __syncthreads();
    if (tile >= 192) {
      const int ttile = tile - 192;
      int mi = 0;
      for (int i = 1; i < 18; i++) if (ttile >= p.mats[i].tile0) mi = i;
      const float* src = p.mats[mi].src; u16* dst = p.mats[mi].dst;
      const int K = p.mats[mi].K, Nsrc = p.mats[mi].Nsrc, Ndst = p.mats[mi].Ndst;
      const int lt = ttile - p.mats[mi].tile0;
      const int ntn = Ndst >> 6;
      const int kt = lt / ntn, nt = lt - kt * ntn;
      float* ts = (float*)smem;
#pragma unroll
      for (int i = 0; i < 4; i++) {
        const int k = i * 16 + (tid >> 4), n4 = (tid & 15) * 4, n = nt * 64 + n4;
        float4 v = {0.f, 0.f, 0.f, 0.f};
        if (n < Nsrc) v = *(const float4*)(src + (size_t)(kt * 64 + k) * Nsrc + n);
        ts[k * 65 + n4] = v.x; ts[k * 65 + n4 + 1] = v.y; ts[k * 65 + n4 + 2] = v.z; ts[k * 65 + n4 + 3] = v.w;
      }
      __syncthreads();
      const int n = tid >> 2, kc = (tid & 3) * 16;
      uint32_t w[8];
#pragma unroll
      for (int e = 0; e < 8; e++) w[e] = pk2(ts[(kc + 2 * e) * 65 + n], ts[(kc + 2 * e + 1) * 65 + n]);
      u16* dp = dst + (size_t)(nt * 64 + n) * K + kt * 64 + kc;
      uint4 v0; v0.x = w[0]; v0.y = w[1]; v0.z = w[2]; v0.w = w[3];
      uint4 v1; v1.x = w[4]; v1.y = w[5]; v1.z = w[6]; v1.w = w[7];
      *(uint4*)dp = v0; *(uint4*)(dp + 8) = v1;
    } else {
      const int at = tile;
      const int layer = at / 48, c0 = (at - layer * 48) * 64;
      float* sc = (float*)smem;
      float* red = sc + 5 * 1024;
      for (int i = tid; i < 5 * 1024; i += 256) {
        const int n = i >> 10, k = i & 1023;
        const float v = (n == 0) ? p.c_ctx[k] : p.c[(n - 1) * 1024 + k];
        sc[i] = silu(v);
      }
      __syncthreads();
      const int c4 = (tid & 15) * 4, kg = tid >> 4;
      float acc[5][4];
#pragma unroll
      for (int n = 0; n < 5; n++) { acc[n][0] = 0.f; acc[n][1] = 0.f; acc[n][2] = 0.f; acc[n][3] = 0.f; }
      const float* w = p.ada_w + (size_t)layer * 1024 * 3072 + c0 + c4;
#pragma unroll 4
      for (int kk = 0; kk < 64; kk++) {
        const int k = kg * 64 + kk;
        const float4 wv = *(const float4*)(w + (size_t)k * 3072);
#pragma unroll
        for (int n = 0; n < 5; n++) {
          const float s = sc[n * 1024 + k];
          acc[n][0] += s * wv.x; acc[n][1] += s * wv.y; acc[n][2] += s * wv.z; acc[n][3] += s * wv.w;
        }
      }
#pragma unroll
      for (int n = 0; n < 5; n++) {
        float4 r; r.x = acc[n][0]; r.y = acc[n][1]; r.z = acc[n][2]; r.w = acc[n][3];
        *(float4*)(red + (kg * 5 + n) * 64 + c4) = r;
      }
      __syncthreads();
      for (int o = tid; o < 320; o += 256) {
        const int n = o >> 6, cc = o & 63;
        float s = 0.f;
#pragma unroll
        for (int g = 0; g < 16; g++) s += red[(g * 5 + n) * 64 + cc];
        s += p.ada_b[layer * 3072 + c0 + cc];
        p.mod[(layer * 5 + n) * 3072 + c0 + cc] = s;
      }
    }
  }
}

DI void ph_h0(const Params& p) {
  for (int idx = blockIdx.x * 256 + threadIdx.x; idx < T * 128; idx += gridDim.x * 256) {
    const int t = idx >> 7, c0 = (idx & 127) * 8;
    const float* xr = (t < TC) ? p.x_prompt + (size_t)t * 1024 : p.x_sample + (size_t)(t - TC) * 1024;
    const float* md = p.mod + cond_of(t) * 3072;
    const float4 x0 = *(const float4*)(xr + c0), x1 = *(const float4*)(xr + c0 + 4);
    const float4 sh0 = *(const float4*)(md + c0), sh1 = *(const float4*)(md + c0 + 4);
    const float4 sc0 = *(const float4*)(md + 1024 + c0), sc1 = *(const float4*)(md + 1024 + c0 + 4);
    uint4 v;
    v.x = pk2(x0.x * (1.f + sc0.x) + sh0.x, x0.y * (1.f + sc0.y) + sh0.y);
    v.y = pk2(x0.z * (1.f + sc0.z) + sh0.z, x0.w * (1.f + sc0.w) + sh0.w);
    v.z = pk2(x1.x * (1.f + sc1.x) + sh1.x, x1.y * (1.f + sc1.y) + sh1.y);
    v.w = pk2(x1.z * (1.f + sc1.z) + sh1.z, x1.w * (1.f + sc1.w) + sh1.w);
    *(uint4*)(p.H + (size_t)t * 1024 + c0) = v;
  }
}

template <class Epi>
DI void gemm_phase(const u16* A, int lda, const u16* Bt, int ldb, int K, int MT, int NT, char* smem, const Epi& epi) {
  const int ntile = MT * NT;
  for (int tile = blockIdx.x; tile < ntile; tile += gridDim.x) {
    const int nt = tile / MT, mt = tile - nt * MT;
    gemm_tile<3>(A, lda, Bt, ldb, K, mt * 192, nt * 128, 0, smem, epi);
  }
}

template <class Epi>
DI void gemm_phase_st(const u16* A, int lda, const u16* Bt, int ldb, int K, int MT, int NT, char* smem, const Epi& epi) {
  const int ntile = MT * NT;
  for (int tile = blockIdx.x; tile < ntile; tile += gridDim.x) {
    const int nt = tile / MT, mt = tile - nt * MT;
    gemm_tile<3, Epi, true>(A, lda, Bt, ldb, K, mt * 192, nt * 128, 0, smem, epi);
  }
}

DI void unpack8(const u32x4& u, float* f) {
  f[0] = __uint_as_float(u[0] << 16); f[1] = __uint_as_float(u[0] & 0xffff0000u);
  f[2] = __uint_as_float(u[1] << 16); f[3] = __uint_as_float(u[1] & 0xffff0000u);
  f[4] = __uint_as_float(u[2] << 16); f[5] = __uint_as_float(u[2] & 0xffff0000u);
  f[6] = __uint_as_float(u[3] << 16); f[7] = __uint_as_float(u[3] & 0xffff0000u);
}
template <int HW>
DI void mix_item(const Params& p, int rpair) {
  const int lane = threadIdx.x & 63;
  constexpr int g = (HW == 1) ? 0 : (HW == 2) ? 1 : (HW == 4) ? 2 : 3;
  constexpr int NR = 8 + 2 * HW;
  const int c0 = (g * 32 + (lane & 31)) * 8;
  const int t0 = (rpair * 2 + (lane >> 5)) * 8;
  int s0, L, tt0;
  if (t0 < TC) { s0 = t0 & ~255; tt0 = t0 & 255; L = 256; } else { s0 = TC + ((t0 - TC) & ~2047); tt0 = (t0 - TC) & 2047; L = 2048; }
  u32x4 rows[NR];
#pragma unroll
  for (int r = 0; r < NR; r++) {
    const int tt = tt0 - HW + r;
    u32x4 v = {0u, 0u, 0u, 0u};
    if (tt >= 0 && tt < L) v = *(const u32x4*)(p.U + (size_t)(s0 + tt) * 1024 + c0);
    rows[r] = v;
  }
  float sum[8];
#pragma unroll
  for (int k = 0; k < 8; k++) sum[k] = 0.f;
#pragma unroll
  for (int r = 0; r < 2 * HW; r++) {
    float f[8]; unpack8(rows[r], f);
#pragma unroll
    for (int k = 0; k < 8; k++) sum[k] += f[k];
  }
#pragma unroll
  for (int e = 0; e < 8; e++) {
    const int tt = tt0 + e;
    const int lo = max(tt - HW, 0), hi = min(tt + HW, L);
    const float ic = 1.f / (float)(hi - lo);
    float own[8]; unpack8(rows[e + HW], own);
    u32x4 v;
    v[0] = pk2(sum[0] * ic - own[0], sum[1] * ic - own[1]);
    v[1] = pk2(sum[2] * ic - own[2], sum[3] * ic - own[3]);
    v[2] = pk2(sum[4] * ic - own[4], sum[5] * ic - own[5]);
    v[3] = pk2(sum[6] * ic - own[6], sum[7] * ic - own[7]);
    *(u32x4*)(p.MIX + (size_t)(s0 + tt) * 1024 + c0) = v;
    if (e < 7) {
      float fo[8], fi[8]; unpack8(rows[e], fo); unpack8(rows[e + 2 * HW], fi);
#pragma unroll
      for (int k = 0; k < 8; k++) sum[k] += fi[k] - fo[k];
    }
  }
}
DI void ph_mix(const Params& p) {
  const int wid = threadIdx.x >> 6;
  for (int item = blockIdx.x * 4 + wid; item < 768 * 4; item += gridDim.x * 4) {
    const int rpair = item >> 2, g = item & 3;
    if (g == 0) mix_item<1>(p, rpair);
    else if (g == 1) mix_item<2>(p, rpair);
    else if (g == 2) mix_item<4>(p, rpair);
    else mix_item<8>(p, rpair);
  }
}

DI void ph_pool_g2(const Params& p, int j, char* smem) {
  EpiPoolG2 epi{p.PM, p.SZ, p.pool_scale + j * 1024};
  for (int tile = blockIdx.x; tile < 64 * 8; tile += gridDim.x) {
    const int gn = tile / 64, mt = tile - gn * 64;
    const int g = gn >> 1, ns = gn & 1;
    gemm_tile<3>(p.MIX + g * 256, 1024, p.Wgrp + (size_t)(j * 4 + g) * 65536, 256, 256, mt * 192, ns * 128, g * 256, smem, epi);
  }
}

DI void ph_ln(const Params& p, int layer) {
  const int lane = threadIdx.x & 63, wid = threadIdx.x >> 6;
  const float* g = p.ln_g + layer * 1024;
  const float* bb = p.ln_b + layer * 1024;
  const int nw = gridDim.x * 4;
  for (int row0 = blockIdx.x * 4 + wid; row0 < T; row0 += 2 * nw) {
    const int row1 = row0 + nw;
    const bool has1 = row1 < T;
    const int r1 = has1 ? row1 : row0;
    float* xr0 = p.out + (size_t)row0 * 1024;
    float* xr1 = p.out + (size_t)r1 * 1024;
    const float* xi0 = (layer > 0) ? xr0 : ((row0 < TC) ? p.x_prompt + (size_t)row0 * 1024 : p.x_sample + (size_t)(row0 - TC) * 1024);
    const float* xi1 = (layer > 0) ? xr1 : ((r1 < TC) ? p.x_prompt + (size_t)r1 * 1024 : p.x_sample + (size_t)(r1 - TC) * 1024);
    float4 v0[4], v1[4];
#pragma unroll
    for (int i = 0; i < 4; i++) {
      v0[i] = *(const float4*)(xi0 + i * 256 + lane * 4); v1[i] = *(const float4*)(xi1 + i * 256 + lane * 4);
      const uint2 g0 = *(const uint2*)(p.GO + (size_t)row0 * 1024 + i * 256 + lane * 4);
      const uint2 g1 = *(const uint2*)(p.GO + (size_t)r1 * 1024 + i * 256 + lane * 4);
      v0[i].x = ALPHA * v0[i].x + bf2f((u16)(g0.x & 0xffff)); v0[i].y = ALPHA * v0[i].y + bf2f((u16)(g0.x >> 16));
      v0[i].z = ALPHA * v0[i].z + bf2f((u16)(g0.y & 0xffff)); v0[i].w = ALPHA * v0[i].w + bf2f((u16)(g0.y >> 16));
      v1[i].x = ALPHA * v1[i].x + bf2f((u16)(g1.x & 0xffff)); v1[i].y = ALPHA * v1[i].y + bf2f((u16)(g1.x >> 16));
      v1[i].z = ALPHA * v1[i].z + bf2f((u16)(g1.y & 0xffff)); v1[i].w = ALPHA * v1[i].w + bf2f((u16)(g1.y >> 16));
    }
    float s0 = 0.f, s1 = 0.f;
#pragma unroll
    for (int i = 0; i < 4; i++) { s0 += v0[i].x + v0[i].y + v0[i].z + v0[i].w; s1 += v1[i].x + v1[i].y + v1[i].z + v1[i].w; }
    const float mu0 = wave_sum(s0) * (1.f / 1024.f), mu1 = wave_sum(s1) * (1.f / 1024.f);
    float q0 = 0.f, q1 = 0.f;
#pragma unroll
    for (int i = 0; i < 4; i++) {
      v0[i].x -= mu0; v0[i].y -= mu0; v0[i].z -= mu0; v0[i].w -= mu0;
      v1[i].x -= mu1; v1[i].y -= mu1; v1[i].z -= mu1; v1[i].w -= mu1;
      q0 += v0[i].x * v0[i].x + v0[i].y * v0[i].y + v0[i].z * v0[i].z + v0[i].w * v0[i].w;
      q1 += v1[i].x * v1[i].x + v1[i].y * v1[i].y + v1[i].z * v1[i].z + v1[i].w * v1[i].w;
    }
    const float rs0 = rsqrtf(wave_sum(q0) * (1.f / 1024.f) + 1e-5f);
    const float rs1 = rsqrtf(wave_sum(q1) * (1.f / 1024.f) + 1e-5f);
    const float* md0 = p.mod + ((layer + 1) * 5 + cond_of(row0)) * 3072;
    const float* md1 = p.mod + ((layer + 1) * 5 + cond_of(has1 ? row1 : row0)) * 3072;
#pragma unroll
    for (int i = 0; i < 4; i++) {
      const int cc = i * 256 + lane * 4;
      const float4 gg = *(const float4*)(g + cc), be = *(const float4*)(bb + cc);
      float4 y0, y1;
      y0.x = v0[i].x * rs0 * gg.x + be.x; y0.y = v0[i].y * rs0 * gg.y + be.y; y0.z = v0[i].z * rs0 * gg.z + be.z; y0.w = v0[i].w * rs0 * gg.w + be.w;
      y1.x = v1[i].x * rs1 * gg.x + be.x; y1.y = v1[i].y * rs1 * gg.y + be.y; y1.z = v1[i].z * rs1 * gg.z + be.z; y1.w = v1[i].w * rs1 * gg.w + be.w;
      *(float4*)(xr0 + cc) = y0;
      if (has1) *(float4*)(xr1 + cc) = y1;
      if (layer < 3) {
        const float4 sh0 = *(const float4*)(md0 + cc), sc0 = *(const float4*)(md0 + 1024 + cc);
        const float4 sh1 = *(const float4*)(md1 + cc), sc1 = *(const float4*)(md1 + 1024 + cc);
        uint2 h0, h1;
        h0.x = pk2(y0.x * (1.f + sc0.x) + sh0.x, y0.y * (1.f + sc0.y) + sh0.y);
        h0.y = pk2(y0.z * (1.f + sc0.z) + sh0.z, y0.w * (1.f + sc0.w) + sh0.w);
        h1.x = pk2(y1.x * (1.f + sc1.x) + sh1.x, y1.y * (1.f + sc1.y) + sh1.y);
        h1.y = pk2(y1.z * (1.f + sc1.z) + sh1.z, y1.w * (1.f + sc1.w) + sh1.w);
        *(uint2*)(p.H + (size_t)row0 * 1024 + cc) = h0;
        if (has1) *(uint2*)(p.H + (size_t)row1 * 1024 + cc) = h1;
      }
    }
  }
}

DI void ph_mla_norm(const Params& p) {
  const int lane = threadIdx.x & 63, wid = threadIdx.x >> 6;
  for (int row = blockIdx.x * 4 + wid; row < T + 1024; row += gridDim.x * 4) {
    if (row < T) {
      const float* rr = p.RAW + (size_t)row * 768;
      const float4 a0 = *(const float4*)(rr + lane * 8), a1 = *(const float4*)(rr + lane * 8 + 4);
      const float4 k0 = *(const float4*)(rr + 512 + lane * 4);
      float s1 = a0.x * a0.x + a0.y * a0.y + a0.z * a0.z + a0.w * a0.w + a1.x * a1.x + a1.y * a1.y + a1.z * a1.z + a1.w * a1.w;
      float s2 = k0.x * k0.x + k0.y * k0.y + k0.z * k0.z + k0.w * k0.w;
      const float r1 = rsqrtf(wave_sum(s1) * (1.f / 512.f) + 1e-6f);
      const float r2 = rsqrtf(wave_sum(s2) * (1.f / 256.f) + 1e-6f);
      const float4 g0 = *(const float4*)(p.mla_q_norm + lane * 8), g1 = *(const float4*)(p.mla_q_norm + lane * 8 + 4);
      uint4 v;
      v.x = pk2(a0.x * r1 * g0.x, a0.y * r1 * g0.y); v.y = pk2(a0.z * r1 * g0.z, a0.w * r1 * g0.w);
      v.z = pk2(a1.x * r1 * g1.x, a1.y * r1 * g1.y); v.w = pk2(a1.z * r1 * g1.z, a1.w * r1 * g1.w);
      *(uint4*)(p.CQN + (size_t)row * 512 + lane * 8) = v;
      const float4 kg = *(const float4*)(p.mla_kv_norm + lane * 4);
      float4 kn; kn.x = k0.x * r2 * kg.x; kn.y = k0.y * r2 * kg.y; kn.z = k0.z * r2 * kg.z; kn.w = k0.w * r2 * kg.w;
      uint2 kv; kv.x = pk2(kn.x, kn.y); kv.y = pk2(kn.z, kn.w);
      *(uint2*)(p.CKVN + (size_t)kvrow_of(row) * 256 + lane * 4) = kv;
      if (row < TC) *(float4*)(p.out + OUT_CKV + (size_t)row * 256 + lane * 4) = kn;
    } else {
      const int cr = row - T, b = cr >> 8, pp = cr & 255;
      const size_t kvr = (size_t)TC + b * 2304 + pp;
      const float4 k0 = *(const float4*)(p.cache_ckv + (size_t)cr * 256 + lane * 4);
      uint2 kv; kv.x = pk2(k0.x, k0.y); kv.y = pk2(k0.z, k0.w);
      *(uint2*)(p.CKVN + kvr * 256 + lane * 4) = kv;
      p.KR[kvr * 64 + lane] = f2bf(p.cache_kr[(size_t)cr * 64 + lane]);
    }
  }
}

DI void ph_mla_g2(const Params& p, char* smem) {
  EpiMlaQ eq{p.Q};
  EpiMlaKV ekv{p.KN, p.VT};
  const int G = gridDim.x, b = blockIdx.x;
  const int nq = 64 * 12, nkv = 104 * 16;
  const int nq2 = nq - G > 0 ? nq - G : 0;
  for (int qt = b; qt < nq; qt += G) {
    const int nt = qt / 64, mt = qt - nt * 64;
    gemm_tile<3>(p.CQN, 512, p.Wuq, 512, 512, mt * 192, nt * 128, 0, smem, eq);
  }
  int k0, kstep, kend;
  if (b < nq2) { k0 = b; kstep = nq2; kend = 2 * nq2; }
  else { k0 = 2 * nq2 + (b - nq2); kstep = G - nq2; kend = nkv; }
  if (nq2 == 0 || 2 * nq2 > nkv) { k0 = b; kstep = G; kend = nkv; }
  for (int kt = k0; kt < kend; kt += kstep) {
    const int nt = kt / 104, mt = kt - nt * 104;
    gemm_tile<2, EpiMlaKV, true>(p.CKVN, 256, p.Wukv, 256, 256, mt * 128, nt * 128, 0, smem, ekv);
  }
}

DI void ph_mla_attn(const Params& p, char* smem) {
  const int wid = threadIdx.x >> 6, l31 = threadIdx.x & 31;
  for (int u = blockIdx.x; u < 768; u += gridDim.x) {
    int t0, kvrow0, nkeys, Lk, h; size_t vbase;
    if (u < 512) {
      const int xcd = u & 7, slot = u >> 3; const int pair = xcd * 4 + (slot >> 4); const int qb = slot & 15;
      const int b = pair >> 3; h = pair & 7;
      t0 = TC + b * 2048 + qb * 128 + wid * 32; kvrow0 = TC + b * 2304; nkeys = 2304; Lk = 2304;
      vbase = (size_t)16 * 8 * 128 * 256 + (size_t)b * (8 * 128 * 2304) + (size_t)h * 128 * 2304;
    } else {
      const int v = u - 512; const int b = v >> 4; h = (v >> 1) & 7; const int qb = v & 1;
      t0 = b * 256 + qb * 128 + wid * 32; kvrow0 = b * 256; nkeys = 256; Lk = 256;
      vbase = (size_t)b * (8 * 128 * 256) + (size_t)h * 128 * 256;
    }
    const int t = t0 + l31;
    attn_dense_block<8, 4, 4>(smem, p.Q + (size_t)t * 1536 + h * 192, p.KN + (size_t)kvrow0 * 1024 + h * 128, 1024,
                             p.KR + (size_t)kvrow0 * 64, p.VT + vbase, Lk, nkeys,
                             p.SZ + (size_t)t * 1024 + h * 128, p.AO + (size_t)t * 1024 + h * 128);
  }
}

DI void ph_na_g1(const Params& p, char* smem) {
  EpiNaG1 epi{p.NQ, p.NK, p.NVT, p.SZ, p.out + OUT_NAK, p.out + OUT_NAV};
  const int n1 = 64 * 32;
  for (int tile = blockIdx.x; tile < n1 + 64; tile += gridDim.x) {
    if (tile < n1) {
      const int nt = tile / 64, mt = tile - nt * 64;
      gemm_tile<3, EpiNaG1, true>(p.H, 1024, p.Wnin, 1024, 1024, mt * 192, nt * 128, 0, smem, epi);
    } else {
      const int ct = tile - n1;
      const int b = ct >> 4, p0 = (ct & 15) * 16;
      const int c4 = threadIdx.x * 4;
      const size_t kvb = (size_t)TC + b * 2304;
      u16* vtb = p.NVT + (size_t)16 * 1024 * 256 + (size_t)b * (1024 * 2304);
      float vv[4][16];
#pragma unroll
      for (int i = 0; i < 16; i++) {
        const size_t src = ((size_t)(b * 256 + p0 + i)) * 1024 + c4;
        const float4 k = *(const float4*)(p.cache_nak + src);
        uint2 kv; kv.x = pk2(k.x, k.y); kv.y = pk2(k.z, k.w);
        *(uint2*)(p.NK + (kvb + p0 + i) * 1024 + c4) = kv;
        const float4 v = *(const float4*)(p.cache_nav + src);
        vv[0][i] = v.x; vv[1][i] = v.y; vv[2][i] = v.z; vv[3][i] = v.w;
      }
#pragma unroll
      for (int e = 0; e < 4; e++) {
        uint4 w0, w1;
        w0.x = pk2(vv[e][0], vv[e][1]); w0.y = pk2(vv[e][2], vv[e][3]); w0.z = pk2(vv[e][4], vv[e][5]); w0.w = pk2(vv[e][6], vv[e][7]);
        w1.x = pk2(vv[e][8], vv[e][9]); w1.y = pk2(vv[e][10], vv[e][11]); w1.z = pk2(vv[e][12], vv[e][13]); w1.w = pk2(vv[e][14], vv[e][15]);
        u16* dp = vtb + (size_t)(c4 + e) * 2304 + p0;
        *(uint4*)dp = w0; *(uint4*)(dp + 8) = w1;
      }
    }
  }
}

DI void ph_na_attn(const Params& p, char* smem) {
  const int wid = threadIdx.x >> 6, l31 = threadIdx.x & 31;
  for (int u = blockIdx.x; u < 1024 + 512; u += gridDim.x) {
    if (u < 1024) {
      const int xcd = u & 7, slot = u >> 3;
      const int pair = xcd * 8 + (slot >> 4), rpair = slot & 15;
      attn_na_block(p, smem, pair >> 4, pair & 15, rpair);
    } else {
      const int v = u - 1024;
      const int b = v >> 5, h = (v >> 1) & 15, qb = v & 1;
      const int t = b * 256 + qb * 128 + wid * 32 + l31;
      attn_dense_block<4, 0, 2>(smem, p.NQ + (size_t)t * 1024 + h * 64, p.NK + (size_t)(b * 256) * 1024 + h * 64, 1024, nullptr,
                               p.NVT + (size_t)b * (1024 * 256) + (size_t)h * 64 * 256, 256, 256,
                               p.SZ + (size_t)t * 1024 + h * 64, p.NAO + (size_t)t * 1024 + h * 64);
    }
  }
}

template <int ph>
DI void run_phase(const Params& p, char* smem) {
  if constexpr (ph == 0) ph_prep(p, smem);
  else if constexpr (ph == 1) ph_h0(p);
  else if constexpr (ph == 2 || ph == 17) {
    constexpr int j = (ph == 2) ? 0 : 1;
    EpiPoolG1 e{p.U, p.SZ};
    gemm_phase(p.H, 1024, p.Wpin + (size_t)j * 2048 * 1024, 1024, 1024, 64, 16, smem, e);
  }
  else if constexpr (ph == 3 || ph == 18) ph_mix(p);
  else if constexpr (ph == 4 || ph == 19) ph_pool_g2(p, (ph == 4) ? 0 : 1, smem);
  else if constexpr (ph == 5) {
    EpiG3 e{p.GO, p.mod};
    gemm_phase_st(p.PM, 1024, p.Wpout, 1024, 1024, 64, 8, smem, e);
  }
  else if constexpr (ph == 20) {
    EpiG3 e{p.GO, p.mod + 3 * 5 * 3072};
    gemm_phase_st(p.PM, 1024, p.Wpout + (size_t)1024 * 1024, 1024, 1024, 64, 8, smem, e);
  }
  else if constexpr (ph == 6) ph_ln(p, 0);
  else if constexpr (ph == 21) ph_ln(p, 3);
  else if constexpr (ph == 7) {
    EpiMlaG1 e{p.RAW, p.KR, p.SZ, p.out + OUT_KR};
    gemm_phase(p.H, 1024, p.Wmin, 1024, 1024, 64, 15, smem, e);
  }
  else if constexpr (ph == 8) ph_mla_norm(p);
  else if constexpr (ph == 9) ph_mla_g2(p, smem);
  else if constexpr (ph == 10) ph_mla_attn(p, smem);
  else if constexpr (ph == 11) {
    EpiG3 e{p.GO, p.mod + 1 * 5 * 3072};
    gemm_phase_st(p.AO, 1024, p.Wmout, 1024, 1024, 64, 8, smem, e);
  }
  else if constexpr (ph == 12) ph_ln(p, 1);
  else if constexpr (ph == 13) ph_na_g1(p, smem);
  else if constexpr (ph == 14) ph_na_attn(p, smem);
  else if constexpr (ph == 15) {
    EpiG3 e{p.GO, p.mod + 2 * 5 * 3072};
    gemm_phase_st(p.NAO, 1024, p.Wnout, 1024, 1024, 64, 8, smem, e);
  }
  else if constexpr (ph == 16) ph_ln(p, 2);
}

#define RUN_PH(n) if (ph_lo <= (n) && (n) < ph_hi) { run_phase<n>(p, smem); if ((n) + 1 < ph_hi) xcd_barrier(xb); }

__global__ void __launch_bounds__(256, 2) mega(Params p, int ph_lo, int ph_hi) {
  __shared__ __attribute__((aligned(16))) char smem[SMEM_BYTES];
  if (ph_lo < 0) { cg::this_grid().sync(); return; }
  const bool multi = (ph_hi - ph_lo) > 1;
  XcdBarrier xb; xb.bar = p.bar; xb.x = 0; xb.nloc = 0u; xb.nx = 0u;
  if (multi) xb = xcd_barrier_post(p.bar);
  RUN_PH(0) RUN_PH(1) RUN_PH(2) RUN_PH(3) RUN_PH(4) RUN_PH(5) RUN_PH(6) RUN_PH(7) RUN_PH(8) RUN_PH(9) RUN_PH(10)
  RUN_PH(11) RUN_PH(12) RUN_PH(13) RUN_PH(14) RUN_PH(15) RUN_PH(16) RUN_PH(17) RUN_PH(18) RUN_PH(19) RUN_PH(20) RUN_PH(21)
}

extern "C" void kernel_launch(void* const* d_in, const int* in_sizes, int n_in, void* d_out, int out_size, void* d_ws, size_t ws_size,
                              hipStream_t stream) {
  Params p;
  memset(&p, 0, sizeof(p));
  const float* const* in = (const float* const*)d_in;
  p.x_prompt = in[0]; p.x_sample = in[1]; p.cache_ckv = in[2]; p.cache_kr = in[3]; p.cache_nak = in[4]; p.cache_nav = in[5];
  p.c = in[6]; p.c_ctx = in[7]; p.ada_w = in[8]; p.ada_b = in[9]; p.ln_g = in[10]; p.ln_b = in[11];
  const float* pool_w_in = in[12]; const float* pool_w_grp = in[13]; p.pool_scale = in[14]; const float* pool_w_out = in[15];
  const float* mla_w_in = in[16]; p.mla_q_norm = in[17]; const float* mla_w_uq = in[18]; p.mla_kv_norm = in[19];
  const float* mla_w_ukv = in[20]; const float* mla_w_out = in[21]; const float* na_w_in = in[22]; p.na_rpb = in[23];
  const float* na_w_out = in[24];
  p.out = (float*)d_out;

  char* ws = (char*)d_ws;
  size_t off = 0;
  auto take = [&](size_t bytes) { char* r = ws + off; off += (bytes + 255) & ~(size_t)255; return r; };
  p.bar = (unsigned*)take(XCD_BAR_WORDS * 4);
  p.mod = (float*)take((size_t)4 * 5 * 3072 * 4);
  p.Wpin = (u16*)take((size_t)2 * 2048 * 1024 * 2);
  p.Wgrp = (u16*)take((size_t)8 * 65536 * 2);
  p.Wpout = (u16*)take((size_t)2 * 1024 * 1024 * 2);
  p.Wmin = (u16*)take((size_t)1920 * 1024 * 2);
  p.Wuq = (u16*)take((size_t)1536 * 512 * 2);
  p.Wukv = (u16*)take((size_t)2048 * 256 * 2);
  p.Wmout = (u16*)take((size_t)1024 * 1024 * 2);
  p.Wnin = (u16*)take((size_t)4096 * 1024 * 2);
  p.Wnout = (u16*)take((size_t)1024 * 1024 * 2);
  p.H = (u16*)take((size_t)T * 1024 * 2);
  p.SZ = (u16*)take((size_t)T * 1024 * 2);
  p.GO = (u16*)take((size_t)T * 1024 * 2);
  const size_t arena0 = off;
  p.U = (u16*)take((size_t)T * 1024 * 2);
  p.MIX = (u16*)take((size_t)T * 1024 * 2);
  p.PM = (u16*)take((size_t)T * 1024 * 2);
  off = arena0;
  p.RAW = (float*)take((size_t)T * 768 * 4);
  p.AO = (u16*)p.RAW;
  p.CQN = (u16*)take((size_t)T * 512 * 2);
  p.CKVN = (u16*)take((size_t)KVR * 256 * 2);
  p.KR = (u16*)take((size_t)KVR * 64 * 2);
  p.Q = (u16*)take((size_t)T * 1536 * 2);
  p.KN = (u16*)take((size_t)KVR * 1024 * 2);
  p.VT = (u16*)take((size_t)KVR * 1024 * 2);
  off = arena0;
  p.NQ = (u16*)take((size_t)T * 1024 * 2);
  p.NK = (u16*)take((size_t)KVR * 1024 * 2);
  p.NVT = (u16*)take((size_t)KVR * 1024 * 2);
  p.NAO = (u16*)take((size_t)T * 1024 * 2);

  int nm = 0, tiles = 0;
  auto add = [&](const float* src, u16* dst, int K, int Nsrc, int Ndst) {
    p.mats[nm].src = src; p.mats[nm].dst = dst; p.mats[nm].K = K; p.mats[nm].Nsrc = Nsrc; p.mats[nm].Ndst = Ndst; p.mats[nm].tile0 = tiles;
    tiles += (K / 64) * (Ndst / 64); nm++;
  };
  for (int j = 0; j < 2; j++) add(pool_w_in + (size_t)j * 1024 * 2048, p.Wpin + (size_t)j * 2048 * 1024, 1024, 2048, 2048);
  for (int j = 0; j < 8; j++) add(pool_w_grp + (size_t)j * 65536, p.Wgrp + (size_t)j * 65536, 256, 256, 256);
  for (int j = 0; j < 2; j++) add(pool_w_out + (size_t)j * 1024 * 1024, p.Wpout + (size_t)j * 1024 * 1024, 1024, 1024, 1024);
  add(mla_w_in, p.Wmin, 1024, 1856, 1920);
  add(mla_w_uq, p.Wuq, 512, 1536, 1536);
  add(mla_w_ukv, p.Wukv, 256, 2048, 2048);
  add(mla_w_out, p.Wmout, 1024, 1024, 1024);
  add(na_w_in, p.Wnin, 1024, 4096, 4096);
  add(na_w_out, p.Wnout, 1024, 1024, 1024);
  p.nmat_tiles = tiles;

  (void)hipMemsetAsync(p.bar, 0, XCD_BAR_WORDS * 4, stream);
#if MULTI_LAUNCH
  for (int ph = 0; ph < NPHASE; ph++) hipLaunchKernelGGL(mega, dim3(512), dim3(256), 0, stream, p, ph, ph + 1);
#else
  static int grid_blocks = 0;
  if (!grid_blocks) {
    int dev = 0, cus = 0, per_cu = 0;
    hipGetDevice(&dev);
    hipDeviceGetAttribute(&cus, hipDeviceAttributeMultiprocessorCount, dev);
    hipOccupancyMaxActiveBlocksPerMultiprocessor(&per_cu, mega, 256, 0);
    if (per_cu > 2) per_cu = 2;
    if (per_cu < 1) per_cu = 1;
    grid_blocks = cus * per_cu;
  }
  int lo = 0, hi = NPHASE;
  void* args[] = {&p, &lo, &hi};
  hipError_t e = hipLaunchCooperativeKernel((void*)mega, dim3(grid_blocks), dim3(256), args, 0, stream);
  if (e != hipSuccess) fprintf(stderr, "cooperative launch failed: %s (grid %d)\n", hipGetErrorString(e), grid_blocks);
#endif
}
```

```cpp
#include <hip/hip_runtime.h>
#include <hip/hip_cooperative_groups.h>
#include <stdint.h>
#include <string.h>
#include <stdio.h>
namespace cg = cooperative_groups;

#ifndef MULTI_LAUNCH
#define MULTI_LAUNCH 0
#endif

typedef __attribute__((ext_vector_type(8))) short bf16x8;
typedef __attribute__((ext_vector_type(4))) float f32x4;
typedef __attribute__((ext_vector_type(16))) float f32x16;
typedef __attribute__((ext_vector_type(4))) uint32_t u32x4;
typedef unsigned short u16;
#define DI __device__ __forceinline__
#define MFMA32(a, b, c) __builtin_amdgcn_mfma_f32_32x32x16_bf16((a), (b), (c), 0, 0, 0)
#define MFMA16(a, b, c) __builtin_amdgcn_mfma_f32_16x16x32_bf16((a), (b), (c), 0, 0, 0)

constexpr int TC = 4096, TL = 8192, T = 12288;
constexpr int KVR = 4096 + 4 * 2304;
constexpr float LOG2E = 1.4426950408889634f;
constexpr float ALPHA = 1.681792830507429f;
constexpr float MLA_QS = 0.07216878364870323f * LOG2E;
constexpr float NA_QS = 0.125f * LOG2E;
constexpr int SMEM_BYTES = 81920;
constexpr int NPHASE = 22;

constexpr size_t OUT_YS = 4194304, OUT_CKV = 12582912, OUT_KR = 13631488, OUT_NAK = 13893632, OUT_NAV = 18087936;

struct MatDesc { const float* src; u16* dst; int K, Nsrc, Ndst, tile0, ld, pad; };

struct Params {
  const float *x_prompt, *x_sample, *cache_ckv, *cache_kr, *cache_nak, *cache_nav, *c, *c_ctx, *ada_w, *ada_b, *ln_g, *ln_b;
  const float *pool_scale, *mla_q_norm, *mla_kv_norm, *na_rpb;
  float* out;
  float* mod;
  u16 *H, *SZ, *GO, *WinU;
  const float* pool_w_in;
  u16 *Wpin, *Wgrp, *Wpout, *Wmin, *Wuq, *Wukv, *Wmout, *Wnin, *Wnout;
  u16 *U, *MIX, *PM;
  float* RAW; u16 *AO, *CQN, *CKVN, *KR, *Q, *KN, *VT;
  u16 *NQ, *NK, *NVT, *NAO;
  unsigned* bar;
  MatDesc mats[18];
  int nmat_tiles; int pad0;
};

DI float bf2f(u16 v) { return __uint_as_float(((uint32_t)v) << 16); }
typedef __attribute__((ext_vector_type(2))) float f32x2;
typedef __attribute__((ext_vector_type(2))) __bf16 bf16x2_t;
DI uint32_t pk2(float a, float b) { f32x2 v = {a, b}; return __builtin_bit_cast(uint32_t, __builtin_convertvector(v, bf16x2_t)); }
DI u16 f2bf(float x) { return (u16)(pk2(x, x) & 0xffffu); }
DI float silu(float v) { return v / (1.f + __expf(-v)); }
DI int cond_of(int t) { return t < TC ? 0 : 1 + ((t - TC) >> 11); }
DI int kvrow_of(int t) { return t < TC ? t : TC + ((t - TC) >> 11) * 2304 + 256 + ((t - TC) & 2047); }
DI int perm16(int key) { const int k = key & 15; return (key & ~15) | (k & 3) | ((k >> 1) & 4) | ((k << 1) & 8); }
DI float wave_sum(float v) {
#pragma unroll
  for (int o = 32; o >= 1; o >>= 1) v += __shfl_xor(v, o);
  return v;
}

#define XB_TMO      128
#define XB_XCNT(j)  (256  + 64 * (j))
#define XB_XSUB(j)  (1280 + 64 * (j))
#define XB_XGEN(j)  (2304 + 64 * (j))
#define XB_TOP      3328
#define XB_TOPGEN   3392
#define XCD_BAR_WORDS 3456
#define XB_SPIN_CAP (1u << 22)
#define LAS __attribute__((address_space(3)))
DI unsigned xb_ld(unsigned* p) { return __hip_atomic_load(p, __ATOMIC_RELAXED, __HIP_MEMORY_SCOPE_AGENT); }
DI unsigned xb_add(unsigned* p, unsigned v) { return __hip_atomic_fetch_add(p, v, __ATOMIC_RELAXED, __HIP_MEMORY_SCOPE_AGENT); }
DI unsigned xb_xcc_id() { return (unsigned)__builtin_amdgcn_s_getreg((3 << 11) | 20) & 0xFu; }
#define XB_SPIN(cond, bar) do { unsigned _sp = 0; while (cond) { __builtin_amdgcn_s_sleep(1); \
    if ((++_sp & 255u) == 0u) { if (xb_ld(&(bar)[XB_TMO])) break; if (_sp > XB_SPIN_CAP) { atomicAdd(&(bar)[XB_TMO], 1u); break; } } } } while (0)
struct XcdBarrier { unsigned* bar; unsigned x; unsigned nloc, nx; };
DI XcdBarrier xcd_barrier_post(unsigned* bar) {
  XcdBarrier b; b.bar = bar; b.x = xb_xcc_id(); b.nloc = 0u; b.nx = 0u;
  if (threadIdx.x == 0) (void)xb_add(&bar[XB_XCNT(b.x)], 1u);
  return b;
}
DI void xcd_barrier_complete(unsigned* bar, unsigned x, unsigned& nloc, unsigned& nx) {
  const unsigned G = gridDim.x * gridDim.y * gridDim.z;
  unsigned sum, cnt, mine, sp = 0u;
  for (;;) {
    sum = 0u; cnt = 0u; mine = 0u;
#pragma unroll
    for (unsigned j = 0; j < 16; ++j) { const unsigned c = xb_ld(&bar[XB_XCNT(j)]); sum += c; cnt += (c > 0u) ? 1u : 0u; mine = (j == x) ? c : mine; }
    if (sum == G) break;
    __builtin_amdgcn_s_sleep(1);
    if ((++sp & 255u) == 0u) { if (xb_ld(&bar[XB_TMO])) break; if (sp > XB_SPIN_CAP) { atomicAdd(&bar[XB_TMO], 1u); break; } }
  }
  nloc = mine > 0u ? mine : 1u; nx = cnt > 0u ? cnt : 1u;
}
DI void xcd_barrier(XcdBarrier& b) {
  asm volatile("s_waitcnt vmcnt(0)" ::: "memory");
  __syncthreads();
  unsigned nloc = b.nloc, nx = b.nx;
  if (threadIdx.x == 0) {
    unsigned* bar = b.bar;
    __builtin_amdgcn_s_waitcnt(0);
    if (nloc == 0u) { xcd_barrier_complete(bar, b.x, nloc, nx); }
    const unsigned old = xb_add(&bar[XB_XSUB(b.x)], 1u);
    const unsigned gen = old / nloc;
    if (old + 1u == (gen + 1u) * nloc) {
      __builtin_amdgcn_fence(__ATOMIC_RELEASE, "agent");
      asm volatile("s_waitcnt vmcnt(0)" ::: "memory");
      const unsigned og = xb_add(&bar[XB_TOP], 1u);
      const unsigned tg = og / nx;
      if (og + 1u == (tg + 1u) * nx) xb_add(&bar[XB_TOPGEN], 1u);
      else XB_SPIN(xb_ld(&bar[XB_TOPGEN]) == tg, bar);
      __builtin_amdgcn_fence(__ATOMIC_ACQUIRE, "agent");
      xb_add(&bar[XB_XGEN(b.x)], 1u);
      asm volatile("s_waitcnt vmcnt(0)" ::: "memory");
    } else {
      XB_SPIN(xb_ld(&bar[XB_XGEN(b.x)]) == gen, bar);
      __builtin_amdgcn_fence(__ATOMIC_ACQUIRE, "agent");
      asm volatile("s_waitcnt vmcnt(0)" ::: "memory");
    }
  }
  if (threadIdx.x < 64) { b.nloc = __builtin_amdgcn_readfirstlane(nloc); b.nx = __builtin_amdgcn_readfirstlane(nx); }
  __syncthreads();
}

template <int MI, class Epi, bool STAGED = false>
DI void gemm_tile(const u16* __restrict__ A, int lda, const u16* __restrict__ Bt, int ldb, int K, int m0, int n0, int nout_off,
                  char* smem, const Epi& epi) {
  constexpr int BM = 64 * MI, ASTG = BM * 128, NG = 2 * MI + 4;
  const int tid = threadIdx.x, lane = tid & 63, wid = tid >> 6;
  const int wm = wid >> 1, wn = wid & 1, l31 = lane & 31, lh = lane >> 5;
  char* As = smem;
  char* Bs = smem + 2 * ASTG;
  const int srow = tid >> 3;
  const int scc = ((tid & 7) ^ ((tid >> 4) & 7)) * 8;
  const u16* ag = A + (size_t)(m0 + srow) * lda + scc;
  const u16* bg = Bt + (size_t)(n0 + srow) * ldb + scc;
  LAS char* awr = (LAS char*)(As + wid * 1024);
  LAS char* bwr = (LAS char*)(Bs + wid * 1024);
  f32x16 acc[MI][2];
#pragma unroll
  for (int i = 0; i < MI; i++)
#pragma unroll
    for (int j = 0; j < 2; j++)
#pragma unroll
      for (int r = 0; r < 16; r++) acc[i][j][r] = 0.f;
  const int nk = K >> 6;
  const int rot = (n0 >> 7) + (m0 >> 6);
  __syncthreads();
#pragma unroll
  for (int t = 0; t < 2; t++) {
#pragma unroll
    for (int i = 0; i < 2 * MI; i++)
      __builtin_amdgcn_global_load_lds((const void*)(ag + (size_t)(32 * i) * lda + ((t + rot) & (nk - 1)) * 64), (LAS void*)(awr + t * ASTG + i * 4096), 16, 0, 0);
#pragma unroll
    for (int i = 0; i < 4; i++)
      __builtin_amdgcn_global_load_lds((const void*)(bg + (size_t)(32 * i) * ldb + ((t + rot) & (nk - 1)) * 64), (LAS void*)(bwr + t * 16384 + i * 4096), 16, 0, 0);
  }
  const int sw = (l31 >> 1) & 7;
  for (int kt = 0; kt < nk; kt++) {
    const int buf = kt & 1;
    if (kt + 1 < nk) asm volatile("s_waitcnt vmcnt(%0)" :: "n"(NG) : "memory");
    else asm volatile("s_waitcnt vmcnt(0)" ::: "memory");
    __builtin_amdgcn_s_barrier();
    const char* as = As + buf * ASTG + (wm * (32 * MI) + l31) * 128;
    const char* bs = Bs + buf * 16384 + (wn * 64 + l31) * 128;
    bf16x8 fa[4][MI], fb[4][2];
#pragma unroll
    for (int ks = 0; ks < 4; ks++) {
      const int co = ((2 * ks + lh) ^ sw) << 4;
      fb[ks][0] = *(const bf16x8*)(bs + co);
      fb[ks][1] = *(const bf16x8*)(bs + 32 * 128 + co);
#pragma unroll
      for (int i = 0; i < MI; i++) fa[ks][i] = *(const bf16x8*)(as + i * 32 * 128 + co);
    }
    asm volatile("s_waitcnt lgkmcnt(0)" ::: "memory");
    __builtin_amdgcn_s_barrier();
    if (kt + 2 < nk) {
#pragma unroll
      for (int i = 0; i < 2 * MI; i++)
        __builtin_amdgcn_global_load_lds((const void*)(ag + (size_t)(32 * i) * lda + ((kt + 2 + rot) & (nk - 1)) * 64), (LAS void*)(awr + buf * ASTG + i * 4096), 16, 0, 0);
#pragma unroll
      for (int i = 0; i < 4; i++)
        __builtin_amdgcn_global_load_lds((const void*)(bg + (size_t)(32 * i) * ldb + ((kt + 2 + rot) & (nk - 1)) * 64), (LAS void*)(bwr + buf * 16384 + i * 4096), 16, 0, 0);
    }
#pragma unroll
    for (int ks = 0; ks < 4; ks++)
#pragma unroll
      for (int i = 0; i < MI; i++) {
        acc[i][0] = MFMA32(fb[ks][0], fa[ks][i], acc[i][0]);
        acc[i][1] = MFMA32(fb[ks][1], fa[ks][i], acc[i][1]);
      }
  }
  if constexpr (STAGED) {
    float* stg = (float*)(smem + wid * 8704);
    const int nbw = nout_off + n0 + wn * 64;
#pragma unroll
    for (int i = 0; i < MI; i++) {
      const int mb = m0 + wm * (32 * MI) + i * 32;
#pragma unroll
      for (int j = 0; j < 2; j++)
#pragma unroll
        for (int g = 0; g < 4; g++) {
          float4 v; v.x = acc[i][j][4 * g]; v.y = acc[i][j][4 * g + 1]; v.z = acc[i][j][4 * g + 2]; v.w = acc[i][j][4 * g + 3];
          *(float4*)(stg + l31 * 68 + j * 32 + 8 * g + 4 * lh) = v;
        }
      asm volatile("s_waitcnt lgkmcnt(0)" ::: "memory");
      __builtin_amdgcn_wave_barrier();
      bool rows = true;
      if constexpr (Epi::HAS_VT) {
        if (epi.is_vt(nbw)) {
          rows = epi.vt_rows(mb);
          const bool perm = epi.vt_perm(mb);
#pragma unroll
          for (int it = 0; it < 4; it++) {
            const int n = lane, q = it;
            float v[8];
            int pos;
            if (perm) {
              const int rb = (q >> 1) * 16 + (q & 1) * 4;
#pragma unroll
              for (int k = 0; k < 8; k++) v[k] = stg[(rb + (k & 3) + 8 * (k >> 2)) * 68 + n];
              pos = (q >> 1) * 16 + (q & 1) * 8;
            } else {
#pragma unroll
              for (int k = 0; k < 8; k++) v[k] = stg[(q * 8 + k) * 68 + n];
              pos = q * 8;
            }
            epi.vt8(mb, nbw + n, pos, v);
          }
        }
      }
      if (rows) {
#pragma unroll
        for (int it = 0; it < 8; it++) {
          const int row = it * 4 + (lane >> 4), col = (lane & 15) * 4;
          const float4 v = *(const float4*)(stg + row * 68 + col);
          epi.row4(mb + row, nbw + col, v);
        }
      }
      asm volatile("s_waitcnt lgkmcnt(0)" ::: "memory");
      __builtin_amdgcn_wave_barrier();
    }
  } else {
#pragma unroll
    for (int i = 0; i < MI; i++)
#pragma unroll
      for (int j = 0; j < 2; j++)
        epi(m0 + wm * (32 * MI) + i * 32 + l31, nout_off + n0 + wn * 64 + j * 32, lh, acc[i][j]);
  }
}

DI void rope_pair(float x1, float x2, int i, float pos, float& o1, float& o2) {
  const float inv = exp2f(-(float)i * (13.287712379549449f / 16.f));
  const float ang = pos * inv;
  const float c = __cosf(ang), s = __sinf(ang);
  o1 = x1 * c - x2 * s;
  o2 = x1 * s + x2 * c;
}

struct EpiPoolG1 {
  u16 *U, *SZ;
  DI void operator()(int m, int nb, int lh, const f32x16& a) const {
#pragma unroll
    for (int g = 0; g < 4; g++) {
      const int n = nb + 8 * g + 4 * lh;
      if (nb < 1024) {
        uint2 v; v.x = pk2(a[4 * g], a[4 * g + 1]); v.y = pk2(a[4 * g + 2], a[4 * g + 3]);
        *(uint2*)(U + (size_t)m * 1024 + n) = v;
      } else {
        uint2 v; v.x = pk2(silu(a[4 * g]), silu(a[4 * g + 1])); v.y = pk2(silu(a[4 * g + 2]), silu(a[4 * g + 3]));
        *(uint2*)(SZ + (size_t)m * 1024 + n - 1024) = v;
      }
    }
  }
};
struct EpiPoolG2 {
  u16* PM; const u16* SZ; const float* scale;
  DI void operator()(int m, int nb, int lh, const f32x16& a) const {
#pragma unroll
    for (int g = 0; g < 4; g++) {
      const int n = nb + 8 * g + 4 * lh;
      const uint2 z = *(const uint2*)(SZ + (size_t)m * 1024 + n);
      const float4 sc = *(const float4*)(scale + n);
      uint2 v;
      v.x = pk2(a[4 * g] * sc.x * bf2f((u16)(z.x & 0xffff)), a[4 * g + 1] * sc.y * bf2f((u16)(z.x >> 16)));
      v.y = pk2(a[4 * g + 2] * sc.z * bf2f((u16)(z.y & 0xffff)), a[4 * g + 3] * sc.w * bf2f((u16)(z.y >> 16)));
      *(uint2*)(PM + (size_t)m * 1024 + n) = v;
    }
  }
};
struct EpiG3 {
  static constexpr bool HAS_VT = false;
  u16* GO; const float* mod_layer;
  DI void row4(int m, int n, const float4& a) const {
    const float4 gt = *(const float4*)(mod_layer + cond_of(m) * 3072 + 2048 + n);
    uint2 v; v.x = pk2(gt.x * a.x, gt.y * a.y); v.y = pk2(gt.z * a.z, gt.w * a.w);
    *(uint2*)(GO + (size_t)m * 1024 + n) = v;
  }
  DI void operator()(int m, int nb, int lh, const f32x16& a) const {
    const float* gate = mod_layer + cond_of(m) * 3072 + 2048;
#pragma unroll
    for (int g = 0; g < 4; g++) {
      const int n = nb + 8 * g + 4 * lh;
      const float4 gt = *(const float4*)(gate + n);
      uint2 v; v.x = pk2(gt.x * a[4 * g], gt.y * a[4 * g + 1]); v.y = pk2(gt.z * a[4 * g + 2], gt.w * a[4 * g + 3]);
      *(uint2*)(GO + (size_t)m * 1024 + n) = v;
    }
  }
};
struct EpiMlaG1 {
  float* RAW; u16* KR; u16* SZ; float* st_kr;
  DI void operator()(int m, int nb, int lh, const f32x16& a) const {
    if (nb >= 1856) return;
    if (nb < 768) {
#pragma unroll
      for (int g = 0; g < 4; g++) {
        const int n = nb + 8 * g + 4 * lh;
        float4 r; r.x = a[4 * g]; r.y = a[4 * g + 1]; r.z = a[4 * g + 2]; r.w = a[4 * g + 3];
        *(float4*)(RAW + (size_t)m * 768 + n) = r;
      }
    } else if (nb < 832) {
      const int off = nb - 768;
      const bool lat = m >= TC;
      const int tt = (m - TC) & 2047;
      const float pos = (off == 0) ? (float)(tt >> 6) : (float)(tt & 63);
      const size_t kr = (size_t)kvrow_of(m) * 64 + off;
#pragma unroll
      for (int g = 0; g < 2; g++) {
        float o1[4], o2[4];
#pragma unroll
        for (int e = 0; e < 4; e++) {
          const int i = 8 * g + 4 * lh + e;
          const float x1 = a[4 * g + e], x2 = a[4 * (g + 2) + e];
          if (lat) rope_pair(x1, x2, i, pos, o1[e], o2[e]); else { o1[e] = x1; o2[e] = x2; }
        }
        const int i0 = 8 * g + 4 * lh;
        if (!lat) {
          float4 r1; r1.x = o1[0]; r1.y = o1[1]; r1.z = o1[2]; r1.w = o1[3];
          float4 r2; r2.x = o2[0]; r2.y = o2[1]; r2.z = o2[2]; r2.w = o2[3];
          *(float4*)(st_kr + (size_t)m * 64 + off + i0) = r1;
          *(float4*)(st_kr + (size_t)m * 64 + off + i0 + 16) = r2;
        }
        uint2 v1; v1.x = pk2(o1[0], o1[1]); v1.y = pk2(o1[2], o1[3]);
        uint2 v2; v2.x = pk2(o2[0], o2[1]); v2.y = pk2(o2[2], o2[3]);
        *(uint2*)(KR + kr + i0) = v1;
        *(uint2*)(KR + kr + i0 + 16) = v2;
      }
    } else {
#pragma unroll
      for (int g = 0; g < 4; g++) {
        const int n = nb + 8 * g + 4 * lh - 832;
        uint2 v; v.x = pk2(silu(a[4 * g]), silu(a[4 * g + 1])); v.y = pk2(silu(a[4 * g + 2]), silu(a[4 * g + 3]));
        *(uint2*)(SZ + (size_t)m * 1024 + n) = v;
      }
    }
  }
};
struct EpiMlaQ {
  u16* Q;
  DI void operator()(int m, int nb, int lh, const f32x16& a) const {
    const int head = nb / 192, off = nb - head * 192;
    u16* qr = Q + (size_t)m * 1536 + nb;
    if (off < 128) {
#pragma unroll
      for (int g = 0; g < 4; g++) {
        uint2 v; v.x = pk2(a[4 * g] * MLA_QS, a[4 * g + 1] * MLA_QS); v.y = pk2(a[4 * g + 2] * MLA_QS, a[4 * g + 3] * MLA_QS);
        *(uint2*)(qr + 8 * g + 4 * lh) = v;
      }
    } else {
      const bool lat = m >= TC;
      const int tt = (m - TC) & 2047;
      const float pos = (off == 128) ? (float)(tt >> 6) : (float)(tt & 63);
#pragma unroll
      for (int g = 0; g < 2; g++) {
        float o1[4], o2[4];
#pragma unroll
        for (int e = 0; e < 4; e++) {
          const int i = 8 * g + 4 * lh + e;
          const float x1 = a[4 * g + e], x2 = a[4 * (g + 2) + e];
          if (lat) rope_pair(x1, x2, i, pos, o1[e], o2[e]); else { o1[e] = x1; o2[e] = x2; }
        }
        const int i0 = 8 * g + 4 * lh;
        uint2 v1; v1.x = pk2(o1[0] * MLA_QS, o1[1] * MLA_QS); v1.y = pk2(o1[2] * MLA_QS, o1[3] * MLA_QS);
        uint2 v2; v2.x = pk2(o2[0] * MLA_QS, o2[1] * MLA_QS); v2.y = pk2(o2[2] * MLA_QS, o2[3] * MLA_QS);
        *(uint2*)(qr + i0) = v1;
        *(uint2*)(qr + i0 + 16) = v2;
      }
    }
  }
};
struct EpiMlaKV {
  u16 *KN, *VT;
  static constexpr bool HAS_VT = true;
  DI bool is_vt(int nb) const { return (nb & 255) >= 128; }
  DI bool vt_perm(int mb) const { return true; }
  DI bool vt_rows(int mb) const { return false; }
  DI void row4(int m, int n, const float4& a) const {
    const int head = n >> 8, off = n & 255;
    uint2 v; v.x = pk2(a.x, a.y); v.y = pk2(a.z, a.w);
    *(uint2*)(KN + (size_t)m * 1024 + head * 128 + off) = v;
  }
  DI void vt8(int mb, int n, int pos, const float* v) const {
    const int head = n >> 8, d = (n & 255) - 128;
    size_t base; int Lk, key0;
    if (mb < TC) { base = (size_t)(mb >> 8) * (8 * 128 * 256); Lk = 256; key0 = mb & 255; }
    else { const int r2 = mb - TC; const int b = r2 / 2304; key0 = r2 - b * 2304; Lk = 2304; base = (size_t)16 * 8 * 128 * 256 + (size_t)b * (8 * 128 * 2304); }
    uint4 w; w.x = pk2(v[0], v[1]); w.y = pk2(v[2], v[3]); w.z = pk2(v[4], v[5]); w.w = pk2(v[6], v[7]);
    *(uint4*)(VT + base + (size_t)(head * 128 + d) * Lk + key0 + pos) = w;
  }
  DI void operator()(int m, int nb, int lh, const f32x16& a) const {
    const int head = nb >> 8, off = nb & 255;
    if (off < 128) {
#pragma unroll
      for (int g = 0; g < 4; g++) {
        uint2 v; v.x = pk2(a[4 * g], a[4 * g + 1]); v.y = pk2(a[4 * g + 2], a[4 * g + 3]);
        *(uint2*)(KN + (size_t)m * 1024 + head * 128 + off + 8 * g + 4 * lh) = v;
      }
    } else {
      size_t base; int Lk, key;
      if (m < TC) { base = (size_t)(m >> 8) * (8 * 128 * 256); Lk = 256; key = m & 255; }
      else { const int r2 = m - TC; const int b = r2 / 2304; key = r2 - b * 2304; Lk = 2304; base = (size_t)16 * 8 * 128 * 256 + (size_t)b * (8 * 128 * 2304); }
      u16* vp = VT + base + (size_t)(head * 128 + off - 128) * Lk + perm16(key);
#pragma unroll
      for (int g = 0; g < 4; g++)
#pragma unroll
        for (int e = 0; e < 4; e++) vp[(size_t)(8 * g + 4 * lh + e) * Lk] = f2bf(a[4 * g + e]);
    }
  }
};
struct EpiNaG1 {
  u16 *NQ, *NK, *NVT, *SZ; float *st_k, *st_v;
  static constexpr bool HAS_VT = true;
  DI bool is_vt(int nb) const { return nb >= 2048 && nb < 3072; }
  DI bool vt_perm(int mb) const { return mb < TC; }
  DI bool vt_rows(int mb) const { return mb < TC; }
  DI void row4(int m, int n, const float4& a) const {
    if (n < 1024) {
      uint2 v; v.x = pk2(a.x * NA_QS, a.y * NA_QS); v.y = pk2(a.z * NA_QS, a.w * NA_QS);
      *(uint2*)(NQ + (size_t)m * 1024 + n) = v;
    } else if (n < 2048) {
      uint2 v; v.x = pk2(a.x, a.y); v.y = pk2(a.z, a.w);
      *(uint2*)(NK + (size_t)kvrow_of(m) * 1024 + (n - 1024)) = v;
      if (m < TC) *(float4*)(st_k + (size_t)m * 1024 + (n - 1024)) = a;
    } else if (n < 3072) {
      if (m < TC) *(float4*)(st_v + (size_t)m * 1024 + (n - 2048)) = a;
    } else {
      uint2 v; v.x = pk2(silu(a.x), silu(a.y)); v.y = pk2(silu(a.z), silu(a.w));
      *(uint2*)(SZ + (size_t)m * 1024 + (n - 3072)) = v;
    }
  }
  DI void vt8(int mb, int n, int pos, const float* v) const {
    const int c0 = n - 2048;
    size_t base; int Lk, key0;
    if (mb < TC) { base = (size_t)(mb >> 8) * (1024 * 256); Lk = 256; key0 = mb & 255; }
    else { const int b = (mb - TC) >> 11; key0 = 256 + ((mb - TC) & 2047); Lk = 2304; base = (size_t)16 * 1024 * 256 + (size_t)b * (1024 * 2304); }
    uint4 w; w.x = pk2(v[0], v[1]); w.y = pk2(v[2], v[3]); w.z = pk2(v[4], v[5]); w.w = pk2(v[6], v[7]);
    *(uint4*)(NVT + base + (size_t)c0 * Lk + key0 + pos) = w;
  }
  DI void operator()(int m, int nb, int lh, const f32x16& a) const {
    if (nb < 1024) {
#pragma unroll
      for (int g = 0; g < 4; g++) {
        uint2 v; v.x = pk2(a[4 * g] * NA_QS, a[4 * g + 1] * NA_QS); v.y = pk2(a[4 * g + 2] * NA_QS, a[4 * g + 3] * NA_QS);
        *(uint2*)(NQ + (size_t)m * 1024 + nb + 8 * g + 4 * lh) = v;
      }
    } else if (nb < 2048) {
      const size_t kr = (size_t)kvrow_of(m) * 1024 + (nb - 1024);
#pragma unroll
      for (int g = 0; g < 4; g++) {
        uint2 v; v.x = pk2(a[4 * g], a[4 * g + 1]); v.y = pk2(a[4 * g + 2], a[4 * g + 3]);
        *(uint2*)(NK + kr + 8 * g + 4 * lh) = v;
        if (m < TC) { float4 r; r.x = a[4 * g]; r.y = a[4 * g + 1]; r.z = a[4 * g + 2]; r.w = a[4 * g + 3];
          *(float4*)(st_k + (size_t)m * 1024 + (nb - 1024) + 8 * g + 4 * lh) = r; }
      }
    } else if (nb < 3072) {
      const int c0 = nb - 2048;
      size_t base; int Lk, key;
      if (m < TC) { base = (size_t)(m >> 8) * (1024 * 256); Lk = 256; key = perm16(m & 255); }
      else { const int b = (m - TC) >> 11; key = 256 + ((m - TC) & 2047); Lk = 2304; base = (size_t)16 * 1024 * 256 + (size_t)b * (1024 * 2304); }
      u16* vp = NVT + base + (size_t)c0 * Lk + key;
#pragma unroll
      for (int g = 0; g < 4; g++) {
#pragma unroll
        for (int e = 0; e < 4; e++) vp[(size_t)(8 * g + 4 * lh + e) * Lk] = f2bf(a[4 * g + e]);
        if (m < TC) { float4 r; r.x = a[4 * g]; r.y = a[4 * g + 1]; r.z = a[4 * g + 2]; r.w = a[4 * g + 3];
          *(float4*)(st_v + (size_t)m * 1024 + c0 + 8 * g + 4 * lh) = r; }
      }
    } else {
#pragma unroll
      for (int g = 0; g < 4; g++) {
        uint2 v; v.x = pk2(silu(a[4 * g]), silu(a[4 * g + 1])); v.y = pk2(silu(a[4 * g + 2]), silu(a[4 * g + 3]));
        *(uint2*)(SZ + (size_t)m * 1024 + (nb - 3072) + 8 * g + 4 * lh) = v;
      }
    }
  }
};

template <int NSA, int NSB, int NDT>
DI void attn_dense_wave(const u16* __restrict__ qrow, const u16* __restrict__ kA, int kAstride, const u16* __restrict__ kB,
                        const u16* __restrict__ vt, int Lk, int nkeys, const u16* __restrict__ szrow, u16* __restrict__ orow) {
  const int lane = threadIdx.x & 63, l31 = lane & 31, lh = lane >> 5;
  bf16x8 qf[NSA + NSB];
#pragma unroll
  for (int s = 0; s < NSA + NSB; s++) qf[s] = *(const bf16x8*)(qrow + s * 16 + lh * 8);
  f32x16 o[NDT];
#pragma unroll
  for (int d = 0; d < NDT; d++)
#pragma unroll
    for (int r = 0; r < 16; r++) o[d][r] = 0.f;
  float m = -1e30f, l = 0.f;
  for (int k0 = 0; k0 < nkeys; k0 += 32) {
    f32x16 sa;
#pragma unroll
    for (int r = 0; r < 16; r++) sa[r] = 0.f;
    const u16* kp = kA + (size_t)(k0 + l31) * kAstride + lh * 8;
#pragma unroll
    for (int s = 0; s < NSA; s++) sa = MFMA32(*(const bf16x8*)(kp + s * 16), qf[s], sa);
    if (NSB > 0) {
      const u16* kp2 = kB + (size_t)(k0 + l31) * 64 + lh * 8;
#pragma unroll
      for (int s = 0; s < NSB; s++) sa = MFMA32(*(const bf16x8*)(kp2 + s * 16), qf[NSA + s], sa);
    }
    float mx = sa[0];
#pragma unroll
    for (int r = 1; r < 16; r++) mx = fmaxf(mx, sa[r]);
    mx = fmaxf(mx, __shfl_xor(mx, 32));
    const float mn = fmaxf(m, mx);
    const float alpha = __builtin_amdgcn_exp2f(m - mn);
    m = mn;
    float ps = 0.f;
#pragma unroll
    for (int r = 0; r < 16; r++) { sa[r] = exp2f(sa[r] - mn); ps += sa[r]; }
    l = l * alpha + ps;
#pragma unroll
    for (int d = 0; d < NDT; d++)
#pragma unroll
      for (int r = 0; r < 16; r++) o[d][r] *= alpha;
#pragma unroll
    for (int sp = 0; sp < 2; sp++) {
      u32x4 pw;
      pw[0] = pk2(sa[8 * sp + 0], sa[8 * sp + 1]); pw[1] = pk2(sa[8 * sp + 2], sa[8 * sp + 3]);
      pw[2] = pk2(sa[8 * sp + 4], sa[8 * sp + 5]); pw[3] = pk2(sa[8 * sp + 6], sa[8 * sp + 7]);
      const bf16x8 pf = __builtin_bit_cast(bf16x8, pw);
#pragma unroll
      for (int d = 0; d < NDT; d++) {
        const u16* vp = vt + (size_t)(d * 32 + l31) * Lk + k0 + 16 * sp + 4 * lh;
        const uint2 lo = *(const uint2*)vp, hi = *(const uint2*)(vp + 8);
        u32x4 vw; vw[0] = lo.x; vw[1] = lo.y; vw[2] = hi.x; vw[3] = hi.y;
        o[d] = MFMA32(__builtin_bit_cast(bf16x8, vw), pf, o[d]);
      }
    }
  }
  l += __shfl_xor(l, 32);
  const float inv = 1.f / l;
#pragma unroll
  for (int d = 0; d < NDT; d++)
#pragma unroll
    for (int g = 0; g < 4; g++) {
      const int d0 = d * 32 + 8 * g + 4 * lh;
      const uint2 z = *(const uint2*)(szrow + d0);
      uint2 v;
      v.x = pk2(o[d][4 * g] * inv * bf2f((u16)(z.x & 0xffff)), o[d][4 * g + 1] * inv * bf2f((u16)(z.x >> 16)));
      v.y = pk2(o[d][4 * g + 2] * inv * bf2f((u16)(z.y & 0xffff)), o[d][4 * g + 3] * inv * bf2f((u16)(z.y >> 16)));
      *(uint2*)(orow + d0) = v;
    }
}


template <int NSA, int NSB, int NDT>
DI void attn_dense_block(char* smem, const u16* __restrict__ qrow, const u16* __restrict__ kA, int kAstride, const u16* __restrict__ kB,
                         const u16* __restrict__ vt, int Lk, int nkeys, const u16* __restrict__ szrow, u16* __restrict__ orow) {
  constexpr int NS = NSA + NSB, DV = 32 * NDT, CA = NSA * 2;
  constexpr int KN_B = 64 * CA * 16, KR_B = (NSB > 0) ? 64 * 128 : 0, V_B = DV * 128, STG = KN_B + KR_B + V_B;
  constexpr int NLA = 64 * CA / 256, NLB = (NSB > 0) ? 2 : 0, NLV = DV * 8 / 256;
  const int tid = threadIdx.x, lane = tid & 63, wid = tid >> 6, l31 = lane & 31, lh = lane >> 5;
  const int arow = (CA == 16) ? (tid >> 4) : (tid >> 3);
  const int acc_ = (CA == 16) ? ((tid & 15) ^ ((tid >> 4) & 15)) : ((tid & 7) ^ ((tid >> 4) & 7));
  const int brow = tid >> 3, bcc = (tid & 7) ^ ((tid >> 4) & 7);
  const u16* ka_src = kA + (size_t)arow * kAstride + acc_ * 8;
  const u16* kb_src = (NSB > 0) ? (kB + (size_t)brow * 64 + bcc * 8) : kA;
  const u16* v_src = vt + (size_t)brow * Lk + bcc * 8;
  LAS char* wbase = (LAS char*)(smem + wid * 1024);
  bf16x8 qf[NS];
#pragma unroll
  for (int s = 0; s < NS; s++) qf[s] = *(const bf16x8*)(qrow + s * 16 + lh * 8);
  f32x16 o[NDT];
#pragma unroll
  for (int d = 0; d < NDT; d++)
#pragma unroll
    for (int r = 0; r < 16; r++) o[d][r] = 0.f;
  float m = -1e30f, l = 0.f;
  const int swA = (CA == 16) ? (l31 & 15) : ((l31 >> 1) & 7);
  const int swB = (l31 >> 1) & 7;

  __syncthreads();
#pragma unroll
  for (int i = 0; i < NLA; i++)
    __builtin_amdgcn_global_load_lds((const void*)(ka_src + (size_t)(i * (256 / CA)) * kAstride), (LAS void*)(wbase + i * 4096), 16, 0, 0);
#pragma unroll
  for (int i = 0; i < NLB; i++)
    __builtin_amdgcn_global_load_lds((const void*)(kb_src + (size_t)(32 * i) * 64), (LAS void*)(wbase + KN_B + i * 4096), 16, 0, 0);
#pragma unroll
  for (int i = 0; i < NLV; i++)
    __builtin_amdgcn_global_load_lds((const void*)(v_src + (size_t)(32 * i) * Lk), (LAS void*)(wbase + KN_B + KR_B + i * 4096), 16, 0, 0);
  asm volatile("s_waitcnt vmcnt(0)" ::: "memory");
  __syncthreads();
  int st = 0;
  for (int k0 = 0; k0 < nkeys; k0 += 64, st ^= 1) {
    if (k0 + 64 < nkeys) {
      const int kn = k0 + 64;
      LAS char* wb = wbase + (st ^ 1) * STG;
#pragma unroll
      for (int i = 0; i < NLA; i++)
        __builtin_amdgcn_global_load_lds((const void*)(ka_src + (size_t)(kn + i * (256 / CA)) * kAstride), (LAS void*)(wb + i * 4096), 16, 0, 0);
#pragma unroll
      for (int i = 0; i < NLB; i++)
        __builtin_amdgcn_global_load_lds((const void*)(kb_src + (size_t)(kn + 32 * i) * 64), (LAS void*)(wb + KN_B + i * 4096), 16, 0, 0);
#pragma unroll
      for (int i = 0; i < NLV; i++)
        __builtin_amdgcn_global_load_lds((const void*)(v_src + (size_t)(32 * i) * Lk + kn), (LAS void*)(wb + KN_B + KR_B + i * 4096), 16, 0, 0);
    }
    const char* Kn = smem + st * STG;
    const char* Kr = Kn + KN_B;
    const char* Vs = Kr + KR_B;
#pragma unroll 1
    for (int hh = 0; hh < 2; hh++) {
      f32x16 s0;
#pragma unroll
      for (int r = 0; r < 16; r++) s0[r] = 0.f;
      const char* kpa = Kn + (hh * 32 + l31) * (CA * 16);
#pragma unroll
      for (int s = 0; s < NSA; s++) s0 = MFMA32(*(const bf16x8*)(kpa + (((2 * s + lh) ^ swA) << 4)), qf[s], s0);
      if constexpr (NSB > 0) {
        const char* kpb = Kr + (hh * 32 + l31) * 128;
#pragma unroll
        for (int s = 0; s < NSB; s++) s0 = MFMA32(*(const bf16x8*)(kpb + (((2 * s + lh) ^ swB) << 4)), qf[NSA + s], s0);
      }
      float mx = s0[0];
#pragma unroll
      for (int r = 1; r < 16; r++) mx = fmaxf(mx, s0[r]);
      mx = fmaxf(mx, __shfl_xor(mx, 32));
      if (__any(mx > m + 8.f)) {
        const float mn = fmaxf(m, mx);
        const float alpha = __builtin_amdgcn_exp2f(m - mn);
        m = mn;
        l *= alpha;
#pragma unroll
        for (int d = 0; d < NDT; d++)
#pragma unroll
          for (int r = 0; r < 16; r++) o[d][r] *= alpha;
      }
      float ps = 0.f;
#pragma unroll
      for (int r = 0; r < 16; r++) { s0[r] = __builtin_amdgcn_exp2f(s0[r] - m); ps += s0[r]; }
      l += ps;
      const char* vp = Vs + l31 * 128;
#pragma unroll
      for (int sp = 0; sp < 2; sp++) {
        u32x4 pw;
        pw[0] = pk2(s0[8 * sp + 0], s0[8 * sp + 1]); pw[1] = pk2(s0[8 * sp + 2], s0[8 * sp + 3]);
        pw[2] = pk2(s0[8 * sp + 4], s0[8 * sp + 5]); pw[3] = pk2(s0[8 * sp + 6], s0[8 * sp + 7]);
        const bf16x8 pf = __builtin_bit_cast(bf16x8, pw);
        const int vo = ((hh * 4 + sp * 2 + lh) ^ swB) << 4;
#pragma unroll
        for (int d = 0; d < NDT; d++) o[d] = MFMA32(*(const bf16x8*)(vp + d * 32 * 128 + vo), pf, o[d]);
      }
    }
    asm volatile("s_waitcnt vmcnt(0)" ::: "memory");
    __syncthreads();
  }
  l += __shfl_xor(l, 32);
  const float inv = 1.f / l;
#pragma unroll
  for (int d = 0; d < NDT; d++)
#pragma unroll
    for (int g = 0; g < 4; g++) {
      const int d0 = d * 32 + 8 * g + 4 * lh;
      const uint2 z = *(const uint2*)(szrow + d0);
      uint2 v;
      v.x = pk2(o[d][4 * g] * inv * bf2f((u16)(z.x & 0xffff)), o[d][4 * g + 1] * inv * bf2f((u16)(z.x >> 16)));
      v.y = pk2(o[d][4 * g + 2] * inv * bf2f((u16)(z.y & 0xffff)), o[d][4 * g + 3] * inv * bf2f((u16)(z.y >> 16)));
      *(uint2*)(orow + d0) = v;
    }
}

DI void attn_na_wave(const Params& p, int b, int h, int r, int j) {
  const int lane = threadIdx.x & 63, l15 = lane & 15, q4 = lane >> 4;
  const int t = TC + b * 2048 + r * 64 + j * 16 + l15;
  const u16* qrow = p.NQ + (size_t)t * 1024 + h * 64;
  const bf16x8 qf0 = *(const bf16x8*)(qrow + q4 * 8);
  const bf16x8 qf1 = *(const bf16x8*)(qrow + 32 + q4 * 8);
  const int rs = min(max(r - 4, 0), 24);
  const int bstart = min(max(j * 16 - 8, 0), 32);
  const int c = j * 16 + l15;
  const int cstart = min(max(c - 8, 0), 48);
  const u16* kb = p.NK + (size_t)(TC + b * 2304) * 1024 + h * 64;
  const u16* vb = p.NVT + (size_t)16 * 1024 * 256 + (size_t)b * (1024 * 2304) + (size_t)(h * 64) * 2304;
  const float* rp = p.na_rpb + h * 465;
  f32x4 o[4];
#pragma unroll
  for (int d = 0; d < 4; d++) { o[d][0] = 0.f; o[d][1] = 0.f; o[d][2] = 0.f; o[d][3] = 0.f; }
  float m = -1e30f, l = 0.f;
  const int krow0 = 8 * (l15 >> 2) + (l15 & 3);
  for (int cg4 = 0; cg4 < 4; cg4++) {
    bf16x8 kf[4][4];
    bf16x8 vf[4][4];
#pragma unroll
    for (int c4 = 0; c4 < 4; c4++) {
      const int ch = cg4 * 4 + c4;
      const int key0 = ch < 8 ? ch * 32 : 256 + (rs + ch - 8) * 64 + bstart;
      const u16* kp = kb + (size_t)(key0 + krow0) * 1024 + q4 * 8;
      kf[c4][0] = *(const bf16x8*)(kp);
      kf[c4][1] = *(const bf16x8*)(kp + 32);
      kf[c4][2] = *(const bf16x8*)(kp + 4 * 1024);
      kf[c4][3] = *(const bf16x8*)(kp + 4 * 1024 + 32);
#pragma unroll
      for (int d = 0; d < 4; d++) vf[c4][d] = *(const bf16x8*)(vb + (size_t)(d * 16 + l15) * 2304 + key0 + q4 * 8);
    }
#pragma unroll
    for (int c4 = 0; c4 < 4; c4++) {
      const int ch = cg4 * 4 + c4;
      f32x4 s0 = {0.f, 0.f, 0.f, 0.f}, s1 = {0.f, 0.f, 0.f, 0.f};
      s0 = MFMA16(kf[c4][0], qf0, s0);
      s0 = MFMA16(kf[c4][1], qf1, s0);
      s1 = MFMA16(kf[c4][2], qf0, s1);
      s1 = MFMA16(kf[c4][3], qf1, s1);
      if (cg4 >= 2) {
        const int dr = rs + (ch - 8) - r + 7;
#pragma unroll
        for (int i = 0; i < 4; i++) {
          const int kc0 = bstart + q4 * 8 + i, kc1 = kc0 + 4;
          const bool v0 = (kc0 >= cstart) && (kc0 < cstart + 16);
          const bool v1 = (kc1 >= cstart) && (kc1 < cstart + 16);
          const int dc0 = min(max(kc0 - c + 15, 0), 30), dc1 = min(max(kc1 - c + 15, 0), 30);
          const float b0 = rp[dr * 31 + dc0] * LOG2E, b1 = rp[dr * 31 + dc1] * LOG2E;
          s0[i] = v0 ? s0[i] + b0 : -1e30f;
          s1[i] = v1 ? s1[i] + b1 : -1e30f;
        }
      }
      float mx = fmaxf(fmaxf(fmaxf(s0[0], s0[1]), fmaxf(s0[2], s0[3])), fmaxf(fmaxf(s1[0], s1[1]), fmaxf(s1[2], s1[3])));
      mx = fmaxf(mx, __shfl_xor(mx, 16));
      mx = fmaxf(mx, __shfl_xor(mx, 32));
      const float mn = fmaxf(m, mx);
      const float alpha = __builtin_amdgcn_exp2f(m - mn);
      m = mn;
      float ps = 0.f;
#pragma unroll
      for (int i = 0; i < 4; i++) { s0[i] = exp2f(s0[i] - mn); s1[i] = exp2f(s1[i] - mn); ps += s0[i] + s1[i]; }
      l = l * alpha + ps;
      u32x4 pw; pw[0] = pk2(s0[0], s0[1]); pw[1] = pk2(s0[2], s0[3]); pw[2] = pk2(s1[0], s1[1]); pw[3] = pk2(s1[2], s1[3]);
      const bf16x8 pf = __builtin_bit_cast(bf16x8, pw);
#pragma unroll
      for (int d = 0; d < 4; d++) {
        o[d][0] *= alpha; o[d][1] *= alpha; o[d][2] *= alpha; o[d][3] *= alpha;
        o[d] = MFMA16(vf[c4][d], pf, o[d]);
      }
    }
  }
  l += __shfl_xor(l, 16);
  l += __shfl_xor(l, 32);
  const float inv = 1.f / l;
  const u16* szrow = p.SZ + (size_t)t * 1024 + h * 64;
  u16* orow = p.NAO + (size_t)t * 1024 + h * 64;
#pragma unroll
  for (int d = 0; d < 4; d++) {
    const int d0 = d * 16 + q4 * 4;
    const uint2 z = *(const uint2*)(szrow + d0);
    uint2 v;
    v.x = pk2(o[d][0] * inv * bf2f((u16)(z.x & 0xffff)), o[d][1] * inv * bf2f((u16)(z.x >> 16)));
    v.y = pk2(o[d][2] * inv * bf2f((u16)(z.y & 0xffff)), o[d][3] * inv * bf2f((u16)(z.y >> 16)));
    *(uint2*)(orow + d0) = v;
  }
}


DI void attn_na_block(const Params& p, char* smem, int b, int h, int rpair) {
  const int tid = threadIdx.x, lane = tid & 63, j = tid >> 6, l31 = lane & 31, lh = lane >> 5;
  float* bl = (float*)(smem + 65536);
  const int r0 = rpair * 2;
  const int qr = r0 + (l31 >> 4), c = j * 16 + (l31 & 15);
  const int t = TC + b * 2048 + qr * 64 + c;
  const int rsq = min(max(qr - 4, 0), 24);
  const int rs0 = min(max(r0 - 4, 0), 24);
  const int nrows = min(max(r0 + 1 - 4, 0), 24) + 8 - rs0;
  const int ntile = 4 + nrows;
  const int bstart = min(max(j * 16 - 8, 0), 32);
  const int cstart = min(max(c - 8, 0), 48);
  const u16* kb = p.NK + (size_t)(TC + b * 2304) * 1024 + h * 64;
  const u16* vb = p.NVT + (size_t)16 * 1024 * 256 + (size_t)b * (1024 * 2304) + (size_t)(h * 64) * 2304;
  const u16* qrow = p.NQ + (size_t)t * 1024 + h * 64;
  bf16x8 qf[4];
#pragma unroll
  for (int s = 0; s < 4; s++) qf[s] = *(const bf16x8*)(qrow + s * 16 + lh * 8);
  f32x16 o[2];
#pragma unroll
  for (int d = 0; d < 2; d++)
#pragma unroll
    for (int r = 0; r < 16; r++) o[d][r] = 0.f;
  float m = -1e30f, l = 0.f;
  const int r16 = l31 & 15;
  const int kap = (l31 & 16) + (r16 & 3) + 4 * ((r16 >> 3) & 1) + 8 * ((r16 >> 2) & 1);
  const int srow = tid >> 3, scc = ((tid & 7) ^ ((tid >> 4) & 7)) * 8;
  const u16* ksrc = kb + (size_t)srow * 1024 + scc;
  const u16* vsrc = vb + (size_t)srow * 2304 + scc;
  LAS char* wbase = (LAS char*)(smem + (tid >> 6) * 1024);
  const int swV = (l31 >> 1) & 7;
  __syncthreads();
  for (int idx = tid; idx < 1024; idx += 256) {
    const int dr = idx >> 6, off = (idx & 63) - 16;
    const float v = p.na_rpb[h * 465 + min(dr, 14) * 31 + min(max(off, 0), 30)] * LOG2E;
    bl[idx] = (dr == 15) ? -1e30f : ((off >= 0 && off < 31) ? v : 0.f);
  }
  float am[16];
#pragma unroll
  for (int i = 0; i < 16; i++) {
    const int kcol = bstart + 16 * (i >> 3) + 8 * lh + (i & 7);
    am[i] = ((kcol >= cstart) && (kcol < cstart + 16)) ? 0.f : -1e30f;
  }
  const int ab = 16 + bstart + 8 * lh - c + 15;
#pragma unroll
  for (int tl = 0; tl < 3; tl++) {
    const int key0 = tl * 64;
    LAS char* wb = wbase + tl * 16384;
    __builtin_amdgcn_global_load_lds((const void*)(ksrc + (size_t)key0 * 1024), (LAS void*)(wb), 16, 0, 0);
    __builtin_amdgcn_global_load_lds((const void*)(ksrc + (size_t)(key0 + 32) * 1024), (LAS void*)(wb + 4096), 16, 0, 0);
    __builtin_amdgcn_global_load_lds((const void*)(vsrc + key0), (LAS void*)(wb + 8192), 16, 0, 0);
    __builtin_amdgcn_global_load_lds((const void*)(vsrc + (size_t)32 * 2304 + key0), (LAS void*)(wb + 8192 + 4096), 16, 0, 0);
  }
  asm volatile("s_waitcnt vmcnt(8)" ::: "memory");
  asm volatile("s_waitcnt lgkmcnt(0)" ::: "memory");
  __builtin_amdgcn_s_barrier();
  for (int tl = 0; tl < ntile; tl++) {
    if (tl + 3 < ntile) {
      const int tn = tl + 3;
      const int key0 = tn < 4 ? tn * 64 : 256 + (rs0 + tn - 4) * 64;
      LAS char* wb = wbase + (tn & 3) * 16384;
      __builtin_amdgcn_global_load_lds((const void*)(ksrc + (size_t)key0 * 1024), (LAS void*)(wb), 16, 0, 0);
      __builtin_amdgcn_global_load_lds((const void*)(ksrc + (size_t)(key0 + 32) * 1024), (LAS void*)(wb + 4096), 16, 0, 0);
      __builtin_amdgcn_global_load_lds((const void*)(vsrc + key0), (LAS void*)(wb + 8192), 16, 0, 0);
      __builtin_amdgcn_global_load_lds((const void*)(vsrc + (size_t)32 * 2304 + key0), (LAS void*)(wb + 8192 + 4096), 16, 0, 0);
    }
    const char* Kc = smem + (tl & 3) * 16384;
    const char* Vc = Kc + 8192;
    const bool local = tl >= 4;
    const int gr = rs0 + tl - 4;
    const int nh = local ? 1 : 2;
    for (int hh = 0; hh < nh; hh++) {
      const int koff = local ? bstart : hh * 32;
      f32x16 s0;
#pragma unroll
      for (int r = 0; r < 16; r++) s0[r] = 0.f;
      const int krow = koff + kap;
      const char* kp = Kc + krow * 128;
      const int swK = (krow >> 1) & 7;
#pragma unroll
      for (int s = 0; s < 4; s++) s0 = MFMA32(*(const bf16x8*)(kp + (((2 * s + lh) ^ swK) << 4)), qf[s], s0);
      if (local) {
        const bool rowvalid = (gr >= rsq) && (gr < rsq + 8);
        const int dr = rowvalid ? min(max(gr - qr + 7, 0), 14) : 15;
        const float* bp = bl + dr * 64 + ab;
#pragma unroll
        for (int i = 0; i < 16; i++) s0[i] += bp[16 * (i >> 3) + (i & 7)] + am[i];
      }
      float mx = s0[0];
#pragma unroll
      for (int r = 1; r < 16; r++) mx = fmaxf(mx, s0[r]);
      mx = fmaxf(mx, __shfl_xor(mx, 32));
      if (__any(mx > m + 8.f)) {
        const float mn = fmaxf(m, mx);
        const float alpha = __builtin_amdgcn_exp2f(m - mn);
        m = mn;
        l *= alpha;
#pragma unroll
        for (int d = 0; d < 2; d++)
#pragma unroll
          for (int r = 0; r < 16; r++) o[d][r] *= alpha;
      }
      float ps = 0.f;
#pragma unroll
      for (int r = 0; r < 16; r++) { s0[r] = __builtin_amdgcn_exp2f(s0[r] - m); ps += s0[r]; }
      l += ps;
      const char* vp = Vc + l31 * 128;
      const int vch = (koff >> 3) + lh;
#pragma unroll
      for (int sp = 0; sp < 2; sp++) {
        u32x4 pw;
        pw[0] = pk2(s0[8 * sp + 0], s0[8 * sp + 1]); pw[1] = pk2(s0[8 * sp + 2], s0[8 * sp + 3]);
        pw[2] = pk2(s0[8 * sp + 4], s0[8 * sp + 5]); pw[3] = pk2(s0[8 * sp + 6], s0[8 * sp + 7]);
        const bf16x8 pf = __builtin_bit_cast(bf16x8, pw);
        const int vo = ((vch + 2 * sp) ^ swV) << 4;
#pragma unroll
        for (int d = 0; d < 2; d++) o[d] = MFMA32(*(const bf16x8*)(vp + d * 32 * 128 + vo), pf, o[d]);
      }
    }
    if (tl + 3 < ntile) asm volatile("s_waitcnt vmcnt(8)" ::: "memory");
    else if (tl + 2 < ntile) asm volatile("s_waitcnt vmcnt(4)" ::: "memory");
    else asm volatile("s_waitcnt vmcnt(0)" ::: "memory");
    asm volatile("s_waitcnt lgkmcnt(0)" ::: "memory");
    __builtin_amdgcn_s_barrier();
  }
  l += __shfl_xor(l, 32);
  const float inv = 1.f / l;
  const u16* szrow = p.SZ + (size_t)t * 1024 + h * 64;
  u16* orow = p.NAO + (size_t)t * 1024 + h * 64;
#pragma unroll
  for (int d = 0; d < 2; d++)
#pragma unroll
    for (int g = 0; g < 4; g++) {
      const int d0 = d * 32 + 8 * g + 4 * lh;
      const uint2 z = *(const uint2*)(szrow + d0);
      uint2 v;
      v.x = pk2(o[d][4 * g] * inv * bf2f((u16)(z.x & 0xffff)), o[d][4 * g + 1] * inv * bf2f((u16)(z.x >> 16)));
      v.y = pk2(o[d][4 * g + 2] * inv * bf2f((u16)(z.y & 0xffff)), o[d][4 * g + 3] * inv * bf2f((u16)(z.y >> 16)));
      *(uint2*)(orow + d0) = v;
    }
}

DI void ph_prep(const Params& p, char* smem) {
  const int tid = threadIdx.x;
  const int ntr = p.nmat_tiles;
  const int ntot = ntr + 192 + 128;
  for (int tile = blockIdx.x; tile < ntot; tile += gridDim.x) {
    __syncthreads();
    if (tile >= 192 && tile < 320) {
      const int ct = tile - 192, j = ct >> 6, r0 = (ct & 63) * 16;
      const float* sp = p.pool_w_in + (size_t)j * 1024 * 2048 + (size_t)r0 * 2048 + tid * 4;
      u16* dp = p.WinU + (size_t)j * 1024 * 1024 + (size_t)r0 * 1024 + tid * 4;
#pragma unroll 4
      for (int r = 0; r < 16; r++) {
        const float4 v = *(const float4*)(sp + (size_t)r * 2048);
        uint2 w; w.x = pk2(v.x, v.y); w.y = pk2(v.z, v.w);
        *(uint2*)(dp + (size_t)r * 1024) = w;
      }
    } else if (tile >= 320) {
      const int ttile = tile - 320;
      int mi = 0;
      for (int i = 1; i < 18; i++) if (ttile >= p.mats[i].tile0) mi = i;
      const float* src = p.mats[mi].src; u16* dst = p.mats[mi].dst;
      const int K = p.mats[mi].K, Nsrc = p.mats[mi].Nsrc, Ndst = p.mats[mi].Ndst;
      const int ldsrc = p.mats[mi].ld;
      const int lt = ttile - p.mats[mi].tile0;
      const int ntn = Ndst >> 6;
      const int kt = lt / ntn, nt = lt - kt * ntn;
      float* ts = (float*)smem;
#pragma unroll
      for (int i = 0; i < 4; i++) {
        const int k = i * 16 + (tid >> 4), n4 = (tid & 15) * 4, n = nt * 64 + n4;
        float4 v = {0.f, 0.f, 0.f, 0.f};
        if (n < Nsrc) v = *(const float4*)(src + (size_t)(kt * 64 + k) * ldsrc + n);
        ts[k * 65 + n4] = v.x; ts[k * 65 + n4 + 1] = v.y; ts[k * 65 + n4 + 2] = v.z; ts[k * 65 + n4 + 3] = v.w;
      }
      __syncthreads();
      const int n = tid >> 2, kc = (tid & 3) * 16;
      uint32_t w[8];
#pragma unroll
      for (int e = 0; e < 8; e++) w[e] = pk2(ts[(kc + 2 * e) * 65 + n], ts[(kc + 2 * e + 1) * 65 + n]);
      u16* dp = dst + (size_t)(nt * 64 + n) * K + kt * 64 + kc;
      uint4 v0; v0.x = w[0]; v0.y = w[1]; v0.z = w[2]; v0.w = w[3];
      uint4 v1; v1.x = w[4]; v1.y = w[5]; v1.z = w[6]; v1.w = w[7];
      *(uint4*)dp = v0; *(uint4*)(dp + 8) = v1;
    } else {
      const int at = tile;
      const int layer = at / 48, c0 = (at - layer * 48) * 64;
      float* sc = (float*)smem;
      float* red = sc + 5 * 1024;
      for (int i = tid; i < 5 * 1024; i += 256) {
        const int n = i >> 10, k = i & 1023;
        const float v = (n == 0) ? p.c_ctx[k] : p.c[(n - 1) * 1024 + k];
        sc[i] = silu(v);
      }
      __syncthreads();
      const int c4 = (tid & 15) * 4, kg = tid >> 4;
      float acc[5][4];
#pragma unroll
      for (int n = 0; n < 5; n++) { acc[n][0] = 0.f; acc[n][1] = 0.f; acc[n][2] = 0.f; acc[n][3] = 0.f; }
      const float* w = p.ada_w + (size_t)layer * 1024 * 3072 + c0 + c4;
#pragma unroll 4
      for (int kk = 0; kk < 64; kk++) {
        const int k = kg * 64 + kk;
        const float4 wv = *(const float4*)(w + (size_t)k * 3072);
#pragma unroll
        for (int n = 0; n < 5; n++) {
          const float s = sc[n * 1024 + k];
          acc[n][0] += s * wv.x; acc[n][1] += s * wv.y; acc[n][2] += s * wv.z; acc[n][3] += s * wv.w;
        }
      }
#pragma unroll
      for (int n = 0; n < 5; n++) {
        float4 r; r.x = acc[n][0]; r.y = acc[n][1]; r.z = acc[n][2]; r.w = acc[n][3];
        *(float4*)(red + (kg * 5 + n) * 64 + c4) = r;
      }
      __syncthreads();
      for (int o = tid; o < 320; o += 256) {
        const int n = o >> 6, cc = o & 63;
        float s = 0.f;
#pragma unroll
        for (int g = 0; g < 16; g++) s += red[(g * 5 + n) * 64 + cc];
        s += p.ada_b[layer * 3072 + c0 + cc];
        p.mod[(layer * 5 + n) * 3072 + c0 + cc] = s;
      }
    }
  }
}

DI void ph_h0(const Params& p) {
  for (int idx = blockIdx.x * 256 + threadIdx.x; idx < T * 128; idx += gridDim.x * 256) {
    const int t = idx >> 7, c0 = (idx & 127) * 8;
    const float* xr = (t < TC) ? p.x_prompt + (size_t)t * 1024 : p.x_sample + (size_t)(t - TC) * 1024;
    const float* md = p.mod + cond_of(t) * 3072;
    const float4 x0 = *(const float4*)(xr + c0), x1 = *(const float4*)(xr + c0 + 4);
    const float4 sh0 = *(const float4*)(md + c0), sh1 = *(const float4*)(md + c0 + 4);
    const float4 sc0 = *(const float4*)(md + 1024 + c0), sc1 = *(const float4*)(md + 1024 + c0 + 4);
    uint4 v;
    v.x = pk2(x0.x * (1.f + sc0.x) + sh0.x, x0.y * (1.f + sc0.y) + sh0.y);
    v.y = pk2(x0.z * (1.f + sc0.z) + sh0.z, x0.w * (1.f + sc0.w) + sh0.w);
    v.z = pk2(x1.x * (1.f + sc1.x) + sh1.x, x1.y * (1.f + sc1.y) + sh1.y);
    v.w = pk2(x1.z * (1.f + sc1.z) + sh1.z, x1.w * (1.f + sc1.w) + sh1.w);
    *(uint4*)(p.H + (size_t)t * 1024 + c0) = v;
  }
}

struct EpiFold {
  u16* dst;
  DI void operator()(int m, int nb, int lh, const f32x16& a) const {
#pragma unroll
    for (int g = 0; g < 4; g++) {
      uint2 v; v.x = pk2(a[4 * g], a[4 * g + 1]); v.y = pk2(a[4 * g + 2], a[4 * g + 3]);
      *(uint2*)(dst + (size_t)m * 1024 + nb + 8 * g + 4 * lh) = v;
    }
  }
};
DI void ph_fold(const Params& p, char* smem) {
  for (int tile = blockIdx.x; tile < 128; tile += gridDim.x) {
    const int jg = tile >> 4, mt = (tile >> 3) & 1, nt = tile & 7;
    const int j = jg >> 2, g = jg & 3;
    EpiFold e{p.Wpin + (size_t)j * 2048 * 1024 + (size_t)(g * 256) * 1024};
    gemm_tile<2>(p.Wgrp + (size_t)jg * 65536, 256, p.WinU + (size_t)j * 1024 * 1024 + g * 256, 1024, 256, mt * 128, nt * 128, 0, smem, e);
  }
}

template <class Epi>
DI void gemm_phase(const u16* A, int lda, const u16* Bt, int ldb, int K, int MT, int NT, char* smem, const Epi& epi) {
  const int ntile = MT * NT;
  for (int tile = blockIdx.x; tile < ntile; tile += gridDim.x) {
    const int nt = tile / MT, mt = tile - nt * MT;
    gemm_tile<3>(A, lda, Bt, ldb, K, mt * 192, nt * 128, 0, smem, epi);
  }
}

template <class Epi>
DI void gemm_phase_st(const u16* A, int lda, const u16* Bt, int ldb, int K, int MT, int NT, char* smem, const Epi& epi) {
  const int ntile = MT * NT;
  for (int tile = blockIdx.x; tile < ntile; tile += gridDim.x) {
    const int nt = tile / MT, mt = tile - nt * MT;
    gemm_tile<3, Epi, true>(A, lda, Bt, ldb, K, mt * 192, nt * 128, 0, smem, epi);
  }
}

DI void unpack8(const u32x4& u, float* f) {
  f[0] = __uint_as_float(u[0] << 16); f[1] = __uint_as_float(u[0] & 0xffff0000u);
  f[2] = __uint_as_float(u[1] << 16); f[3] = __uint_as_float(u[1] & 0xffff0000u);
  f[4] = __uint_as_float(u[2] << 16); f[5] = __uint_as_float(u[2] & 0xffff0000u);
  f[6] = __uint_as_float(u[3] << 16); f[7] = __uint_as_float(u[3] & 0xffff0000u);
}
template <int HW>
DI void mix_item(const Params& p, int rpair, const float* scale) {
  const int lane = threadIdx.x & 63;
  constexpr int g = (HW == 1) ? 0 : (HW == 2) ? 1 : (HW == 4) ? 2 : 3;
  constexpr int NR = 8 + 2 * HW;
  const int c0 = (g * 32 + (lane & 31)) * 8;
  const int t0 = (rpair * 2 + (lane >> 5)) * 8;
  int s0, L, tt0;
  if (t0 < TC) { s0 = t0 & ~255; tt0 = t0 & 255; L = 256; } else { s0 = TC + ((t0 - TC) & ~2047); tt0 = (t0 - TC) & 2047; L = 2048; }
  u32x4 rows[NR];
#pragma unroll
  for (int r = 0; r < NR; r++) {
    const int tt = tt0 - HW + r;
    u32x4 v = {0u, 0u, 0u, 0u};
    if (tt >= 0 && tt < L) v = *(const u32x4*)(p.U + (size_t)(s0 + tt) * 1024 + c0);
    rows[r] = v;
  }
  float sc8[8];
  { const float4 a = *(const float4*)(scale + c0), b = *(const float4*)(scale + c0 + 4); sc8[0] = a.x; sc8[1] = a.y; sc8[2] = a.z; sc8[3] = a.w; sc8[4] = b.x; sc8[5] = b.y; sc8[6] = b.z; sc8[7] = b.w; }
  float sum[8];
#pragma unroll
  for (int k = 0; k < 8; k++) sum[k] = 0.f;
#pragma unroll
  for (int r = 0; r < 2 * HW; r++) {
    float f[8]; unpack8(rows[r], f);
#pragma unroll
    for (int k = 0; k < 8; k++) sum[k] += f[k];
  }
#pragma unroll
  for (int e = 0; e < 8; e++) {
    const int tt = tt0 + e;
    const int lo = max(tt - HW, 0), hi = min(tt + HW, L);
    const float ic = 1.f / (float)(hi - lo);
    float own[8]; unpack8(rows[e + HW], own);
    float zz[8]; unpack8(*(const u32x4*)(p.SZ + (size_t)(s0 + tt) * 1024 + c0), zz);
    u32x4 v;
    v[0] = pk2((sum[0] * ic - own[0]) * sc8[0] * zz[0], (sum[1] * ic - own[1]) * sc8[1] * zz[1]);
    v[1] = pk2((sum[2] * ic - own[2]) * sc8[2] * zz[2], (sum[3] * ic - own[3]) * sc8[3] * zz[3]);
    v[2] = pk2((sum[4] * ic - own[4]) * sc8[4] * zz[4], (sum[5] * ic - own[5]) * sc8[5] * zz[5]);
    v[3] = pk2((sum[6] * ic - own[6]) * sc8[6] * zz[6], (sum[7] * ic - own[7]) * sc8[7] * zz[7]);
    *(u32x4*)(p.PM + (size_t)(s0 + tt) * 1024 + c0) = v;
    if (e < 7) {
      float fo[8], fi[8]; unpack8(rows[e], fo); unpack8(rows[e + 2 * HW], fi);
#pragma unroll
      for (int k = 0; k < 8; k++) sum[k] += fi[k] - fo[k];
    }
  }
}
DI void ph_mix(const Params& p, int j) {
  const int wid = threadIdx.x >> 6;
  const float* scale = p.pool_scale + j * 1024;
  for (int item = blockIdx.x * 4 + wid; item < 768 * 4; item += gridDim.x * 4) {
    const int rpair = item >> 2, g = item & 3;
    if (g == 0) mix_item<1>(p, rpair, scale);
    else if (g == 1) mix_item<2>(p, rpair, scale);
    else if (g == 2) mix_item<4>(p, rpair, scale);
    else mix_item<8>(p, rpair, scale);
  }
}

DI void ph_pool_g2(const Params& p, int j, char* smem) {
  EpiPoolG2 epi{p.PM, p.SZ, p.pool_scale + j * 1024};
  for (int tile = blockIdx.x; tile < 64 * 8; tile += gridDim.x) {
    const int gn = tile / 64, mt = tile - gn * 64;
    const int g = gn >> 1, ns = gn & 1;
    gemm_tile<3>(p.MIX + g * 256, 1024, p.Wgrp + (size_t)(j * 4 + g) * 65536, 256, 256, mt * 192, ns * 128, g * 256, smem, epi);
  }
}

DI void ph_ln(const Params& p, int layer) {
  const int lane = threadIdx.x & 63, wid = threadIdx.x >> 6;
  const float* g = p.ln_g + layer * 1024;
  const float* bb = p.ln_b + layer * 1024;
  const int nw = gridDim.x * 4;
  for (int row0 = blockIdx.x * 4 + wid; row0 < T; row0 += 2 * nw) {
    const int row1 = row0 + nw;
    const bool has1 = row1 < T;
    const int r1 = has1 ? row1 : row0;
    float* xr0 = p.out + (size_t)row0 * 1024;
    float* xr1 = p.out + (size_t)r1 * 1024;
    const float* xi0 = (layer > 0) ? xr0 : ((row0 < TC) ? p.x_prompt + (size_t)row0 * 1024 : p.x_sample + (size_t)(row0 - TC) * 1024);
    const float* xi1 = (layer > 0) ? xr1 : ((r1 < TC) ? p.x_prompt + (size_t)r1 * 1024 : p.x_sample + (size_t)(r1 - TC) * 1024);
    float4 v0[4], v1[4];
#pragma unroll
    for (int i = 0; i < 4; i++) {
      v0[i] = *(const float4*)(xi0 + i * 256 + lane * 4); v1[i] = *(const float4*)(xi1 + i * 256 + lane * 4);
      const uint2 g0 = *(const uint2*)(p.GO + (size_t)row0 * 1024 + i * 256 + lane * 4);
      const uint2 g1 = *(const uint2*)(p.GO + (size_t)r1 * 1024 + i * 256 + lane * 4);
      v0[i].x = ALPHA * v0[i].x + bf2f((u16)(g0.x & 0xffff)); v0[i].y = ALPHA * v0[i].y + bf2f((u16)(g0.x >> 16));
      v0[i].z = ALPHA * v0[i].z + bf2f((u16)(g0.y & 0xffff)); v0[i].w = ALPHA * v0[i].w + bf2f((u16)(g0.y >> 16));
      v1[i].x = ALPHA * v1[i].x + bf2f((u16)(g1.x & 0xffff)); v1[i].y = ALPHA * v1[i].y + bf2f((u16)(g1.x >> 16));
      v1[i].z = ALPHA * v1[i].z + bf2f((u16)(g1.y & 0xffff)); v1[i].w = ALPHA * v1[i].w + bf2f((u16)(g1.y >> 16));
    }
    float s0 = 0.f, s1 = 0.f;
#pragma unroll
    for (int i = 0; i < 4; i++) { s0 += v0[i].x + v0[i].y + v0[i].z + v0[i].w; s1 += v1[i].x + v1[i].y + v1[i].z + v1[i].w; }
    const float mu0 = wave_sum(s0) * (1.f / 1024.f), mu1 = wave_sum(s1) * (1.f / 1024.f);
    float q0 = 0.f, q1 = 0.f;
#pragma unroll
    for (int i = 0; i < 4; i++) {
      v0[i].x -= mu0; v0[i].y -= mu0; v0[i].z -= mu0; v0[i].w -= mu0;
      v1[i].x -= mu1; v1[i].y -= mu1; v1[i].z -= mu1; v1[i].w -= mu1;
      q0 += v0[i].x * v0[i].x + v0[i].y * v0[i].y + v0[i].z * v0[i].z + v0[i].w * v0[i].w;
      q1 += v1[i].x * v1[i].x + v1[i].y * v1[i].y + v1[i].z * v1[i].z + v1[i].w * v1[i].w;
    }
    const float rs0 = rsqrtf(wave_sum(q0) * (1.f / 1024.f) + 1e-5f);
    const float rs1 = rsqrtf(wave_sum(q1) * (1.f / 1024.f) + 1e-5f);
    const float* md0 = p.mod + ((layer + 1) * 5 + cond_of(row0)) * 3072;
    const float* md1 = p.mod + ((layer + 1) * 5 + cond_of(has1 ? row1 : row0)) * 3072;
#pragma unroll
    for (int i = 0; i < 4; i++) {
      const int cc = i * 256 + lane * 4;
      const float4 gg = *(const float4*)(g + cc), be = *(const float4*)(bb + cc);
      float4 y0, y1;
      y0.x = v0[i].x * rs0 * gg.x + be.x; y0.y = v0[i].y * rs0 * gg.y + be.y; y0.z = v0[i].z * rs0 * gg.z + be.z; y0.w = v0[i].w * rs0 * gg.w + be.w;
      y1.x = v1[i].x * rs1 * gg.x + be.x; y1.y = v1[i].y * rs1 * gg.y + be.y; y1.z = v1[i].z * rs1 * gg.z + be.z; y1.w = v1[i].w * rs1 * gg.w + be.w;
      *(float4*)(xr0 + cc) = y0;
      if (has1) *(float4*)(xr1 + cc) = y1;
      if (layer < 3) {
        const float4 sh0 = *(const float4*)(md0 + cc), sc0 = *(const float4*)(md0 + 1024 + cc);
        const float4 sh1 = *(const float4*)(md1 + cc), sc1 = *(const float4*)(md1 + 1024 + cc);
        uint2 h0, h1;
        h0.x = pk2(y0.x * (1.f + sc0.x) + sh0.x, y0.y * (1.f + sc0.y) + sh0.y);
        h0.y = pk2(y0.z * (1.f + sc0.z) + sh0.z, y0.w * (1.f + sc0.w) + sh0.w);
        h1.x = pk2(y1.x * (1.f + sc1.x) + sh1.x, y1.y * (1.f + sc1.y) + sh1.y);
        h1.y = pk2(y1.z * (1.f + sc1.z) + sh1.z, y1.w * (1.f + sc1.w) + sh1.w);
        *(uint2*)(p.H + (size_t)row0 * 1024 + cc) = h0;
        if (has1) *(uint2*)(p.H + (size_t)row1 * 1024 + cc) = h1;
      }
    }
  }
}

DI void ph_mla_norm(const Params& p) {
  const int lane = threadIdx.x & 63, wid = threadIdx.x >> 6;
  for (int row = blockIdx.x * 4 + wid; row < T + 1024; row += gridDim.x * 4) {
    if (row < T) {
      const float* rr = p.RAW + (size_t)row * 768;
      const float4 a0 = *(const float4*)(rr + lane * 8), a1 = *(const float4*)(rr + lane * 8 + 4);
      const float4 k0 = *(const float4*)(rr + 512 + lane * 4);
      float s1 = a0.x * a0.x + a0.y * a0.y + a0.z * a0.z + a0.w * a0.w + a1.x * a1.x + a1.y * a1.y + a1.z * a1.z + a1.w * a1.w;
      float s2 = k0.x * k0.x + k0.y * k0.y + k0.z * k0.z + k0.w * k0.w;
      const float r1 = rsqrtf(wave_sum(s1) * (1.f / 512.f) + 1e-6f);
      const float r2 = rsqrtf(wave_sum(s2) * (1.f / 256.f) + 1e-6f);
      const float4 g0 = *(const float4*)(p.mla_q_norm + lane * 8), g1 = *(const float4*)(p.mla_q_norm + lane * 8 + 4);
      uint4 v;
      v.x = pk2(a0.x * r1 * g0.x, a0.y * r1 * g0.y); v.y = pk2(a0.z * r1 * g0.z, a0.w * r1 * g0.w);
      v.z = pk2(a1.x * r1 * g1.x, a1.y * r1 * g1.y); v.w = pk2(a1.z * r1 * g1.z, a1.w * r1 * g1.w);
      *(uint4*)(p.CQN + (size_t)row * 512 + lane * 8) = v;
      const float4 kg = *(const float4*)(p.mla_kv_norm + lane * 4);
      float4 kn; kn.x = k0.x * r2 * kg.x; kn.y = k0.y * r2 * kg.y; kn.z = k0.z * r2 * kg.z; kn.w = k0.w * r2 * kg.w;
      uint2 kv; kv.x = pk2(kn.x, kn.y); kv.y = pk2(kn.z, kn.w);
      *(uint2*)(p.CKVN + (size_t)kvrow_of(row) * 256 + lane * 4) = kv;
      if (row < TC) *(float4*)(p.out + OUT_CKV + (size_t)row * 256 + lane * 4) = kn;
    } else {
      const int cr = row - T, b = cr >> 8, pp = cr & 255;
      const size_t kvr = (size_t)TC + b * 2304 + pp;
      const float4 k0 = *(const float4*)(p.cache_ckv + (size_t)cr * 256 + lane * 4);
      uint2 kv; kv.x = pk2(k0.x, k0.y); kv.y = pk2(k0.z, k0.w);
      *(uint2*)(p.CKVN + kvr * 256 + lane * 4) = kv;
      p.KR[kvr * 64 + lane] = f2bf(p.cache_kr[(size_t)cr * 64 + lane]);
    }
  }
}

DI void ph_mla_g2(const Params& p, char* smem) {
  EpiMlaQ eq{p.Q};
  EpiMlaKV ekv{p.KN, p.VT};
  const int G = gridDim.x, b = blockIdx.x;
  const int nq = 64 * 12, nkv = 104 * 16;
  const int nq2 = nq - G > 0 ? nq - G : 0;
  for (int qt = b; qt < nq; qt += G) {
    const int nt = qt / 64, mt = qt - nt * 64;
    gemm_tile<3>(p.CQN, 512, p.Wuq, 512, 512, mt * 192, nt * 128, 0, smem, eq);
  }
  int k0, kstep, kend;
  if (b < nq2) { k0 = b; kstep = nq2; kend = 2 * nq2; }
  else { k0 = 2 * nq2 + (b - nq2); kstep = G - nq2; kend = nkv; }
  if (nq2 == 0 || 2 * nq2 > nkv) { k0 = b; kstep = G; kend = nkv; }
  for (int kt = k0; kt < kend; kt += kstep) {
    const int nt = kt / 104, mt = kt - nt * 104;
    gemm_tile<2, EpiMlaKV, true>(p.CKVN, 256, p.Wukv, 256, 256, mt * 128, nt * 128, 0, smem, ekv);
  }
}

DI void ph_mla_attn(const Params& p, char* smem) {
  const int wid = threadIdx.x >> 6, l31 = threadIdx.x & 31;
  for (int u = blockIdx.x; u < 768; u += gridDim.x) {
    int t0, kvrow0, nkeys, Lk, h; size_t vbase;
    if (u < 512) {
      const int xcd = u & 7, slot = u >> 3; const int pair = xcd * 4 + (slot >> 4); const int qb = slot & 15;
      const int b = pair >> 3; h = pair & 7;
      t0 = TC + b * 2048 + qb * 128 + wid * 32; kvrow0 = TC + b * 2304; nkeys = 2304; Lk = 2304;
      vbase = (size_t)16 * 8 * 128 * 256 + (size_t)b * (8 * 128 * 2304) + (size_t)h * 128 * 2304;
    } else {
      const int v = u - 512; const int b = v >> 4; h = (v >> 1) & 7; const int qb = v & 1;
      t0 = b * 256 + qb * 128 + wid * 32; kvrow0 = b * 256; nkeys = 256; Lk = 256;
      vbase = (size_t)b * (8 * 128 * 256) + (size_t)h * 128 * 256;
    }
    const int t = t0 + l31;
    attn_dense_block<8, 4, 4>(smem, p.Q + (size_t)t * 1536 + h * 192, p.KN + (size_t)kvrow0 * 1024 + h * 128, 1024,
                             p.KR + (size_t)kvrow0 * 64, p.VT + vbase, Lk, nkeys,
                             p.SZ + (size_t)t * 1024 + h * 128, p.AO + (size_t)t * 1024 + h * 128);
  }
}

DI void ph_na_g1(const Params& p, char* smem) {
  EpiNaG1 epi{p.NQ, p.NK, p.NVT, p.SZ, p.out + OUT_NAK, p.out + OUT_NAV};
  const int n1 = 64 * 32;
  for (int tile = blockIdx.x; tile < n1 + 64; tile += gridDim.x) {
    if (tile < n1) {
      const int nt = tile / 64, mt = tile - nt * 64;
      gemm_tile<3, EpiNaG1, true>(p.H, 1024, p.Wnin, 1024, 1024, mt * 192, nt * 128, 0, smem, epi);
    } else {
      const int ct = tile - n1;
      const int b = ct >> 4, p0 = (ct & 15) * 16;
      const int c4 = threadIdx.x * 4;
      const size_t kvb = (size_t)TC + b * 2304;
      u16* vtb = p.NVT + (size_t)16 * 1024 * 256 + (size_t)b * (1024 * 2304);
      float vv[4][16];
#pragma unroll
      for (int i = 0; i < 16; i++) {
        const size_t src = ((size_t)(b * 256 + p0 + i)) * 1024 + c4;
        const float4 k = *(const float4*)(p.cache_nak + src);
        uint2 kv; kv.x = pk2(k.x, k.y); kv.y = pk2(k.z, k.w);
        *(uint2*)(p.NK + (kvb + p0 + i) * 1024 + c4) = kv;
        const float4 v = *(const float4*)(p.cache_nav + src);
        vv[0][i] = v.x; vv[1][i] = v.y; vv[2][i] = v.z; vv[3][i] = v.w;
      }
#pragma unroll
      for (int e = 0; e < 4; e++) {
        uint4 w0, w1;
        w0.x = pk2(vv[e][0], vv[e][1]); w0.y = pk2(vv[e][2], vv[e][3]); w0.z = pk2(vv[e][4], vv[e][5]); w0.w = pk2(vv[e][6], vv[e][7]);
        w1.x = pk2(vv[e][8], vv[e][9]); w1.y = pk2(vv[e][10], vv[e][11]); w1.z = pk2(vv[e][12], vv[e][13]); w1.w = pk2(vv[e][14], vv[e][15]);
        u16* dp = vtb + (size_t)(c4 + e) * 2304 + p0;
        *(uint4*)dp = w0; *(uint4*)(dp + 8) = w1;
      }
    }
  }
}

DI void ph_na_attn(const Params& p, char* smem) {
  const int wid = threadIdx.x >> 6, l31 = threadIdx.x & 31;
  for (int u = blockIdx.x; u < 1024 + 512; u += gridDim.x) {
    if (u < 1024) {
      const int xcd = u & 7, slot = u >> 3;
      const int pair = xcd * 8 + (slot >> 4), rpair = slot & 15;
      attn_na_block(p, smem, pair >> 4, pair & 15, rpair);
    } else {
      const int v = u - 1024;
      const int b = v >> 5, h = (v >> 1) & 15, qb = v & 1;
      const int t = b * 256 + qb * 128 + wid * 32 + l31;
      attn_dense_block<4, 0, 2>(smem, p.NQ + (size_t)t * 1024 + h * 64, p.NK + (size_t)(b * 256) * 1024 + h * 64, 1024, nullptr,
                               p.NVT + (size_t)b * (1024 * 256) + (size_t)h * 64 * 256, 256, 256,
                               p.SZ + (size_t)t * 1024 + h * 64, p.NAO + (size_t)t * 1024 + h * 64);
    }
  }
}

template <int ph>
DI void run_phase(const Params& p, char* smem) {
  if constexpr (ph == 0) ph_prep(p, smem);
  else if constexpr (ph == 1) { ph_h0(p); ph_fold(p, smem); }
  else if constexpr (ph == 2 || ph == 17) {
    constexpr int j = (ph == 2) ? 0 : 1;
    EpiPoolG1 e{p.U, p.SZ};
    gemm_phase(p.H, 1024, p.Wpin + (size_t)j * 2048 * 1024, 1024, 1024, 64, 16, smem, e);
  }
  else if constexpr (ph == 3 || ph == 18) ph_mix(p, (ph == 3) ? 0 : 1);
  else if constexpr (ph == 5) {
    EpiG3 e{p.GO, p.mod};
    gemm_phase_st(p.PM, 1024, p.Wpout, 1024, 1024, 64, 8, smem, e);
  }
  else if constexpr (ph == 20) {
    EpiG3 e{p.GO, p.mod + 3 * 5 * 3072};
    gemm_phase_st(p.PM, 1024, p.Wpout + (size_t)1024 * 1024, 1024, 1024, 64, 8, smem, e);
  }
  else if constexpr (ph == 6) ph_ln(p, 0);
  else if constexpr (ph == 21) ph_ln(p, 3);
  else if constexpr (ph == 7) {
    EpiMlaG1 e{p.RAW, p.KR, p.SZ, p.out + OUT_KR};
    gemm_phase(p.H, 1024, p.Wmin, 1024, 1024, 64, 15, smem, e);
  }
  else if constexpr (ph == 8) ph_mla_norm(p);
  else if constexpr (ph == 9) ph_mla_g2(p, smem);
  else if constexpr (ph == 10) ph_mla_attn(p, smem);
  else if constexpr (ph == 11) {
    EpiG3 e{p.GO, p.mod + 1 * 5 * 3072};
    gemm_phase_st(p.AO, 1024, p.Wmout, 1024, 1024, 64, 8, smem, e);
  }
  else if constexpr (ph == 12) ph_ln(p, 1);
  else if constexpr (ph == 13) ph_na_g1(p, smem);
  else if constexpr (ph == 14) ph_na_attn(p, smem);
  else if constexpr (ph == 15) {
    EpiG3 e{p.GO, p.mod + 2 * 5 * 3072};
    gemm_phase_st(p.NAO, 1024, p.Wnout, 1024, 1024, 64, 8, smem, e);
  }
  else if constexpr (ph == 16) ph_ln(p, 2);
}

#define RUN_PH(n) if (ph_lo <= (n) && (n) < ph_hi) { run_phase<n>(p, smem); if ((n) + 1 < ph_hi) xcd_barrier(xb); }

__global__ void __launch_bounds__(256, 2) mega(Params p, int ph_lo, int ph_hi) {
  __shared__ __attribute__((aligned(16))) char smem[SMEM_BYTES];
  if (ph_lo < 0) { cg::this_grid().sync(); return; }
  const bool multi = (ph_hi - ph_lo) > 1;
  XcdBarrier xb; xb.bar = p.bar; xb.x = 0; xb.nloc = 0u; xb.nx = 0u;
  if (multi) xb = xcd_barrier_post(p.bar);
  RUN_PH(0) RUN_PH(1) RUN_PH(2) RUN_PH(3) RUN_PH(5) RUN_PH(6) RUN_PH(7) RUN_PH(8) RUN_PH(9) RUN_PH(10)
  RUN_PH(11) RUN_PH(12) RUN_PH(13) RUN_PH(14) RUN_PH(15) RUN_PH(16) RUN_PH(17) RUN_PH(18) RUN_PH(20) RUN_PH(21)
}

extern "C" void kernel_launch(void* const* d_in, const int* in_sizes, int n_in, void* d_out, int out_size, void* d_ws, size_t ws_size,
                              hipStream_t stream) {
  Params p;
  memset(&p, 0, sizeof(p));
  const float* const* in = (const float* const*)d_in;
  p.x_prompt = in[0]; p.x_sample = in[1]; p.cache_ckv = in[2]; p.cache_kr = in[3]; p.cache_nak = in[4]; p.cache_nav = in[5];
  p.c = in[6]; p.c_ctx = in[7]; p.ada_w = in[8]; p.ada_b = in[9]; p.ln_g = in[10]; p.ln_b = in[11];
  const float* pool_w_in = in[12]; const float* pool_w_grp = in[13]; p.pool_scale = in[14]; const float* pool_w_out = in[15];
  const float* mla_w_in = in[16]; p.mla_q_norm = in[17]; const float* mla_w_uq = in[18]; p.mla_kv_norm = in[19];
  const float* mla_w_ukv = in[20]; const float* mla_w_out = in[21]; const float* na_w_in = in[22]; p.na_rpb = in[23];
  const float* na_w_out = in[24];
  p.out = (float*)d_out;

  char* ws = (char*)d_ws;
  size_t off = 0;
  auto take = [&](size_t bytes) { char* r = ws + off; off += (bytes + 255) & ~(size_t)255; return r; };
  p.bar = (unsigned*)take(XCD_BAR_WORDS * 4);
  p.mod = (float*)take((size_t)4 * 5 * 3072 * 4);
  p.Wpin = (u16*)take((size_t)2 * 2048 * 1024 * 2);
  p.Wgrp = (u16*)take((size_t)8 * 65536 * 2);
  p.Wpout = (u16*)take((size_t)2 * 1024 * 1024 * 2);
  p.Wmin = (u16*)take((size_t)1920 * 1024 * 2);
  p.Wuq = (u16*)take((size_t)1536 * 512 * 2);
  p.Wukv = (u16*)take((size_t)2048 * 256 * 2);
  p.Wmout = (u16*)take((size_t)1024 * 1024 * 2);
  p.Wnin = (u16*)take((size_t)4096 * 1024 * 2);
  p.Wnout = (u16*)take((size_t)1024 * 1024 * 2);
  p.H = (u16*)take((size_t)T * 1024 * 2);
  p.SZ = (u16*)take((size_t)T * 1024 * 2);
  p.GO = (u16*)take((size_t)T * 1024 * 2);
  p.WinU = (u16*)take((size_t)2 * 1024 * 1024 * 2);
  p.pool_w_in = pool_w_in;
  const size_t arena0 = off;
  p.U = (u16*)take((size_t)T * 1024 * 2);
  p.MIX = (u16*)take((size_t)T * 1024 * 2);
  p.PM = (u16*)take((size_t)T * 1024 * 2);
  off = arena0;
  p.RAW = (float*)take((size_t)T * 768 * 4);
  p.AO = (u16*)p.RAW;
  p.CQN = (u16*)take((size_t)T * 512 * 2);
  p.CKVN = (u16*)take((size_t)KVR * 256 * 2);
  p.KR = (u16*)take((size_t)KVR * 64 * 2);
  p.Q = (u16*)take((size_t)T * 1536 * 2);
  p.KN = (u16*)take((size_t)KVR * 1024 * 2);
  p.VT = (u16*)take((size_t)KVR * 1024 * 2);
  off = arena0;
  p.NQ = (u16*)take((size_t)T * 1024 * 2);
  p.NK = (u16*)take((size_t)KVR * 1024 * 2);
  p.NVT = (u16*)take((size_t)KVR * 1024 * 2);
  p.NAO = (u16*)take((size_t)T * 1024 * 2);

  int nm = 0, tiles = 0;
  auto add = [&](const float* src, u16* dst, int K, int Nsrc, int Ndst, int ld = 0) {
    p.mats[nm].src = src; p.mats[nm].dst = dst; p.mats[nm].K = K; p.mats[nm].Nsrc = Nsrc; p.mats[nm].Ndst = Ndst; p.mats[nm].tile0 = tiles; p.mats[nm].ld = ld ? ld : Nsrc;
    tiles += (K / 64) * (Ndst / 64); nm++;
  };
  for (int j = 0; j < 2; j++) add(pool_w_in + (size_t)j * 1024 * 2048 + 1024, p.Wpin + (size_t)j * 2048 * 1024 + (size_t)1024 * 1024, 1024, 1024, 1024, 2048);
  for (int j = 0; j < 8; j++) add(pool_w_grp + (size_t)j * 65536, p.Wgrp + (size_t)j * 65536, 256, 256, 256);
  for (int j = 0; j < 2; j++) add(pool_w_out + (size_t)j * 1024 * 1024, p.Wpout + (size_t)j * 1024 * 1024, 1024, 1024, 1024);
  add(mla_w_in, p.Wmin, 1024, 1856, 1920);
  add(mla_w_uq, p.Wuq, 512, 1536, 1536);
  add(mla_w_ukv, p.Wukv, 256, 2048, 2048);
  add(mla_w_out, p.Wmout, 1024, 1024, 1024);
  add(na_w_in, p.Wnin, 1024, 4096, 4096);
  add(na_w_out, p.Wnout, 1024, 1024, 1024);
  p.nmat_tiles = tiles;

  (void)hipMemsetAsync(p.bar, 0, XCD_BAR_WORDS * 4, stream);
#if MULTI_LAUNCH
  for (int ph = 0; ph < NPHASE; ph++) hipLaunchKernelGGL(mega, dim3(512), dim3(256), 0, stream, p, ph, ph + 1);
#else
  static int grid_blocks = 0;
  if (!grid_blocks) {
    int dev = 0, cus = 0, per_cu = 0;
    hipGetDevice(&dev);
    hipDeviceGetAttribute(&cus, hipDeviceAttributeMultiprocessorCount, dev);
    hipOccupancyMaxActiveBlocksPerMultiprocessor(&per_cu, mega, 256, 0);
    if (per_cu > 2) per_cu = 2;
    if (per_cu < 1) per_cu = 1;
    grid_blocks = cus * per_cu;
  }
  int lo = 0, hi = NPHASE;
  void* args[] = {&p, &lo, &hi};
  hipError_t e = hipLaunchCooperativeKernel((void*)mega, dim3(grid_blocks), dim3(256), args, 0, stream);
  if (e != hipSuccess) fprintf(stderr, "cooperative launch failed: %s (grid %d)\n", hipGetErrorString(e), grid_blocks);
#endif
}
```

```cpp
#include <hip/hip_runtime.h>
#include <hip/hip_cooperative_groups.h>
#include <stdint.h>
#include <string.h>
#include <stdio.h>
namespace cg = cooperative_groups;

#ifndef MULTI_LAUNCH
#define MULTI_LAUNCH 0
#endif

typedef __attribute__((ext_vector_type(8))) short bf16x8;
typedef __attribute__((ext_vector_type(4))) float f32x4;
typedef __attribute__((ext_vector_type(16))) float f32x16;
typedef __attribute__((ext_vector_type(4))) uint32_t u32x4;
typedef unsigned short u16;
#define DI __device__ __forceinline__
#define MFMA32(a, b, c) __builtin_amdgcn_mfma_f32_32x32x16_bf16((a), (b), (c), 0, 0, 0)
#define MFMA16(a, b, c) __builtin_amdgcn_mfma_f32_16x16x32_bf16((a), (b), (c), 0, 0, 0)

constexpr int TC = 4096, TL = 8192, T = 12288;
constexpr int KVR = 4096 + 4 * 2304;
constexpr float LOG2E = 1.4426950408889634f;
constexpr float ALPHA = 1.681792830507429f;
constexpr float MLA_QS = 0.07216878364870323f * LOG2E;
constexpr float NA_QS = 0.125f * LOG2E;
constexpr int SMEM_BYTES = 81920;
constexpr int NPHASE = 22;

constexpr size_t OUT_YS = 4194304, OUT_CKV = 12582912, OUT_KR = 13631488, OUT_NAK = 13893632, OUT_NAV = 18087936;

struct MatDesc { const float* src; u16* dst; int K, Nsrc, Ndst, tile0, ld, pad; };

struct Params {
  const float *x_prompt, *x_sample, *cache_ckv, *cache_kr, *cache_nak, *cache_nav, *c, *c_ctx, *ada_w, *ada_b, *ln_g, *ln_b;
  const float *pool_scale, *mla_q_norm, *mla_kv_norm, *na_rpb;
  float* out;
  float* mod;
  u16 *H, *SZ, *GO, *WinU, *XB;
  const float* pool_w_in;
  u16 *Wpin, *Wgrp, *Wpout, *Wmin, *Wuq, *Wukv, *Wmout, *Wnin, *Wnout;
  u16 *U, *MIX, *PM;
  float* RAW; u16 *AO, *CQN, *CKVN, *KR, *Q, *KN, *VT;
  u16 *NQ, *NK, *NVT, *NAO;
  unsigned* bar;
  MatDesc mats[18];
  int nmat_tiles; int pad0;
};

DI float bf2f(u16 v) { return __uint_as_float(((uint32_t)v) << 16); }
typedef __attribute__((ext_vector_type(2))) float f32x2;
typedef __attribute__((ext_vector_type(2))) __bf16 bf16x2_t;
DI uint32_t pk2(float a, float b) { f32x2 v = {a, b}; return __builtin_bit_cast(uint32_t, __builtin_convertvector(v, bf16x2_t)); }
DI u16 f2bf(float x) { return (u16)(pk2(x, x) & 0xffffu); }
DI float4 ldnt4(const float* p) {
  typedef __attribute__((ext_vector_type(4))) float f4;
  const f4 v = __builtin_nontemporal_load((const f4*)p);
  float4 r; r.x = v[0]; r.y = v[1]; r.z = v[2]; r.w = v[3];
  return r;
}
DI uint2 ldnt2u(const void* p) {
  typedef __attribute__((ext_vector_type(2))) uint32_t u2;
  const u2 v = __builtin_nontemporal_load((const u2*)p);
  uint2 r; r.x = v[0]; r.y = v[1];
  return r;
}
DI void stnt4(float* p, const float4& a) {
  typedef __attribute__((ext_vector_type(4))) float f4;
  f4 v; v[0] = a.x; v[1] = a.y; v[2] = a.z; v[3] = a.w;
  __builtin_nontemporal_store(v, (f4*)p);
}
DI void stnt2u(void* p, const uint2& a) {
  typedef __attribute__((ext_vector_type(2))) uint32_t u2;
  u2 v; v[0] = a.x; v[1] = a.y;
  __builtin_nontemporal_store(v, (u2*)p);
}
DI float silu(float v) { return v / (1.f + __expf(-v)); }
DI int cond_of(int t) { return t < TC ? 0 : 1 + ((t - TC) >> 11); }
DI int kvrow_of(int t) { return t < TC ? t : TC + ((t - TC) >> 11) * 2304 + 256 + ((t - TC) & 2047); }
DI int perm16(int key) { const int k = key & 15; return (key & ~15) | (k & 3) | ((k >> 1) & 4) | ((k << 1) & 8); }
DI float wave_sum(float v) {
#pragma unroll
  for (int o = 32; o >= 1; o >>= 1) v += __shfl_xor(v, o);
  return v;
}

#define XB_TMO      128
#define XB_XCNT(j)  (256  + 64 * (j))
#define XB_XSUB(j)  (1280 + 64 * (j))
#define XB_XGEN(j)  (2304 + 64 * (j))
#define XB_TOP      3328
#define XB_TOPGEN   3392
#define XCD_BAR_WORDS 3456
#define XB_SPIN_CAP (1u << 22)
#define LAS __attribute__((address_space(3)))
DI unsigned xb_ld(unsigned* p) { return __hip_atomic_load(p, __ATOMIC_RELAXED, __HIP_MEMORY_SCOPE_AGENT); }
DI unsigned xb_add(unsigned* p, unsigned v) { return __hip_atomic_fetch_add(p, v, __ATOMIC_RELAXED, __HIP_MEMORY_SCOPE_AGENT); }
DI unsigned xb_xcc_id() { return (unsigned)__builtin_amdgcn_s_getreg((3 << 11) | 20) & 0xFu; }
#define XB_SPIN(cond, bar) do { unsigned _sp = 0; while (cond) { __builtin_amdgcn_s_sleep(1); \
    if ((++_sp & 255u) == 0u) { if (xb_ld(&(bar)[XB_TMO])) break; if (_sp > XB_SPIN_CAP) { atomicAdd(&(bar)[XB_TMO], 1u); break; } } } } while (0)
struct XcdBarrier { unsigned* bar; unsigned x; unsigned nloc, nx; };
DI XcdBarrier xcd_barrier_post(unsigned* bar) {
  XcdBarrier b; b.bar = bar; b.x = xb_xcc_id(); b.nloc = 0u; b.nx = 0u;
  if (threadIdx.x == 0) (void)xb_add(&bar[XB_XCNT(b.x)], 1u);
  return b;
}
DI void xcd_barrier_complete(unsigned* bar, unsigned x, unsigned& nloc, unsigned& nx) {
  const unsigned G = gridDim.x * gridDim.y * gridDim.z;
  unsigned sum, cnt, mine, sp = 0u;
  for (;;) {
    sum = 0u; cnt = 0u; mine = 0u;
#pragma unroll
    for (unsigned j = 0; j < 16; ++j) { const unsigned c = xb_ld(&bar[XB_XCNT(j)]); sum += c; cnt += (c > 0u) ? 1u : 0u; mine = (j == x) ? c : mine; }
    if (sum == G) break;
    __builtin_amdgcn_s_sleep(1);
    if ((++sp & 255u) == 0u) { if (xb_ld(&bar[XB_TMO])) break; if (sp > XB_SPIN_CAP) { atomicAdd(&bar[XB_TMO], 1u); break; } }
  }
  nloc = mine > 0u ? mine : 1u; nx = cnt > 0u ? cnt : 1u;
}
DI void xcd_barrier(XcdBarrier& b) {
  asm volatile("s_waitcnt vmcnt(0)" ::: "memory");
  __syncthreads();
  unsigned nloc = b.nloc, nx = b.nx;
  if (threadIdx.x == 0) {
    unsigned* bar = b.bar;
    __builtin_amdgcn_s_waitcnt(0);
    if (nloc == 0u) { xcd_barrier_complete(bar, b.x, nloc, nx); }
    const unsigned old = xb_add(&bar[XB_XSUB(b.x)], 1u);
    const unsigned gen = old / nloc;
    if (old + 1u == (gen + 1u) * nloc) {
      __builtin_amdgcn_fence(__ATOMIC_RELEASE, "agent");
      asm volatile("s_waitcnt vmcnt(0)" ::: "memory");
      const unsigned og = xb_add(&bar[XB_TOP], 1u);
      const unsigned tg = og / nx;
      if (og + 1u == (tg + 1u) * nx) xb_add(&bar[XB_TOPGEN], 1u);
      else XB_SPIN(xb_ld(&bar[XB_TOPGEN]) == tg, bar);
      __builtin_amdgcn_fence(__ATOMIC_ACQUIRE, "agent");
      xb_add(&bar[XB_XGEN(b.x)], 1u);
      asm volatile("s_waitcnt vmcnt(0)" ::: "memory");
    } else {
      XB_SPIN(xb_ld(&bar[XB_XGEN(b.x)]) == gen, bar);
      __builtin_amdgcn_fence(__ATOMIC_ACQUIRE, "agent");
      asm volatile("s_waitcnt vmcnt(0)" ::: "memory");
    }
  }
  if (threadIdx.x < 64) { b.nloc = __builtin_amdgcn_readfirstlane(nloc); b.nx = __builtin_amdgcn_readfirstlane(nx); }
  __syncthreads();
}

template <int MI, class Epi, bool STAGED = false>
DI void gemm_tile(const u16* __restrict__ A, int lda, const u16* __restrict__ Bt, int ldb, int K, int m0, int n0, int nout_off,
                  char* smem, const Epi& epi) {
  constexpr int BM = 64 * MI, ASTG = BM * 128, NG = 2 * MI + 4;
  const int tid = threadIdx.x, lane = tid & 63, wid = tid >> 6;
  const int wm = wid >> 1, wn = wid & 1, l31 = lane & 31, lh = lane >> 5;
  char* As = smem;
  char* Bs = smem + 2 * ASTG;
  const int srow = tid >> 3;
  const int scc = ((tid & 7) ^ ((tid >> 4) & 7)) * 8;
  const u16* ag = A + (size_t)(m0 + srow) * lda + scc;
  const u16* bg = Bt + (size_t)(n0 + srow) * ldb + scc;
  LAS char* awr = (LAS char*)(As + wid * 1024);
  LAS char* bwr = (LAS char*)(Bs + wid * 1024);
  f32x16 acc[MI][2];
#pragma unroll
  for (int i = 0; i < MI; i++)
#pragma unroll
    for (int j = 0; j < 2; j++)
#pragma unroll
      for (int r = 0; r < 16; r++) acc[i][j][r] = 0.f;
  const int nk = K >> 6;
  const int rot = (n0 >> 7) + (m0 >> 6);
  __syncthreads();
#pragma unroll
  for (int t = 0; t < 2; t++) {
#pragma unroll
    for (int i = 0; i < 2 * MI; i++)
      __builtin_amdgcn_global_load_lds((const void*)(ag + (size_t)(32 * i) * lda + ((t + rot) & (nk - 1)) * 64), (LAS void*)(awr + t * ASTG + i * 4096), 16, 0, 0);
#pragma unroll
    for (int i = 0; i < 4; i++)
      __builtin_amdgcn_global_load_lds((const void*)(bg + (size_t)(32 * i) * ldb + ((t + rot) & (nk - 1)) * 64), (LAS void*)(bwr + t * 16384 + i * 4096), 16, 0, 0);
  }
  const int sw = (l31 >> 1) & 7;
  for (int kt = 0; kt < nk; kt++) {
    const int buf = kt & 1;
    if (kt + 1 < nk) asm volatile("s_waitcnt vmcnt(%0)" :: "n"(NG) : "memory");
    else asm volatile("s_waitcnt vmcnt(0)" ::: "memory");
    __builtin_amdgcn_s_barrier();
    const char* as = As + buf * ASTG + (wm * (32 * MI) + l31) * 128;
    const char* bs = Bs + buf * 16384 + (wn * 64 + l31) * 128;
    bf16x8 fa[4][MI], fb[4][2];
#pragma unroll
    for (int ks = 0; ks < 4; ks++) {
      const int co = ((2 * ks + lh) ^ sw) << 4;
      fb[ks][0] = *(const bf16x8*)(bs + co);
      fb[ks][1] = *(const bf16x8*)(bs + 32 * 128 + co);
#pragma unroll
      for (int i = 0; i < MI; i++) fa[ks][i] = *(const bf16x8*)(as + i * 32 * 128 + co);
    }
    asm volatile("s_waitcnt lgkmcnt(0)" ::: "memory");
    __builtin_amdgcn_s_barrier();
    if (kt + 2 < nk) {
#pragma unroll
      for (int i = 0; i < 2 * MI; i++)
        __builtin_amdgcn_global_load_lds((const void*)(ag + (size_t)(32 * i) * lda + ((kt + 2 + rot) & (nk - 1)) * 64), (LAS void*)(awr + buf * ASTG + i * 4096), 16, 0, 0);
#pragma unroll
      for (int i = 0; i < 4; i++)
        __builtin_amdgcn_global_load_lds((const void*)(bg + (size_t)(32 * i) * ldb + ((kt + 2 + rot) & (nk - 1)) * 64), (LAS void*)(bwr + buf * 16384 + i * 4096), 16, 0, 0);
    }
#pragma unroll
    for (int ks = 0; ks < 4; ks++)
#pragma unroll
      for (int i = 0; i < MI; i++) {
        acc[i][0] = MFMA32(fb[ks][0], fa[ks][i], acc[i][0]);
        acc[i][1] = MFMA32(fb[ks][1], fa[ks][i], acc[i][1]);
      }
  }
  if constexpr (STAGED) {
    float* stg = (float*)(smem + wid * 8704);
    const int nbw = nout_off + n0 + wn * 64;
#pragma unroll
    for (int i = 0; i < MI; i++) {
      const int mb = m0 + wm * (32 * MI) + i * 32;
#pragma unroll
      for (int j = 0; j < 2; j++)
#pragma unroll
        for (int g = 0; g < 4; g++) {
          float4 v; v.x = acc[i][j][4 * g]; v.y = acc[i][j][4 * g + 1]; v.z = acc[i][j][4 * g + 2]; v.w = acc[i][j][4 * g + 3];
          *(float4*)(stg + l31 * 68 + j * 32 + 8 * g + 4 * lh) = v;
        }
      asm volatile("s_waitcnt lgkmcnt(0)" ::: "memory");
      __builtin_amdgcn_wave_barrier();
      bool rows = true;
      if constexpr (Epi::HAS_VT) {
        if (epi.is_vt(nbw)) {
          rows = epi.vt_rows(mb);
          const bool perm = epi.vt_perm(mb);
#pragma unroll
          for (int it = 0; it < 4; it++) {
            const int n = lane, q = it;
            float v[8];
            int pos;
            if (perm) {
              const int rb = (q >> 1) * 16 + (q & 1) * 4;
#pragma unroll
              for (int k = 0; k < 8; k++) v[k] = stg[(rb + (k & 3) + 8 * (k >> 2)) * 68 + n];
              pos = (q >> 1) * 16 + (q & 1) * 8;
            } else {
#pragma unroll
              for (int k = 0; k < 8; k++) v[k] = stg[(q * 8 + k) * 68 + n];
              pos = q * 8;
            }
            epi.vt8(mb, nbw + n, pos, v);
          }
        }
      }
      if (rows) {
#pragma unroll
        for (int it = 0; it < 8; it++) {
          const int row = it * 4 + (lane >> 4), col = (lane & 15) * 4;
          const float4 v = *(const float4*)(stg + row * 68 + col);
          epi.row4(mb + row, nbw + col, v);
        }
      }
      asm volatile("s_waitcnt lgkmcnt(0)" ::: "memory");
      __builtin_amdgcn_wave_barrier();
    }
  } else {
#pragma unroll
    for (int i = 0; i < MI; i++)
#pragma unroll
      for (int j = 0; j < 2; j++)
        epi(m0 + wm * (32 * MI) + i * 32 + l31, nout_off + n0 + wn * 64 + j * 32, lh, acc[i][j]);
  }
}

DI void rope_pair(float x1, float x2, int i, float pos, float& o1, float& o2) {
  const float inv = exp2f(-(float)i * (13.287712379549449f / 16.f));
  const float ang = pos * inv;
  const float c = __cosf(ang), s = __sinf(ang);
  o1 = x1 * c - x2 * s;
  o2 = x1 * s + x2 * c;
}

struct EpiPoolG1 {
  u16 *U, *SZ;
  DI void operator()(int m, int nb, int lh, const f32x16& a) const {
#pragma unroll
    for (int g = 0; g < 4; g++) {
      const int n = nb + 8 * g + 4 * lh;
      if (nb < 1024) {
        uint2 v; v.x = pk2(a[4 * g], a[4 * g + 1]); v.y = pk2(a[4 * g + 2], a[4 * g + 3]);
        *(uint2*)(U + (size_t)m * 1024 + n) = v;
      } else {
        uint2 v; v.x = pk2(silu(a[4 * g]), silu(a[4 * g + 1])); v.y = pk2(silu(a[4 * g + 2]), silu(a[4 * g + 3]));
        *(uint2*)(SZ + (size_t)m * 1024 + n - 1024) = v;
      }
    }
  }
};
struct EpiPoolG2 {
  u16* PM; const u16* SZ; const float* scale;
  DI void operator()(int m, int nb, int lh, const f32x16& a) const {
#pragma unroll
    for (int g = 0; g < 4; g++) {
      const int n = nb + 8 * g + 4 * lh;
      const uint2 z = *(const uint2*)(SZ + (size_t)m * 1024 + n);
      const float4 sc = *(const float4*)(scale + n);
      uint2 v;
      v.x = pk2(a[4 * g] * sc.x * bf2f((u16)(z.x & 0xffff)), a[4 * g + 1] * sc.y * bf2f((u16)(z.x >> 16)));
      v.y = pk2(a[4 * g + 2] * sc.z * bf2f((u16)(z.y & 0xffff)), a[4 * g + 3] * sc.w * bf2f((u16)(z.y >> 16)));
      *(uint2*)(PM + (size_t)m * 1024 + n) = v;
    }
  }
};
struct EpiG3 {
  static constexpr bool HAS_VT = false;
  u16* GO; const float* mod_layer;
  DI void row4(int m, int n, const float4& a) const {
    const float4 gt = *(const float4*)(mod_layer + cond_of(m) * 3072 + 2048 + n);
    uint2 v; v.x = pk2(gt.x * a.x, gt.y * a.y); v.y = pk2(gt.z * a.z, gt.w * a.w);
    *(uint2*)(GO + (size_t)m * 1024 + n) = v;
  }
  DI void operator()(int m, int nb, int lh, const f32x16& a) const {
    const float* gate = mod_layer + cond_of(m) * 3072 + 2048;
#pragma unroll
    for (int g = 0; g < 4; g++) {
      const int n = nb + 8 * g + 4 * lh;
      const float4 gt = *(const float4*)(gate + n);
      uint2 v; v.x = pk2(gt.x * a[4 * g], gt.y * a[4 * g + 1]); v.y = pk2(gt.z * a[4 * g + 2], gt.w * a[4 * g + 3]);
      *(uint2*)(GO + (size_t)m * 1024 + n) = v;
    }
  }
};
struct EpiMlaG1 {
  float* RAW; u16* KR; u16* SZ; float* st_kr;
  DI void operator()(int m, int nb, int lh, const f32x16& a) const {
    if (nb >= 1856) return;
    if (nb < 768) {
#pragma unroll
      for (int g = 0; g < 4; g++) {
        const int n = nb + 8 * g + 4 * lh;
        float4 r; r.x = a[4 * g]; r.y = a[4 * g + 1]; r.z = a[4 * g + 2]; r.w = a[4 * g + 3];
        *(float4*)(RAW + (size_t)m * 768 + n) = r;
      }
    } else if (nb < 832) {
      const int off = nb - 768;
      const bool lat = m >= TC;
      const int tt = (m - TC) & 2047;
      const float pos = (off == 0) ? (float)(tt >> 6) : (float)(tt & 63);
      const size_t kr = (size_t)kvrow_of(m) * 64 + off;
#pragma unroll
      for (int g = 0; g < 2; g++) {
        float o1[4], o2[4];
#pragma unroll
        for (int e = 0; e < 4; e++) {
          const int i = 8 * g + 4 * lh + e;
          const float x1 = a[4 * g + e], x2 = a[4 * (g + 2) + e];
          if (lat) rope_pair(x1, x2, i, pos, o1[e], o2[e]); else { o1[e] = x1; o2[e] = x2; }
        }
        const int i0 = 8 * g + 4 * lh;
        if (!lat) {
          float4 r1; r1.x = o1[0]; r1.y = o1[1]; r1.z = o1[2]; r1.w = o1[3];
          float4 r2; r2.x = o2[0]; r2.y = o2[1]; r2.z = o2[2]; r2.w = o2[3];
          *(float4*)(st_kr + (size_t)m * 64 + off + i0) = r1;
          *(float4*)(st_kr + (size_t)m * 64 + off + i0 + 16) = r2;
        }
        uint2 v1; v1.x = pk2(o1[0], o1[1]); v1.y = pk2(o1[2], o1[3]);
        uint2 v2; v2.x = pk2(o2[0], o2[1]); v2.y = pk2(o2[2], o2[3]);
        *(uint2*)(KR + kr + i0) = v1;
        *(uint2*)(KR + kr + i0 + 16) = v2;
      }
    } else {
#pragma unroll
      for (int g = 0; g < 4; g++) {
        const int n = nb + 8 * g + 4 * lh - 832;
        uint2 v; v.x = pk2(silu(a[4 * g]), silu(a[4 * g + 1])); v.y = pk2(silu(a[4 * g + 2]), silu(a[4 * g + 3]));
        *(uint2*)(SZ + (size_t)m * 1024 + n) = v;
      }
    }
  }
};
struct EpiMlaQ {
  u16* Q;
  DI void operator()(int m, int nb, int lh, const f32x16& a) const {
    const int head = nb / 192, off = nb - head * 192;
    u16* qr = Q + (size_t)m * 1536 + nb;
    if (off < 128) {
#pragma unroll
      for (int g = 0; g < 4; g++) {
        uint2 v; v.x = pk2(a[4 * g] * MLA_QS, a[4 * g + 1] * MLA_QS); v.y = pk2(a[4 * g + 2] * MLA_QS, a[4 * g + 3] * MLA_QS);
        *(uint2*)(qr + 8 * g + 4 * lh) = v;
      }
    } else {
      const bool lat = m >= TC;
      const int tt = (m - TC) & 2047;
      const float pos = (off == 128) ? (float)(tt >> 6) : (float)(tt & 63);
#pragma unroll
      for (int g = 0; g < 2; g++) {
        float o1[4], o2[4];
#pragma unroll
        for (int e = 0; e < 4; e++) {
          const int i = 8 * g + 4 * lh + e;
          const float x1 = a[4 * g + e], x2 = a[4 * (g + 2) + e];
          if (lat) rope_pair(x1, x2, i, pos, o1[e], o2[e]); else { o1[e] = x1; o2[e] = x2; }
        }
        const int i0 = 8 * g + 4 * lh;
        uint2 v1; v1.x = pk2(o1[0] * MLA_QS, o1[1] * MLA_QS); v1.y = pk2(o1[2] * MLA_QS, o1[3] * MLA_QS);
        uint2 v2; v2.x = pk2(o2[0] * MLA_QS, o2[1] * MLA_QS); v2.y = pk2(o2[2] * MLA_QS, o2[3] * MLA_QS);
        *(uint2*)(qr + i0) = v1;
        *(uint2*)(qr + i0 + 16) = v2;
      }
    }
  }
};
struct EpiMlaKV {
  u16 *KN, *VT;
  static constexpr bool HAS_VT = true;
  DI bool is_vt(int nb) const { return (nb & 255) >= 128; }
  DI bool vt_perm(int mb) const { return true; }
  DI bool vt_rows(int mb) const { return false; }
  DI void row4(int m, int n, const float4& a) const {
    const int head = n >> 8, off = n & 255;
    uint2 v; v.x = pk2(a.x, a.y); v.y = pk2(a.z, a.w);
    *(uint2*)(KN + (size_t)m * 1024 + head * 128 + off) = v;
  }
  DI void vt8(int mb, int n, int pos, const float* v) const {
    const int head = n >> 8, d = (n & 255) - 128;
    size_t base; int Lk, key0;
    if (mb < TC) { base = (size_t)(mb >> 8) * (8 * 128 * 256); Lk = 256; key0 = mb & 255; }
    else { const int r2 = mb - TC; const int b = r2 / 2304; key0 = r2 - b * 2304; Lk = 2304; base = (size_t)16 * 8 * 128 * 256 + (size_t)b * (8 * 128 * 2304); }
    uint4 w; w.x = pk2(v[0], v[1]); w.y = pk2(v[2], v[3]); w.z = pk2(v[4], v[5]); w.w = pk2(v[6], v[7]);
    *(uint4*)(VT + base + (size_t)(head * 128 + d) * Lk + key0 + pos) = w;
  }
  DI void operator()(int m, int nb, int lh, const f32x16& a) const {
    const int head = nb >> 8, off = nb & 255;
    if (off < 128) {
#pragma unroll
      for (int g = 0; g < 4; g++) {
        uint2 v; v.x = pk2(a[4 * g], a[4 * g + 1]); v.y = pk2(a[4 * g + 2], a[4 * g + 3]);
        *(uint2*)(KN + (size_t)m * 1024 + head * 128 + off + 8 * g + 4 * lh) = v;
      }
    } else {
      size_t base; int Lk, key;
      if (m < TC) { base = (size_t)(m >> 8) * (8 * 128 * 256); Lk = 256; key = m & 255; }
      else { const int r2 = m - TC; const int b = r2 / 2304; key = r2 - b * 2304; Lk = 2304; base = (size_t)16 * 8 * 128 * 256 + (size_t)b * (8 * 128 * 2304); }
      u16* vp = VT + base + (size_t)(head * 128 + off - 128) * Lk + perm16(key);
#pragma unroll
      for (int g = 0; g < 4; g++)
#pragma unroll
        for (int e = 0; e < 4; e++) vp[(size_t)(8 * g + 4 * lh + e) * Lk] = f2bf(a[4 * g + e]);
    }
  }
};
struct EpiNaG1 {
  u16 *NQ, *NK, *NVT, *SZ; float *st_k, *st_v;
  static constexpr bool HAS_VT = true;
  DI bool is_vt(int nb) const { return nb >= 2048 && nb < 3072; }
  DI bool vt_perm(int mb) const { return mb < TC; }
  DI bool vt_rows(int mb) const { return mb < TC; }
  DI void row4(int m, int n, const float4& a) const {
    if (n < 1024) {
      uint2 v; v.x = pk2(a.x * NA_QS, a.y * NA_QS); v.y = pk2(a.z * NA_QS, a.w * NA_QS);
      *(uint2*)(NQ + (size_t)m * 1024 + n) = v;
    } else if (n < 2048) {
      uint2 v; v.x = pk2(a.x, a.y); v.y = pk2(a.z, a.w);
      *(uint2*)(NK + (size_t)kvrow_of(m) * 1024 + (n - 1024)) = v;
      if (m < TC) stnt4(st_k + (size_t)m * 1024 + (n - 1024), a);
    } else if (n < 3072) {
      if (m < TC) stnt4(st_v + (size_t)m * 1024 + (n - 2048), a);
    } else {
      uint2 v; v.x = pk2(silu(a.x), silu(a.y)); v.y = pk2(silu(a.z), silu(a.w));
      *(uint2*)(SZ + (size_t)m * 1024 + (n - 3072)) = v;
    }
  }
  DI void vt8(int mb, int n, int pos, const float* v) const {
    const int c0 = n - 2048;
    size_t base; int Lk, key0;
    if (mb < TC) { base = (size_t)(mb >> 8) * (1024 * 256); Lk = 256; key0 = mb & 255; }
    else { const int b = (mb - TC) >> 11; key0 = 256 + ((mb - TC) & 2047); Lk = 2304; base = (size_t)16 * 1024 * 256 + (size_t)b * (1024 * 2304); }
    uint4 w; w.x = pk2(v[0], v[1]); w.y = pk2(v[2], v[3]); w.z = pk2(v[4], v[5]); w.w = pk2(v[6], v[7]);
    *(uint4*)(NVT + base + (size_t)c0 * Lk + key0 + pos) = w;
  }
  DI void operator()(int m, int nb, int lh, const f32x16& a) const {
    if (nb < 1024) {
#pragma unroll
      for (int g = 0; g < 4; g++) {
        uint2 v; v.x = pk2(a[4 * g] * NA_QS, a[4 * g + 1] * NA_QS); v.y = pk2(a[4 * g + 2] * NA_QS, a[4 * g + 3] * NA_QS);
        *(uint2*)(NQ + (size_t)m * 1024 + nb + 8 * g + 4 * lh) = v;
      }
    } else if (nb < 2048) {
      const size_t kr = (size_t)kvrow_of(m) * 1024 + (nb - 1024);
#pragma unroll
      for (int g = 0; g < 4; g++) {
        uint2 v; v.x = pk2(a[4 * g], a[4 * g + 1]); v.y = pk2(a[4 * g + 2], a[4 * g + 3]);
        *(uint2*)(NK + kr + 8 * g + 4 * lh) = v;
        if (m < TC) { float4 r; r.x = a[4 * g]; r.y = a[4 * g + 1]; r.z = a[4 * g + 2]; r.w = a[4 * g + 3];
          *(float4*)(st_k + (size_t)m * 1024 + (nb - 1024) + 8 * g + 4 * lh) = r; }
      }
    } else if (nb < 3072) {
      const int c0 = nb - 2048;
      size_t base; int Lk, key;
      if (m < TC) { base = (size_t)(m >> 8) * (1024 * 256); Lk = 256; key = perm16(m & 255); }
      else { const int b = (m - TC) >> 11; key = 256 + ((m - TC) & 2047); Lk = 2304; base = (size_t)16 * 1024 * 256 + (size_t)b * (1024 * 2304); }
      u16* vp = NVT + base + (size_t)c0 * Lk + key;
#pragma unroll
      for (int g = 0; g < 4; g++) {
#pragma unroll
        for (int e = 0; e < 4; e++) vp[(size_t)(8 * g + 4 * lh + e) * Lk] = f2bf(a[4 * g + e]);
        if (m < TC) { float4 r; r.x = a[4 * g]; r.y = a[4 * g + 1]; r.z = a[4 * g + 2]; r.w = a[4 * g + 3];
          *(float4*)(st_v + (size_t)m * 1024 + c0 + 8 * g + 4 * lh) = r; }
      }
    } else {
#pragma unroll
      for (int g = 0; g < 4; g++) {
        uint2 v; v.x = pk2(silu(a[4 * g]), silu(a[4 * g + 1])); v.y = pk2(silu(a[4 * g + 2]), silu(a[4 * g + 3]));
        *(uint2*)(SZ + (size_t)m * 1024 + (nb - 3072) + 8 * g + 4 * lh) = v;
      }
    }
  }
};

template <int NSA, int NSB, int NDT>
DI void attn_dense_wave(const u16* __restrict__ qrow, const u16* __restrict__ kA, int kAstride, const u16* __restrict__ kB,
                        const u16* __restrict__ vt, int Lk, int nkeys, const u16* __restrict__ szrow, u16* __restrict__ orow) {
  const int lane = threadIdx.x & 63, l31 = lane & 31, lh = lane >> 5;
  bf16x8 qf[NSA + NSB];
#pragma unroll
  for (int s = 0; s < NSA + NSB; s++) qf[s] = *(const bf16x8*)(qrow + s * 16 + lh * 8);
  f32x16 o[NDT];
#pragma unroll
  for (int d = 0; d < NDT; d++)
#pragma unroll
    for (int r = 0; r < 16; r++) o[d][r] = 0.f;
  float m = -1e30f, l = 0.f;
  for (int k0 = 0; k0 < nkeys; k0 += 32) {
    f32x16 sa;
#pragma unroll
    for (int r = 0; r < 16; r++) sa[r] = 0.f;
    const u16* kp = kA + (size_t)(k0 + l31) * kAstride + lh * 8;
#pragma unroll
    for (int s = 0; s < NSA; s++) sa = MFMA32(*(const bf16x8*)(kp + s * 16), qf[s], sa);
    if (NSB > 0) {
      const u16* kp2 = kB + (size_t)(k0 + l31) * 64 + lh * 8;
#pragma unroll
      for (int s = 0; s < NSB; s++) sa = MFMA32(*(const bf16x8*)(kp2 + s * 16), qf[NSA + s], sa);
    }
    float mx = sa[0];
#pragma unroll
    for (int r = 1; r < 16; r++) mx = fmaxf(mx, sa[r]);
    mx = fmaxf(mx, __shfl_xor(mx, 32));
    const float mn = fmaxf(m, mx);
    const float alpha = __builtin_amdgcn_exp2f(m - mn);
    m = mn;
    float ps = 0.f;
#pragma unroll
    for (int r = 0; r < 16; r++) { sa[r] = exp2f(sa[r] - mn); ps += sa[r]; }
    l = l * alpha + ps;
#pragma unroll
    for (int d = 0; d < NDT; d++)
#pragma unroll
      for (int r = 0; r < 16; r++) o[d][r] *= alpha;
#pragma unroll
    for (int sp = 0; sp < 2; sp++) {
      u32x4 pw;
      pw[0] = pk2(sa[8 * sp + 0], sa[8 * sp + 1]); pw[1] = pk2(sa[8 * sp + 2], sa[8 * sp + 3]);
      pw[2] = pk2(sa[8 * sp + 4], sa[8 * sp + 5]); pw[3] = pk2(sa[8 * sp + 6], sa[8 * sp + 7]);
      const bf16x8 pf = __builtin_bit_cast(bf16x8, pw);
#pragma unroll
      for (int d = 0; d < NDT; d++) {
        const u16* vp = vt + (size_t)(d * 32 + l31) * Lk + k0 + 16 * sp + 4 * lh;
        const uint2 lo = *(const uint2*)vp, hi = *(const uint2*)(vp + 8);
        u32x4 vw; vw[0] = lo.x; vw[1] = lo.y; vw[2] = hi.x; vw[3] = hi.y;
        o[d] = MFMA32(__builtin_bit_cast(bf16x8, vw), pf, o[d]);
      }
    }
  }
  l += __shfl_xor(l, 32);
  const float inv = 1.f / l;
#pragma unroll
  for (int d = 0; d < NDT; d++)
#pragma unroll
    for (int g = 0; g < 4; g++) {
      const int d0 = d * 32 + 8 * g + 4 * lh;
      const uint2 z = *(const uint2*)(szrow + d0);
      uint2 v;
      v.x = pk2(o[d][4 * g] * inv * bf2f((u16)(z.x & 0xffff)), o[d][4 * g + 1] * inv * bf2f((u16)(z.x >> 16)));
      v.y = pk2(o[d][4 * g + 2] * inv * bf2f((u16)(z.y & 0xffff)), o[d][4 * g + 3] * inv * bf2f((u16)(z.y >> 16)));
      *(uint2*)(orow + d0) = v;
    }
}


template <int NSA, int NSB, int NDT>
DI void attn_dense_block(char* smem, const u16* __restrict__ qrow, const u16* __restrict__ kA, int kAstride, const u16* __restrict__ kB,
                         const u16* __restrict__ vt, int Lk, int nkeys, const u16* __restrict__ szrow, u16* __restrict__ orow) {
  constexpr int NS = NSA + NSB, DV = 32 * NDT, CA = NSA * 2;
  constexpr int KN_B = 64 * CA * 16, KR_B = (NSB > 0) ? 64 * 128 : 0, V_B = DV * 128, STG = KN_B + KR_B + V_B;
  constexpr int NLA = 64 * CA / 256, NLB = (NSB > 0) ? 2 : 0, NLV = DV * 8 / 256;
  const int tid = threadIdx.x, lane = tid & 63, wid = tid >> 6, l31 = lane & 31, lh = lane >> 5;
  const int arow = (CA == 16) ? (tid >> 4) : (tid >> 3);
  const int acc_ = (CA == 16) ? ((tid & 15) ^ ((tid >> 4) & 15)) : ((tid & 7) ^ ((tid >> 4) & 7));
  const int brow = tid >> 3, bcc = (tid & 7) ^ ((tid >> 4) & 7);
  const u16* ka_src = kA + (size_t)arow * kAstride + acc_ * 8;
  const u16* kb_src = (NSB > 0) ? (kB + (size_t)brow * 64 + bcc * 8) : kA;
  const u16* v_src = vt + (size_t)brow * Lk + bcc * 8;
  LAS char* wbase = (LAS char*)(smem + wid * 1024);
  bf16x8 qf[NS];
#pragma unroll
  for (int s = 0; s < NS; s++) qf[s] = *(const bf16x8*)(qrow + s * 16 + lh * 8);
  f32x16 o[NDT];
#pragma unroll
  for (int d = 0; d < NDT; d++)
#pragma unroll
    for (int r = 0; r < 16; r++) o[d][r] = 0.f;
  float m = -1e30f, l = 0.f;
  const int swA = (CA == 16) ? (l31 & 15) : ((l31 >> 1) & 7);
  const int swB = (l31 >> 1) & 7;

  __syncthreads();
#pragma unroll
  for (int i = 0; i < NLA; i++)
    __builtin_amdgcn_global_load_lds((const void*)(ka_src + (size_t)(i * (256 / CA)) * kAstride), (LAS void*)(wbase + i * 4096), 16, 0, 0);
#pragma unroll
  for (int i = 0; i < NLB; i++)
    __builtin_amdgcn_global_load_lds((const void*)(kb_src + (size_t)(32 * i) * 64), (LAS void*)(wbase + KN_B + i * 4096), 16, 0, 0);
#pragma unroll
  for (int i = 0; i < NLV; i++)
    __builtin_amdgcn_global_load_lds((const void*)(v_src + (size_t)(32 * i) * Lk), (LAS void*)(wbase + KN_B + KR_B + i * 4096), 16, 0, 0);
  asm volatile("s_waitcnt vmcnt(0)" ::: "memory");
  __syncthreads();
  int st = 0;
  for (int k0 = 0; k0 < nkeys; k0 += 64, st ^= 1) {
    if (k0 + 64 < nkeys) {
      const int kn = k0 + 64;
      LAS char* wb = wbase + (st ^ 1) * STG;
#pragma unroll
      for (int i = 0; i < NLA; i++)
        __builtin_amdgcn_global_load_lds((const void*)(ka_src + (size_t)(kn + i * (256 / CA)) * kAstride), (LAS void*)(wb + i * 4096), 16, 0, 0);
#pragma unroll
      for (int i = 0; i < NLB; i++)
        __builtin_amdgcn_global_load_lds((const void*)(kb_src + (size_t)(kn + 32 * i) * 64), (LAS void*)(wb + KN_B + i * 4096), 16, 0, 0);
#pragma unroll
      for (int i = 0; i < NLV; i++)
        __builtin_amdgcn_global_load_lds((const void*)(v_src + (size_t)(32 * i) * Lk + kn), (LAS void*)(wb + KN_B + KR_B + i * 4096), 16, 0, 0);
    }
    const char* Kn = smem + st * STG;
    const char* Kr = Kn + KN_B;
    const char* Vs = Kr + KR_B;
#pragma unroll 1
    for (int hh = 0; hh < 2; hh++) {
      f32x16 s0;
#pragma unroll
      for (int r = 0; r < 16; r++) s0[r] = 0.f;
      const char* kpa = Kn + (hh * 32 + l31) * (CA * 16);
#pragma unroll
      for (int s = 0; s < NSA; s++) s0 = MFMA32(*(const bf16x8*)(kpa + (((2 * s + lh) ^ swA) << 4)), qf[s], s0);
      if constexpr (NSB > 0) {
        const char* kpb = Kr + (hh * 32 + l31) * 128;
#pragma unroll
        for (int s = 0; s < NSB; s++) s0 = MFMA32(*(const bf16x8*)(kpb + (((2 * s + lh) ^ swB) << 4)), qf[NSA + s], s0);
      }
      float mx = s0[0];
#pragma unroll
      for (int r = 1; r < 16; r++) mx = fmaxf(mx, s0[r]);
      mx = fmaxf(mx, __shfl_xor(mx, 32));
      if (__any(mx > m + 8.f)) {
        const float mn = fmaxf(m, mx);
        const float alpha = __builtin_amdgcn_exp2f(m - mn);
        m = mn;
        l *= alpha;
#pragma unroll
        for (int d = 0; d < NDT; d++)
#pragma unroll
          for (int r = 0; r < 16; r++) o[d][r] *= alpha;
      }
      float ps = 0.f;
#pragma unroll
      for (int r = 0; r < 16; r++) { s0[r] = __builtin_amdgcn_exp2f(s0[r] - m); ps += s0[r]; }
      l += ps;
      const char* vp = Vs + l31 * 128;
#pragma unroll
      for (int sp = 0; sp < 2; sp++) {
        u32x4 pw;
        pw[0] = pk2(s0[8 * sp + 0], s0[8 * sp + 1]); pw[1] = pk2(s0[8 * sp + 2], s0[8 * sp + 3]);
        pw[2] = pk2(s0[8 * sp + 4], s0[8 * sp + 5]); pw[3] = pk2(s0[8 * sp + 6], s0[8 * sp + 7]);
        const bf16x8 pf = __builtin_bit_cast(bf16x8, pw);
        const int vo = ((hh * 4 + sp * 2 + lh) ^ swB) << 4;
#pragma unroll
        for (int d = 0; d < NDT; d++) o[d] = MFMA32(*(const bf16x8*)(vp + d * 32 * 128 + vo), pf, o[d]);
      }
    }
    asm volatile("s_waitcnt vmcnt(0)" ::: "memory");
    __syncthreads();
  }
  l += __shfl_xor(l, 32);
  const float inv = 1.f / l;
#pragma unroll
  for (int d = 0; d < NDT; d++)
#pragma unroll
    for (int g = 0; g < 4; g++) {
      const int d0 = d * 32 + 8 * g + 4 * lh;
      const uint2 z = *(const uint2*)(szrow + d0);
      uint2 v;
      v.x = pk2(o[d][4 * g] * inv * bf2f((u16)(z.x & 0xffff)), o[d][4 * g + 1] * inv * bf2f((u16)(z.x >> 16)));
      v.y = pk2(o[d][4 * g + 2] * inv * bf2f((u16)(z.y & 0xffff)), o[d][4 * g + 3] * inv * bf2f((u16)(z.y >> 16)));
      *(uint2*)(orow + d0) = v;
    }
}

DI void attn_na_wave(const Params& p, int b, int h, int r, int j) {
  const int lane = threadIdx.x & 63, l15 = lane & 15, q4 = lane >> 4;
  const int t = TC + b * 2048 + r * 64 + j * 16 + l15;
  const u16* qrow = p.NQ + (size_t)t * 1024 + h * 64;
  const bf16x8 qf0 = *(const bf16x8*)(qrow + q4 * 8);
  const bf16x8 qf1 = *(const bf16x8*)(qrow + 32 + q4 * 8);
  const int rs = min(max(r - 4, 0), 24);
  const int bstart = min(max(j * 16 - 8, 0), 32);
  const int c = j * 16 + l15;
  const int cstart = min(max(c - 8, 0), 48);
  const u16* kb = p.NK + (size_t)(TC + b * 2304) * 1024 + h * 64;
  const u16* vb = p.NVT + (size_t)16 * 1024 * 256 + (size_t)b * (1024 * 2304) + (size_t)(h * 64) * 2304;
  const float* rp = p.na_rpb + h * 465;
  f32x4 o[4];
#pragma unroll
  for (int d = 0; d < 4; d++) { o[d][0] = 0.f; o[d][1] = 0.f; o[d][2] = 0.f; o[d][3] = 0.f; }
  float m = -1e30f, l = 0.f;
  const int krow0 = 8 * (l15 >> 2) + (l15 & 3);
  for (int cg4 = 0; cg4 < 4; cg4++) {
    bf16x8 kf[4][4];
    bf16x8 vf[4][4];
#pragma unroll
    for (int c4 = 0; c4 < 4; c4++) {
      const int ch = cg4 * 4 + c4;
      const int key0 = ch < 8 ? ch * 32 : 256 + (rs + ch - 8) * 64 + bstart;
      const u16* kp = kb + (size_t)(key0 + krow0) * 1024 + q4 * 8;
      kf[c4][0] = *(const bf16x8*)(kp);
      kf[c4][1] = *(const bf16x8*)(kp + 32);
      kf[c4][2] = *(const bf16x8*)(kp + 4 * 1024);
      kf[c4][3] = *(const bf16x8*)(kp + 4 * 1024 + 32);
#pragma unroll
      for (int d = 0; d < 4; d++) vf[c4][d] = *(const bf16x8*)(vb + (size_t)(d * 16 + l15) * 2304 + key0 + q4 * 8);
    }
#pragma unroll
    for (int c4 = 0; c4 < 4; c4++) {
      const int ch = cg4 * 4 + c4;
      f32x4 s0 = {0.f, 0.f, 0.f, 0.f}, s1 = {0.f, 0.f, 0.f, 0.f};
      s0 = MFMA16(kf[c4][0], qf0, s0);
      s0 = MFMA16(kf[c4][1], qf1, s0);
      s1 = MFMA16(kf[c4][2], qf0, s1);
      s1 = MFMA16(kf[c4][3], qf1, s1);
      if (cg4 >= 2) {
        const int dr = rs + (ch - 8) - r + 7;
#pragma unroll
        for (int i = 0; i < 4; i++) {
          const int kc0 = bstart + q4 * 8 + i, kc1 = kc0 + 4;
          const bool v0 = (kc0 >= cstart) && (kc0 < cstart + 16);
          const bool v1 = (kc1 >= cstart) && (kc1 < cstart + 16);
          const int dc0 = min(max(kc0 - c + 15, 0), 30), dc1 = min(max(kc1 - c + 15, 0), 30);
          const float b0 = rp[dr * 31 + dc0] * LOG2E, b1 = rp[dr * 31 + dc1] * LOG2E;
          s0[i] = v0 ? s0[i] + b0 : -1e30f;
          s1[i] = v1 ? s1[i] + b1 : -1e30f;
        }
      }
      float mx = fmaxf(fmaxf(fmaxf(s0[0], s0[1]), fmaxf(s0[2], s0[3])), fmaxf(fmaxf(s1[0], s1[1]), fmaxf(s1[2], s1[3])));
      mx = fmaxf(mx, __shfl_xor(mx, 16));
      mx = fmaxf(mx, __shfl_xor(mx, 32));
      const float mn = fmaxf(m, mx);
      const float alpha = __builtin_amdgcn_exp2f(m - mn);
      m = mn;
      float ps = 0.f;
#pragma unroll
      for (int i = 0; i < 4; i++) { s0[i] = exp2f(s0[i] - mn); s1[i] = exp2f(s1[i] - mn); ps += s0[i] + s1[i]; }
      l = l * alpha + ps;
      u32x4 pw; pw[0] = pk2(s0[0], s0[1]); pw[1] = pk2(s0[2], s0[3]); pw[2] = pk2(s1[0], s1[1]); pw[3] = pk2(s1[2], s1[3]);
      const bf16x8 pf = __builtin_bit_cast(bf16x8, pw);
#pragma unroll
      for (int d = 0; d < 4; d++) {
        o[d][0] *= alpha; o[d][1] *= alpha; o[d][2] *= alpha; o[d][3] *= alpha;
        o[d] = MFMA16(vf[c4][d], pf, o[d]);
      }
    }
  }
  l += __shfl_xor(l, 16);
  l += __shfl_xor(l, 32);
  const float inv = 1.f / l;
  const u16* szrow = p.SZ + (size_t)t * 1024 + h * 64;
  u16* orow = p.NAO + (size_t)t * 1024 + h * 64;
#pragma unroll
  for (int d = 0; d < 4; d++) {
    const int d0 = d * 16 + q4 * 4;
    const uint2 z = *(const uint2*)(szrow + d0);
    uint2 v;
    v.x = pk2(o[d][0] * inv * bf2f((u16)(z.x & 0xffff)), o[d][1] * inv * bf2f((u16)(z.x >> 16)));
    v.y = pk2(o[d][2] * inv * bf2f((u16)(z.y & 0xffff)), o[d][3] * inv * bf2f((u16)(z.y >> 16)));
    *(uint2*)(orow + d0) = v;
  }
}


DI void attn_na_block(const Params& p, char* smem, int b, int h, int rpair) {
  const int tid = threadIdx.x, lane = tid & 63, j = tid >> 6, l31 = lane & 31, lh = lane >> 5;
  float* bl = (float*)(smem + 65536);
  const int r0 = rpair * 2;
  const int qr = r0 + (l31 >> 4), c = j * 16 + (l31 & 15);
  const int t = TC + b * 2048 + qr * 64 + c;
  const int rsq = min(max(qr - 4, 0), 24);
  const int rs0 = min(max(r0 - 4, 0), 24);
  const int nrows = min(max(r0 + 1 - 4, 0), 24) + 8 - rs0;
  const int ntile = 4 + nrows;
  const int bstart = min(max(j * 16 - 8, 0), 32);
  const int cstart = min(max(c - 8, 0), 48);
  const u16* kb = p.NK + (size_t)(TC + b * 2304) * 1024 + h * 64;
  const u16* vb = p.NVT + (size_t)16 * 1024 * 256 + (size_t)b * (1024 * 2304) + (size_t)(h * 64) * 2304;
  const u16* qrow = p.NQ + (size_t)t * 1024 + h * 64;
  bf16x8 qf[4];
#pragma unroll
  for (int s = 0; s < 4; s++) qf[s] = *(const bf16x8*)(qrow + s * 16 + lh * 8);
  f32x16 o[2];
#pragma unroll
  for (int d = 0; d < 2; d++)
#pragma unroll
    for (int r = 0; r < 16; r++) o[d][r] = 0.f;
  float m = -1e30f, l = 0.f;
  const int r16 = l31 & 15;
  const int kap = (l31 & 16) + (r16 & 3) + 4 * ((r16 >> 3) & 1) + 8 * ((r16 >> 2) & 1);
  const int srow = tid >> 3, scc = ((tid & 7) ^ ((tid >> 4) & 7)) * 8;
  const u16* ksrc = kb + (size_t)srow * 1024 + scc;
  const u16* vsrc = vb + (size_t)srow * 2304 + scc;
  LAS char* wbase = (LAS char*)(smem + (tid >> 6) * 1024);
  const int swV = (l31 >> 1) & 7;
  __syncthreads();
  for (int idx = tid; idx < 1024; idx += 256) {
    const int dr = idx >> 6, off = (idx & 63) - 16;
    const float v = p.na_rpb[h * 465 + min(dr, 14) * 31 + min(max(off, 0), 30)] * LOG2E;
    bl[idx] = (dr == 15) ? -1e30f : ((off >= 0 && off < 31) ? v : 0.f);
  }
  float am[16];
#pragma unroll
  for (int i = 0; i < 16; i++) {
    const int kcol = bstart + 16 * (i >> 3) + 8 * lh + (i & 7);
    am[i] = ((kcol >= cstart) && (kcol < cstart + 16)) ? 0.f : -1e30f;
  }
  const int ab = 16 + bstart + 8 * lh - c + 15;
#pragma unroll
  for (int tl = 0; tl < 3; tl++) {
    const int key0 = tl * 64;
    LAS char* wb = wbase + tl * 16384;
    __builtin_amdgcn_global_load_lds((const void*)(ksrc + (size_t)key0 * 1024), (LAS void*)(wb), 16, 0, 0);
    __builtin_amdgcn_global_load_lds((const void*)(ksrc + (size_t)(key0 + 32) * 1024), (LAS void*)(wb + 4096), 16, 0, 0);
    __builtin_amdgcn_global_load_lds((const void*)(vsrc + key0), (LAS void*)(wb + 8192), 16, 0, 0);
    __builtin_amdgcn_global_load_lds((const void*)(vsrc + (size_t)32 * 2304 + key0), (LAS void*)(wb + 8192 + 4096), 16, 0, 0);
  }
  asm volatile("s_waitcnt vmcnt(8)" ::: "memory");
  asm volatile("s_waitcnt lgkmcnt(0)" ::: "memory");
  __builtin_amdgcn_s_barrier();
  for (int tl = 0; tl < ntile; tl++) {
    if (tl + 3 < ntile) {
      const int tn = tl + 3;
      const int key0 = tn < 4 ? tn * 64 : 256 + (rs0 + tn - 4) * 64;
      LAS char* wb = wbase + (tn & 3) * 16384;
      __builtin_amdgcn_global_load_lds((const void*)(ksrc + (size_t)key0 * 1024), (LAS void*)(wb), 16, 0, 0);
      __builtin_amdgcn_global_load_lds((const void*)(ksrc + (size_t)(key0 + 32) * 1024), (LAS void*)(wb + 4096), 16, 0, 0);
      __builtin_amdgcn_global_load_lds((const void*)(vsrc + key0), (LAS void*)(wb + 8192), 16, 0, 0);
      __builtin_amdgcn_global_load_lds((const void*)(vsrc + (size_t)32 * 2304 + key0), (LAS void*)(wb + 8192 + 4096), 16, 0, 0);
    }
    const char* Kc = smem + (tl & 3) * 16384;
    const char* Vc = Kc + 8192;
    const bool local = tl >= 4;
    const int gr = rs0 + tl - 4;
    const int nh = local ? 1 : 2;
    for (int hh = 0; hh < nh; hh++) {
      const int koff = local ? bstart : hh * 32;
      f32x16 s0;
#pragma unroll
      for (int r = 0; r < 16; r++) s0[r] = 0.f;
      const int krow = koff + kap;
      const char* kp = Kc + krow * 128;
      const int swK = (krow >> 1) & 7;
#pragma unroll
      for (int s = 0; s < 4; s++) s0 = MFMA32(*(const bf16x8*)(kp + (((2 * s + lh) ^ swK) << 4)), qf[s], s0);
      if (local) {
        const bool rowvalid = (gr >= rsq) && (gr < rsq + 8);
        const int dr = rowvalid ? min(max(gr - qr + 7, 0), 14) : 15;
        const float* bp = bl + dr * 64 + ab;
#pragma unroll
        for (int i = 0; i < 16; i++) s0[i] += bp[16 * (i >> 3) + (i & 7)] + am[i];
      }
      float mx = s0[0];
#pragma unroll
      for (int r = 1; r < 16; r++) mx = fmaxf(mx, s0[r]);
      mx = fmaxf(mx, __shfl_xor(mx, 32));
      if (__any(mx > m + 8.f)) {
        const float mn = fmaxf(m, mx);
        const float alpha = __builtin_amdgcn_exp2f(m - mn);
        m = mn;
        l *= alpha;
#pragma unroll
        for (int d = 0; d < 2; d++)
#pragma unroll
          for (int r = 0; r < 16; r++) o[d][r] *= alpha;
      }
      float ps = 0.f;
#pragma unroll
      for (int r = 0; r < 16; r++) { s0[r] = __builtin_amdgcn_exp2f(s0[r] - m); ps += s0[r]; }
      l += ps;
      const char* vp = Vc + l31 * 128;
      const int vch = (koff >> 3) + lh;
#pragma unroll
      for (int sp = 0; sp < 2; sp++) {
        u32x4 pw;
        pw[0] = pk2(s0[8 * sp + 0], s0[8 * sp + 1]); pw[1] = pk2(s0[8 * sp + 2], s0[8 * sp + 3]);
        pw[2] = pk2(s0[8 * sp + 4], s0[8 * sp + 5]); pw[3] = pk2(s0[8 * sp + 6], s0[8 * sp + 7]);
        const bf16x8 pf = __builtin_bit_cast(bf16x8, pw);
        const int vo = ((vch + 2 * sp) ^ swV) << 4;
#pragma unroll
        for (int d = 0; d < 2; d++) o[d] = MFMA32(*(const bf16x8*)(vp + d * 32 * 128 + vo), pf, o[d]);
      }
    }
    if (tl + 3 < ntile) asm volatile("s_waitcnt vmcnt(8)" ::: "memory");
    else if (tl + 2 < ntile) asm volatile("s_waitcnt vmcnt(4)" ::: "memory");
    else asm volatile("s_waitcnt vmcnt(0)" ::: "memory");
    asm volatile("s_waitcnt lgkmcnt(0)" ::: "memory");
    __builtin_amdgcn_s_barrier();
  }
  l += __shfl_xor(l, 32);
  const float inv = 1.f / l;
  const u16* szrow = p.SZ + (size_t)t * 1024 + h * 64;
  u16* orow = p.NAO + (size_t)t * 1024 + h * 64;
#pragma unroll
  for (int d = 0; d < 2; d++)
#pragma unroll
    for (int g = 0; g < 4; g++) {
      const int d0 = d * 32 + 8 * g + 4 * lh;
      const uint2 z = *(const uint2*)(szrow + d0);
      uint2 v;
      v.x = pk2(o[d][4 * g] * inv * bf2f((u16)(z.x & 0xffff)), o[d][4 * g + 1] * inv * bf2f((u16)(z.x >> 16)));
      v.y = pk2(o[d][4 * g + 2] * inv * bf2f((u16)(z.y & 0xffff)), o[d][4 * g + 3] * inv * bf2f((u16)(z.y >> 16)));
      *(uint2*)(orow + d0) = v;
    }
}

DI void ph_prep(const Params& p, char* smem) {
  const int tid = threadIdx.x;
  const int ntr = p.nmat_tiles;
  const int ntot = ntr + 192 + 128;
  for (int tile = blockIdx.x; tile < ntot; tile += gridDim.x) {
    __syncthreads();
    if (tile >= 192 && tile < 320) {
      const int ct = tile - 192, j = ct >> 6, r0 = (ct & 63) * 16;
      const float* sp = p.pool_w_in + (size_t)j * 1024 * 2048 + (size_t)r0 * 2048 + tid * 4;
      u16* dp = p.WinU + (size_t)j * 1024 * 1024 + (size_t)r0 * 1024 + tid * 4;
#pragma unroll 4
      for (int r = 0; r < 16; r++) {
        const float4 v = ldnt4(sp + (size_t)r * 2048);
        uint2 w; w.x = pk2(v.x, v.y); w.y = pk2(v.z, v.w);
        *(uint2*)(dp + (size_t)r * 1024) = w;
      }
    } else if (tile >= 320) {
      const int ttile = tile - 320;
      int mi = 0;
      for (int i = 1; i < 18; i++) if (ttile >= p.mats[i].tile0) mi = i;
      const float* src = p.mats[mi].src; u16* dst = p.mats[mi].dst;
      const int K = p.mats[mi].K, Nsrc = p.mats[mi].Nsrc, Ndst = p.mats[mi].Ndst;
      const int ldsrc = p.mats[mi].ld;
      const int lt = ttile - p.mats[mi].tile0;
      const int ntn = Ndst >> 6;
      const int kt = lt / ntn, nt = lt - kt * ntn;
      float* ts = (float*)smem;
#pragma unroll
      for (int i = 0; i < 4; i++) {
        const int k = i * 16 + (tid >> 4), n4 = (tid & 15) * 4, n = nt * 64 + n4;
        float4 v = {0.f, 0.f, 0.f, 0.f};
        if (n < Nsrc) v = ldnt4(src + (size_t)(kt * 64 + k) * ldsrc + n);
        ts[k * 65 + n4] = v.x; ts[k * 65 + n4 + 1] = v.y; ts[k * 65 + n4 + 2] = v.z; ts[k * 65 + n4 + 3] = v.w;
      }
      __syncthreads();
      const int n = tid >> 2, kc = (tid & 3) * 16;
      uint32_t w[8];
#pragma unroll
      for (int e = 0; e < 8; e++) w[e] = pk2(ts[(kc + 2 * e) * 65 + n], ts[(kc + 2 * e + 1) * 65 + n]);
      u16* dp = dst + (size_t)(nt * 64 + n) * K + kt * 64 + kc;
      uint4 v0; v0.x = w[0]; v0.y = w[1]; v0.z = w[2]; v0.w = w[3];
      uint4 v1; v1.x = w[4]; v1.y = w[5]; v1.z = w[6]; v1.w = w[7];
      *(uint4*)dp = v0; *(uint4*)(dp + 8) = v1;
    } else {
      const int at = tile;
      const int layer = at / 48, c0 = (at - layer * 48) * 64;
      float* sc = (float*)smem;
      float* red = sc + 5 * 1024;
      for (int i = tid; i < 5 * 1024; i += 256) {
        const int n = i >> 10, k = i & 1023;
        const float v = (n == 0) ? p.c_ctx[k] : p.c[(n - 1) * 1024 + k];
        sc[i] = silu(v);
      }
      __syncthreads();
      const int c4 = (tid & 15) * 4, kg = tid >> 4;
      float acc[5][4];
#pragma unroll
      for (int n = 0; n < 5; n++) { acc[n][0] = 0.f; acc[n][1] = 0.f; acc[n][2] = 0.f; acc[n][3] = 0.f; }
      const float* w = p.ada_w + (size_t)layer * 1024 * 3072 + c0 + c4;
#pragma unroll 4
      for (int kk = 0; kk < 64; kk++) {
        const int k = kg * 64 + kk;
        const float4 wv = ldnt4(w + (size_t)k * 3072);
#pragma unroll
        for (int n = 0; n < 5; n++) {
          const float s = sc[n * 1024 + k];
          acc[n][0] += s * wv.x; acc[n][1] += s * wv.y; acc[n][2] += s * wv.z; acc[n][3] += s * wv.w;
        }
      }
#pragma unroll
      for (int n = 0; n < 5; n++) {
        float4 r; r.x = acc[n][0]; r.y = acc[n][1]; r.z = acc[n][2]; r.w = acc[n][3];
        *(float4*)(red + (kg * 5 + n) * 64 + c4) = r;
      }
      __syncthreads();
      for (int o = tid; o < 320; o += 256) {
        const int n = o >> 6, cc = o & 63;
        float s = 0.f;
#pragma unroll
        for (int g = 0; g < 16; g++) s += red[(g * 5 + n) * 64 + cc];
        s += p.ada_b[layer * 3072 + c0 + cc];
        p.mod[(layer * 5 + n) * 3072 + c0 + cc] = s;
      }
    }
  }
}

DI void ph_h0(const Params& p) {
  for (int idx = blockIdx.x * 256 + threadIdx.x; idx < T * 128; idx += gridDim.x * 256) {
    const int t = idx >> 7, c0 = (idx & 127) * 8;
    const float* xr = (t < TC) ? p.x_prompt + (size_t)t * 1024 : p.x_sample + (size_t)(t - TC) * 1024;
    const float* md = p.mod + cond_of(t) * 3072;
    const float4 x0 = *(const float4*)(xr + c0), x1 = *(const float4*)(xr + c0 + 4);
    const float4 sh0 = *(const float4*)(md + c0), sh1 = *(const float4*)(md + c0 + 4);
    const float4 sc0 = *(const float4*)(md + 1024 + c0), sc1 = *(const float4*)(md + 1024 + c0 + 4);
    uint4 v;
    v.x = pk2(x0.x * (1.f + sc0.x) + sh0.x, x0.y * (1.f + sc0.y) + sh0.y);
    v.y = pk2(x0.z * (1.f + sc0.z) + sh0.z, x0.w * (1.f + sc0.w) + sh0.w);
    v.z = pk2(x1.x * (1.f + sc1.x) + sh1.x, x1.y * (1.f + sc1.y) + sh1.y);
    v.w = pk2(x1.z * (1.f + sc1.z) + sh1.z, x1.w * (1.f + sc1.w) + sh1.w);
    *(uint4*)(p.H + (size_t)t * 1024 + c0) = v;
  }
}

struct EpiFold {
  u16* dst;
  DI void operator()(int m, int nb, int lh, const f32x16& a) const {
#pragma unroll
    for (int g = 0; g < 4; g++) {
      uint2 v; v.x = pk2(a[4 * g], a[4 * g + 1]); v.y = pk2(a[4 * g + 2], a[4 * g + 3]);
      *(uint2*)(dst + (size_t)m * 1024 + nb + 8 * g + 4 * lh) = v;
    }
  }
};
DI void ph_fold(const Params& p, char* smem) {
  for (int tile = blockIdx.x; tile < 128; tile += gridDim.x) {
    const int jg = tile >> 4, mt = (tile >> 3) & 1, nt = tile & 7;
    const int j = jg >> 2, g = jg & 3;
    EpiFold e{p.Wpin + (size_t)j * 2048 * 1024 + (size_t)(g * 256) * 1024};
    gemm_tile<2>(p.Wgrp + (size_t)jg * 65536, 256, p.WinU + (size_t)j * 1024 * 1024 + g * 256, 1024, 256, mt * 128, nt * 128, 0, smem, e);
  }
}

template <class Epi>
DI void gemm_phase(const u16* A, int lda, const u16* Bt, int ldb, int K, int MT, int NT, char* smem, const Epi& epi) {
  const int ntile = MT * NT;
  for (int tile = blockIdx.x; tile < ntile; tile += gridDim.x) {
    const int nt = tile / MT, mt = tile - nt * MT;
    gemm_tile<3>(A, lda, Bt, ldb, K, mt * 192, nt * 128, 0, smem, epi);
  }
}

template <class Epi>
DI void gemm_phase_st(const u16* A, int lda, const u16* Bt, int ldb, int K, int MT, int NT, char* smem, const Epi& epi) {
  const int ntile = MT * NT;
  for (int tile = blockIdx.x; tile < ntile; tile += gridDim.x) {
    const int nt = tile / MT, mt = tile - nt * MT;
    gemm_tile<3, Epi, true>(A, lda, Bt, ldb, K, mt * 192, nt * 128, 0, smem, epi);
  }
}

DI void unpack8(const u32x4& u, float* f) {
  f[0] = __uint_as_float(u[0] << 16); f[1] = __uint_as_float(u[0] & 0xffff0000u);
  f[2] = __uint_as_float(u[1] << 16); f[3] = __uint_as_float(u[1] & 0xffff0000u);
  f[4] = __uint_as_float(u[2] << 16); f[5] = __uint_as_float(u[2] & 0xffff0000u);
  f[6] = __uint_as_float(u[3] << 16); f[7] = __uint_as_float(u[3] & 0xffff0000u);
}
template <int HW>
DI void mix_item(const Params& p, int rpair, const float* scale) {
  const int lane = threadIdx.x & 63;
  constexpr int g = (HW == 1) ? 0 : (HW == 2) ? 1 : (HW == 4) ? 2 : 3;
  constexpr int NR = 8 + 2 * HW;
  const int c0 = (g * 32 + (lane & 31)) * 8;
  const int t0 = (rpair * 2 + (lane >> 5)) * 8;
  int s0, L, tt0;
  if (t0 < TC) { s0 = t0 & ~255; tt0 = t0 & 255; L = 256; } else { s0 = TC + ((t0 - TC) & ~2047); tt0 = (t0 - TC) & 2047; L = 2048; }
  u32x4 rows[NR];
#pragma unroll
  for (int r = 0; r < NR; r++) {
    const int tt = tt0 - HW + r;
    u32x4 v = {0u, 0u, 0u, 0u};
    if (tt >= 0 && tt < L) v = *(const u32x4*)(p.U + (size_t)(s0 + tt) * 1024 + c0);
    rows[r] = v;
  }
  float sc8[8];
  { const float4 a = *(const float4*)(scale + c0), b = *(const float4*)(scale + c0 + 4); sc8[0] = a.x; sc8[1] = a.y; sc8[2] = a.z; sc8[3] = a.w; sc8[4] = b.x; sc8[5] = b.y; sc8[6] = b.z; sc8[7] = b.w; }
  float sum[8];
#pragma unroll
  for (int k = 0; k < 8; k++) sum[k] = 0.f;
#pragma unroll
  for (int r = 0; r < 2 * HW; r++) {
    float f[8]; unpack8(rows[r], f);
#pragma unroll
    for (int k = 0; k < 8; k++) sum[k] += f[k];
  }
#pragma unroll
  for (int e = 0; e < 8; e++) {
    const int tt = tt0 + e;
    const int lo = max(tt - HW, 0), hi = min(tt + HW, L);
    const float ic = 1.f / (float)(hi - lo);
    float own[8]; unpack8(rows[e + HW], own);
    float zz[8]; unpack8(*(const u32x4*)(p.SZ + (size_t)(s0 + tt) * 1024 + c0), zz);
    u32x4 v;
    v[0] = pk2((sum[0] * ic - own[0]) * sc8[0] * zz[0], (sum[1] * ic - own[1]) * sc8[1] * zz[1]);
    v[1] = pk2((sum[2] * ic - own[2]) * sc8[2] * zz[2], (sum[3] * ic - own[3]) * sc8[3] * zz[3]);
    v[2] = pk2((sum[4] * ic - own[4]) * sc8[4] * zz[4], (sum[5] * ic - own[5]) * sc8[5] * zz[5]);
    v[3] = pk2((sum[6] * ic - own[6]) * sc8[6] * zz[6], (sum[7] * ic - own[7]) * sc8[7] * zz[7]);
    *(u32x4*)(p.PM + (size_t)(s0 + tt) * 1024 + c0) = v;
    if (e < 7) {
      float fo[8], fi[8]; unpack8(rows[e], fo); unpack8(rows[e + 2 * HW], fi);
#pragma unroll
      for (int k = 0; k < 8; k++) sum[k] += fi[k] - fo[k];
    }
  }
}
DI void ph_mix(const Params& p, int j) {
  const int wid = threadIdx.x >> 6;
  const float* scale = p.pool_scale + j * 1024;
  for (int item = blockIdx.x * 4 + wid; item < 768 * 4; item += gridDim.x * 4) {
    const int rpair = item >> 2, g = item & 3;
    if (g == 0) mix_item<1>(p, rpair, scale);
    else if (g == 1) mix_item<2>(p, rpair, scale);
    else if (g == 2) mix_item<4>(p, rpair, scale);
    else mix_item<8>(p, rpair, scale);
  }
}

DI void ph_pool_g2(const Params& p, int j, char* smem) {
  EpiPoolG2 epi{p.PM, p.SZ, p.pool_scale + j * 1024};
  for (int tile = blockIdx.x; tile < 64 * 8; tile += gridDim.x) {
    const int gn = tile / 64, mt = tile - gn * 64;
    const int g = gn >> 1, ns = gn & 1;
    gemm_tile<3>(p.MIX + g * 256, 1024, p.Wgrp + (size_t)(j * 4 + g) * 65536, 256, 256, mt * 192, ns * 128, g * 256, smem, epi);
  }
}

DI void ln_load_row(const Params& p, int layer, int row, int lane, float* v) {
#pragma unroll
  for (int i = 0; i < 2; i++) {
    const int cc = i * 512 + lane * 8;
    float x[8];
    if (layer == 0) {
      const float* xi = (row < TC) ? p.x_prompt + (size_t)row * 1024 : p.x_sample + (size_t)(row - TC) * 1024;
      const float4 a = ldnt4(xi + cc), b = ldnt4(xi + cc + 4);
      x[0] = a.x; x[1] = a.y; x[2] = a.z; x[3] = a.w; x[4] = b.x; x[5] = b.y; x[6] = b.z; x[7] = b.w;
    } else {
      unpack8(*(const u32x4*)(p.XB + (size_t)row * 1024 + cc), x);
    }
    float g[8];
    unpack8(__builtin_nontemporal_load((const u32x4*)(p.GO + (size_t)row * 1024 + cc)), g);
#pragma unroll
    for (int k = 0; k < 8; k++) v[i * 8 + k] = ALPHA * x[k] + g[k];
  }
}
DI void ln_store_row(const Params& p, int layer, int row, int lane, const float* v, float rstd, const float* g, const float* bb) {
  const float* md = p.mod + ((layer + 1) * 5 + cond_of(row)) * 3072;
#pragma unroll
  for (int i = 0; i < 2; i++) {
    const int cc = i * 512 + lane * 8;
    const float4 g0 = *(const float4*)(g + cc), g1 = *(const float4*)(g + cc + 4);
    const float4 b0 = *(const float4*)(bb + cc), b1 = *(const float4*)(bb + cc + 4);
    float y[8];
    y[0] = v[i * 8 + 0] * rstd * g0.x + b0.x; y[1] = v[i * 8 + 1] * rstd * g0.y + b0.y;
    y[2] = v[i * 8 + 2] * rstd * g0.z + b0.z; y[3] = v[i * 8 + 3] * rstd * g0.w + b0.w;
    y[4] = v[i * 8 + 4] * rstd * g1.x + b1.x; y[5] = v[i * 8 + 5] * rstd * g1.y + b1.y;
    y[6] = v[i * 8 + 6] * rstd * g1.z + b1.z; y[7] = v[i * 8 + 7] * rstd * g1.w + b1.w;
    if (layer == 3) {
      float4 o0, o1; o0.x = y[0]; o0.y = y[1]; o0.z = y[2]; o0.w = y[3]; o1.x = y[4]; o1.y = y[5]; o1.z = y[6]; o1.w = y[7];
      stnt4(p.out + (size_t)row * 1024 + cc, o0); stnt4(p.out + (size_t)row * 1024 + cc + 4, o1);
    } else {
      u32x4 q; q[0] = pk2(y[0], y[1]); q[1] = pk2(y[2], y[3]); q[2] = pk2(y[4], y[5]); q[3] = pk2(y[6], y[7]);
      __builtin_nontemporal_store(q, (u32x4*)(p.XB + (size_t)row * 1024 + cc));
      const float4 sh0 = *(const float4*)(md + cc), sh1 = *(const float4*)(md + cc + 4);
      const float4 sc0 = *(const float4*)(md + 1024 + cc), sc1 = *(const float4*)(md + 1024 + cc + 4);
      u32x4 h;
      h[0] = pk2(y[0] * (1.f + sc0.x) + sh0.x, y[1] * (1.f + sc0.y) + sh0.y);
      h[1] = pk2(y[2] * (1.f + sc0.z) + sh0.z, y[3] * (1.f + sc0.w) + sh0.w);
      h[2] = pk2(y[4] * (1.f + sc1.x) + sh1.x, y[5] * (1.f + sc1.y) + sh1.y);
      h[3] = pk2(y[6] * (1.f + sc1.z) + sh1.z, y[7] * (1.f + sc1.w) + sh1.w);
      *(u32x4*)(p.H + (size_t)row * 1024 + cc) = h;
    }
  }
}
DI void ph_ln(const Params& p, int layer) {
  const int lane = threadIdx.x & 63, wid = threadIdx.x >> 6;
  const float* g = p.ln_g + layer * 1024;
  const float* bb = p.ln_b + layer * 1024;
  const int nw = gridDim.x * 4;
  for (int row0 = blockIdx.x * 4 + wid; row0 < T; row0 += 2 * nw) {
    const int row1 = row0 + nw;
    const bool has1 = row1 < T;
    const int r1 = has1 ? row1 : row0;
    float v0[16], v1[16];
    ln_load_row(p, layer, row0, lane, v0);
    ln_load_row(p, layer, r1, lane, v1);
    float s0 = 0.f, s1 = 0.f;
#pragma unroll
    for (int k = 0; k < 16; k++) { s0 += v0[k]; s1 += v1[k]; }
    const float mu0 = wave_sum(s0) * (1.f / 1024.f), mu1 = wave_sum(s1) * (1.f / 1024.f);
    float q0 = 0.f, q1 = 0.f;
#pragma unroll
    for (int k = 0; k < 16; k++) { v0[k] -= mu0; v1[k] -= mu1; q0 += v0[k] * v0[k]; q1 += v1[k] * v1[k]; }
    const float rs0 = rsqrtf(wave_sum(q0) * (1.f / 1024.f) + 1e-5f);
    const float rs1 = rsqrtf(wave_sum(q1) * (1.f / 1024.f) + 1e-5f);
    ln_store_row(p, layer, row0, lane, v0, rs0, g, bb);
    if (has1) ln_store_row(p, layer, row1, lane, v1, rs1, g, bb);
  }
}

DI void ph_mla_norm(const Params& p) {
  const int lane = threadIdx.x & 63, wid = threadIdx.x >> 6;
  for (int row = blockIdx.x * 4 + wid; row < T + 1024; row += gridDim.x * 4) {
    if (row < T) {
      const float* rr = p.RAW + (size_t)row * 768;
      const float4 a0 = ldnt4(rr + lane * 8), a1 = ldnt4(rr + lane * 8 + 4);
      const float4 k0 = ldnt4(rr + 512 + lane * 4);
      float s1 = a0.x * a0.x + a0.y * a0.y + a0.z * a0.z + a0.w * a0.w + a1.x * a1.x + a1.y * a1.y + a1.z * a1.z + a1.w * a1.w;
      float s2 = k0.x * k0.x + k0.y * k0.y + k0.z * k0.z + k0.w * k0.w;
      const float r1 = rsqrtf(wave_sum(s1) * (1.f / 512.f) + 1e-6f);
      const float r2 = rsqrtf(wave_sum(s2) * (1.f / 256.f) + 1e-6f);
      const float4 g0 = *(const float4*)(p.mla_q_norm + lane * 8), g1 = *(const float4*)(p.mla_q_norm + lane * 8 + 4);
      uint4 v;
      v.x = pk2(a0.x * r1 * g0.x, a0.y * r1 * g0.y); v.y = pk2(a0.z * r1 * g0.z, a0.w * r1 * g0.w);
      v.z = pk2(a1.x * r1 * g1.x, a1.y * r1 * g1.y); v.w = pk2(a1.z * r1 * g1.z, a1.w * r1 * g1.w);
      *(uint4*)(p.CQN + (size_t)row * 512 + lane * 8) = v;
      const float4 kg = *(const float4*)(p.mla_kv_norm + lane * 4);
      float4 kn; kn.x = k0.x * r2 * kg.x; kn.y = k0.y * r2 * kg.y; kn.z = k0.z * r2 * kg.z; kn.w = k0.w * r2 * kg.w;
      uint2 kv; kv.x = pk2(kn.x, kn.y); kv.y = pk2(kn.z, kn.w);
      *(uint2*)(p.CKVN + (size_t)kvrow_of(row) * 256 + lane * 4) = kv;
      if (row < TC) stnt4(p.out + OUT_CKV + (size_t)row * 256 + lane * 4, kn);
    } else {
      const int cr = row - T, b = cr >> 8, pp = cr & 255;
      const size_t kvr = (size_t)TC + b * 2304 + pp;
      const float4 k0 = ldnt4(p.cache_ckv + (size_t)cr * 256 + lane * 4);
      uint2 kv; kv.x = pk2(k0.x, k0.y); kv.y = pk2(k0.z, k0.w);
      *(uint2*)(p.CKVN + kvr * 256 + lane * 4) = kv;
      p.KR[kvr * 64 + lane] = f2bf(p.cache_kr[(size_t)cr * 64 + lane]);
    }
  }
}

DI void ph_mla_g2(const Params& p, char* smem) {
  EpiMlaQ eq{p.Q};
  EpiMlaKV ekv{p.KN, p.VT};
  const int G = gridDim.x, b = blockIdx.x;
  const int nq = 64 * 12, nkv = 104 * 16;
  const int nq2 = nq - G > 0 ? nq - G : 0;
  for (int qt = b; qt < nq; qt += G) {
    const int nt = qt / 64, mt = qt - nt * 64;
    gemm_tile<3>(p.CQN, 512, p.Wuq, 512, 512, mt * 192, nt * 128, 0, smem, eq);
  }
  int k0, kstep, kend;
  if (b < nq2) { k0 = b; kstep = nq2; kend = 2 * nq2; }
  else { k0 = 2 * nq2 + (b - nq2); kstep = G - nq2; kend = nkv; }
  if (G != 512) { k0 = b; kstep = G; kend = nkv; }
  for (int kt = k0; kt < kend; kt += kstep) {
    const int nt = kt / 104, mt = kt - nt * 104;
    gemm_tile<2, EpiMlaKV, true>(p.CKVN, 256, p.Wukv, 256, 256, mt * 128, nt * 128, 0, smem, ekv);
  }
}

DI void ph_mla_attn(const Params& p, char* smem) {
  const int wid = threadIdx.x >> 6, l31 = threadIdx.x & 31;
  for (int u = blockIdx.x; u < 768; u += gridDim.x) {
    int t0, kvrow0, nkeys, Lk, h; size_t vbase;
    if (u < 512) {
      const int xcd = u & 7, slot = u >> 3; const int pair = xcd * 4 + (slot >> 4); const int qb = slot & 15;
      const int b = pair >> 3; h = pair & 7;
      t0 = TC + b * 2048 + qb * 128 + wid * 32; kvrow0 = TC + b * 2304; nkeys = 2304; Lk = 2304;
      vbase = (size_t)16 * 8 * 128 * 256 + (size_t)b * (8 * 128 * 2304) + (size_t)h * 128 * 2304;
    } else {
      const int v = u - 512; const int b = v >> 4; h = (v >> 1) & 7; const int qb = v & 1;
      t0 = b * 256 + qb * 128 + wid * 32; kvrow0 = b * 256; nkeys = 256; Lk = 256;
      vbase = (size_t)b * (8 * 128 * 256) + (size_t)h * 128 * 256;
    }
    const int t = t0 + l31;
    attn_dense_block<8, 4, 4>(smem, p.Q + (size_t)t * 1536 + h * 192, p.KN + (size_t)kvrow0 * 1024 + h * 128, 1024,
                             p.KR + (size_t)kvrow0 * 64, p.VT + vbase, Lk, nkeys,
                             p.SZ + (size_t)t * 1024 + h * 128, p.AO + (size_t)t * 1024 + h * 128);
  }
}

DI void ph_na_g1(const Params& p, char* smem) {
  EpiNaG1 epi{p.NQ, p.NK, p.NVT, p.SZ, p.out + OUT_NAK, p.out + OUT_NAV};
  const int n1 = 64 * 32;
  for (int tile = blockIdx.x; tile < n1 + 64; tile += gridDim.x) {
    if (tile < n1) {
      const int nt = tile / 64, mt = tile - nt * 64;
      gemm_tile<3, EpiNaG1, true>(p.H, 1024, p.Wnin, 1024, 1024, mt * 192, nt * 128, 0, smem, epi);
    } else {
      const int ct = tile - n1;
      const int b = ct >> 4, p0 = (ct & 15) * 16;
      const int c4 = threadIdx.x * 4;
      const size_t kvb = (size_t)TC + b * 2304;
      u16* vtb = p.NVT + (size_t)16 * 1024 * 256 + (size_t)b * (1024 * 2304);
      float vv[4][16];
#pragma unroll
      for (int i = 0; i < 16; i++) {
        const size_t src = ((size_t)(b * 256 + p0 + i)) * 1024 + c4;
        const float4 k = ldnt4(p.cache_nak + src);
        uint2 kv; kv.x = pk2(k.x, k.y); kv.y = pk2(k.z, k.w);
        *(uint2*)(p.NK + (kvb + p0 + i) * 1024 + c4) = kv;
        const float4 v = ldnt4(p.cache_nav + src);
        vv[0][i] = v.x; vv[1][i] = v.y; vv[2][i] = v.z; vv[3][i] = v.w;
      }
#pragma unroll
      for (int e = 0; e < 4; e++) {
        uint4 w0, w1;
        w0.x = pk2(vv[e][0], vv[e][1]); w0.y = pk2(vv[e][2], vv[e][3]); w0.z = pk2(vv[e][4], vv[e][5]); w0.w = pk2(vv[e][6], vv[e][7]);
        w1.x = pk2(vv[e][8], vv[e][9]); w1.y = pk2(vv[e][10], vv[e][11]); w1.z = pk2(vv[e][12], vv[e][13]); w1.w = pk2(vv[e][14], vv[e][15]);
        u16* dp = vtb + (size_t)(c4 + e) * 2304 + p0;
        *(uint4*)dp = w0; *(uint4*)(dp + 8) = w1;
      }
    }
  }
}

DI void ph_na_attn(const Params& p, char* smem) {
  const int wid = threadIdx.x >> 6, l31 = threadIdx.x & 31;
  for (int u = blockIdx.x; u < 1024 + 512; u += gridDim.x) {
    if (u < 1024) {
      const int xcd = u & 7, slot = u >> 3;
      const int pair = xcd * 8 + (slot >> 4), rpair = slot & 15;
      attn_na_block(p, smem, pair >> 4, pair & 15, rpair);
    } else {
      const int v = u - 1024;
      const int b = v >> 5, h = (v >> 1) & 15, qb = v & 1;
      const int t = b * 256 + qb * 128 + wid * 32 + l31;
      attn_dense_block<4, 0, 2>(smem, p.NQ + (size_t)t * 1024 + h * 64, p.NK + (size_t)(b * 256) * 1024 + h * 64, 1024, nullptr,
                               p.NVT + (size_t)b * (1024 * 256) + (size_t)h * 64 * 256, 256, 256,
                               p.SZ + (size_t)t * 1024 + h * 64, p.NAO + (size_t)t * 1024 + h * 64);
    }
  }
}

template <int ph>
DI void run_phase(const Params& p, char* smem) {
  if constexpr (ph == 0) ph_prep(p, smem);
  else if constexpr (ph == 1) { ph_h0(p); ph_fold(p, smem); }
  else if constexpr (ph == 2 || ph == 17) {
    constexpr int j = (ph == 2) ? 0 : 1;
    EpiPoolG1 e{p.U, p.SZ};
    gemm_phase(p.H, 1024, p.Wpin + (size_t)j * 2048 * 1024, 1024, 1024, 64, 16, smem, e);
  }
  else if constexpr (ph == 3 || ph == 18) ph_mix(p, (ph == 3) ? 0 : 1);
  else if constexpr (ph == 5) {
    EpiG3 e{p.GO, p.mod};
    gemm_phase_st(p.PM, 1024, p.Wpout, 1024, 1024, 64, 8, smem, e);
  }
  else if constexpr (ph == 20) {
    EpiG3 e{p.GO, p.mod + 3 * 5 * 3072};
    gemm_phase_st(p.PM, 1024, p.Wpout + (size_t)1024 * 1024, 1024, 1024, 64, 8, smem, e);
  }
  else if constexpr (ph == 6) ph_ln(p, 0);
  else if constexpr (ph == 21) ph_ln(p, 3);
  else if constexpr (ph == 7) {
    EpiMlaG1 e{p.RAW, p.KR, p.SZ, p.out + OUT_KR};
    gemm_phase(p.H, 1024, p.Wmin, 1024, 1024, 64, 15, smem, e);
  }
  else if constexpr (ph == 8) ph_mla_norm(p);
  else if constexpr (ph == 9) ph_mla_g2(p, smem);
  else if constexpr (ph == 10) ph_mla_attn(p, smem);
  else if constexpr (ph == 11) {
    EpiG3 e{p.GO, p.mod + 1 * 5 * 3072};
    gemm_phase_st(p.AO, 1024, p.Wmout, 1024, 1024, 64, 8, smem, e);
  }
  else if constexpr (ph == 12) ph_ln(p, 1);
  else if constexpr (ph == 13) ph_na_g1(p, smem);
  else if constexpr (ph == 14) ph_na_attn(p, smem);
  else if constexpr (ph == 15) {
    EpiG3 e{p.GO, p.mod + 2 * 5 * 3072};
    gemm_phase_st(p.NAO, 1024, p.Wnout, 1024, 1024, 64, 8, smem, e);
  }
  else if constexpr (ph == 16) ph_ln(p, 2);
}

#define RUN_PH(n) if (ph_lo <= (n) && (n) < ph_hi) { run_phase<n>(p, smem); if ((n) + 1 < ph_hi) xcd_barrier(xb); }

__global__ void __launch_bounds__(256, 2) mega(Params p, int ph_lo, int ph_hi) {
  __shared__ __attribute__((aligned(16))) char smem[SMEM_BYTES];
  if (ph_lo < 0) { cg::this_grid().sync(); return; }
  const bool multi = (ph_hi - ph_lo) > 1;
  XcdBarrier xb; xb.bar = p.bar; xb.x = 0; xb.nloc = 0u; xb.nx = 0u;
  if (multi) xb = xcd_barrier_post(p.bar);
  RUN_PH(0) RUN_PH(1) RUN_PH(2) RUN_PH(3) RUN_PH(5) RUN_PH(6) RUN_PH(7) RUN_PH(8) RUN_PH(9) RUN_PH(10)
  RUN_PH(11) RUN_PH(12) RUN_PH(13) RUN_PH(14) RUN_PH(15) RUN_PH(16) RUN_PH(17) RUN_PH(18) RUN_PH(20) RUN_PH(21)
}

extern "C" void kernel_launch(void* const* d_in, const int* in_sizes, int n_in, void* d_out, int out_size, void* d_ws, size_t ws_size,
                              hipStream_t stream) {
  Params p;
  memset(&p, 0, sizeof(p));
  const float* const* in = (const float* const*)d_in;
  p.x_prompt = in[0]; p.x_sample = in[1]; p.cache_ckv = in[2]; p.cache_kr = in[3]; p.cache_nak = in[4]; p.cache_nav = in[5];
  p.c = in[6]; p.c_ctx = in[7]; p.ada_w = in[8]; p.ada_b = in[9]; p.ln_g = in[10]; p.ln_b = in[11];
  const float* pool_w_in = in[12]; const float* pool_w_grp = in[13]; p.pool_scale = in[14]; const float* pool_w_out = in[15];
  const float* mla_w_in = in[16]; p.mla_q_norm = in[17]; const float* mla_w_uq = in[18]; p.mla_kv_norm = in[19];
  const float* mla_w_ukv = in[20]; const float* mla_w_out = in[21]; const float* na_w_in = in[22]; p.na_rpb = in[23];
  const float* na_w_out = in[24];
  p.out = (float*)d_out;

  char* ws = (char*)d_ws;
  size_t off = 0;
  auto take = [&](size_t bytes) { char* r = ws + off; off += (bytes + 255) & ~(size_t)255; return r; };
  p.bar = (unsigned*)take(XCD_BAR_WORDS * 4);
  p.mod = (float*)take((size_t)4 * 5 * 3072 * 4);
  p.Wpin = (u16*)take((size_t)2 * 2048 * 1024 * 2);
  p.Wgrp = (u16*)take((size_t)8 * 65536 * 2);
  p.Wpout = (u16*)take((size_t)2 * 1024 * 1024 * 2);
  p.Wmin = (u16*)take((size_t)1920 * 1024 * 2);
  p.Wuq = (u16*)take((size_t)1536 * 512 * 2);
  p.Wukv = (u16*)take((size_t)2048 * 256 * 2);
  p.Wmout = (u16*)take((size_t)1024 * 1024 * 2);
  p.Wnin = (u16*)take((size_t)4096 * 1024 * 2);
  p.Wnout = (u16*)take((size_t)1024 * 1024 * 2);
  p.H = (u16*)take((size_t)T * 1024 * 2);
  p.SZ = (u16*)take((size_t)T * 1024 * 2);
  p.XB = (u16*)take((size_t)T * 1024 * 2);
  p.WinU = (u16*)take((size_t)2 * 1024 * 1024 * 2);
  p.pool_w_in = pool_w_in;
  const size_t arena0 = off;
  p.U = (u16*)take((size_t)T * 1024 * 2);
  p.MIX = (u16*)take((size_t)T * 1024 * 2);
  p.GO = p.MIX;
  p.PM = (u16*)take((size_t)T * 1024 * 2);
  off = arena0;
  p.RAW = (float*)take((size_t)T * 768 * 4);
  p.AO = (u16*)p.RAW;
  p.CQN = (u16*)take((size_t)T * 512 * 2);
  p.CKVN = (u16*)take((size_t)KVR * 256 * 2);
  p.KR = (u16*)take((size_t)KVR * 64 * 2);
  p.Q = (u16*)take((size_t)T * 1536 * 2);
  p.KN = (u16*)take((size_t)KVR * 1024 * 2);
  p.VT = (u16*)take((size_t)KVR * 1024 * 2);
  off = arena0;
  p.NQ = (u16*)take((size_t)T * 1024 * 2);
  p.NK = (u16*)take((size_t)KVR * 1024 * 2);
  p.NVT = (u16*)take((size_t)KVR * 1024 * 2);
  p.NAO = (u16*)take((size_t)T * 1024 * 2);

  int nm = 0, tiles = 0;
  auto add = [&](const float* src, u16* dst, int K, int Nsrc, int Ndst, int ld = 0) {
    p.mats[nm].src = src; p.mats[nm].dst = dst; p.mats[nm].K = K; p.mats[nm].Nsrc = Nsrc; p.mats[nm].Ndst = Ndst; p.mats[nm].tile0 = tiles; p.mats[nm].ld = ld ? ld : Nsrc;
    tiles += (K / 64) * (Ndst / 64); nm++;
  };
  for (int j = 0; j < 2; j++) add(pool_w_in + (size_t)j * 1024 * 2048 + 1024, p.Wpin + (size_t)j * 2048 * 1024 + (size_t)1024 * 1024, 1024, 1024, 1024, 2048);
  for (int j = 0; j < 8; j++) add(pool_w_grp + (size_t)j * 65536, p.Wgrp + (size_t)j * 65536, 256, 256, 256);
  for (int j = 0; j < 2; j++) add(pool_w_out + (size_t)j * 1024 * 1024, p.Wpout + (size_t)j * 1024 * 1024, 1024, 1024, 1024);
  add(mla_w_in, p.Wmin, 1024, 1856, 1920);
  add(mla_w_uq, p.Wuq, 512, 1536, 1536);
  add(mla_w_ukv, p.Wukv, 256, 2048, 2048);
  add(mla_w_out, p.Wmout, 1024, 1024, 1024);
  add(na_w_in, p.Wnin, 1024, 4096, 4096);
  add(na_w_out, p.Wnout, 1024, 1024, 1024);
  p.nmat_tiles = tiles;

  (void)hipMemsetAsync(p.bar, 0, XCD_BAR_WORDS * 4, stream);
#if MULTI_LAUNCH
  for (int ph = 0; ph < NPHASE; ph++) hipLaunchKernelGGL(mega, dim3(512), dim3(256), 0, stream, p, ph, ph + 1);
#else
  static int grid_blocks = 0;
  if (!grid_blocks) {
    int dev = 0, cus = 0, per_cu = 0;
    hipGetDevice(&dev);
    hipDeviceGetAttribute(&cus, hipDeviceAttributeMultiprocessorCount, dev);
    hipOccupancyMaxActiveBlocksPerMultiprocessor(&per_cu, mega, 256, 0);
    if (per_cu > 2) per_cu = 2;
    if (per_cu < 1) per_cu = 1;
    grid_blocks = cus * per_cu;
  }
  int lo = 0, hi = NPHASE;
  void* args[] = {&p, &lo, &hi};
  hipError_t e = hipLaunchCooperativeKernel((void*)mega, dim3(grid_blocks), dim3(256), args, 0, stream);
  if (e != hipSuccess) fprintf(stderr, "cooperative launch failed: %s (grid %d)\n", hipGetErrorString(e), grid_blocks);
#endif
}
```

```cpp
#include <hip/hip_runtime.h>
#include <hip/hip_cooperative_groups.h>
#include <stdint.h>
#include <string.h>
#include <stdio.h>
namespace cg = cooperative_groups;

#ifndef MULTI_LAUNCH
#define MULTI_LAUNCH 0
#endif

typedef __attribute__((ext_vector_type(8))) short bf16x8;
typedef __attribute__((ext_vector_type(4))) float f32x4;
typedef __attribute__((ext_vector_type(16))) float f32x16;
typedef __attribute__((ext_vector_type(4))) uint32_t u32x4;
typedef unsigned short u16;
#define DI __device__ __forceinline__
#define MFMA32(a, b, c) __builtin_amdgcn_mfma_f32_32x32x16_bf16((a), (b), (c), 0, 0, 0)
#define MFMA16(a, b, c) __builtin_amdgcn_mfma_f32_16x16x32_bf16((a), (b), (c), 0, 0, 0)

constexpr int TC = 4096, TL = 8192, T = 12288;
constexpr int KVR = 4096 + 4 * 2304;
constexpr float LOG2E = 1.4426950408889634f;
constexpr float ALPHA = 1.681792830507429f;
constexpr float MLA_QS = 0.07216878364870323f * LOG2E;
constexpr float NA_QS = 0.125f * LOG2E;
constexpr int SMEM_BYTES = 81920;
constexpr int NPHASE = 22;

constexpr size_t OUT_YS = 4194304, OUT_CKV = 12582912, OUT_KR = 13631488, OUT_NAK = 13893632, OUT_NAV = 18087936;

struct MatDesc { const float* src; u16* dst; int K, Nsrc, Ndst, tile0, ld, pad; };

struct Params {
  const float *x_prompt, *x_sample, *cache_ckv, *cache_kr, *cache_nak, *cache_nav, *c, *c_ctx, *ada_w, *ada_b, *ln_g, *ln_b;
  const float *pool_scale, *mla_q_norm, *mla_kv_norm, *na_rpb;
  float* out;
  float* mod;
  u16 *H, *SZ, *GO, *WinU, *XB;
  const float* pool_w_in;
  u16 *Wpin, *Wgrp, *Wpout, *Wmin, *Wuq, *Wukv, *Wmout, *Wnin, *Wnout;
  u16 *U, *MIX, *PM;
  float* RAW; u16 *AO, *CQN, *CKVN, *KR, *Q, *KN, *VT;
  u16 *NQ, *NK, *NVT, *NAO;
  unsigned* bar;
  MatDesc mats[18];
  int nmat_tiles; int pad0;
};

DI float bf2f(u16 v) { return __uint_as_float(((uint32_t)v) << 16); }
typedef __attribute__((ext_vector_type(2))) float f32x2;
typedef __attribute__((ext_vector_type(2))) __bf16 bf16x2_t;
DI uint32_t pk2(float a, float b) { f32x2 v = {a, b}; return __builtin_bit_cast(uint32_t, __builtin_convertvector(v, bf16x2_t)); }
DI u16 f2bf(float x) { return (u16)(pk2(x, x) & 0xffffu); }
DI float4 ldnt4(const float* p) {
  typedef __attribute__((ext_vector_type(4))) float f4;
  const f4 v = __builtin_nontemporal_load((const f4*)p);
  float4 r; r.x = v[0]; r.y = v[1]; r.z = v[2]; r.w = v[3];
  return r;
}
DI uint2 ldnt2u(const void* p) {
  typedef __attribute__((ext_vector_type(2))) uint32_t u2;
  const u2 v = __builtin_nontemporal_load((const u2*)p);
  uint2 r; r.x = v[0]; r.y = v[1];
  return r;
}
DI void stnt4(float* p, const float4& a) {
  typedef __attribute__((ext_vector_type(4))) float f4;
  f4 v; v[0] = a.x; v[1] = a.y; v[2] = a.z; v[3] = a.w;
  __builtin_nontemporal_store(v, (f4*)p);
}
DI void stnt2u(void* p, const uint2& a) {
  typedef __attribute__((ext_vector_type(2))) uint32_t u2;
  u2 v; v[0] = a.x; v[1] = a.y;
  __builtin_nontemporal_store(v, (u2*)p);
}
DI float silu(float v) { return v / (1.f + __expf(-v)); }
DI int cond_of(int t) { return t < TC ? 0 : 1 + ((t - TC) >> 11); }
DI int kvrow_of(int t) { return t < TC ? t : TC + ((t - TC) >> 11) * 2304 + 256 + ((t - TC) & 2047); }
DI int perm16(int key) { const int k = key & 15; return (key & ~15) | (k & 3) | ((k >> 1) & 4) | ((k << 1) & 8); }
DI float wave_sum(float v) {
#pragma unroll
  for (int o = 32; o >= 1; o >>= 1) v += __shfl_xor(v, o);
  return v;
}

#define XB_TMO      128
#define XB_XCNT(j)  (256  + 64 * (j))
#define XB_XSUB(j)  (1280 + 64 * (j))
#define XB_XGEN(j)  (2304 + 64 * (j))
#define XB_TOP      3328
#define XB_TOPGEN   3392
#define XCD_BAR_WORDS 3456
#define XB_SPIN_CAP (1u << 22)
#define LAS __attribute__((address_space(3)))
DI unsigned xb_ld(unsigned* p) { return __hip_atomic_load(p, __ATOMIC_RELAXED, __HIP_MEMORY_SCOPE_AGENT); }
DI unsigned xb_add(unsigned* p, unsigned v) { return __hip_atomic_fetch_add(p, v, __ATOMIC_RELAXED, __HIP_MEMORY_SCOPE_AGENT); }
DI unsigned xb_xcc_id() { return (unsigned)__builtin_amdgcn_s_getreg((3 << 11) | 20) & 0xFu; }
#define XB_SPIN(cond, bar) do { unsigned _sp = 0; while (cond) { __builtin_amdgcn_s_sleep(1); \
    if ((++_sp & 255u) == 0u) { if (xb_ld(&(bar)[XB_TMO])) break; if (_sp > XB_SPIN_CAP) { atomicAdd(&(bar)[XB_TMO], 1u); break; } } } } while (0)
struct XcdBarrier { unsigned* bar; unsigned x; unsigned nloc, nx; };
DI XcdBarrier xcd_barrier_post(unsigned* bar) {
  XcdBarrier b; b.bar = bar; b.x = xb_xcc_id(); b.nloc = 0u; b.nx = 0u;
  if (threadIdx.x == 0) (void)xb_add(&bar[XB_XCNT(b.x)], 1u);
  return b;
}
DI void xcd_barrier_complete(unsigned* bar, unsigned x, unsigned& nloc, unsigned& nx) {
  const unsigned G = gridDim.x * gridDim.y * gridDim.z;
  unsigned sum, cnt, mine, sp = 0u;
  for (;;) {
    sum = 0u; cnt = 0u; mine = 0u;
#pragma unroll
    for (unsigned j = 0; j < 16; ++j) { const unsigned c = xb_ld(&bar[XB_XCNT(j)]); sum += c; cnt += (c > 0u) ? 1u : 0u; mine = (j == x) ? c : mine; }
    if (sum == G) break;
    __builtin_amdgcn_s_sleep(1);
    if ((++sp & 255u) == 0u) { if (xb_ld(&bar[XB_TMO])) break; if (sp > XB_SPIN_CAP) { atomicAdd(&bar[XB_TMO], 1u); break; } }
  }
  nloc = mine > 0u ? mine : 1u; nx = cnt > 0u ? cnt : 1u;
}
DI void xcd_barrier(XcdBarrier& b) {
  asm volatile("s_waitcnt vmcnt(0)" ::: "memory");
  __syncthreads();
  unsigned nloc = b.nloc, nx = b.nx;
  if (threadIdx.x == 0) {
    unsigned* bar = b.bar;
    __builtin_amdgcn_s_waitcnt(0);
    if (nloc == 0u) { xcd_barrier_complete(bar, b.x, nloc, nx); }
    const unsigned old = xb_add(&bar[XB_XSUB(b.x)], 1u);
    const unsigned gen = old / nloc;
    if (old + 1u == (gen + 1u) * nloc) {
      __builtin_amdgcn_fence(__ATOMIC_RELEASE, "agent");
      asm volatile("s_waitcnt vmcnt(0)" ::: "memory");
      const unsigned og = xb_add(&bar[XB_TOP], 1u);
      const unsigned tg = og / nx;
      if (og + 1u == (tg + 1u) * nx) xb_add(&bar[XB_TOPGEN], 1u);
      else XB_SPIN(xb_ld(&bar[XB_TOPGEN]) == tg, bar);
      __builtin_amdgcn_fence(__ATOMIC_ACQUIRE, "agent");
      xb_add(&bar[XB_XGEN(b.x)], 1u);
      asm volatile("s_waitcnt vmcnt(0)" ::: "memory");
    } else {
      XB_SPIN(xb_ld(&bar[XB_XGEN(b.x)]) == gen, bar);
      __builtin_amdgcn_fence(__ATOMIC_ACQUIRE, "agent");
      asm volatile("s_waitcnt vmcnt(0)" ::: "memory");
    }
  }
  if (threadIdx.x < 64) { b.nloc = __builtin_amdgcn_readfirstlane(nloc); b.nx = __builtin_amdgcn_readfirstlane(nx); }
  __syncthreads();
}

template <int MI, class Epi, bool STAGED = false>
DI void gemm_tile(const u16* __restrict__ A, int lda, const u16* __restrict__ Bt, int ldb, int K, int m0, int n0, int nout_off,
                  char* smem, const Epi& epi) {
  constexpr int BM = 64 * MI, ASTG = BM * 128, NG = 2 * MI + 4;
  const int tid = threadIdx.x, lane = tid & 63, wid = tid >> 6;
  const int wm = wid >> 1, wn = wid & 1, l31 = lane & 31, lh = lane >> 5;
  char* As = smem;
  char* Bs = smem + 2 * ASTG;
  const int srow = tid >> 3;
  const int scc = ((tid & 7) ^ ((tid >> 4) & 7)) * 8;
  const u16* ag = A + (size_t)(m0 + srow) * lda + scc;
  const u16* bg = Bt + (size_t)(n0 + srow) * ldb + scc;
  LAS char* awr = (LAS char*)(As + wid * 1024);
  LAS char* bwr = (LAS char*)(Bs + wid * 1024);
  f32x16 acc[MI][2];
#pragma unroll
  for (int i = 0; i < MI; i++)
#pragma unroll
    for (int j = 0; j < 2; j++)
#pragma unroll
      for (int r = 0; r < 16; r++) acc[i][j][r] = 0.f;
  const int nk = K >> 6;
  const int rot = (n0 >> 7) + (m0 >> 6);
  __syncthreads();
#pragma unroll
  for (int t = 0; t < 2; t++) {
#pragma unroll
    for (int i = 0; i < 2 * MI; i++)
      __builtin_amdgcn_global_load_lds((const void*)(ag + (size_t)(32 * i) * lda + ((t + rot) & (nk - 1)) * 64), (LAS void*)(awr + t * ASTG + i * 4096), 16, 0, 0);
#pragma unroll
    for (int i = 0; i < 4; i++)
      __builtin_amdgcn_global_load_lds((const void*)(bg + (size_t)(32 * i) * ldb + ((t + rot) & (nk - 1)) * 64), (LAS void*)(bwr + t * 16384 + i * 4096), 16, 0, 0);
  }
  const int sw = (l31 >> 1) & 7;
  for (int kt = 0; kt < nk; kt++) {
    const int buf = kt & 1;
    if (kt + 1 < nk) asm volatile("s_waitcnt vmcnt(%0)" :: "n"(NG) : "memory");
    else asm volatile("s_waitcnt vmcnt(0)" ::: "memory");
    __builtin_amdgcn_s_barrier();
    const char* as = As + buf * ASTG + (wm * (32 * MI) + l31) * 128;
    const char* bs = Bs + buf * 16384 + (wn * 64 + l31) * 128;
    bf16x8 fa[4][MI], fb[4][2];
#pragma unroll
    for (int ks = 0; ks < 4; ks++) {
      const int co = ((2 * ks + lh) ^ sw) << 4;
      fb[ks][0] = *(const bf16x8*)(bs + co);
      fb[ks][1] = *(const bf16x8*)(bs + 32 * 128 + co);
#pragma unroll
      for (int i = 0; i < MI; i++) fa[ks][i] = *(const bf16x8*)(as + i * 32 * 128 + co);
    }
    asm volatile("s_waitcnt lgkmcnt(0)" ::: "memory");
    __builtin_amdgcn_s_barrier();
    if (kt + 2 < nk) {
#pragma unroll
      for (int i = 0; i < 2 * MI; i++)
        __builtin_amdgcn_global_load_lds((const void*)(ag + (size_t)(32 * i) * lda + ((kt + 2 + rot) & (nk - 1)) * 64), (LAS void*)(awr + buf * ASTG + i * 4096), 16, 0, 0);
#pragma unroll
      for (int i = 0; i < 4; i++)
        __builtin_amdgcn_global_load_lds((const void*)(bg + (size_t)(32 * i) * ldb + ((kt + 2 + rot) & (nk - 1)) * 64), (LAS void*)(bwr + buf * 16384 + i * 4096), 16, 0, 0);
    }
#pragma unroll
    for (int ks = 0; ks < 4; ks++)
#pragma unroll
      for (int i = 0; i < MI; i++) {
        acc[i][0] = MFMA32(fb[ks][0], fa[ks][i], acc[i][0]);
        acc[i][1] = MFMA32(fb[ks][1], fa[ks][i], acc[i][1]);
      }
  }
  if constexpr (STAGED) {
    float* stg = (float*)(smem + wid * 8704);
    const int nbw = nout_off + n0 + wn * 64;
#pragma unroll
    for (int i = 0; i < MI; i++) {
      const int mb = m0 + wm * (32 * MI) + i * 32;
#pragma unroll
      for (int j = 0; j < 2; j++)
#pragma unroll
        for (int g = 0; g < 4; g++) {
          float4 v; v.x = acc[i][j][4 * g]; v.y = acc[i][j][4 * g + 1]; v.z = acc[i][j][4 * g + 2]; v.w = acc[i][j][4 * g + 3];
          *(float4*)(stg + l31 * 68 + j * 32 + 8 * g + 4 * lh) = v;
        }
      asm volatile("s_waitcnt lgkmcnt(0)" ::: "memory");
      __builtin_amdgcn_wave_barrier();
      bool rows = true;
      if constexpr (Epi::HAS_VT) {
        if (epi.is_vt(nbw)) {
          rows = epi.vt_rows(mb);
          const bool perm = epi.vt_perm(mb);
#pragma unroll
          for (int it = 0; it < 4; it++) {
            const int n = lane, q = it;
            float v[8];
            int pos;
            if (perm) {
              const int rb = (q >> 1) * 16 + (q & 1) * 4;
#pragma unroll
              for (int k = 0; k < 8; k++) v[k] = stg[(rb + (k & 3) + 8 * (k >> 2)) * 68 + n];
              pos = (q >> 1) * 16 + (q & 1) * 8;
            } else {
#pragma unroll
              for (int k = 0; k < 8; k++) v[k] = stg[(q * 8 + k) * 68 + n];
              pos = q * 8;
            }
            epi.vt8(mb, nbw + n, pos, v);
          }
        }
      }
      if (rows) {
#pragma unroll
        for (int it = 0; it < 8; it++) {
          const int row = it * 4 + (lane >> 4), col = (lane & 15) * 4;
          const float4 v = *(const float4*)(stg + row * 68 + col);
          epi.row4(mb + row, nbw + col, v);
        }
      }
      asm volatile("s_waitcnt lgkmcnt(0)" ::: "memory");
      __builtin_amdgcn_wave_barrier();
    }
  } else {
#pragma unroll
    for (int i = 0; i < MI; i++)
#pragma unroll
      for (int j = 0; j < 2; j++)
        epi(m0 + wm * (32 * MI) + i * 32 + l31, nout_off + n0 + wn * 64 + j * 32, lh, acc[i][j]);
  }
}

DI void rope_pair(float x1, float x2, int i, float pos, float& o1, float& o2) {
  const float inv = exp2f(-(float)i * (13.287712379549449f / 16.f));
  const float ang = pos * inv;
  const float c = __cosf(ang), s = __sinf(ang);
  o1 = x1 * c - x2 * s;
  o2 = x1 * s + x2 * c;
}

struct EpiPoolG1 {
  u16 *U, *SZ;
  DI void operator()(int m, int nb, int lh, const f32x16& a) const {
#pragma unroll
    for (int g = 0; g < 4; g++) {
      const int n = nb + 8 * g + 4 * lh;
      if (nb < 1024) {
        uint2 v; v.x = pk2(a[4 * g], a[4 * g + 1]); v.y = pk2(a[4 * g + 2], a[4 * g + 3]);
        *(uint2*)(U + (size_t)m * 1024 + n) = v;
      } else {
        uint2 v; v.x = pk2(silu(a[4 * g]), silu(a[4 * g + 1])); v.y = pk2(silu(a[4 * g + 2]), silu(a[4 * g + 3]));
        *(uint2*)(SZ + (size_t)m * 1024 + n - 1024) = v;
      }
    }
  }
};
struct EpiPoolG2 {
  u16* PM; const u16* SZ; const float* scale;
  DI void operator()(int m, int nb, int lh, const f32x16& a) const {
#pragma unroll
    for (int g = 0; g < 4; g++) {
      const int n = nb + 8 * g + 4 * lh;
      const uint2 z = *(const uint2*)(SZ + (size_t)m * 1024 + n);
      const float4 sc = *(const float4*)(scale + n);
      uint2 v;
      v.x = pk2(a[4 * g] * sc.x * bf2f((u16)(z.x & 0xffff)), a[4 * g + 1] * sc.y * bf2f((u16)(z.x >> 16)));
      v.y = pk2(a[4 * g + 2] * sc.z * bf2f((u16)(z.y & 0xffff)), a[4 * g + 3] * sc.w * bf2f((u16)(z.y >> 16)));
      *(uint2*)(PM + (size_t)m * 1024 + n) = v;
    }
  }
};
struct EpiG3 {
  static constexpr bool HAS_VT = false;
  u16* GO; const float* mod_layer;
  DI void row4(int m, int n, const float4& a) const {
    const float4 gt = *(const float4*)(mod_layer + cond_of(m) * 3072 + 2048 + n);
    uint2 v; v.x = pk2(gt.x * a.x, gt.y * a.y); v.y = pk2(gt.z * a.z, gt.w * a.w);
    *(uint2*)(GO + (size_t)m * 1024 + n) = v;
  }
  DI void operator()(int m, int nb, int lh, const f32x16& a) const {
    const float* gate = mod_layer + cond_of(m) * 3072 + 2048;
#pragma unroll
    for (int g = 0; g < 4; g++) {
      const int n = nb + 8 * g + 4 * lh;
      const float4 gt = *(const float4*)(gate + n);
      uint2 v; v.x = pk2(gt.x * a[4 * g], gt.y * a[4 * g + 1]); v.y = pk2(gt.z * a[4 * g + 2], gt.w * a[4 * g + 3]);
      *(uint2*)(GO + (size_t)m * 1024 + n) = v;
    }
  }
};
struct EpiMlaG1 {
  float* RAW; u16* KR; u16* SZ; float* st_kr;
  DI void operator()(int m, int nb, int lh, const f32x16& a) const {
    if (nb >= 1856) return;
    if (nb < 768) {
#pragma unroll
      for (int g = 0; g < 4; g++) {
        const int n = nb + 8 * g + 4 * lh;
        float4 r; r.x = a[4 * g]; r.y = a[4 * g + 1]; r.z = a[4 * g + 2]; r.w = a[4 * g + 3];
        *(float4*)(RAW + (size_t)m * 768 + n) = r;
      }
    } else if (nb < 832) {
      const int off = nb - 768;
      const bool lat = m >= TC;
      const int tt = (m - TC) & 2047;
      const float pos = (off == 0) ? (float)(tt >> 6) : (float)(tt & 63);
      const size_t kr = (size_t)kvrow_of(m) * 64 + off;
#pragma unroll
      for (int g = 0; g < 2; g++) {
        float o1[4], o2[4];
#pragma unroll
        for (int e = 0; e < 4; e++) {
          const int i = 8 * g + 4 * lh + e;
          const float x1 = a[4 * g + e], x2 = a[4 * (g + 2) + e];
          if (lat) rope_pair(x1, x2, i, pos, o1[e], o2[e]); else { o1[e] = x1; o2[e] = x2; }
        }
        const int i0 = 8 * g + 4 * lh;
        if (!lat) {
          float4 r1; r1.x = o1[0]; r1.y = o1[1]; r1.z = o1[2]; r1.w = o1[3];
          float4 r2; r2.x = o2[0]; r2.y = o2[1]; r2.z = o2[2]; r2.w = o2[3];
          *(float4*)(st_kr + (size_t)m * 64 + off + i0) = r1;
          *(float4*)(st_kr + (size_t)m * 64 + off + i0 + 16) = r2;
        }
        uint2 v1; v1.x = pk2(o1[0], o1[1]); v1.y = pk2(o1[2], o1[3]);
        uint2 v2; v2.x = pk2(o2[0], o2[1]); v2.y = pk2(o2[2], o2[3]);
        *(uint2*)(KR + kr + i0) = v1;
        *(uint2*)(KR + kr + i0 + 16) = v2;
      }
    } else {
#pragma unroll
      for (int g = 0; g < 4; g++) {
        const int n = nb + 8 * g + 4 * lh - 832;
        uint2 v; v.x = pk2(silu(a[4 * g]), silu(a[4 * g + 1])); v.y = pk2(silu(a[4 * g + 2]), silu(a[4 * g + 3]));
        *(uint2*)(SZ + (size_t)m * 1024 + n) = v;
      }
    }
  }
};
struct EpiMlaQ {
  u16* Q;
  DI void operator()(int m, int nb, int lh, const f32x16& a) const {
    const int head = nb / 192, off = nb - head * 192;
    u16* qr = Q + (size_t)m * 1536 + nb;
    if (off < 128) {
#pragma unroll
      for (int g = 0; g < 4; g++) {
        uint2 v; v.x = pk2(a[4 * g] * MLA_QS, a[4 * g + 1] * MLA_QS); v.y = pk2(a[4 * g + 2] * MLA_QS, a[4 * g + 3] * MLA_QS);
        *(uint2*)(qr + 8 * g + 4 * lh) = v;
      }
    } else {
      const bool lat = m >= TC;
      const int tt = (m - TC) & 2047;
      const float pos = (off == 128) ? (float)(tt >> 6) : (float)(tt & 63);
#pragma unroll
      for (int g = 0; g < 2; g++) {
        float o1[4], o2[4];
#pragma unroll
        for (int e = 0; e < 4; e++) {
          const int i = 8 * g + 4 * lh + e;
          const float x1 = a[4 * g + e], x2 = a[4 * (g + 2) + e];
          if (lat) rope_pair(x1, x2, i, pos, o1[e], o2[e]); else { o1[e] = x1; o2[e] = x2; }
        }
        const int i0 = 8 * g + 4 * lh;
        uint2 v1; v1.x = pk2(o1[0] * MLA_QS, o1[1] * MLA_QS); v1.y = pk2(o1[2] * MLA_QS, o1[3] * MLA_QS);
        uint2 v2; v2.x = pk2(o2[0] * MLA_QS, o2[1] * MLA_QS); v2.y = pk2(o2[2] * MLA_QS, o2[3] * MLA_QS);
        *(uint2*)(qr + i0) = v1;
        *(uint2*)(qr + i0 + 16) = v2;
      }
    }
  }
};
struct EpiMlaKV {
  u16 *KN, *VT;
  static constexpr bool HAS_VT = true;
  DI bool is_vt(int nb) const { return (nb & 255) >= 128; }
  DI bool vt_perm(int mb) const { return true; }
  DI bool vt_rows(int mb) const { return false; }
  DI void row4(int m, int n, const float4& a) const {
    const int head = n >> 8, off = n & 255;
    uint2 v; v.x = pk2(a.x, a.y); v.y = pk2(a.z, a.w);
    *(uint2*)(KN + (size_t)m * 1024 + head * 128 + off) = v;
  }
  DI void vt8(int mb, int n, int pos, const float* v) const {
    const int head = n >> 8, d = (n & 255) - 128;
    size_t base; int Lk, key0;
    if (mb < TC) { base = (size_t)(mb >> 8) * (8 * 128 * 256); Lk = 256; key0 = mb & 255; }
    else { const int r2 = mb - TC; const int b = r2 / 2304; key0 = r2 - b * 2304; Lk = 2304; base = (size_t)16 * 8 * 128 * 256 + (size_t)b * (8 * 128 * 2304); }
    uint4 w; w.x = pk2(v[0], v[1]); w.y = pk2(v[2], v[3]); w.z = pk2(v[4], v[5]); w.w = pk2(v[6], v[7]);
    *(uint4*)(VT + base + (size_t)(head * 128 + d) * Lk + key0 + pos) = w;
  }
  DI void operator()(int m, int nb, int lh, const f32x16& a) const {
    const int head = nb >> 8, off = nb & 255;
    if (off < 128) {
#pragma unroll
      for (int g = 0; g < 4; g++) {
        uint2 v; v.x = pk2(a[4 * g], a[4 * g + 1]); v.y = pk2(a[4 * g + 2], a[4 * g + 3]);
        *(uint2*)(KN + (size_t)m * 1024 + head * 128 + off + 8 * g + 4 * lh) = v;
      }
    } else {
      size_t base; int Lk, key;
      if (m < TC) { base = (size_t)(m >> 8) * (8 * 128 * 256); Lk = 256; key = m & 255; }
      else { const int r2 = m - TC; const int b = r2 / 2304; key = r2 - b * 2304; Lk = 2304; base = (size_t)16 * 8 * 128 * 256 + (size_t)b * (8 * 128 * 2304); }
      u16* vp = VT + base + (size_t)(head * 128 + off - 128) * Lk + perm16(key);
#pragma unroll
      for (int g = 0; g < 4; g++)
#pragma unroll
        for (int e = 0; e < 4; e++) vp[(size_t)(8 * g + 4 * lh + e) * Lk] = f2bf(a[4 * g + e]);
    }
  }
};
struct EpiNaG1 {
  u16 *NQ, *NK, *NVT, *SZ; float *st_k, *st_v;
  static constexpr bool HAS_VT = true;
  DI bool is_vt(int nb) const { return nb >= 2048 && nb < 3072; }
  DI bool vt_perm(int mb) const { return mb < TC; }
  DI bool vt_rows(int mb) const { return mb < TC; }
  DI void row4(int m, int n, const float4& a) const {
    if (n < 1024) {
      uint2 v; v.x = pk2(a.x * NA_QS, a.y * NA_QS); v.y = pk2(a.z * NA_QS, a.w * NA_QS);
      *(uint2*)(NQ + (size_t)m * 1024 + n) = v;
    } else if (n < 2048) {
      uint2 v; v.x = pk2(a.x, a.y); v.y = pk2(a.z, a.w);
      *(uint2*)(NK + (size_t)kvrow_of(m) * 1024 + (n - 1024)) = v;
      if (m < TC) stnt4(st_k + (size_t)m * 1024 + (n - 1024), a);
    } else if (n < 3072) {
      if (m < TC) stnt4(st_v + (size_t)m * 1024 + (n - 2048), a);
    } else {
      uint2 v; v.x = pk2(silu(a.x), silu(a.y)); v.y = pk2(silu(a.z), silu(a.w));
      *(uint2*)(SZ + (size_t)m * 1024 + (n - 3072)) = v;
    }
  }
  DI void vt8(int mb, int n, int pos, const float* v) const {
    const int c0 = n - 2048;
    size_t base; int Lk, key0;
    if (mb < TC) { base = (size_t)(mb >> 8) * (1024 * 256); Lk = 256; key0 = mb & 255; }
    else { const int b = (mb - TC) >> 11; key0 = 256 + ((mb - TC) & 2047); Lk = 2304; base = (size_t)16 * 1024 * 256 + (size_t)b * (1024 * 2304); }
    uint4 w; w.x = pk2(v[0], v[1]); w.y = pk2(v[2], v[3]); w.z = pk2(v[4], v[5]); w.w = pk2(v[6], v[7]);
    *(uint4*)(NVT + base + (size_t)c0 * Lk + key0 + pos) = w;
  }
  DI void operator()(int m, int nb, int lh, const f32x16& a) const {
    if (nb < 1024) {
#pragma unroll
      for (int g = 0; g < 4; g++) {
        uint2 v; v.x = pk2(a[4 * g] * NA_QS, a[4 * g + 1] * NA_QS); v.y = pk2(a[4 * g + 2] * NA_QS, a[4 * g + 3] * NA_QS);
        *(uint2*)(NQ + (size_t)m * 1024 + nb + 8 * g + 4 * lh) = v;
      }
    } else if (nb < 2048) {
      const size_t kr = (size_t)kvrow_of(m) * 1024 + (nb - 1024);
#pragma unroll
      for (int g = 0; g < 4; g++) {
        uint2 v; v.x = pk2(a[4 * g], a[4 * g + 1]); v.y = pk2(a[4 * g + 2], a[4 * g + 3]);
        *(uint2*)(NK + kr + 8 * g + 4 * lh) = v;
        if (m < TC) { float4 r; r.x = a[4 * g]; r.y = a[4 * g + 1]; r.z = a[4 * g + 2]; r.w = a[4 * g + 3];
          *(float4*)(st_k + (size_t)m * 1024 + (nb - 1024) + 8 * g + 4 * lh) = r; }
      }
    } else if (nb < 3072) {
      const int c0 = nb - 2048;
      size_t base; int Lk, key;
      if (m < TC) { base = (size_t)(m >> 8) * (1024 * 256); Lk = 256; key = perm16(m & 255); }
      else { const int b = (m - TC) >> 11; key = 256 + ((m - TC) & 2047); Lk = 2304; base = (size_t)16 * 1024 * 256 + (size_t)b * (1024 * 2304); }
      u16* vp = NVT + base + (size_t)c0 * Lk + key;
#pragma unroll
      for (int g = 0; g < 4; g++) {
#pragma unroll
        for (int e = 0; e < 4; e++) vp[(size_t)(8 * g + 4 * lh + e) * Lk] = f2bf(a[4 * g + e]);
        if (m < TC) { float4 r; r.x = a[4 * g]; r.y = a[4 * g + 1]; r.z = a[4 * g + 2]; r.w = a[4 * g + 3];
          *(float4*)(st_v + (size_t)m * 1024 + c0 + 8 * g + 4 * lh) = r; }
      }
    } else {
#pragma unroll
      for (int g = 0; g < 4; g++) {
        uint2 v; v.x = pk2(silu(a[4 * g]), silu(a[4 * g + 1])); v.y = pk2(silu(a[4 * g + 2]), silu(a[4 * g + 3]));
        *(uint2*)(SZ + (size_t)m * 1024 + (nb - 3072) + 8 * g + 4 * lh) = v;
      }
    }
  }
};

template <int NSA, int NSB, int NDT>
DI void attn_dense_wave(const u16* __restrict__ qrow, const u16* __restrict__ kA, int kAstride, const u16* __restrict__ kB,
                        const u16* __restrict__ vt, int Lk, int nkeys, const u16* __restrict__ szrow, u16* __restrict__ orow) {
  const int lane = threadIdx.x & 63, l31 = lane & 31, lh = lane >> 5;
  bf16x8 qf[NSA + NSB];
#pragma unroll
  for (int s = 0; s < NSA + NSB; s++) qf[s] = *(const bf16x8*)(qrow + s * 16 + lh * 8);
  f32x16 o[NDT];
#pragma unroll
  for (int d = 0; d < NDT; d++)
#pragma unroll
    for (int r = 0; r < 16; r++) o[d][r] = 0.f;
  float m = -1e30f, l = 0.f;
  for (int k0 = 0; k0 < nkeys; k0 += 32) {
    f32x16 sa;
#pragma unroll
    for (int r = 0; r < 16; r++) sa[r] = 0.f;
    const u16* kp = kA + (size_t)(k0 + l31) * kAstride + lh * 8;
#pragma unroll
    for (int s = 0; s < NSA; s++) sa = MFMA32(*(const bf16x8*)(kp + s * 16), qf[s], sa);
    if (NSB > 0) {
      const u16* kp2 = kB + (size_t)(k0 + l31) * 64 + lh * 8;
#pragma unroll
      for (int s = 0; s < NSB; s++) sa = MFMA32(*(const bf16x8*)(kp2 + s * 16), qf[NSA + s], sa);
    }
    float mx = sa[0];
#pragma unroll
    for (int r = 1; r < 16; r++) mx = fmaxf(mx, sa[r]);
    mx = fmaxf(mx, __shfl_xor(mx, 32));
    const float mn = fmaxf(m, mx);
    const float alpha = __builtin_amdgcn_exp2f(m - mn);
    m = mn;
    float ps = 0.f;
#pragma unroll
    for (int r = 0; r < 16; r++) { sa[r] = exp2f(sa[r] - mn); ps += sa[r]; }
    l = l * alpha + ps;
#pragma unroll
    for (int d = 0; d < NDT; d++)
#pragma unroll
      for (int r = 0; r < 16; r++) o[d][r] *= alpha;
#pragma unroll
    for (int sp = 0; sp < 2; sp++) {
      u32x4 pw;
      pw[0] = pk2(sa[8 * sp + 0], sa[8 * sp + 1]); pw[1] = pk2(sa[8 * sp + 2], sa[8 * sp + 3]);
      pw[2] = pk2(sa[8 * sp + 4], sa[8 * sp + 5]); pw[3] = pk2(sa[8 * sp + 6], sa[8 * sp + 7]);
      const bf16x8 pf = __builtin_bit_cast(bf16x8, pw);
#pragma unroll
      for (int d = 0; d < NDT; d++) {
        const u16* vp = vt + (size_t)(d * 32 + l31) * Lk + k0 + 16 * sp + 4 * lh;
        const uint2 lo = *(const uint2*)vp, hi = *(const uint2*)(vp + 8);
        u32x4 vw; vw[0] = lo.x; vw[1] = lo.y; vw[2] = hi.x; vw[3] = hi.y;
        o[d] = MFMA32(__builtin_bit_cast(bf16x8, vw), pf, o[d]);
      }
    }
  }
  l += __shfl_xor(l, 32);
  const float inv = 1.f / l;
#pragma unroll
  for (int d = 0; d < NDT; d++)
#pragma unroll
    for (int g = 0; g < 4; g++) {
      const int d0 = d * 32 + 8 * g + 4 * lh;
      const uint2 z = *(const uint2*)(szrow + d0);
      uint2 v;
      v.x = pk2(o[d][4 * g] * inv * bf2f((u16)(z.x & 0xffff)), o[d][4 * g + 1] * inv * bf2f((u16)(z.x >> 16)));
      v.y = pk2(o[d][4 * g + 2] * inv * bf2f((u16)(z.y & 0xffff)), o[d][4 * g + 3] * inv * bf2f((u16)(z.y >> 16)));
      *(uint2*)(orow + d0) = v;
    }
}


template <int NSA, int NSB, int NDT>
DI void attn_dense_block(char* smem, const u16* __restrict__ qrow, const u16* __restrict__ kA, int kAstride, const u16* __restrict__ kB,
                         const u16* __restrict__ vt, int Lk, int nkeys, const u16* __restrict__ szrow, u16* __restrict__ orow) {
  constexpr int NS = NSA + NSB, DV = 32 * NDT, CA = NSA * 2;
  constexpr int KN_B = 64 * CA * 16, KR_B = (NSB > 0) ? 64 * 128 : 0, V_B = DV * 128, STG = KN_B + KR_B + V_B;
  constexpr int NLA = 64 * CA / 256, NLB = (NSB > 0) ? 2 : 0, NLV = DV * 8 / 256;
  const int tid = threadIdx.x, lane = tid & 63, wid = tid >> 6, l31 = lane & 31, lh = lane >> 5;
  const int arow = (CA == 16) ? (tid >> 4) : (tid >> 3);
  const int acc_ = (CA == 16) ? ((tid & 15) ^ ((tid >> 4) & 15)) : ((tid & 7) ^ ((tid >> 4) & 7));
  const int brow = tid >> 3, bcc = (tid & 7) ^ ((tid >> 4) & 7);
  const u16* ka_src = kA + (size_t)arow * kAstride + acc_ * 8;
  const u16* kb_src = (NSB > 0) ? (kB + (size_t)brow * 64 + bcc * 8) : kA;
  const u16* v_src = vt + (size_t)brow * Lk + bcc * 8;
  LAS char* wbase = (LAS char*)(smem + wid * 1024);
  bf16x8 qf[NS];
#pragma unroll
  for (int s = 0; s < NS; s++) qf[s] = *(const bf16x8*)(qrow + s * 16 + lh * 8);
  f32x16 o[NDT];
#pragma unroll
  for (int d = 0; d < NDT; d++)
#pragma unroll
    for (int r = 0; r < 16; r++) o[d][r] = 0.f;
  float m = -1e30f, l = 0.f;
  const int swA = (CA == 16) ? (l31 & 15) : ((l31 >> 1) & 7);
  const int swB = (l31 >> 1) & 7;

  __syncthreads();
#pragma unroll
  for (int i = 0; i < NLA; i++)
    __builtin_amdgcn_global_load_lds((const void*)(ka_src + (size_t)(i * (256 / CA)) * kAstride), (LAS void*)(wbase + i * 4096), 16, 0, 0);
#pragma unroll
  for (int i = 0; i < NLB; i++)
    __builtin_amdgcn_global_load_lds((const void*)(kb_src + (size_t)(32 * i) * 64), (LAS void*)(wbase + KN_B + i * 4096), 16, 0, 0);
#pragma unroll
  for (int i = 0; i < NLV; i++)
    __builtin_amdgcn_global_load_lds((const void*)(v_src + (size_t)(32 * i) * Lk), (LAS void*)(wbase + KN_B + KR_B + i * 4096), 16, 0, 0);
  asm volatile("s_waitcnt vmcnt(0)" ::: "memory");
  __syncthreads();
  int st = 0;
  for (int k0 = 0; k0 < nkeys; k0 += 64, st ^= 1) {
    if (k0 + 64 < nkeys) {
      const int kn = k0 + 64;
      LAS char* wb = wbase + (st ^ 1) * STG;
#pragma unroll
      for (int i = 0; i < NLA; i++)
        __builtin_amdgcn_global_load_lds((const void*)(ka_src + (size_t)(kn + i * (256 / CA)) * kAstride), (LAS void*)(wb + i * 4096), 16, 0, 0);
#pragma unroll
      for (int i = 0; i < NLB; i++)
        __builtin_amdgcn_global_load_lds((const void*)(kb_src + (size_t)(kn + 32 * i) * 64), (LAS void*)(wb + KN_B + i * 4096), 16, 0, 0);
#pragma unroll
      for (int i = 0; i < NLV; i++)
        __builtin_amdgcn_global_load_lds((const void*)(v_src + (size_t)(32 * i) * Lk + kn), (LAS void*)(wb + KN_B + KR_B + i * 4096), 16, 0, 0);
    }
    const char* Kn = smem + st * STG;
    const char* Kr = Kn + KN_B;
    const char* Vs = Kr + KR_B;
#pragma unroll 1
    for (int hh = 0; hh < 2; hh++) {
      f32x16 s0;
#pragma unroll
      for (int r = 0; r < 16; r++) s0[r] = 0.f;
      const char* kpa = Kn + (hh * 32 + l31) * (CA * 16);
#pragma unroll
      for (int s = 0; s < NSA; s++) s0 = MFMA32(*(const bf16x8*)(kpa + (((2 * s + lh) ^ swA) << 4)), qf[s], s0);
      if constexpr (NSB > 0) {
        const char* kpb = Kr + (hh * 32 + l31) * 128;
#pragma unroll
        for (int s = 0; s < NSB; s++) s0 = MFMA32(*(const bf16x8*)(kpb + (((2 * s + lh) ^ swB) << 4)), qf[NSA + s], s0);
      }
      float mx = s0[0];
#pragma unroll
      for (int r = 1; r < 16; r++) mx = fmaxf(mx, s0[r]);
      mx = fmaxf(mx, __shfl_xor(mx, 32));
      if (__any(mx > m + 8.f)) {
        const float mn = fmaxf(m, mx);
        const float alpha = __builtin_amdgcn_exp2f(m - mn);
        m = mn;
        l *= alpha;
#pragma unroll
        for (int d = 0; d < NDT; d++)
#pragma unroll
          for (int r = 0; r < 16; r++) o[d][r] *= alpha;
      }
      float ps = 0.f;
#pragma unroll
      for (int r = 0; r < 16; r++) { s0[r] = __builtin_amdgcn_exp2f(s0[r] - m); ps += s0[r]; }
      l += ps;
      const char* vp = Vs + l31 * 128;
#pragma unroll
      for (int sp = 0; sp < 2; sp++) {
        u32x4 pw;
        pw[0] = pk2(s0[8 * sp + 0], s0[8 * sp + 1]); pw[1] = pk2(s0[8 * sp + 2], s0[8 * sp + 3]);
        pw[2] = pk2(s0[8 * sp + 4], s0[8 * sp + 5]); pw[3] = pk2(s0[8 * sp + 6], s0[8 * sp + 7]);
        const bf16x8 pf = __builtin_bit_cast(bf16x8, pw);
        const int vo = ((hh * 4 + sp * 2 + lh) ^ swB) << 4;
#pragma unroll
        for (int d = 0; d < NDT; d++) o[d] = MFMA32(*(const bf16x8*)(vp + d * 32 * 128 + vo), pf, o[d]);
      }
    }
    asm volatile("s_waitcnt vmcnt(0)" ::: "memory");
    __syncthreads();
  }
  l += __shfl_xor(l, 32);
  const float inv = 1.f / l;
#pragma unroll
  for (int d = 0; d < NDT; d++)
#pragma unroll
    for (int g = 0; g < 4; g++) {
      const int d0 = d * 32 + 8 * g + 4 * lh;
      const uint2 z = *(const uint2*)(szrow + d0);
      uint2 v;
      v.x = pk2(o[d][4 * g] * inv * bf2f((u16)(z.x & 0xffff)), o[d][4 * g + 1] * inv * bf2f((u16)(z.x >> 16)));
      v.y = pk2(o[d][4 * g + 2] * inv * bf2f((u16)(z.y & 0xffff)), o[d][4 * g + 3] * inv * bf2f((u16)(z.y >> 16)));
      *(uint2*)(orow + d0) = v;
    }
}

DI void attn_na_wave(const Params& p, int b, int h, int r, int j) {
  const int lane = threadIdx.x & 63, l15 = lane & 15, q4 = lane >> 4;
  const int t = TC + b * 2048 + r * 64 + j * 16 + l15;
  const u16* qrow = p.NQ + (size_t)t * 1024 + h * 64;
  const bf16x8 qf0 = *(const bf16x8*)(qrow + q4 * 8);
  const bf16x8 qf1 = *(const bf16x8*)(qrow + 32 + q4 * 8);
  const int rs = min(max(r - 4, 0), 24);
  const int bstart = min(max(j * 16 - 8, 0), 32);
  const int c = j * 16 + l15;
  const int cstart = min(max(c - 8, 0), 48);
  const u16* kb = p.NK + (size_t)(TC + b * 2304) * 1024 + h * 64;
  const u16* vb = p.NVT + (size_t)16 * 1024 * 256 + (size_t)b * (1024 * 2304) + (size_t)(h * 64) * 2304;
  const float* rp = p.na_rpb + h * 465;
  f32x4 o[4];
#pragma unroll
  for (int d = 0; d < 4; d++) { o[d][0] = 0.f; o[d][1] = 0.f; o[d][2] = 0.f; o[d][3] = 0.f; }
  float m = -1e30f, l = 0.f;
  const int krow0 = 8 * (l15 >> 2) + (l15 & 3);
  for (int cg4 = 0; cg4 < 4; cg4++) {
    bf16x8 kf[4][4];
    bf16x8 vf[4][4];
#pragma unroll
    for (int c4 = 0; c4 < 4; c4++) {
      const int ch = cg4 * 4 + c4;
      const int key0 = ch < 8 ? ch * 32 : 256 + (rs + ch - 8) * 64 + bstart;
      const u16* kp = kb + (size_t)(key0 + krow0) * 1024 + q4 * 8;
      kf[c4][0] = *(const bf16x8*)(kp);
      kf[c4][1] = *(const bf16x8*)(kp + 32);
      kf[c4][2] = *(const bf16x8*)(kp + 4 * 1024);
      kf[c4][3] = *(const bf16x8*)(kp + 4 * 1024 + 32);
#pragma unroll
      for (int d = 0; d < 4; d++) vf[c4][d] = *(const bf16x8*)(vb + (size_t)(d * 16 + l15) * 2304 + key0 + q4 * 8);
    }
#pragma unroll
    for (int c4 = 0; c4 < 4; c4++) {
      const int ch = cg4 * 4 + c4;
      f32x4 s0 = {0.f, 0.f, 0.f, 0.f}, s1 = {0.f, 0.f, 0.f, 0.f};
      s0 = MFMA16(kf[c4][0], qf0, s0);
      s0 = MFMA16(kf[c4][1], qf1, s0);
      s1 = MFMA16(kf[c4][2], qf0, s1);
      s1 = MFMA16(kf[c4][3], qf1, s1);
      if (cg4 >= 2) {
        const int dr = rs + (ch - 8) - r + 7;
#pragma unroll
        for (int i = 0; i < 4; i++) {
          const int kc0 = bstart + q4 * 8 + i, kc1 = kc0 + 4;
          const bool v0 = (kc0 >= cstart) && (kc0 < cstart + 16);
          const bool v1 = (kc1 >= cstart) && (kc1 < cstart + 16);
          const int dc0 = min(max(kc0 - c + 15, 0), 30), dc1 = min(max(kc1 - c + 15, 0), 30);
          const float b0 = rp[dr * 31 + dc0] * LOG2E, b1 = rp[dr * 31 + dc1] * LOG2E;
          s0[i] = v0 ? s0[i] + b0 : -1e30f;
          s1[i] = v1 ? s1[i] + b1 : -1e30f;
        }
      }
      float mx = fmaxf(fmaxf(fmaxf(s0[0], s0[1]), fmaxf(s0[2], s0[3])), fmaxf(fmaxf(s1[0], s1[1]), fmaxf(s1[2], s1[3])));
      mx = fmaxf(mx, __shfl_xor(mx, 16));
      mx = fmaxf(mx, __shfl_xor(mx, 32));
      const float mn = fmaxf(m, mx);
      const float alpha = __builtin_amdgcn_exp2f(m - mn);
      m = mn;
      float ps = 0.f;
#pragma unroll
      for (int i = 0; i < 4; i++) { s0[i] = exp2f(s0[i] - mn); s1[i] = exp2f(s1[i] - mn); ps += s0[i] + s1[i]; }
      l = l * alpha + ps;
      u32x4 pw; pw[0] = pk2(s0[0], s0[1]); pw[1] = pk2(s0[2], s0[3]); pw[2] = pk2(s1[0], s1[1]); pw[3] = pk2(s1[2], s1[3]);
      const bf16x8 pf = __builtin_bit_cast(bf16x8, pw);
#pragma unroll
      for (int d = 0; d < 4; d++) {
        o[d][0] *= alpha; o[d][1] *= alpha; o[d][2] *= alpha; o[d][3] *= alpha;
        o[d] = MFMA16(vf[c4][d], pf, o[d]);
      }
    }
  }
  l += __shfl_xor(l, 16);
  l += __shfl_xor(l, 32);
  const float inv = 1.f / l;
  const u16* szrow = p.SZ + (size_t)t * 1024 + h * 64;
  u16* orow = p.NAO + (size_t)t * 1024 + h * 64;
#pragma unroll
  for (int d = 0; d < 4; d++) {
    const int d0 = d * 16 + q4 * 4;
    const uint2 z = *(const uint2*)(szrow + d0);
    uint2 v;
    v.x = pk2(o[d][0] * inv * bf2f((u16)(z.x & 0xffff)), o[d][1] * inv * bf2f((u16)(z.x >> 16)));
    v.y = pk2(o[d][2] * inv * bf2f((u16)(z.y & 0xffff)), o[d][3] * inv * bf2f((u16)(z.y >> 16)));
    *(uint2*)(orow + d0) = v;
  }
}


DI void attn_na_block(const Params& p, char* smem, int b, int h, int rpair) {
  const int tid = threadIdx.x, lane = tid & 63, j = tid >> 6, l31 = lane & 31, lh = lane >> 5;
  float* bl = (float*)(smem + 65536);
  const int r0 = rpair * 2;
  const int qr = r0 + (l31 >> 4), c = j * 16 + (l31 & 15);
  const int t = TC + b * 2048 + qr * 64 + c;
  const int rsq = min(max(qr - 4, 0), 24);
  const int rs0 = min(max(r0 - 4, 0), 24);
  const int nrows = min(max(r0 + 1 - 4, 0), 24) + 8 - rs0;
  const int ntile = 4 + nrows;
  const int bstart = min(max(j * 16 - 8, 0), 32);
  const int cstart = min(max(c - 8, 0), 48);
  const u16* kb = p.NK + (size_t)(TC + b * 2304) * 1024 + h * 64;
  const u16* vb = p.NVT + (size_t)16 * 1024 * 256 + (size_t)b * (1024 * 2304) + (size_t)(h * 64) * 2304;
  const u16* qrow = p.NQ + (size_t)t * 1024 + h * 64;
  bf16x8 qf[4];
#pragma unroll
  for (int s = 0; s < 4; s++) qf[s] = *(const bf16x8*)(qrow + s * 16 + lh * 8);
  f32x16 o[2];
#pragma unroll
  for (int d = 0; d < 2; d++)
#pragma unroll
    for (int r = 0; r < 16; r++) o[d][r] = 0.f;
  float m = -1e30f, l = 0.f;
  const int r16 = l31 & 15;
  const int kap = (l31 & 16) + (r16 & 3) + 4 * ((r16 >> 3) & 1) + 8 * ((r16 >> 2) & 1);
  const int srow = tid >> 3, scc = ((tid & 7) ^ ((tid >> 4) & 7)) * 8;
  const u16* ksrc = kb + (size_t)srow * 1024 + scc;
  const u16* vsrc = vb + (size_t)srow * 2304 + scc;
  LAS char* wbase = (LAS char*)(smem + (tid >> 6) * 1024);
  const int swV = (l31 >> 1) & 7;
  __syncthreads();
  for (int idx = tid; idx < 1024; idx += 256) {
    const int dr = idx >> 6, off = (idx & 63) - 16;
    const float v = p.na_rpb[h * 465 + min(dr, 14) * 31 + min(max(off, 0), 30)] * LOG2E;
    bl[idx] = (dr == 15) ? -1e30f : ((off >= 0 && off < 31) ? v : 0.f);
  }
  float am[16];
#pragma unroll
  for (int i = 0; i < 16; i++) {
    const int kcol = bstart + 16 * (i >> 3) + 8 * lh + (i & 7);
    am[i] = ((kcol >= cstart) && (kcol < cstart + 16)) ? 0.f : -1e30f;
  }
  const int ab = 16 + bstart + 8 * lh - c + 15;
#pragma unroll
  for (int tl = 0; tl < 3; tl++) {
    const int key0 = tl * 64;
    LAS char* wb = wbase + tl * 16384;
    __builtin_amdgcn_global_load_lds((const void*)(ksrc + (size_t)key0 * 1024), (LAS void*)(wb), 16, 0, 0);
    __builtin_amdgcn_global_load_lds((const void*)(ksrc + (size_t)(key0 + 32) * 1024), (LAS void*)(wb + 4096), 16, 0, 0);
    __builtin_amdgcn_global_load_lds((const void*)(vsrc + key0), (LAS void*)(wb + 8192), 16, 0, 0);
    __builtin_amdgcn_global_load_lds((const void*)(vsrc + (size_t)32 * 2304 + key0), (LAS void*)(wb + 8192 + 4096), 16, 0, 0);
  }
  asm volatile("s_waitcnt vmcnt(8)" ::: "memory");
  asm volatile("s_waitcnt lgkmcnt(0)" ::: "memory");
  __builtin_amdgcn_s_barrier();
  for (int tl = 0; tl < ntile; tl++) {
    if (tl + 3 < ntile) {
      const int tn = tl + 3;
      const int key0 = tn < 4 ? tn * 64 : 256 + (rs0 + tn - 4) * 64;
      LAS char* wb = wbase + (tn & 3) * 16384;
      __builtin_amdgcn_global_load_lds((const void*)(ksrc + (size_t)key0 * 1024), (LAS void*)(wb), 16, 0, 0);
      __builtin_amdgcn_global_load_lds((const void*)(ksrc + (size_t)(key0 + 32) * 1024), (LAS void*)(wb + 4096), 16, 0, 0);
      __builtin_amdgcn_global_load_lds((const void*)(vsrc + key0), (LAS void*)(wb + 8192), 16, 0, 0);
      __builtin_amdgcn_global_load_lds((const void*)(vsrc + (size_t)32 * 2304 + key0), (LAS void*)(wb + 8192 + 4096), 16, 0, 0);
    }
    const char* Kc = smem + (tl & 3) * 16384;
    const char* Vc = Kc + 8192;
    const bool local = tl >= 4;
    const int gr = rs0 + tl - 4;
    const int nh = local ? 1 : 2;
    for (int hh = 0; hh < nh; hh++) {
      const int koff = local ? bstart : hh * 32;
      f32x16 s0;
#pragma unroll
      for (int r = 0; r < 16; r++) s0[r] = 0.f;
      const int krow = koff + kap;
      const char* kp = Kc + krow * 128;
      const int swK = (krow >> 1) & 7;
#pragma unroll
      for (int s = 0; s < 4; s++) s0 = MFMA32(*(const bf16x8*)(kp + (((2 * s + lh) ^ swK) << 4)), qf[s], s0);
      if (local) {
        const bool rowvalid = (gr >= rsq) && (gr < rsq + 8);
        const int dr = rowvalid ? min(max(gr - qr + 7, 0), 14) : 15;
        const float* bp = bl + dr * 64 + ab;
#pragma unroll
        for (int i = 0; i < 16; i++) s0[i] += bp[16 * (i >> 3) + (i & 7)] + am[i];
      }
      float mx = s0[0];
#pragma unroll
      for (int r = 1; r < 16; r++) mx = fmaxf(mx, s0[r]);
      mx = fmaxf(mx, __shfl_xor(mx, 32));
      if (__any(mx > m + 8.f)) {
        const float mn = fmaxf(m, mx);
        const float alpha = __builtin_amdgcn_exp2f(m - mn);
        m = mn;
        l *= alpha;
#pragma unroll
        for (int d = 0; d < 2; d++)
#pragma unroll
          for (int r = 0; r < 16; r++) o[d][r] *= alpha;
      }
      float ps = 0.f;
#pragma unroll
      for (int r = 0; r < 16; r++) { s0[r] = __builtin_amdgcn_exp2f(s0[r] - m); ps += s0[r]; }
      l += ps;
      const char* vp = Vc + l31 * 128;
      const int vch = (koff >> 3) + lh;
#pragma unroll
      for (int sp = 0; sp < 2; sp++) {
        u32x4 pw;
        pw[0] = pk2(s0[8 * sp + 0], s0[8 * sp + 1]); pw[1] = pk2(s0[8 * sp + 2], s0[8 * sp + 3]);
        pw[2] = pk2(s0[8 * sp + 4], s0[8 * sp + 5]); pw[3] = pk2(s0[8 * sp + 6], s0[8 * sp + 7]);
        const bf16x8 pf = __builtin_bit_cast(bf16x8, pw);
        const int vo = ((vch + 2 * sp) ^ swV) << 4;
#pragma unroll
        for (int d = 0; d < 2; d++) o[d] = MFMA32(*(const bf16x8*)(vp + d * 32 * 128 + vo), pf, o[d]);
      }
    }
    if (tl + 3 < ntile) asm volatile("s_waitcnt vmcnt(8)" ::: "memory");
    else if (tl + 2 < ntile) asm volatile("s_waitcnt vmcnt(4)" ::: "memory");
    else asm volatile("s_waitcnt vmcnt(0)" ::: "memory");
    asm volatile("s_waitcnt lgkmcnt(0)" ::: "memory");
    __builtin_amdgcn_s_barrier();
  }
  l += __shfl_xor(l, 32);
  const float inv = 1.f / l;
  const u16* szrow = p.SZ + (size_t)t * 1024 + h * 64;
  u16* orow = p.NAO + (size_t)t * 1024 + h * 64;
#pragma unroll
  for (int d = 0; d < 2; d++)
#pragma unroll
    for (int g = 0; g < 4; g++) {
      const int d0 = d * 32 + 8 * g + 4 * lh;
      const uint2 z = *(const uint2*)(szrow + d0);
      uint2 v;
      v.x = pk2(o[d][4 * g] * inv * bf2f((u16)(z.x & 0xffff)), o[d][4 * g + 1] * inv * bf2f((u16)(z.x >> 16)));
      v.y = pk2(o[d][4 * g + 2] * inv * bf2f((u16)(z.y & 0xffff)), o[d][4 * g + 3] * inv * bf2f((u16)(z.y >> 16)));
      *(uint2*)(orow + d0) = v;
    }
}

DI void ph_prep(const Params& p, char* smem) {
  const int tid = threadIdx.x;
  const int ntr = p.nmat_tiles;
  const int ntot = ntr + 192 + 128;
  for (int tile = blockIdx.x; tile < ntot; tile += gridDim.x) {
    __syncthreads();
    if (tile >= 192 && tile < 320) {
      const int ct = tile - 192, j = ct >> 6, r0 = (ct & 63) * 16;
      const float* sp = p.pool_w_in + (size_t)j * 1024 * 2048 + (size_t)r0 * 2048 + tid * 4;
      u16* dp = p.WinU + (size_t)j * 1024 * 1024 + (size_t)r0 * 1024 + tid * 4;
#pragma unroll 4
      for (int r = 0; r < 16; r++) {
        const float4 v = ldnt4(sp + (size_t)r * 2048);
        uint2 w; w.x = pk2(v.x, v.y); w.y = pk2(v.z, v.w);
        *(uint2*)(dp + (size_t)r * 1024) = w;
      }
    } else if (tile >= 320) {
      const int ttile = tile - 320;
      int mi = 0;
      for (int i = 1; i < 18; i++) if (ttile >= p.mats[i].tile0) mi = i;
      const float* src = p.mats[mi].src; u16* dst = p.mats[mi].dst;
      const int K = p.mats[mi].K, Nsrc = p.mats[mi].Nsrc, Ndst = p.mats[mi].Ndst;
      const int ldsrc = p.mats[mi].ld;
      const int lt = ttile - p.mats[mi].tile0;
      const int ntn = Ndst >> 6;
      const int kt = lt / ntn, nt = lt - kt * ntn;
      float* ts = (float*)smem;
#pragma unroll
      for (int i = 0; i < 4; i++) {
        const int k = i * 16 + (tid >> 4), n4 = (tid & 15) * 4, n = nt * 64 + n4;
        float4 v = {0.f, 0.f, 0.f, 0.f};
        if (n < Nsrc) v = ldnt4(src + (size_t)(kt * 64 + k) * ldsrc + n);
        ts[k * 65 + n4] = v.x; ts[k * 65 + n4 + 1] = v.y; ts[k * 65 + n4 + 2] = v.z; ts[k * 65 + n4 + 3] = v.w;
      }
      __syncthreads();
      const int n = tid >> 2, kc = (tid & 3) * 16;
      uint32_t w[8];
#pragma unroll
      for (int e = 0; e < 8; e++) w[e] = pk2(ts[(kc + 2 * e) * 65 + n], ts[(kc + 2 * e + 1) * 65 + n]);
      u16* dp = dst + (size_t)(nt * 64 + n) * K + kt * 64 + kc;
      uint4 v0; v0.x = w[0]; v0.y = w[1]; v0.z = w[2]; v0.w = w[3];
      uint4 v1; v1.x = w[4]; v1.y = w[5]; v1.z = w[6]; v1.w = w[7];
      *(uint4*)dp = v0; *(uint4*)(dp + 8) = v1;
    } else {
      const int at = tile;
      const int layer = at / 48, c0 = (at - layer * 48) * 64;
      float* sc = (float*)smem;
      float* red = sc + 5 * 1024;
      for (int i = tid; i < 5 * 1024; i += 256) {
        const int n = i >> 10, k = i & 1023;
        const float v = (n == 0) ? p.c_ctx[k] : p.c[(n - 1) * 1024 + k];
        sc[i] = silu(v);
      }
      __syncthreads();
      const int c4 = (tid & 15) * 4, kg = tid >> 4;
      float acc[5][4];
#pragma unroll
      for (int n = 0; n < 5; n++) { acc[n][0] = 0.f; acc[n][1] = 0.f; acc[n][2] = 0.f; acc[n][3] = 0.f; }
      const float* w = p.ada_w + (size_t)layer * 1024 * 3072 + c0 + c4;
#pragma unroll 4
      for (int kk = 0; kk < 64; kk++) {
        const int k = kg * 64 + kk;
        const float4 wv = ldnt4(w + (size_t)k * 3072);
#pragma unroll
        for (int n = 0; n < 5; n++) {
          const float s = sc[n * 1024 + k];
          acc[n][0] += s * wv.x; acc[n][1] += s * wv.y; acc[n][2] += s * wv.z; acc[n][3] += s * wv.w;
        }
      }
#pragma unroll
      for (int n = 0; n < 5; n++) {
        float4 r; r.x = acc[n][0]; r.y = acc[n][1]; r.z = acc[n][2]; r.w = acc[n][3];
        *(float4*)(red + (kg * 5 + n) * 64 + c4) = r;
      }
      __syncthreads();
      for (int o = tid; o < 320; o += 256) {
        const int n = o >> 6, cc = o & 63;
        float s = 0.f;
#pragma unroll
        for (int g = 0; g < 16; g++) s += red[(g * 5 + n) * 64 + cc];
        s += p.ada_b[layer * 3072 + c0 + cc];
        p.mod[(layer * 5 + n) * 3072 + c0 + cc] = s;
      }
    }
  }
}

DI void ph_h0(const Params& p) {
  for (int idx = blockIdx.x * 256 + threadIdx.x; idx < T * 128; idx += gridDim.x * 256) {
    const int t = idx >> 7, c0 = (idx & 127) * 8;
    const float* xr = (t < TC) ? p.x_prompt + (size_t)t * 1024 : p.x_sample + (size_t)(t - TC) * 1024;
    const float* md = p.mod + cond_of(t) * 3072;
    const float4 x0 = *(const float4*)(xr + c0), x1 = *(const float4*)(xr + c0 + 4);
    const float4 sh0 = *(const float4*)(md + c0), sh1 = *(const float4*)(md + c0 + 4);
    const float4 sc0 = *(const float4*)(md + 1024 + c0), sc1 = *(const float4*)(md + 1024 + c0 + 4);
    uint4 v;
    v.x = pk2(x0.x * (1.f + sc0.x) + sh0.x, x0.y * (1.f + sc0.y) + sh0.y);
    v.y = pk2(x0.z * (1.f + sc0.z) + sh0.z, x0.w * (1.f + sc0.w) + sh0.w);
    v.z = pk2(x1.x * (1.f + sc1.x) + sh1.x, x1.y * (1.f + sc1.y) + sh1.y);
    v.w = pk2(x1.z * (1.f + sc1.z) + sh1.z, x1.w * (1.f + sc1.w) + sh1.w);
    *(uint4*)(p.H + (size_t)t * 1024 + c0) = v;
  }
}

struct EpiFold {
  u16* dst;
  DI void operator()(int m, int nb, int lh, const f32x16& a) const {
#pragma unroll
    for (int g = 0; g < 4; g++) {
      uint2 v; v.x = pk2(a[4 * g], a[4 * g + 1]); v.y = pk2(a[4 * g + 2], a[4 * g + 3]);
      *(uint2*)(dst + (size_t)m * 1024 + nb + 8 * g + 4 * lh) = v;
    }
  }
};
DI void ph_fold(const Params& p, char* smem) {
  for (int tile = blockIdx.x; tile < 128; tile += gridDim.x) {
    const int jg = tile >> 4, mt = (tile >> 3) & 1, nt = tile & 7;
    const int j = jg >> 2, g = jg & 3;
    EpiFold e{p.Wpin + (size_t)j * 2048 * 1024 + (size_t)(g * 256) * 1024};
    gemm_tile<2>(p.Wgrp + (size_t)jg * 65536, 256, p.WinU + (size_t)j * 1024 * 1024 + g * 256, 1024, 256, mt * 128, nt * 128, 0, smem, e);
  }
}

template <class Epi>
DI void gemm_phase(const u16* A, int lda, const u16* Bt, int ldb, int K, int MT, int NT, char* smem, const Epi& epi) {
  const int ntile = MT * NT;
  for (int tile = blockIdx.x; tile < ntile; tile += gridDim.x) {
    const int nt = tile / MT, mt = tile - nt * MT;
    gemm_tile<3>(A, lda, Bt, ldb, K, mt * 192, nt * 128, 0, smem, epi);
  }
}

template <class Epi>
DI void gemm_phase_st(const u16* A, int lda, const u16* Bt, int ldb, int K, int MT, int NT, char* smem, const Epi& epi) {
  const int ntile = MT * NT;
  for (int tile = blockIdx.x; tile < ntile; tile += gridDim.x) {
    const int nt = tile / MT, mt = tile - nt * MT;
    gemm_tile<3, Epi, true>(A, lda, Bt, ldb, K, mt * 192, nt * 128, 0, smem, epi);
  }
}

DI void unpack8(const u32x4& u, float* f) {
  f[0] = __uint_as_float(u[0] << 16); f[1] = __uint_as_float(u[0] & 0xffff0000u);
  f[2] = __uint_as_float(u[1] << 16); f[3] = __uint_as_float(u[1] & 0xffff0000u);
  f[4] = __uint_as_float(u[2] << 16); f[5] = __uint_as_float(u[2] & 0xffff0000u);
  f[6] = __uint_as_float(u[3] << 16); f[7] = __uint_as_float(u[3] & 0xffff0000u);
}
template <int HW>
DI void mix_item(const Params& p, int rpair, const float* scale) {
  const int lane = threadIdx.x & 63;
  constexpr int g = (HW == 1) ? 0 : (HW == 2) ? 1 : (HW == 4) ? 2 : 3;
  constexpr int NR = 8 + 2 * HW;
  const int c0 = (g * 32 + (lane & 31)) * 8;
  const int t0 = (rpair * 2 + (lane >> 5)) * 8;
  int s0, L, tt0;
  if (t0 < TC) { s0 = t0 & ~255; tt0 = t0 & 255; L = 256; } else { s0 = TC + ((t0 - TC) & ~2047); tt0 = (t0 - TC) & 2047; L = 2048; }
  u32x4 rows[NR];
#pragma unroll
  for (int r = 0; r < NR; r++) {
    const int tt = tt0 - HW + r;
    u32x4 v = {0u, 0u, 0u, 0u};
    if (tt >= 0 && tt < L) v = *(const u32x4*)(p.U + (size_t)(s0 + tt) * 1024 + c0);
    rows[r] = v;
  }
  float sc8[8];
  { const float4 a = *(const float4*)(scale + c0), b = *(const float4*)(scale + c0 + 4); sc8[0] = a.x; sc8[1] = a.y; sc8[2] = a.z; sc8[3] = a.w; sc8[4] = b.x; sc8[5] = b.y; sc8[6] = b.z; sc8[7] = b.w; }
  float sum[8];
#pragma unroll
  for (int k = 0; k < 8; k++) sum[k] = 0.f;
#pragma unroll
  for (int r = 0; r < 2 * HW; r++) {
    float f[8]; unpack8(rows[r], f);
#pragma unroll
    for (int k = 0; k < 8; k++) sum[k] += f[k];
  }
#pragma unroll
  for (int e = 0; e < 8; e++) {
    const int tt = tt0 + e;
    const int lo = max(tt - HW, 0), hi = min(tt + HW, L);
    const float ic = 1.f / (float)(hi - lo);
    float own[8]; unpack8(rows[e + HW], own);
    float zz[8]; unpack8(*(const u32x4*)(p.SZ + (size_t)(s0 + tt) * 1024 + c0), zz);
    u32x4 v;
    v[0] = pk2((sum[0] * ic - own[0]) * sc8[0] * zz[0], (sum[1] * ic - own[1]) * sc8[1] * zz[1]);
    v[1] = pk2((sum[2] * ic - own[2]) * sc8[2] * zz[2], (sum[3] * ic - own[3]) * sc8[3] * zz[3]);
    v[2] = pk2((sum[4] * ic - own[4]) * sc8[4] * zz[4], (sum[5] * ic - own[5]) * sc8[5] * zz[5]);
    v[3] = pk2((sum[6] * ic - own[6]) * sc8[6] * zz[6], (sum[7] * ic - own[7]) * sc8[7] * zz[7]);
    *(u32x4*)(p.PM + (size_t)(s0 + tt) * 1024 + c0) = v;
    if (e < 7) {
      float fo[8], fi[8]; unpack8(rows[e], fo); unpack8(rows[e + 2 * HW], fi);
#pragma unroll
      for (int k = 0; k < 8; k++) sum[k] += fi[k] - fo[k];
    }
  }
}
DI void ph_mix(const Params& p, int j) {
  const int wid = threadIdx.x >> 6;
  const float* scale = p.pool_scale + j * 1024;
  for (int item = blockIdx.x * 4 + wid; item < 768 * 4; item += gridDim.x * 4) {
    const int rpair = item >> 2, g = item & 3;
    if (g == 0) mix_item<1>(p, rpair, scale);
    else if (g == 1) mix_item<2>(p, rpair, scale);
    else if (g == 2) mix_item<4>(p, rpair, scale);
    else mix_item<8>(p, rpair, scale);
  }
}

DI void ph_pool_g2(const Params& p, int j, char* smem) {
  EpiPoolG2 epi{p.PM, p.SZ, p.pool_scale + j * 1024};
  for (int tile = blockIdx.x; tile < 64 * 8; tile += gridDim.x) {
    const int gn = tile / 64, mt = tile - gn * 64;
    const int g = gn >> 1, ns = gn & 1;
    gemm_tile<3>(p.MIX + g * 256, 1024, p.Wgrp + (size_t)(j * 4 + g) * 65536, 256, 256, mt * 192, ns * 128, g * 256, smem, epi);
  }
}

DI void ph_ln(const Params& p, int layer) {
  const int lane = threadIdx.x & 63, wid = threadIdx.x >> 6;
  const float* g = p.ln_g + layer * 1024;
  const float* bb = p.ln_b + layer * 1024;
  const int nw = gridDim.x * 4;
  for (int row0 = blockIdx.x * 4 + wid; row0 < T; row0 += 2 * nw) {
    const int row1 = row0 + nw;
    const bool has1 = row1 < T;
    const int r1 = has1 ? row1 : row0;
    float* xr0 = p.out + (size_t)row0 * 1024;
    float* xr1 = p.out + (size_t)r1 * 1024;
    const float* xi0 = (row0 < TC) ? p.x_prompt + (size_t)row0 * 1024 : p.x_sample + (size_t)(row0 - TC) * 1024;
    const float* xi1 = (r1 < TC) ? p.x_prompt + (size_t)r1 * 1024 : p.x_sample + (size_t)(r1 - TC) * 1024;
    float4 v0[4], v1[4];
#pragma unroll
    for (int i = 0; i < 4; i++) {
      if (layer == 0) { v0[i] = ldnt4(xi0 + i * 256 + lane * 4); v1[i] = ldnt4(xi1 + i * 256 + lane * 4); }
      else {
        const uint2 b0 = *(const uint2*)(p.XB + (size_t)row0 * 1024 + i * 256 + lane * 4);
        const uint2 b1 = *(const uint2*)(p.XB + (size_t)r1 * 1024 + i * 256 + lane * 4);
        v0[i].x = bf2f((u16)(b0.x & 0xffff)); v0[i].y = bf2f((u16)(b0.x >> 16)); v0[i].z = bf2f((u16)(b0.y & 0xffff)); v0[i].w = bf2f((u16)(b0.y >> 16));
        v1[i].x = bf2f((u16)(b1.x & 0xffff)); v1[i].y = bf2f((u16)(b1.x >> 16)); v1[i].z = bf2f((u16)(b1.y & 0xffff)); v1[i].w = bf2f((u16)(b1.y >> 16));
      }
      const uint2 g0 = ldnt2u(p.GO + (size_t)row0 * 1024 + i * 256 + lane * 4);
      const uint2 g1 = ldnt2u(p.GO + (size_t)r1 * 1024 + i * 256 + lane * 4);
      v0[i].x = ALPHA * v0[i].x + bf2f((u16)(g0.x & 0xffff)); v0[i].y = ALPHA * v0[i].y + bf2f((u16)(g0.x >> 16));
      v0[i].z = ALPHA * v0[i].z + bf2f((u16)(g0.y & 0xffff)); v0[i].w = ALPHA * v0[i].w + bf2f((u16)(g0.y >> 16));
      v1[i].x = ALPHA * v1[i].x + bf2f((u16)(g1.x & 0xffff)); v1[i].y = ALPHA * v1[i].y + bf2f((u16)(g1.x >> 16));
      v1[i].z = ALPHA * v1[i].z + bf2f((u16)(g1.y & 0xffff)); v1[i].w = ALPHA * v1[i].w + bf2f((u16)(g1.y >> 16));
    }
    float s0 = 0.f, s1 = 0.f;
#pragma unroll
    for (int i = 0; i < 4; i++) { s0 += v0[i].x + v0[i].y + v0[i].z + v0[i].w; s1 += v1[i].x + v1[i].y + v1[i].z + v1[i].w; }
    const float mu0 = wave_sum(s0) * (1.f / 1024.f), mu1 = wave_sum(s1) * (1.f / 1024.f);
    float q0 = 0.f, q1 = 0.f;
#pragma unroll
    for (int i = 0; i < 4; i++) {
      v0[i].x -= mu0; v0[i].y -= mu0; v0[i].z -= mu0; v0[i].w -= mu0;
      v1[i].x -= mu1; v1[i].y -= mu1; v1[i].z -= mu1; v1[i].w -= mu1;
      q0 += v0[i].x * v0[i].x + v0[i].y * v0[i].y + v0[i].z * v0[i].z + v0[i].w * v0[i].w;
      q1 += v1[i].x * v1[i].x + v1[i].y * v1[i].y + v1[i].z * v1[i].z + v1[i].w * v1[i].w;
    }
    const float rs0 = rsqrtf(wave_sum(q0) * (1.f / 1024.f) + 1e-5f);
    const float rs1 = rsqrtf(wave_sum(q1) * (1.f / 1024.f) + 1e-5f);
    const float* md0 = p.mod + ((layer + 1) * 5 + cond_of(row0)) * 3072;
    const float* md1 = p.mod + ((layer + 1) * 5 + cond_of(has1 ? row1 : row0)) * 3072;
#pragma unroll
    for (int i = 0; i < 4; i++) {
      const int cc = i * 256 + lane * 4;
      const float4 gg = *(const float4*)(g + cc), be = *(const float4*)(bb + cc);
      float4 y0, y1;
      y0.x = v0[i].x * rs0 * gg.x + be.x; y0.y = v0[i].y * rs0 * gg.y + be.y; y0.z = v0[i].z * rs0 * gg.z + be.z; y0.w = v0[i].w * rs0 * gg.w + be.w;
      y1.x = v1[i].x * rs1 * gg.x + be.x; y1.y = v1[i].y * rs1 * gg.y + be.y; y1.z = v1[i].z * rs1 * gg.z + be.z; y1.w = v1[i].w * rs1 * gg.w + be.w;
      if (layer == 3) { stnt4(xr0 + cc, y0); if (has1) stnt4(xr1 + cc, y1); }
      else {
        uint2 q0, q1;
        q0.x = pk2(y0.x, y0.y); q0.y = pk2(y0.z, y0.w); q1.x = pk2(y1.x, y1.y); q1.y = pk2(y1.z, y1.w);
        stnt2u(p.XB + (size_t)row0 * 1024 + cc, q0);
        if (has1) stnt2u(p.XB + (size_t)row1 * 1024 + cc, q1);
      }
      if (layer < 3) {
        const float4 sh0 = *(const float4*)(md0 + cc), sc0 = *(const float4*)(md0 + 1024 + cc);
        const float4 sh1 = *(const float4*)(md1 + cc), sc1 = *(const float4*)(md1 + 1024 + cc);
        uint2 h0, h1;
        h0.x = pk2(y0.x * (1.f + sc0.x) + sh0.x, y0.y * (1.f + sc0.y) + sh0.y);
        h0.y = pk2(y0.z * (1.f + sc0.z) + sh0.z, y0.w * (1.f + sc0.w) + sh0.w);
        h1.x = pk2(y1.x * (1.f + sc1.x) + sh1.x, y1.y * (1.f + sc1.y) + sh1.y);
        h1.y = pk2(y1.z * (1.f + sc1.z) + sh1.z, y1.w * (1.f + sc1.w) + sh1.w);
        *(uint2*)(p.H + (size_t)row0 * 1024 + cc) = h0;
        if (has1) *(uint2*)(p.H + (size_t)row1 * 1024 + cc) = h1;
      }
    }
  }
}

DI void ph_mla_norm(const Params& p) {
  const int lane = threadIdx.x & 63, wid = threadIdx.x >> 6;
  for (int row = blockIdx.x * 4 + wid; row < T + 1024; row += gridDim.x * 4) {
    if (row < T) {
      const float* rr = p.RAW + (size_t)row * 768;
      const float4 a0 = ldnt4(rr + lane * 8), a1 = ldnt4(rr + lane * 8 + 4);
      const float4 k0 = ldnt4(rr + 512 + lane * 4);
      float s1 = a0.x * a0.x + a0.y * a0.y + a0.z * a0.z + a0.w * a0.w + a1.x * a1.x + a1.y * a1.y + a1.z * a1.z + a1.w * a1.w;
      float s2 = k0.x * k0.x + k0.y * k0.y + k0.z * k0.z + k0.w * k0.w;
      const float r1 = rsqrtf(wave_sum(s1) * (1.f / 512.f) + 1e-6f);
      const float r2 = rsqrtf(wave_sum(s2) * (1.f / 256.f) + 1e-6f);
      const float4 g0 = *(const float4*)(p.mla_q_norm + lane * 8), g1 = *(const float4*)(p.mla_q_norm + lane * 8 + 4);
      uint4 v;
      v.x = pk2(a0.x * r1 * g0.x, a0.y * r1 * g0.y); v.y = pk2(a0.z * r1 * g0.z, a0.w * r1 * g0.w);
      v.z = pk2(a1.x * r1 * g1.x, a1.y * r1 * g1.y); v.w = pk2(a1.z * r1 * g1.z, a1.w * r1 * g1.w);
      *(uint4*)(p.CQN + (size_t)row * 512 + lane * 8) = v;
      const float4 kg = *(const float4*)(p.mla_kv_norm + lane * 4);
      float4 kn; kn.x = k0.x * r2 * kg.x; kn.y = k0.y * r2 * kg.y; kn.z = k0.z * r2 * kg.z; kn.w = k0.w * r2 * kg.w;
      uint2 kv; kv.x = pk2(kn.x, kn.y); kv.y = pk2(kn.z, kn.w);
      *(uint2*)(p.CKVN + (size_t)kvrow_of(row) * 256 + lane * 4) = kv;
      if (row < TC) stnt4(p.out + OUT_CKV + (size_t)row * 256 + lane * 4, kn);
    } else {
      const int cr = row - T, b = cr >> 8, pp = cr & 255;
      const size_t kvr = (size_t)TC + b * 2304 + pp;
      const float4 k0 = ldnt4(p.cache_ckv + (size_t)cr * 256 + lane * 4);
      uint2 kv; kv.x = pk2(k0.x, k0.y); kv.y = pk2(k0.z, k0.w);
      *(uint2*)(p.CKVN + kvr * 256 + lane * 4) = kv;
      p.KR[kvr * 64 + lane] = f2bf(p.cache_kr[(size_t)cr * 64 + lane]);
    }
  }
}

DI void ph_mla_g2(const Params& p, char* smem) {
  EpiMlaQ eq{p.Q};
  EpiMlaKV ekv{p.KN, p.VT};
  const int G = gridDim.x, b = blockIdx.x;
  const int nq = 64 * 12, nkv = 104 * 16;
  const int nq2 = nq - G > 0 ? nq - G : 0;
  for (int qt = b; qt < nq; qt += G) {
    const int nt = qt / 64, mt = qt - nt * 64;
    gemm_tile<3>(p.CQN, 512, p.Wuq, 512, 512, mt * 192, nt * 128, 0, smem, eq);
  }
  int k0, kstep, kend;
  if (b < nq2) { k0 = b; kstep = nq2; kend = 2 * nq2; }
  else { k0 = 2 * nq2 + (b - nq2); kstep = G - nq2; kend = nkv; }
  if (G != 512) { k0 = b; kstep = G; kend = nkv; }
  for (int kt = k0; kt < kend; kt += kstep) {
    const int nt = kt / 104, mt = kt - nt * 104;
    gemm_tile<2, EpiMlaKV, true>(p.CKVN, 256, p.Wukv, 256, 256, mt * 128, nt * 128, 0, smem, ekv);
  }
}

DI void ph_mla_attn(const Params& p, char* smem) {
  const int wid = threadIdx.x >> 6, l31 = threadIdx.x & 31;
  for (int u = blockIdx.x; u < 768; u += gridDim.x) {
    int t0, kvrow0, nkeys, Lk, h; size_t vbase;
    if (u < 512) {
      const int xcd = u & 7, slot = u >> 3; const int pair = xcd * 4 + (slot >> 4); const int qb = slot & 15;
      const int b = pair >> 3; h = pair & 7;
      t0 = TC + b * 2048 + qb * 128 + wid * 32; kvrow0 = TC + b * 2304; nkeys = 2304; Lk = 2304;
      vbase = (size_t)16 * 8 * 128 * 256 + (size_t)b * (8 * 128 * 2304) + (size_t)h * 128 * 2304;
    } else {
      const int v = u - 512; const int b = v >> 4; h = (v >> 1) & 7; const int qb = v & 1;
      t0 = b * 256 + qb * 128 + wid * 32; kvrow0 = b * 256; nkeys = 256; Lk = 256;
      vbase = (size_t)b * (8 * 128 * 256) + (size_t)h * 128 * 256;
    }
    const int t = t0 + l31;
    attn_dense_block<8, 4, 4>(smem, p.Q + (size_t)t * 1536 + h * 192, p.KN + (size_t)kvrow0 * 1024 + h * 128, 1024,
                             p.KR + (size_t)kvrow0 * 64, p.VT + vbase, Lk, nkeys,
                             p.SZ + (size_t)t * 1024 + h * 128, p.AO + (size_t)t * 1024 + h * 128);
  }
}

DI void ph_na_g1(const Params& p, char* smem) {
  EpiNaG1 epi{p.NQ, p.NK, p.NVT, p.SZ, p.out + OUT_NAK, p.out + OUT_NAV};
  const int n1 = 64 * 32;
  for (int tile = blockIdx.x; tile < n1 + 64; tile += gridDim.x) {
    if (tile < n1) {
      const int nt = tile / 64, mt = tile - nt * 64;
      gemm_tile<3, EpiNaG1, true>(p.H, 1024, p.Wnin, 1024, 1024, mt * 192, nt * 128, 0, smem, epi);
    } else {
      const int ct = tile - n1;
      const int b = ct >> 4, p0 = (ct & 15) * 16;
      const int c4 = threadIdx.x * 4;
      const size_t kvb = (size_t)TC + b * 2304;
      u16* vtb = p.NVT + (size_t)16 * 1024 * 256 + (size_t)b * (1024 * 2304);
      float vv[4][16];
#pragma unroll
      for (int i = 0; i < 16; i++) {
        const size_t src = ((size_t)(b * 256 + p0 + i)) * 1024 + c4;
        const float4 k = ldnt4(p.cache_nak + src);
        uint2 kv; kv.x = pk2(k.x, k.y); kv.y = pk2(k.z, k.w);
        *(uint2*)(p.NK + (kvb + p0 + i) * 1024 + c4) = kv;
        const float4 v = ldnt4(p.cache_nav + src);
        vv[0][i] = v.x; vv[1][i] = v.y; vv[2][i] = v.z; vv[3][i] = v.w;
      }
#pragma unroll
      for (int e = 0; e < 4; e++) {
        uint4 w0, w1;
        w0.x = pk2(vv[e][0], vv[e][1]); w0.y = pk2(vv[e][2], vv[e][3]); w0.z = pk2(vv[e][4], vv[e][5]); w0.w = pk2(vv[e][6], vv[e][7]);
        w1.x = pk2(vv[e][8], vv[e][9]); w1.y = pk2(vv[e][10], vv[e][11]); w1.z = pk2(vv[e][12], vv[e][13]); w1.w = pk2(vv[e][14], vv[e][15]);
        u16* dp = vtb + (size_t)(c4 + e) * 2304 + p0;
        *(uint4*)dp = w0; *(uint4*)(dp + 8) = w1;
      }
    }
  }
}

DI void ph_na_attn(const Params& p, char* smem) {
  const int wid = threadIdx.x >> 6, l31 = threadIdx.x & 31;
  for (int u = blockIdx.x; u < 1024 + 512; u += gridDim.x) {
    if (u < 1024) {
      const int xcd = u & 7, slot = u >> 3;
      const int pair = xcd * 8 + (slot >> 4), rpair = slot & 15;
      attn_na_block(p, smem, pair >> 4, pair & 15, rpair);
    } else {
      const int v = u - 1024;
      const int b = v >> 5, h = (v >> 1) & 15, qb = v & 1;
      const int t = b * 256 + qb * 128 + wid * 32 + l31;
      attn_dense_block<4, 0, 2>(smem, p.NQ + (size_t)t * 1024 + h * 64, p.NK + (size_t)(b * 256) * 1024 + h * 64, 1024, nullptr,
                               p.NVT + (size_t)b * (1024 * 256) + (size_t)h * 64 * 256, 256, 256,
                               p.SZ + (size_t)t * 1024 + h * 64, p.NAO + (size_t)t * 1024 + h * 64);
    }
  }
}

template <int ph>
DI void run_phase(const Params& p, char* smem) {
  if constexpr (ph == 0) ph_prep(p, smem);
  else if constexpr (ph == 1) { ph_h0(p); ph_fold(p, smem); }
  else if constexpr (ph == 2 || ph == 17) {
    constexpr int j = (ph == 2) ? 0 : 1;
    EpiPoolG1 e{p.U, p.SZ};
    gemm_phase(p.H, 1024, p.Wpin + (size_t)j * 2048 * 1024, 1024, 1024, 64, 16, smem, e);
  }
  else if constexpr (ph == 3 || ph == 18) ph_mix(p, (ph == 3) ? 0 : 1);
  else if constexpr (ph == 5) {
    EpiG3 e{p.GO, p.mod};
    gemm_phase_st(p.PM, 1024, p.Wpout, 1024, 1024, 64, 8, smem, e);
  }
  else if constexpr (ph == 20) {
    EpiG3 e{p.GO, p.mod + 3 * 5 * 3072};
    gemm_phase_st(p.PM, 1024, p.Wpout + (size_t)1024 * 1024, 1024, 1024, 64, 8, smem, e);
  }
  else if constexpr (ph == 6) ph_ln(p, 0);
  else if constexpr (ph == 21) ph_ln(p, 3);
  else if constexpr (ph == 7) {
    EpiMlaG1 e{p.RAW, p.KR, p.SZ, p.out + OUT_KR};
    gemm_phase(p.H, 1024, p.Wmin, 1024, 1024, 64, 15, smem, e);
  }
  else if constexpr (ph == 8) ph_mla_norm(p);
  else if constexpr (ph == 9) ph_mla_g2(p, smem);
  else if constexpr (ph == 10) ph_mla_attn(p, smem);
  else if constexpr (ph == 11) {
    EpiG3 e{p.GO, p.mod + 1 * 5 * 3072};
    gemm_phase_st(p.AO, 1024, p.Wmout, 1024, 1024, 64, 8, smem, e);
  }
  else if constexpr (ph == 12) ph_ln(p, 1);
  else if constexpr (ph == 13) ph_na_g1(p, smem);
  else if constexpr (ph == 14) ph_na_attn(p, smem);
  else if constexpr (ph == 15) {
    EpiG3 e{p.GO, p.mod + 2 * 5 * 3072};
    gemm_phase_st(p.NAO, 1024, p.Wnout, 1024, 1024, 64, 8, smem, e);
  }
  else if constexpr (ph == 16) ph_ln(p, 2);
}

#define RUN_PH(n) if (ph_lo <= (n) && (n) < ph_hi) { run_phase<n>(p, smem); if ((n) + 1 < ph_hi) xcd_barrier(xb); }

__global__ void __launch_bounds__(256, 2) mega(Params p, int ph_lo, int ph_hi) {
  __shared__ __attribute__((aligned(16))) char smem[SMEM_BYTES];
  if (ph_lo < 0) { cg::this_grid().sync(); return; }
  const bool multi = (ph_hi - ph_lo) > 1;
  XcdBarrier xb; xb.bar = p.bar; xb.x = 0; xb.nloc = 0u; xb.nx = 0u;
  if (multi) xb = xcd_barrier_post(p.bar);
  RUN_PH(0) RUN_PH(1) RUN_PH(2) RUN_PH(3) RUN_PH(5) RUN_PH(6) RUN_PH(7) RUN_PH(8) RUN_PH(9) RUN_PH(10)
  RUN_PH(11) RUN_PH(12) RUN_PH(13) RUN_PH(14) RUN_PH(15) RUN_PH(16) RUN_PH(17) RUN_PH(18) RUN_PH(20) RUN_PH(21)
}

extern "C" void kernel_launch(void* const* d_in, const int* in_sizes, int n_in, void* d_out, int out_size, void* d_ws, size_t ws_size,
                              hipStream_t stream) {
  Params p;
  memset(&p, 0, sizeof(p));
  const float* const* in = (const float* const*)d_in;
  p.x_prompt = in[0]; p.x_sample = in[1]; p.cache_ckv = in[2]; p.cache_kr = in[3]; p.cache_nak = in[4]; p.cache_nav = in[5];
  p.c = in[6]; p.c_ctx = in[7]; p.ada_w = in[8]; p.ada_b = in[9]; p.ln_g = in[10]; p.ln_b = in[11];
  const float* pool_w_in = in[12]; const float* pool_w_grp = in[13]; p.pool_scale = in[14]; const float* pool_w_out = in[15];
  const float* mla_w_in = in[16]; p.mla_q_norm = in[17]; const float* mla_w_uq = in[18]; p.mla_kv_norm = in[19];
  const float* mla_w_ukv = in[20]; const float* mla_w_out = in[21]; const float* na_w_in = in[22]; p.na_rpb = in[23];
  const float* na_w_out = in[24];
  p.out = (float*)d_out;

  char* ws = (char*)d_ws;
  size_t off = 0;
  auto take = [&](size_t bytes) { char* r = ws + off; off += (bytes + 255) & ~(size_t)255; return r; };
  p.bar = (unsigned*)take(XCD_BAR_WORDS * 4);
  p.mod = (float*)take((size_t)4 * 5 * 3072 * 4);
  p.Wpin = (u16*)take((size_t)2 * 2048 * 1024 * 2);
  p.Wgrp = (u16*)take((size_t)8 * 65536 * 2);
  p.Wpout = (u16*)take((size_t)2 * 1024 * 1024 * 2);
  p.Wmin = (u16*)take((size_t)1920 * 1024 * 2);
  p.Wuq = (u16*)take((size_t)1536 * 512 * 2);
  p.Wukv = (u16*)take((size_t)2048 * 256 * 2);
  p.Wmout = (u16*)take((size_t)1024 * 1024 * 2);
  p.Wnin = (u16*)take((size_t)4096 * 1024 * 2);
  p.Wnout = (u16*)take((size_t)1024 * 1024 * 2);
  p.H = (u16*)take((size_t)T * 1024 * 2);
  p.SZ = (u16*)take((size_t)T * 1024 * 2);
  p.XB = (u16*)take((size_t)T * 1024 * 2);
  p.WinU = (u16*)take((size_t)2 * 1024 * 1024 * 2);
  p.pool_w_in = pool_w_in;
  const size_t arena0 = off;
  p.U = (u16*)take((size_t)T * 1024 * 2);
  p.MIX = (u16*)take((size_t)T * 1024 * 2);
  p.GO = p.MIX;
  p.PM = (u16*)take((size_t)T * 1024 * 2);
  off = arena0;
  p.RAW = (float*)take((size_t)T * 768 * 4);
  p.AO = (u16*)p.RAW;
  p.CQN = (u16*)take((size_t)T * 512 * 2);
  p.CKVN = (u16*)take((size_t)KVR * 256 * 2);
  p.KR = (u16*)take((size_t)KVR * 64 * 2);
  p.Q = (u16*)take((size_t)T * 1536 * 2);
  p.KN = (u16*)take((size_t)KVR * 1024 * 2);
  p.VT = (u16*)take((size_t)KVR * 1024 * 2);
  off = arena0;
  p.NQ = (u16*)take((size_t)T * 1024 * 2);
  p.NK = (u16*)take((size_t)KVR * 1024 * 2);
  p.NVT = (u16*)take((size_t)KVR * 1024 * 2);
  p.NAO = (u16*)take((size_t)T * 1024 * 2);

  int nm = 0, tiles = 0;
  auto add = [&](const float* src, u16* dst, int K, int Nsrc, int Ndst, int ld = 0) {
    p.mats[nm].src = src; p.mats[nm].dst = dst; p.mats[nm].K = K; p.mats[nm].Nsrc = Nsrc; p.mats[nm].Ndst = Ndst; p.mats[nm].tile0 = tiles; p.mats[nm].ld = ld ? ld : Nsrc;
    tiles += (K / 64) * (Ndst / 64); nm++;
  };
  for (int j = 0; j < 2; j++) add(pool_w_in + (size_t)j * 1024 * 2048 + 1024, p.Wpin + (size_t)j * 2048 * 1024 + (size_t)1024 * 1024, 1024, 1024, 1024, 2048);
  for (int j = 0; j < 8; j++) add(pool_w_grp + (size_t)j * 65536, p.Wgrp + (size_t)j * 65536, 256, 256, 256);
  for (int j = 0; j < 2; j++) add(pool_w_out + (size_t)j * 1024 * 1024, p.Wpout + (size_t)j * 1024 * 1024, 1024, 1024, 1024);
  add(mla_w_in, p.Wmin, 1024, 1856, 1920);
  add(mla_w_uq, p.Wuq, 512, 1536, 1536);
  add(mla_w_ukv, p.Wukv, 256, 2048, 2048);
  add(mla_w_out, p.Wmout, 1024, 1024, 1024);
  add(na_w_in, p.Wnin, 1024, 4096, 4096);
  add(na_w_out, p.Wnout, 1024, 1024, 1024);
  p.nmat_tiles = tiles;

  (void)hipMemsetAsync(p.bar, 0, XCD_BAR_WORDS * 4, stream);
#if MULTI_LAUNCH
  for (int ph = 0; ph < NPHASE; ph++) hipLaunchKernelGGL(mega, dim3(512), dim3(256), 0, stream, p, ph, ph + 1);
#else
  static int grid_blocks = 0;
  if (!grid_blocks) {
    int dev = 0, cus = 0, per_cu = 0;
    hipGetDevice(&dev);
    hipDeviceGetAttribute(&cus, hipDeviceAttributeMultiprocessorCount, dev);
    hipOccupancyMaxActiveBlocksPerMultiprocessor(&per_cu, mega, 256, 0);
    if (per_cu > 2) per_cu = 2;
    if (per_cu < 1) per_cu = 1;
    grid_blocks = cus * per_cu;
  }
  int lo = 0, hi = NPHASE;
  void* args[] = {&p, &lo, &hi};
  hipError_t e = hipLaunchCooperativeKernel((void*)mega, dim3(grid_blocks), dim3(256), args, 0, stream);
  if (e != hipSuccess) fprintf(stderr, "cooperative launch failed: %s (grid %d)\n", hipGetErrorString(e), grid_blocks);
#endif
}
```
